# Optimizing an MI355X kernel written in HIP

```python
import math
import jax, jax.numpy as jnp
from jax import lax
import numpy as np

D_MODEL = 1024
BATCH = 8
SEQ = 4096
DEPTH = 2

HEAD_DIM = 64
NUM_BUCKETS = 32
MAX_DISTANCE = 128
N_BIAS_HEADS = 16
A_HEADS = 8
A_KV = 2
A_WINDOW = 128
B_HEADS = 8
B_KV = 2
CMP_BLOCK = 32
CMP_STRIDE = 16
CMP_HIDDEN = 256
SLC_BLOCK = 64
SLC_TOPN = 16
B_WINDOW = 512
C_HEADS = 16
IDX_HEADS = 8
IDX_DIM = 32
C_TOPK_MAX = 256
D_FF = 2816
N_EXPERTS = 8
TOP_K = 2
Q_BLOCK = 128
SLC_Q_CHUNK = 64
ALPHA = (2.0 * DEPTH) ** 0.25
BETA = (8.0 * DEPTH) ** -0.25
LN_EPS = 1e-5
NEG = -1e30
POS_BIG = 1e30

A_Q = A_HEADS * HEAD_DIM
A_KVW = A_KV * HEAD_DIM
B_Q = B_HEADS * HEAD_DIM
B_KVW = B_KV * HEAD_DIM
W_IN0_SIZES = [A_Q, A_KVW, A_KVW, B_Q, 6 * B_KVW, 3 * B_HEADS]
W_IN0_COLS = sum(W_IN0_SIZES)
W_IN1_SIZES = [C_HEADS * HEAD_DIM, HEAD_DIM, HEAD_DIM, IDX_HEADS * IDX_DIM, IDX_DIM, IDX_HEADS]
W_IN1_COLS = sum(W_IN1_SIZES)
CMP_IN = CMP_BLOCK * HEAD_DIM

kernel_name = 'hybrid_swa_nsa_dsa_deepnorm'

f32 = jnp.float32


def _split_cols(x, sizes):
    return jnp.split(x, np.cumsum(sizes)[:-1].tolist(), axis=-1)


def layer_norm(x, g, b):
    xf = x.astype(f32)
    mu = xf.mean(-1, keepdims=True)
    var = jnp.square(xf - mu).mean(-1, keepdims=True)
    return ((xf - mu) * lax.rsqrt(var + LN_EPS) * g + b).astype(x.dtype)


def t5_bucket(dist):
    n = jnp.maximum(dist, 0)
    max_exact = NUM_BUCKETS // 2
    nf = jnp.maximum(n, 1).astype(f32)
    large = max_exact + (jnp.log(nf / max_exact) / math.log(MAX_DISTANCE / max_exact)
                         * (NUM_BUCKETS - max_exact)).astype(jnp.int32)
    large = jnp.minimum(large, NUM_BUCKETS - 1)
    return jnp.where(n < max_exact, n, large)


def swiglu(x, w_gate, w_up, w_down):
    return (jax.nn.silu(x @ w_gate) * (x @ w_up)) @ w_down


def banded_gqa(q, k, v, table, window, sinks):
    Bn, S, G, R, dh = q.shape
    pad = -(-(window - 1) // Q_BLOCK) * Q_BLOCK
    kw = pad + Q_BLOCK
    kp = jnp.pad(k, ((0, 0), (pad, 0), (0, 0), (0, 0)))
    vp = jnp.pad(v, ((0, 0), (pad, 0), (0, 0), (0, 0)))
    ki = jnp.arange(kw)[None, :]
    dist = jnp.arange(Q_BLOCK)[:, None] + pad - ki
    band = (dist >= 0) & (dist < window)
    bias = jnp.transpose(table[t5_bucket(dist)], (2, 3, 0, 1))
    scale = dh ** -0.5

    def one_block(i):
        start = i * Q_BLOCK
        qb = lax.dynamic_slice_in_dim(q, start, Q_BLOCK, axis=1)
        kb = lax.dynamic_slice_in_dim(kp, start, kw, axis=1)
        vb = lax.dynamic_slice_in_dim(vp, start, kw, axis=1)
        s = jnp.einsum('bqgrd,bkgd->bgrqk', qb, kb).astype(f32) * scale + bias
        valid = band & (start - pad + ki >= 0)
        s = jnp.where(valid, s, NEG)
        if sinks is None:
            p = jax.nn.softmax(s, axis=-1)
        else:
            sk = sinks.astype(f32)[None, :, :, None, None]
            m = jnp.maximum(s.max(-1, keepdims=True), sk)
            e = jnp.exp(s - m)
            p = e / (e.sum(-1, keepdims=True) + jnp.exp(sk - m))
        return jnp.einsum('bgrqk,bkgd->bqgrd', p.astype(vb.dtype), vb)

    out = lax.map(one_block, jnp.arange(S // Q_BLOCK))
    return jnp.moveaxis(out, 0, 1).reshape(Bn, S, G, R, dh)


def nsa_compress(kv, pos, w1, w2):
    Bn, S, G, dh = kv.shape
    n_cmp = (S - CMP_BLOCK) // CMP_STRIDE + 1
    idx = jnp.arange(n_cmp)[:, None] * CMP_STRIDE + jnp.arange(CMP_BLOCK)[None, :]
    blocks = kv[:, idx] + pos[:, None, :]
    blocks = jnp.moveaxis(blocks, 3, 2).reshape(Bn, n_cmp, G, CMP_BLOCK * dh)
    return jax.nn.gelu(blocks @ w1) @ w2


def nsa_selected(q, k, v, sel, table):
    Bn, S, G, R, dh = q.shape
    n_keys = sel.shape[-1] * SLC_BLOCK
    kb = k.reshape(Bn, S // SLC_BLOCK, SLC_BLOCK, G, dh).transpose(0, 3, 1, 2, 4)
    vb = v.reshape(Bn, S // SLC_BLOCK, SLC_BLOCK, G, dh).transpose(0, 3, 1, 2, 4)
    tbg = table.transpose(1, 0, 2)
    bi = jnp.arange(Bn)[:, None, None, None]
    gi = jnp.arange(G)[None, :, None, None]
    offs = jnp.arange(SLC_BLOCK)
    scale = dh ** -0.5

    def one_chunk(i):
        start = i * SLC_Q_CHUNK
        qc = lax.dynamic_slice_in_dim(q, start, SLC_Q_CHUNK, axis=1)
        sc = lax.dynamic_slice_in_dim(sel, start, SLC_Q_CHUNK, axis=2)
        kg = kb[bi, gi, sc].reshape(Bn, G, SLC_Q_CHUNK, n_keys, dh)
        vg = vb[bi, gi, sc].reshape(Bn, G, SLC_Q_CHUNK, n_keys, dh)
        kpos = (sc[..., None] * SLC_BLOCK + offs).reshape(Bn, G, SLC_Q_CHUNK, n_keys)
        dist = (start + jnp.arange(SLC_Q_CHUNK))[:, None] - kpos
        valid = (dist >= 0)[:, :, :, None, :]
        bias = jnp.moveaxis(tbg[gi, t5_bucket(dist)], 4, 3)
        s = jnp.einsum('bqgrd,bgqkd->bgqrk', qc, kg).astype(f32) * scale + bias
        p = jax.nn.softmax(jnp.where(valid, s, NEG), axis=-1)
        return jnp.einsum('bgqrk,bgqkd->bqgrd', p.astype(vg.dtype), vg)

    out = lax.map(one_chunk, jnp.arange(S // SLC_Q_CHUNK))
    return jnp.moveaxis(out, 0, 1).reshape(Bn, S, G, R, dh)


def nsa_attention(q, k_cmp, v_cmp, k_slc, v_slc, k_win, v_win, gates, table,
                  cmpk_pos, cmpk_w1, cmpk_w2, cmpv_pos, cmpv_w1, cmpv_w2):
    Bn, S, G, R, dh = q.shape
    scale = dh ** -0.5
    tpos = jnp.arange(S)
    kc = nsa_compress(k_cmp, cmpk_pos, cmpk_w1, cmpk_w2)
    vc = nsa_compress(v_cmp, cmpv_pos, cmpv_w1, cmpv_w2)
    n_cmp = kc.shape[1]
    cmp_end = jnp.arange(n_cmp) * CMP_STRIDE + (CMP_BLOCK - 1)
    dist_c = tpos[:, None] - cmp_end[None, :]
    valid_c = dist_c >= 0
    bias_c = jnp.transpose(table[t5_bucket(dist_c)], (2, 3, 0, 1))
    s_c = jnp.einsum('bsgrd,bngd->bgrsn', q, kc).astype(f32) * scale + bias_c
    p_c = jax.nn.softmax(jnp.where(valid_c, s_c, NEG), axis=-1) * valid_c
    o_cmp = jnp.einsum('bgrsn,bngd->bsgrd', p_c.astype(vc.dtype), vc)
    n_slc = S // SLC_BLOCK
    n_sel = min(SLC_TOPN, n_slc)
    ci = np.arange(n_cmp)[:, None] * CMP_STRIDE
    sj = np.arange(n_slc)[None, :] * SLC_BLOCK
    overlap = np.clip(np.minimum(ci + CMP_BLOCK, sj + SLC_BLOCK) - np.maximum(ci, sj), 0, None) / CMP_BLOCK
    imp = jnp.einsum('bgrsn,nj->bgsj', p_c, jnp.asarray(overlap, dtype=f32))
    blk = jnp.arange(n_slc)
    cur = (tpos // SLC_BLOCK)[:, None]
    forced = (blk == 0) | (blk == cur) | (blk == cur - 1)
    adm = blk * SLC_BLOCK <= tpos[:, None]
    score = jnp.where(forced, POS_BIG, jnp.where(adm, imp, NEG))
    _, sel = lax.top_k(score, n_sel)
    o_slc = nsa_selected(q, k_slc, v_slc, sel, table)
    o_win = banded_gqa(q, k_win, v_win, table, B_WINDOW, None)
    g = jax.nn.sigmoid(gates.astype(f32))[..., None].astype(q.dtype)
    return g[:, :, 0] * o_cmp + g[:, :, 1] * o_slc + g[:, :, 2] * o_win


def dsa_attention(q, k, v, q_idx, k_idx, w_idx, table):
    Bn, S, H, dh = q.shape
    topk = min(C_TOPK_MAX, S // 4)
    scale = dh ** -0.5
    kpos = jnp.arange(S)
    bi = jnp.arange(Bn)[:, None, None]
    w_idx = w_idx.astype(f32)

    def one_block(i):
        start = i * Q_BLOCK
        qb = lax.dynamic_slice_in_dim(q, start, Q_BLOCK, axis=1)
        qib = lax.dynamic_slice_in_dim(q_idx, start, Q_BLOCK, axis=1)
        wib = lax.dynamic_slice_in_dim(w_idx, start, Q_BLOCK, axis=1)
        qpos = start + jnp.arange(Q_BLOCK)
        rel = jax.nn.relu(jnp.einsum('bqhd,bsd->bqhs', qib, k_idx).astype(f32))
        index_score = jnp.einsum('bqh,bqhs->bqs', wib, rel)
        index_score = jnp.where(kpos[None, :] <= qpos[:, None], index_score, NEG)
        _, sel = lax.top_k(index_score, topk)
        kg = k[bi, sel]
        vg = v[bi, sel]
        dist = qpos[:, None] - sel
        valid = (dist >= 0)[:, :, None, :]
        bias = jnp.moveaxis(table[t5_bucket(dist)], 3, 2)
        s = jnp.einsum('bqhd,bqkd->bqhk', qb, kg).astype(f32) * scale + bias
        p = jax.nn.softmax(jnp.where(valid, s, NEG), axis=-1)
        return jnp.einsum('bqhk,bqkd->bqhd', p.astype(vg.dtype), vg)

    out = lax.map(one_block, jnp.arange(S // Q_BLOCK))
    return jnp.moveaxis(out, 0, 1).reshape(Bn, S, H * dh)


def moe_swiglu(x, router, w_gate, w_up, w_down):
    xt = x.reshape(-1, x.shape[-1])
    logits = (xt @ router).astype(f32)
    top_v, top_i = lax.top_k(logits, TOP_K)
    gates = jax.nn.softmax(top_v, axis=-1)
    combine = jnp.sum(jax.nn.one_hot(top_i, N_EXPERTS, dtype=f32) * gates[..., None], axis=1)
    y = jnp.zeros_like(xt)
    for e in range(N_EXPERTS):
        y = y + combine[:, e:e + 1].astype(xt.dtype) * swiglu(xt, w_gate[e], w_up[e], w_down[e])
    return y.reshape(x.shape)


def even_layer(x, rel_bias, w_in, sinks, cmpk_pos, cmpk_w1, cmpk_w2, cmpv_pos, cmpv_w1, cmpv_w2,
               w_out, ln1_g, ln1_b, ffn_gate, ffn_up, ffn_down, ln2_g, ln2_b):
    Bn, S, _ = x.shape
    ra, rb = A_HEADS // A_KV, B_HEADS // B_KV
    qa, ka, va, qb, kvb, gb = _split_cols(x @ w_in, W_IN0_SIZES)
    table_a = rel_bias[:, :A_HEADS].reshape(NUM_BUCKETS, A_KV, ra)
    out_a = banded_gqa(qa.reshape(Bn, S, A_KV, ra, HEAD_DIM), ka.reshape(Bn, S, A_KV, HEAD_DIM),
                       va.reshape(Bn, S, A_KV, HEAD_DIM), table_a, A_WINDOW, sinks.reshape(A_KV, ra))
    kvb = kvb.reshape(Bn, S, 6, B_KV, HEAD_DIM)
    table_b = rel_bias[:, A_HEADS:A_HEADS + B_HEADS].reshape(NUM_BUCKETS, B_KV, rb)
    out_b = nsa_attention(qb.reshape(Bn, S, B_KV, rb, HEAD_DIM),
                          kvb[:, :, 0], kvb[:, :, 1], kvb[:, :, 2], kvb[:, :, 3], kvb[:, :, 4], kvb[:, :, 5],
                          gb.reshape(Bn, S, 3, B_KV, rb), table_b,
                          cmpk_pos, cmpk_w1, cmpk_w2, cmpv_pos, cmpv_w1, cmpv_w2)
    mix = jnp.concatenate([out_a.reshape(Bn, S, A_Q), out_b.reshape(Bn, S, B_Q)], axis=-1)
    x = layer_norm(ALPHA * x + mix @ w_out, ln1_g, ln1_b)
    return layer_norm(ALPHA * x + swiglu(x, ffn_gate, ffn_up, ffn_down), ln2_g, ln2_b)


def odd_layer(x, rel_bias, w_in, w_out, ln1_g, ln1_b, router, exp_gate, exp_up, exp_down, ln2_g, ln2_b):
    Bn, S, _ = x.shape
    q, k, v, qi, ki, wi = _split_cols(x @ w_in, W_IN1_SIZES)
    mix = dsa_attention(q.reshape(Bn, S, C_HEADS, HEAD_DIM), k, v,
                        qi.reshape(Bn, S, IDX_HEADS, IDX_DIM), ki, wi, rel_bias[:, :C_HEADS])
    x = layer_norm(ALPHA * x + mix @ w_out, ln1_g, ln1_b)
    return layer_norm(ALPHA * x + moe_swiglu(x, router, exp_gate, exp_up, exp_down), ln2_g, ln2_b)


def setup_inputs(seed: int = 0) -> dict:
    key = jax.random.key(seed)
    ks = jax.random.split(key, 28)

    def nrm(i, shape, scale):
        return jax.random.normal(ks[i], shape, dtype=jnp.float32) * scale

    d = D_MODEL
    return {
        'x': nrm(0, (BATCH, SEQ, d), 1.0),
        'rel_bias': nrm(1, (NUM_BUCKETS, N_BIAS_HEADS), 0.3),
        'l0_w_in': nrm(2, (d, W_IN0_COLS), d ** -0.5),
        'l0_sinks': nrm(3, (A_HEADS,), 0.5),
        'l0_cmpk_pos': nrm(4, (CMP_BLOCK, HEAD_DIM), 0.1),
        'l0_cmpk_w1': nrm(5, (CMP_IN, CMP_HIDDEN), CMP_IN ** -0.5),
        'l0_cmpk_w2': nrm(6, (CMP_HIDDEN, HEAD_DIM), CMP_HIDDEN ** -0.5),
        'l0_cmpv_pos': nrm(7, (CMP_BLOCK, HEAD_DIM), 0.1),
        'l0_cmpv_w1': nrm(8, (CMP_IN, CMP_HIDDEN), CMP_IN ** -0.5),
        'l0_cmpv_w2': nrm(9, (CMP_HIDDEN, HEAD_DIM), CMP_HIDDEN ** -0.5),
        'l0_w_out': nrm(10, (A_Q + B_Q, d), BETA * (A_Q + B_Q) ** -0.5),
        'l0_ln1_g': 1.0 + nrm(11, (d,), 0.01),
        'l0_ln1_b': nrm(12, (d,), 0.01),
        'l0_ffn_gate': nrm(13, (d, D_FF), d ** -0.5),
        'l0_ffn_up': nrm(14, (d, D_FF), d ** -0.5),
        'l0_ffn_down': nrm(15, (D_FF, d), BETA * D_FF ** -0.5),
        'l0_ln2_g': 1.0 + nrm(16, (d,), 0.01),
        'l0_ln2_b': nrm(17, (d,), 0.01),
        'l1_w_in': nrm(18, (d, W_IN1_COLS), d ** -0.5),
        'l1_w_out': nrm(19, (C_HEADS * HEAD_DIM, d), BETA * (C_HEADS * HEAD_DIM) ** -0.5),
        'l1_ln1_g': 1.0 + nrm(20, (d,), 0.01),
        'l1_ln1_b': nrm(21, (d,), 0.01),
        'l1_router': nrm(22, (d, N_EXPERTS), d ** -0.5),
        'l1_exp_gate': nrm(23, (N_EXPERTS, d, D_FF), d ** -0.5),
        'l1_exp_up': nrm(24, (N_EXPERTS, d, D_FF), d ** -0.5),
        'l1_exp_down': nrm(25, (N_EXPERTS, D_FF, d), BETA * D_FF ** -0.5),
        'l1_ln2_g': 1.0 + nrm(26, (d,), 0.01),
        'l1_ln2_b': nrm(27, (d,), 0.01),
    }


def reference(x, rel_bias, l0_w_in, l0_sinks, l0_cmpk_pos, l0_cmpk_w1, l0_cmpk_w2, l0_cmpv_pos,
              l0_cmpv_w1, l0_cmpv_w2, l0_w_out, l0_ln1_g, l0_ln1_b, l0_ffn_gate, l0_ffn_up, l0_ffn_down,
              l0_ln2_g, l0_ln2_b, l1_w_in, l1_w_out, l1_ln1_g, l1_ln1_b, l1_router, l1_exp_gate,
              l1_exp_up, l1_exp_down, l1_ln2_g, l1_ln2_b):
    layer_params = (
        (l0_w_in, l0_sinks, l0_cmpk_pos, l0_cmpk_w1, l0_cmpk_w2, l0_cmpv_pos, l0_cmpv_w1, l0_cmpv_w2,
         l0_w_out, l0_ln1_g, l0_ln1_b, l0_ffn_gate, l0_ffn_up, l0_ffn_down, l0_ln2_g, l0_ln2_b),
        (l1_w_in, l1_w_out, l1_ln1_g, l1_ln1_b, l1_router, l1_exp_gate, l1_exp_up, l1_exp_down,
         l1_ln2_g, l1_ln2_b),
    )
    for i in range(DEPTH):
        if i % 2 == 0:
            x = even_layer(x, rel_bias, *layer_params[i])
        else:
            x = odd_layer(x, rel_bias, *layer_params[i])
    return x
```

```cpp
#include <hip/hip_runtime.h>
#include <cstdio>
#include <cstdint>

#ifndef MK_N_LAUNCHES
#define MK_N_LAUNCHES 1
#endif

#define LAS __attribute__((address_space(3)))
#define GAS __attribute__((address_space(1)))
typedef unsigned short bf16_t;
typedef short bf16x8 __attribute__((ext_vector_type(8)));
typedef short s16x4 __attribute__((ext_vector_type(4)));
typedef float f32x2 __attribute__((ext_vector_type(2)));
typedef float f32x4 __attribute__((ext_vector_type(4)));
typedef float f32x16 __attribute__((ext_vector_type(16)));
typedef unsigned u32x2 __attribute__((ext_vector_type(2)));
typedef unsigned u32x4 __attribute__((ext_vector_type(4)));

constexpr int NBATCH = 8, SEQ = 4096, T = NBATCH * SEQ, DM = 1024, DFF = 2816, NEXP = 8;
constexpr int N_IN0 = 2072, N_IN0P = 2304, N_IN1 = 1448, N_IN1P = 1536;
constexpr float ALPHA = 1.41421356237309515f;
constexpr float LN_EPS = 1e-5f;
constexpr float LOG2E = 1.4426950408889634f;
constexpr float QSCALE = 0.125f * LOG2E;

constexpr size_t MiB = 1u << 20;
constexpr size_t WS_CTL = 0, CTL_ZERO_BYTES = 1 * MiB;
constexpr size_t WS_KC = 1 * MiB;
constexpr size_t WS_POSW = 2 * MiB;
constexpr size_t WS_MOECNT = 2 * MiB + 64 * 1024;
constexpr size_t WS_MOEMETA = 2 * MiB + 128 * 1024;
constexpr size_t WS_TOKINFO = 2 * MiB + 256 * 1024;
constexpr size_t WS_WGU1 = 4 * MiB;
constexpr size_t WS_WDN1 = 92 * MiB;
constexpr size_t WS_WIN0 = 136 * MiB;
constexpr size_t WS_WC1 = 141 * MiB;
constexpr size_t WS_WOUT0 = 143 * MiB;
constexpr size_t WS_WGU0 = 145 * MiB;
constexpr size_t WS_WDN0 = 156 * MiB;
constexpr size_t WS_WIN1 = 162 * MiB;
constexpr size_t WS_WOUT1 = 165 * MiB;
constexpr size_t WS_XB = 168 * MiB;
constexpr size_t WS_QA = 232 * MiB;
constexpr size_t WS_QB = 264 * MiB;
constexpr size_t WS_KA = 296 * MiB;
constexpr size_t WS_VA = 304 * MiB;
constexpr size_t WS_KCMP = 312 * MiB;
constexpr size_t WS_VCMP = 320 * MiB;
constexpr size_t WS_KSLC = 328 * MiB;
constexpr size_t WS_VSLC = 336 * MiB;
constexpr size_t WS_KWIN = 344 * MiB;
constexpr size_t WS_VWIN = 352 * MiB;
constexpr size_t WS_GATES = 360 * MiB;
constexpr size_t WS_HCMP = 364 * MiB;
constexpr size_t WS_MIX0 = WS_XB;
constexpr size_t WS_X1B = 232 * MiB;
constexpr size_t WS_H0 = 296 * MiB;
constexpr size_t WS_X2B = WS_XB;
constexpr size_t WS_Q1 = 232 * MiB;
constexpr size_t WS_K1 = 296 * MiB;
constexpr size_t WS_V1 = 300 * MiB;
constexpr size_t WS_QI = 304 * MiB;
constexpr size_t WS_KI = 320 * MiB;
constexpr size_t WS_WI = 322 * MiB;
constexpr size_t WS_MIX1 = 328 * MiB;
constexpr size_t WS_Y3 = 392 * MiB;
constexpr size_t WS_X3B = 200 * MiB;
constexpr size_t WS_ROWTOK = 3 * MiB;
constexpr size_t WS_XG = 136 * MiB;
constexpr size_t WS_H1 = 268 * MiB;
constexpr size_t WS_END = 512 * MiB;
constexpr int MOE_PASS_TILES = 128;
constexpr int MOE_MAX_TILES = 264;

constexpr int CW_BAR = 4096;

constexpr int RING_BYTES = 131072;
constexpr int LDS_EXTRA_OFF = RING_BYTES;
constexpr int LDS_MISC_OFF = RING_BYTES + 16384;
constexpr int LDS_BYTES = RING_BYTES + 16384 + 512;

typedef __bf16 bf16x2_t __attribute__((ext_vector_type(2)));
__device__ __forceinline__ unsigned cvt_pk_bf16(float lo, float hi) { const f32x2 v = {lo, hi}; const bf16x2_t b = __builtin_convertvector(v, bf16x2_t); return __builtin_bit_cast(unsigned, b); }
__device__ __forceinline__ float bf_lo(unsigned w) { return __uint_as_float(w << 16); }
__device__ __forceinline__ float bf_hi(unsigned w) { return __uint_as_float(w & 0xffff0000u); }
__device__ __forceinline__ float wave_sum(float v) {
#pragma unroll
    for (int o = 1; o < 64; o <<= 1) v += __shfl_xor(v, o);
    return v;
}
__device__ __forceinline__ float swap_max(float m) { auto rr = __builtin_amdgcn_permlane32_swap(__float_as_uint(m), __float_as_uint(m), false, false); return fmaxf(__uint_as_float(rr[0]), __uint_as_float(rr[1])); }
__device__ __forceinline__ float swap_sum(float m) { auto rr = __builtin_amdgcn_permlane32_swap(__float_as_uint(m), __float_as_uint(m), false, false); return __uint_as_float(rr[0]) + __uint_as_float(rr[1]); }
__device__ __forceinline__ int t5_bucket(int n) {
    if (n < 16) return n;
    int b = 16;
    b += (n >= 19); b += (n >= 21); b += (n >= 24); b += (n >= 27); b += (n >= 31); b += (n >= 35); b += (n >= 40); b += (n >= 46);
    b += (n >= 52); b += (n >= 59); b += (n >= 67); b += (n >= 77); b += (n >= 87); b += (n >= 99); b += (n >= 113);
    return b;
}
namespace pg8 {
#define PG8_LAS __attribute__((address_space(3)))
constexpr int BM = 256, BK = 64, HALF = 128, HTB = HALF * BK * 2  , STAGE_BYTES = 8 * HTB, NXCD = 8, WGM = 8;
__host__ __device__ __forceinline__ int lds_byte(int r, int c) { const int st = (r >> 4) * 2 + (c >> 5), rr = r & 15, cc = c & 31, ob = rr * 64 + cc * 2; return st * 1024 + (ob ^ (((ob >> 9) & 1) << 5)); }
__host__ __device__ __forceinline__ void stage_rc(int b, int& R, int& C) { const int st = b / 1024, sb = b % 1024, swz = sb ^ (((sb >> 9) & 1) << 5); R = (st >> 1) * 16 + swz / 64; C = (st & 1) * 32 + (swz % 64) / 2; }
__host__ __device__ __forceinline__ int perm32(int rho) { const int n = rho >> 4, i = rho & 15; return 8 * (i >> 2) + 4 * n + (i & 3); }

struct Unit { int pa, pb, pm, pn; };
struct Gemm { const bf16_t* A; const bf16_t* Bt; int K; };

struct StaticOrder {
    int nM, nN, nwg, G, c; const int* rowlist; int gpitch;
    __host__ __device__ void init(int nM_, int nN_, int G_, int c_) { nM = nM_; nN = nN_; nwg = nM * nN; G = G_; c = c_; }
    __host__ __device__ bool next(int i, Unit& u) const {
        const long L = (long)i * G + c; if (L >= nwg) return false;
        int wgid = (int)L; { const int q = nwg / NXCD, r = nwg % NXCD, xcd = wgid % NXCD, off = wgid / NXCD; wgid = (xcd < r ? xcd * (q + 1) : r * (q + 1) + (xcd - r) * q) + off; }
        const int nig = WGM * nN, gid = wgid / nig, fm = gid * WGM, gsz = (nM - fm) < WGM ? (nM - fm) : WGM;
        u.pm = fm + ((wgid % nig) % gsz); u.pn = (wgid % nig) / gsz; u.pa = u.pm; u.pb = u.pn; return true;
    }
    __device__ __forceinline__ void a_ready(const Unit&) const {}
    __device__ __forceinline__ void done(const Unit&) const {}
};
template <class Epi, class Sched, bool ALIGN_EPI = false, bool SP2 = false, bool GATHER = false>
__device__ __forceinline__ void gemm_phase(PG8_LAS unsigned char* lds, const Gemm g, const Sched& S, const Epi& E) {
    const int tid = threadIdx.x, wid = __builtin_amdgcn_readfirstlane(tid >> 6), lane = tid & 63, wr = wid >> 2, wc = wid & 3, fr = lane & 15, fq = lane >> 4;
    const int K = g.K, nt = K / BK;
    unsigned voffA[2], voffB[2]; int rA[2], cA2[2];
#pragma unroll
    for (int i = 0; i < 2; ++i) { int R, C; stage_rc(tid * 16 + i * 8192, R, C); const int Rb = Epi::PERM ? ((R & ~31) + perm32(R & 31)) : R;
        voffA[i] = (unsigned)(R * K + C) * 2u; voffB[i] = (unsigned)(Rb * K + C) * 2u; rA[i] = R; cA2[i] = C; }
    unsigned vofC[2][2], vofN[2][2];
#define PG8_GOFF(dst, unit) do { if constexpr (GATHER) { _Pragma("unroll") for (int h_ = 0; h_ < 2; ++h_) _Pragma("unroll") for (int i_ = 0; i_ < 2; ++i_) \
        dst[h_][i_] = ((unsigned)S.rowlist[(unit).pm * BM + h_ * HALF + rA[i_]] * (unsigned)S.gpitch + (unsigned)cA2[i_]) * 2u; } } while (0)
    const size_t kstep = (size_t)(BK * 2);
    const size_t hstep = (size_t)HALF * K * 2;
    const size_t tstep = 2 * hstep;
    const unsigned ldsw = (unsigned)wid * 1024u;
    const int aoff = lds_byte(wr * 64 + fr, fq * 8), boff = lds_byte(wc * 32 + fr, fq * 8);
#define PG8_SA(b, h) (((b) * 2 + (h)) * HTB)
#define PG8_SB(b, h) ((4 + (b) * 2 + (h)) * HTB)
#define PG8_STAGE(bufoff, gbase, voff) do { _Pragma("unroll") for (int _i = 0; _i < 2; ++_i) \
        __builtin_amdgcn_global_load_lds((const unsigned*)((const char*)(gbase) + (voff)[_i]), (PG8_LAS unsigned*)(lds + (bufoff) + ldsw + _i * 8192), 16, 0, 0); } while (0)
#define PG8_STAGE_A(bufoff, gbase, h, VO) do { if constexpr (GATHER) PG8_STAGE(bufoff, gbase, VO[h]); else PG8_STAGE(bufoff, (gbase) + (h) * hstep, voffA); } while (0)
#define PG8_LDA(dst, b, h) do { _Pragma("unroll") for (int m = 0; m < 4; ++m) _Pragma("unroll") for (int k = 0; k < 2; ++k) dst[m][k] = *(const PG8_LAS bf16x8*)(lds + PG8_SA(b, h) + aoff + m * 2048 + k * 1024); } while (0)
#define PG8_LDB(dst, b, h) do { _Pragma("unroll") for (int n = 0; n < 2; ++n) _Pragma("unroll") for (int k = 0; k < 2; ++k) dst[n][k] = *(const PG8_LAS bf16x8*)(lds + PG8_SB(b, h) + boff + n * 2048 + k * 1024); } while (0)
#define PG8_MMA(ai, bj, At, Bt) do { __builtin_amdgcn_s_setprio(1); _Pragma("unroll") for (int m = 0; m < 4; ++m) _Pragma("unroll") for (int n = 0; n < 2; ++n) _Pragma("unroll") for (int k = 0; k < 2; ++k) \
        acc[ai][bj][m][n] = __builtin_amdgcn_mfma_f32_16x16x32_bf16(Bt[n][k], At[m][k], acc[ai][bj][m][n], 0, 0, 0); __builtin_amdgcn_s_setprio(0); } while (0)
#define PG8_WAIT_V(n) asm volatile("s_waitcnt vmcnt(" #n ")" ::: "memory")
#define PG8_WAIT_L(n) asm volatile("s_waitcnt lgkmcnt(" #n ")" ::: "memory")
#define PG8_BAR __builtin_amdgcn_s_barrier()
#define PG8_SCHED __builtin_amdgcn_sched_barrier(0)
    Unit cur, nxt; int ui = 0;
    if (!S.next(0, cur)) return;
    f32x4 acc[2][2][4][2];
#pragma unroll
    for (int a = 0; a < 2; ++a)
#pragma unroll
        for (int b = 0; b < 2; ++b)
#pragma unroll
            for (int m = 0; m < 4; ++m)
#pragma unroll
                for (int n = 0; n < 2; ++n) acc[a][b][m][n] = (f32x4){0.f, 0.f, 0.f, 0.f};
    bf16x8 At[4][2], B0[2][2], B1[2][2];
    const char* cA = (const char*)g.A + (size_t)cur.pa * tstep; const char* cB = (const char*)g.Bt + (size_t)cur.pb * tstep;
    S.a_ready(cur);
    PG8_GOFF(vofC, cur);
#pragma unroll
    for (int h_ = 0; h_ < 2; ++h_)
#pragma unroll
        for (int i_ = 0; i_ < 2; ++i_) { if constexpr (!GATHER) vofC[h_][i_] = 0u; vofN[h_][i_] = vofC[h_][i_]; }
    if constexpr (SP2) {
        PG8_STAGE(PG8_SB(0, 0), cB, voffB); PG8_STAGE(PG8_SB(0, 1), cB + hstep, voffB); PG8_STAGE_A(PG8_SA(0, 0), cA, 0, vofC); PG8_STAGE_A(PG8_SA(0, 1), cA, 1, vofC);
        if (wr == 1) PG8_BAR;
        PG8_WAIT_V(2); PG8_BAR;
        PG8_STAGE(PG8_SB(1, 0), cB + kstep, voffB); PG8_STAGE_A(PG8_SA(1, 0), cA + kstep, 0, vofC); PG8_STAGE(PG8_SB(1, 1), cB + hstep + kstep, voffB);
        PG8_WAIT_V(6); PG8_BAR;
    } else {
        PG8_STAGE(PG8_SB(0, 0), cB, voffB); PG8_STAGE_A(PG8_SA(0, 0), cA, 0, vofC); PG8_STAGE(PG8_SB(0, 1), cB + hstep, voffB); PG8_STAGE_A(PG8_SA(0, 1), cA, 1, vofC);
        if (wr == 1) PG8_BAR;
        PG8_WAIT_V(4); PG8_BAR;
        PG8_STAGE(PG8_SB(1, 0), cB + kstep, voffB); PG8_STAGE_A(PG8_SA(1, 0), cA + kstep, 0, vofC); PG8_STAGE(PG8_SB(1, 1), cB + hstep + kstep, voffB);
        PG8_WAIT_V(6); PG8_BAR;
    }
    for (;;) {
        const bool has_next = S.next(ui + 1, nxt);
        if constexpr (GATHER) { if (has_next) PG8_GOFF(vofN, nxt); }
        const char* nA = has_next ? (const char*)g.A + (size_t)nxt.pa * tstep : cA; const char* nB = has_next ? (const char*)g.Bt + (size_t)nxt.pb * tstep : cB;
        for (int t = 0; t < nt; t += 2) {
            const bool last = (t == nt - 2);
            unsigned vsel[2][2];
#pragma unroll
            for (int h_ = 0; h_ < 2; ++h_)
#pragma unroll
                for (int i_ = 0; i_ < 2; ++i_) vsel[h_][i_] = last ? vofN[h_][i_] : vofC[h_][i_];
            const char* a1 = cA + (size_t)(t + 1) * kstep;
            const char* a2 = last ? nA : cA + (size_t)(t + 2) * kstep; const char* b2 = last ? nB : cB + (size_t)(t + 2) * kstep;
            const char* a3 = a2 + kstep; const char* b3 = b2 + kstep;
            if (last && has_next) S.a_ready(nxt);
            if constexpr (SP2) {
            PG8_LDB(B0, 0, 0); PG8_LDB(B1, 0, 1); PG8_SCHED; PG8_LDA(At, 0, 0); PG8_STAGE_A(PG8_SA(1, 1), a1, 1, vofC);
            PG8_WAIT_V(8); PG8_WAIT_L(0); PG8_BAR; PG8_MMA(0, 0, At, B0); PG8_MMA(0, 1, At, B1); PG8_BAR; PG8_SCHED;
            PG8_LDA(At, 0, 1); PG8_STAGE(PG8_SB(0, 0), b2, voffB); PG8_STAGE(PG8_SB(0, 1), b2 + hstep, voffB); PG8_STAGE_A(PG8_SA(0, 0), a2, 0, vsel);
            PG8_WAIT_V(8); PG8_WAIT_L(0); PG8_BAR; PG8_MMA(1, 0, At, B0); PG8_MMA(1, 1, At, B1); PG8_BAR; PG8_SCHED;
            PG8_LDB(B0, 1, 0); PG8_LDB(B1, 1, 1); PG8_SCHED; PG8_LDA(At, 1, 0); PG8_STAGE_A(PG8_SA(0, 1), a2, 1, vsel);
            PG8_WAIT_V(8); PG8_WAIT_L(0); PG8_BAR; PG8_MMA(0, 0, At, B0); PG8_MMA(0, 1, At, B1); PG8_BAR; PG8_SCHED;
            PG8_LDA(At, 1, 1); PG8_STAGE(PG8_SB(1, 0), b3, voffB); PG8_STAGE(PG8_SB(1, 1), b3 + hstep, voffB); PG8_STAGE_A(PG8_SA(1, 0), a3, 0, vsel);
            PG8_WAIT_V(8); PG8_WAIT_L(0); PG8_BAR; PG8_MMA(1, 0, At, B0); PG8_MMA(1, 1, At, B1); PG8_BAR; PG8_SCHED;
            } else {
            PG8_LDB(B0, 0, 0); PG8_SCHED; PG8_LDA(At, 0, 0); PG8_STAGE_A(PG8_SA(1, 1), a1, 1, vofC);
            PG8_WAIT_L(8); PG8_BAR; PG8_WAIT_L(0); PG8_MMA(0, 0, At, B0); PG8_BAR; PG8_SCHED;
            PG8_LDB(B1, 0, 1); PG8_STAGE(PG8_SB(0, 0), b2, voffB);
            PG8_BAR; PG8_WAIT_L(0); PG8_MMA(0, 1, At, B1); PG8_BAR;
            PG8_LDA(At, 0, 1); PG8_STAGE_A(PG8_SA(0, 0), a2, 0, vsel);
            PG8_BAR; PG8_WAIT_L(0); PG8_MMA(1, 0, At, B0); PG8_BAR; PG8_SCHED;
            PG8_STAGE(PG8_SB(0, 1), b2 + hstep, voffB);
            PG8_WAIT_V(6); PG8_BAR; PG8_MMA(1, 1, At, B1); PG8_BAR;
            PG8_LDB(B0, 1, 0); PG8_SCHED; PG8_LDA(At, 1, 0); PG8_STAGE_A(PG8_SA(0, 1), a2, 1, vsel);
            PG8_WAIT_L(8); PG8_BAR; PG8_WAIT_L(0); PG8_MMA(0, 0, At, B0); PG8_BAR; PG8_SCHED;
            PG8_LDB(B1, 1, 1); PG8_STAGE(PG8_SB(1, 0), b3, voffB);
            PG8_BAR; PG8_WAIT_L(0); PG8_MMA(0, 1, At, B1); PG8_BAR;
            PG8_LDA(At, 1, 1); PG8_STAGE_A(PG8_SA(1, 0), a3, 0, vsel);
            PG8_BAR; PG8_WAIT_L(0); PG8_MMA(1, 0, At, B0); PG8_BAR; PG8_SCHED;
            PG8_STAGE(PG8_SB(1, 1), b3 + hstep, voffB);
            PG8_WAIT_V(6); PG8_BAR; PG8_MMA(1, 1, At, B1); PG8_BAR;
            }
        }
        if constexpr (ALIGN_EPI) { if (wr == 0) PG8_BAR; }
        if constexpr (!Epi::AFTER_DRAIN) { E(acc, cur, wr, wc, fr, fq); S.done(cur); }
        if (!has_next) break;
#pragma unroll
        for (int a = 0; a < 2; ++a)
#pragma unroll
            for (int b = 0; b < 2; ++b)
#pragma unroll
                for (int m = 0; m < 4; ++m)
#pragma unroll
                    for (int n = 0; n < 2; ++n) acc[a][b][m][n] = (f32x4){0.f, 0.f, 0.f, 0.f};
        cur = nxt; cA = nA; cB = nB; ++ui;
#pragma unroll
        for (int h_ = 0; h_ < 2; ++h_)
#pragma unroll
            for (int i_ = 0; i_ < 2; ++i_) vofC[h_][i_] = vofN[h_][i_];
        if constexpr (ALIGN_EPI) { if (wr == 1) PG8_BAR; }
    }
    PG8_WAIT_V(0);
    if constexpr (!ALIGN_EPI) { if (wr == 0) PG8_BAR; }
    PG8_BAR;
    if constexpr (Epi::AFTER_DRAIN) { E.fused(acc, cur, wr, wc, fr, fq, lds, wid, lane); S.done(cur); }
#undef PG8_SA
#undef PG8_SB
#undef PG8_STAGE
#undef PG8_STAGE_A
#undef PG8_GOFF
#undef PG8_LDA
#undef PG8_LDB
#undef PG8_MMA
#undef PG8_WAIT_V
#undef PG8_WAIT_L
#undef PG8_BAR
#undef PG8_SCHED
}
}
#define XB_TMO      128
#define XB_XCNT(j)  (256  + 64 * (j))
#define XB_XSUB(j)  (1280 + 64 * (j))
#define XB_XGEN(j)  (2304 + 64 * (j))
#define XB_TOP      3328
#define XB_TOPGEN   3392
#define XCD_BAR_WORDS 3456
#define XB_SPIN_CAP (1u << 18)

__device__ __forceinline__ unsigned xb_ld(unsigned* p)              { return __hip_atomic_load(p, __ATOMIC_RELAXED, __HIP_MEMORY_SCOPE_AGENT); }
__device__ __forceinline__ unsigned xb_add(unsigned* p, unsigned v) { return __hip_atomic_fetch_add(p, v, __ATOMIC_RELAXED, __HIP_MEMORY_SCOPE_AGENT); }
__device__ __forceinline__ unsigned xb_xcc_id() { return (unsigned)__builtin_amdgcn_s_getreg((3 << 11) | 20) & 0xFu; }
#define XB_SPIN(cond, bar) do { unsigned _sp = 0; while (cond) { __builtin_amdgcn_s_sleep(1); \
    if ((++_sp & 255u) == 0u) { if (xb_ld(&(bar)[XB_TMO])) break; if (_sp > XB_SPIN_CAP) { atomicAdd(&(bar)[XB_TMO], 1u); break; } } } } while (0)

struct XcdBarrier {
    unsigned* bar; unsigned x;
    volatile LAS unsigned* st;
};

__device__ __forceinline__ XcdBarrier xcd_barrier_post(unsigned* bar, volatile LAS unsigned* st) {
    XcdBarrier b; b.bar = bar; b.x = xb_xcc_id(); b.st = st;
    if (threadIdx.x == 0) (void)xb_add(&bar[XB_XCNT(b.x)], 1u);
    return b;
}
__device__ __forceinline__ void xcd_barrier_complete(unsigned* bar, unsigned x, unsigned& nloc, unsigned& nx) {
    const unsigned G = gridDim.x * gridDim.y * gridDim.z;
    unsigned sum, cnt, mine, sp = 0u;
    for (;;) {
        sum = 0u; cnt = 0u; mine = 0u;
#pragma unroll
        for (unsigned j = 0; j < 16; ++j) { const unsigned c = xb_ld(&bar[XB_XCNT(j)]); sum += c; cnt += (c > 0u) ? 1u : 0u; mine = (j == x) ? c : mine; }
        if (sum == G) break;
        __builtin_amdgcn_s_sleep(1);
        if ((++sp & 255u) == 0u) { if (xb_ld(&bar[XB_TMO])) break; if (sp > XB_SPIN_CAP) { atomicAdd(&bar[XB_TMO], 1u); break; } }
    }
    nloc = mine > 0u ? mine : 1u; nx = cnt > 0u ? cnt : 1u;
}

__device__ __forceinline__ void xcd_barrier(const XcdBarrier& b) {
    asm volatile("s_waitcnt vmcnt(0)" ::: "memory");
    __syncthreads();
    if (threadIdx.x == 0) {
        unsigned* bar = b.bar;
        __builtin_amdgcn_s_waitcnt(0);
        unsigned nloc = b.st[0], nx = b.st[1];
        if (nloc == 0u) { xcd_barrier_complete(bar, b.x, nloc, nx); b.st[0] = nloc; b.st[1] = nx; }
        const unsigned old = xb_add(&bar[XB_XSUB(b.x)], 1u);
        const unsigned gen = old / nloc;
        if (old + 1u == (gen + 1u) * nloc) {
            __builtin_amdgcn_fence(__ATOMIC_RELEASE, "agent");
            asm volatile("s_waitcnt vmcnt(0)" ::: "memory");
            const unsigned og = xb_add(&bar[XB_TOP], 1u);
            const unsigned tg = og / nx;
            if (og + 1u == (tg + 1u) * nx) xb_add(&bar[XB_TOPGEN], 1u);
            else XB_SPIN(xb_ld(&bar[XB_TOPGEN]) == tg, bar);
            __builtin_amdgcn_fence(__ATOMIC_ACQUIRE, "agent");
            xb_add(&bar[XB_XGEN(b.x)], 1u);
            asm volatile("s_waitcnt vmcnt(0)" ::: "memory");
        } else {
            XB_SPIN(xb_ld(&bar[XB_XGEN(b.x)]) == gen, bar);
            __builtin_amdgcn_fence(__ATOMIC_ACQUIRE, "agent");
            asm volatile("s_waitcnt vmcnt(0)" ::: "memory");
        }
    }
    __syncthreads();
}
struct Args {
    const float* in[28];
    float* out; unsigned char* ws;
    int ph_lo, ph_hi;
};
struct Frame {
    LAS unsigned char* lds;
    int tid, lane, wave, G, bid;
    unsigned char* ws; float* out;
};
#define WSP(type, off) ((type*)(F.ws + (off)))
constexpr int LDS_PTR_OFF = LDS_MISC_OFF + 16;
__device__ __forceinline__ const float* in_ptr(LAS unsigned char* lds, int k) {
    const unsigned long long v = *(volatile LAS unsigned long long*)(lds + LDS_PTR_OFF + 8 * k);
    const unsigned lo = __builtin_amdgcn_readfirstlane((unsigned)v), hi = __builtin_amdgcn_readfirstlane((unsigned)(v >> 32));
    return (const float*)(((unsigned long long)hi << 32) | lo);
}
#define INP(k) in_ptr(F.lds, (k))

namespace pg8 {
struct EpiProj0 {
    static constexpr bool PERM = true, AFTER_DRAIN = false;
    unsigned char* ws;
    __device__ __forceinline__ void operator()(const f32x4 (&acc)[2][2][4][2], const Unit& u, int wr, int wc, int fr, int fq) const {
        const int row0 = u.pm * BM + wr * 64 + fr, cl = wc * 32 + 8 * fq;
        if (u.pn >= 16) {
            float* H = (float*)(ws + WS_HCMP);
#pragma unroll
            for (int ai = 0; ai < 2; ++ai)
#pragma unroll
                for (int m = 0; m < 4; ++m) { float* rp = H + (size_t)(row0 + ai * HALF + m * 16) * 512 + (u.pn - 16) * BM + cl;
#pragma unroll
                    for (int bj = 0; bj < 2; ++bj) { *(f32x4*)(rp + bj * HALF) = acc[ai][bj][m][0]; *(f32x4*)(rp + bj * HALF + 4) = acc[ai][bj][m][1]; } }
            return;
        }
#pragma unroll
        for (int bj = 0; bj < 2; ++bj) {
            const int hb = 2 * u.pn + bj;
            bf16_t* dst = nullptr; int pitch = 128, cb = cl, mode = 0; float sc = 1.f;
            if (hb < 4) { dst = (bf16_t*)(ws + WS_QA); pitch = 512; cb = hb * 128 + cl; sc = QSCALE; }
            else if (hb == 4) dst = (bf16_t*)(ws + WS_KA);
            else if (hb == 5) dst = (bf16_t*)(ws + WS_VA);
            else if (hb < 10) { dst = (bf16_t*)(ws + WS_QB); pitch = 512; cb = (hb - 6) * 128 + cl; sc = QSCALE; }
            else if (hb == 10) { dst = (bf16_t*)(ws + WS_KCMP); mode = 1; }
            else if (hb == 11) { dst = (bf16_t*)(ws + WS_VCMP); mode = 1; }
            else if (hb == 12) dst = (bf16_t*)(ws + WS_KSLC);
            else if (hb == 13) dst = (bf16_t*)(ws + WS_VSLC);
            else if (hb == 14) dst = (bf16_t*)(ws + WS_KWIN);
            else if (hb == 15) dst = (bf16_t*)(ws + WS_VWIN);
            else if (hb == 16) mode = (cl < 24) ? 2 : 3;
            else mode = 3;
            if (mode == 3) continue;
#pragma unroll
            for (int ai = 0; ai < 2; ++ai)
#pragma unroll
                for (int m = 0; m < 4; ++m) {
                    const int row = row0 + ai * HALF + m * 16;
                    const f32x4 v0 = acc[ai][bj][m][0], v1 = acc[ai][bj][m][1];
                    if (mode == 2) {
                        float* gp = (float*)(ws + WS_GATES) + (size_t)row * 24 + cl;
                        f32x4 a, b;
#pragma unroll
                        for (int i = 0; i < 4; ++i) { a[i] = 1.f / (1.f + __expf(-v0[i])); b[i] = 1.f / (1.f + __expf(-v1[i])); }
                        *(f32x4*)gp = a; *(f32x4*)(gp + 4) = b;
                    } else {
                        u32x4 w; w.x = cvt_pk_bf16(v0[0] * sc, v0[1] * sc); w.y = cvt_pk_bf16(v0[2] * sc, v0[3] * sc); w.z = cvt_pk_bf16(v1[0] * sc, v1[1] * sc); w.w = cvt_pk_bf16(v1[2] * sc, v1[3] * sc);
                        size_t off;
                        if (mode == 1) { const int b = row >> 12, t = row & 4095, g = cb >> 6, d = cb & 63; off = ((size_t)((b * 2 + g) * 4096 + t)) * 64 + d; }
                        else off = (size_t)row * pitch + cb;
                        *(u32x4*)(dst + off) = w;
                    }
                }
        }
    }
};
struct EpiProj1 {
    static constexpr bool PERM = true, AFTER_DRAIN = false;
    unsigned char* ws;
    __device__ __forceinline__ void operator()(const f32x4 (&acc)[2][2][4][2], const Unit& u, int wr, int wc, int fr, int fq) const {
        const int row0 = u.pm * BM + wr * 64 + fr, cl = wc * 32 + 8 * fq;
#pragma unroll
        for (int bj = 0; bj < 2; ++bj) {
            const int hb = 2 * u.pn + bj;
            bf16_t* dst = nullptr; int pitch = 1024, cb = cl, mode = 0; float sc = 1.f;
            if (hb < 8) { dst = (bf16_t*)(ws + WS_Q1); cb = hb * 128 + cl; sc = QSCALE; }
            else if (hb == 8) { if (cl < 64) { dst = (bf16_t*)(ws + WS_K1); pitch = 64; } else { dst = (bf16_t*)(ws + WS_V1); pitch = 64; cb = cl - 64; } }
            else if (hb < 11) { dst = (bf16_t*)(ws + WS_QI); pitch = 256; cb = (hb - 9) * 128 + cl; }
            else if (hb == 11) { if (cl < 32) { dst = (bf16_t*)(ws + WS_KI); pitch = 32; } else if (cl < 40) mode = 2; else mode = 3; }
            else mode = 3;
            if (mode == 3) continue;
#pragma unroll
            for (int ai = 0; ai < 2; ++ai)
#pragma unroll
                for (int m = 0; m < 4; ++m) {
                    const int row = row0 + ai * HALF + m * 16;
                    const f32x4 v0 = acc[ai][bj][m][0], v1 = acc[ai][bj][m][1];
                    if (mode == 2) { float* gp = (float*)(ws + WS_WI) + (size_t)row * 8; *(f32x4*)gp = v0; *(f32x4*)(gp + 4) = v1; }
                    else { u32x4 w; w.x = cvt_pk_bf16(v0[0] * sc, v0[1] * sc); w.y = cvt_pk_bf16(v0[2] * sc, v0[3] * sc); w.z = cvt_pk_bf16(v1[0] * sc, v1[1] * sc); w.w = cvt_pk_bf16(v1[2] * sc, v1[3] * sc);
                        *(u32x4*)(dst + (size_t)row * pitch + cb) = w; }
                }
        }
    }
};
struct EpiF32 {
    static constexpr bool PERM = false, AFTER_DRAIN = false;
    float* out; int ldc;
    __device__ __forceinline__ void operator()(const f32x4 (&acc)[2][2][4][2], const Unit& u, int wr, int wc, int fr, int fq) const {
#pragma unroll
        for (int ai = 0; ai < 2; ++ai)
#pragma unroll
            for (int m = 0; m < 4; ++m) { float* rp = out + (size_t)(u.pm * BM + ai * HALF + wr * 64 + m * 16 + fr) * ldc + u.pn * BM + wc * 32 + 4 * fq;
#pragma unroll
                for (int bj = 0; bj < 2; ++bj)
#pragma unroll
                    for (int n = 0; n < 2; ++n) *(f32x4*)(rp + bj * HALF + n * 16) = acc[ai][bj][m][n]; }
    }
};
struct EpiRes {
    static constexpr bool PERM = true, AFTER_DRAIN = false;
    const float* resf; const bf16_t* resb; bf16_t* out;
    __device__ __forceinline__ void operator()(const f32x4 (&acc)[2][2][4][2], const Unit& u, int wr, int wc, int fr, int fq) const {
#pragma unroll
        for (int ai = 0; ai < 2; ++ai)
#pragma unroll
            for (int m = 0; m < 4; ++m) { const size_t ro = (size_t)(u.pm * BM + ai * HALF + wr * 64 + m * 16 + fr) * DM + u.pn * BM + wc * 32 + 8 * fq;
#pragma unroll
                for (int bj = 0; bj < 2; ++bj) { const size_t o = ro + bj * HALF; f32x4 r0, r1;
                    if (resf) { r0 = *(const f32x4*)(resf + o); r1 = *(const f32x4*)(resf + o + 4); }
                    else { const u32x4 w = *(const u32x4*)(resb + o); r0 = (f32x4){bf_lo(w.x), bf_hi(w.x), bf_lo(w.y), bf_hi(w.y)}; r1 = (f32x4){bf_lo(w.z), bf_hi(w.z), bf_lo(w.w), bf_hi(w.w)}; }
                    const f32x4 v0 = r0 * ALPHA + acc[ai][bj][m][0], v1 = r1 * ALPHA + acc[ai][bj][m][1];
                    u32x4 q; q.x = cvt_pk_bf16(v0[0], v0[1]); q.y = cvt_pk_bf16(v0[2], v0[3]); q.z = cvt_pk_bf16(v1[0], v1[1]); q.w = cvt_pk_bf16(v1[2], v1[3]);
                    *(u32x4*)(out + o) = q; } }
    }
};
struct EpiSwiglu {
    static constexpr bool PERM = true, AFTER_DRAIN = false;
    bf16_t* H; int row_tile0;
    __device__ __forceinline__ void operator()(const f32x4 (&acc)[2][2][4][2], const Unit& u, int wr, int wc, int fr, int fq) const {
        const int row0 = (u.pm - row_tile0) * BM + wr * 64 + fr, col = u.pn * HALF + wc * 32 + 8 * fq;
#pragma unroll
        for (int ai = 0; ai < 2; ++ai)
#pragma unroll
            for (int m = 0; m < 4; ++m) {
                float h[8];
#pragma unroll
                for (int n = 0; n < 2; ++n)
#pragma unroll
                    for (int i = 0; i < 4; ++i) { const float g = acc[ai][0][m][n][i], up = acc[ai][1][m][n][i];
                        h[n * 4 + i] = g * __builtin_amdgcn_rcpf(1.f + __builtin_amdgcn_exp2f(-g * LOG2E)) * up; }
                u32x4 w; w.x = cvt_pk_bf16(h[0], h[1]); w.y = cvt_pk_bf16(h[2], h[3]); w.z = cvt_pk_bf16(h[4], h[5]); w.w = cvt_pk_bf16(h[6], h[7]);
                *(u32x4*)(H + (size_t)(row0 + ai * HALF + m * 16) * DFF + col) = w;
            }
    }
};
struct EpiBf16 {
    static constexpr bool PERM = true, AFTER_DRAIN = false;
    bf16_t* O;
    __device__ __forceinline__ void operator()(const f32x4 (&acc)[2][2][4][2], const Unit& u, int wr, int wc, int fr, int fq) const {
        const int row0 = u.pm * BM + wr * 64 + fr, col0 = u.pn * BM + wc * 32 + 8 * fq;
#pragma unroll
        for (int ai = 0; ai < 2; ++ai)
#pragma unroll
            for (int m = 0; m < 4; ++m) { bf16_t* rowp = O + (size_t)(row0 + ai * HALF + m * 16) * DM + col0;
#pragma unroll
                for (int bj = 0; bj < 2; ++bj) { const f32x4 v0 = acc[ai][bj][m][0], v1 = acc[ai][bj][m][1];
                    u32x4 w; w.x = cvt_pk_bf16(v0[0], v0[1]); w.y = cvt_pk_bf16(v0[2], v0[3]); w.z = cvt_pk_bf16(v1[0], v1[1]); w.w = cvt_pk_bf16(v1[2], v1[3]);
                    *(u32x4*)(rowp + bj * HALF) = w; } }
    }
};
struct Proj0OrderA {
    int G, c; const int* rowlist; int gpitch;
    __device__ bool next(int i, Unit& u) const { const int L = i * G + c; if (L >= 256) return false; u.pm = L >> 1; u.pa = u.pm; u.pn = (L & 1) ? 8 : 5; u.pb = u.pn; return true; }
    __device__ __forceinline__ void a_ready(const Unit&) const {}
    __device__ __forceinline__ void done(const Unit&) const {}
};
struct Proj0OrderB {
    StaticOrder so; int G, c; const int* rowlist; int gpitch;
    __device__ bool next(int i, Unit& u) const {
        if (so.next(i, u)) { u.pn = u.pn < 5 ? u.pn : u.pn + 1; u.pb = u.pn; return true; }
        const int L = i * G + c - 896; if (L < 0 || L >= 64) return false;
        const int ct = L >> 1; u.pm = ct; u.pa = (int)((WS_KCMP - WS_XB) / (512 * 1024)) + ct; u.pn = 16 + (L & 1); u.pb = (int)((WS_WC1 - WS_WIN0) / (512 * 1024)) + (ct >> 4) * 2 + (L & 1); return true;
    }
    __device__ __forceinline__ void a_ready(const Unit&) const {}
    __device__ __forceinline__ void done(const Unit&) const {}
};
struct MoeOrder {
    StaticOrder so; int tile0, nN, a_local, gpitch; const LAS int* tile_e; const int* rowlist;
    __device__ bool next(int i, Unit& u) const {
        if (!so.next(i, u)) return false;
        const int tile = tile0 + u.pm; u.pa = a_local ? u.pm : 0; u.pb = tile_e[tile] * nN + u.pn; u.pm = tile; return true;
    }
    __device__ __forceinline__ void a_ready(const Unit&) const {}
    __device__ __forceinline__ void done(const Unit&) const {}
};
}
enum { I_X = 0, I_RELB, I_L0_WIN, I_L0_SINKS, I_CK_POS, I_CK_W1, I_CK_W2, I_CV_POS, I_CV_W1, I_CV_W2, I_L0_WOUT, I_L0_LN1G, I_L0_LN1B, I_L0_GATE, I_L0_UP, I_L0_DOWN, I_L0_LN2G, I_L0_LN2B,
       I_L1_WIN, I_L1_WOUT, I_L1_LN1G, I_L1_LN1B, I_L1_ROUTER, I_L1_EGATE, I_L1_EUP, I_L1_EDOWN, I_L1_LN2G, I_L1_LN2B };

__device__ __forceinline__ void p0_transpose_item(const float* W, int ldw, int ncols, bf16_t* WT, int dk, int k0, int n0, int drow0, LAS float* scr, int lane) {
    const int cn = n0 + (lane & 31); const bool okc = cn < ncols;
    float tv[32];
#pragma unroll
    for (int i = 0; i < 32; ++i) { const int kk = 2 * i + (lane >> 5); tv[i] = okc ? W[(size_t)(k0 + kk) * ldw + cn] : 0.f; }
#pragma unroll
    for (int i = 0; i < 32; ++i) { const int kk = 2 * i + (lane >> 5); scr[kk * 33 + (lane & 31)] = tv[i]; }
    asm volatile("s_waitcnt lgkmcnt(0)" ::: "memory");
    const int c = lane & 7;
#pragma unroll
    for (int j = 0; j < 4; ++j) { const int n = (lane >> 3) + 8 * j; const LAS float* s = scr + (8 * c) * 33 + n;
        u32x4 o; o.x = cvt_pk_bf16(s[0 * 33], s[1 * 33]); o.y = cvt_pk_bf16(s[2 * 33], s[3 * 33]); o.z = cvt_pk_bf16(s[4 * 33], s[5 * 33]); o.w = cvt_pk_bf16(s[6 * 33], s[7 * 33]);
        *(u32x4*)(WT + (size_t)(drow0 + n) * dk + k0 + 8 * c) = o; }
    asm volatile("s_waitcnt lgkmcnt(0)" ::: "memory");
}
struct TJob { const float* W; bf16_t* WT; int ldw, ncols, npad, ksrc, dk, map; };
__device__ __forceinline__ int tjob_items(const TJob& j) { return (j.ksrc / 64) * (j.npad / 32); }
__device__ __forceinline__ void tjob_run(const TJob& j, int item, LAS float* scr, int lane) {
    const int nblk = j.npad / 32, kb = item / nblk, nb = item % nblk, n0 = nb * 32;
    int drow0 = n0; if (j.map) drow0 = 256 * (n0 >> 7) + (n0 & 127) + (j.map == 2 ? 128 : 0);
    p0_transpose_item(j.W, j.ldw, j.ncols, j.WT, j.dk, kb * 64, n0, drow0, scr, lane);
}
__device__ __forceinline__ void p0_prologue(Frame& F, const Args& A) {
    LAS float* scr = (LAS float*)(F.lds + F.wave * 16384);
    const int gw = F.bid * 8 + F.wave, NGW = F.G * 8;
    int base = 0;
#define RUN_JOB(jb) do { const TJob j_ = (jb); const int n_ = tjob_items(j_); \
        int it_ = gw - (base % NGW); if (it_ < 0) it_ += NGW; for (; it_ < n_; it_ += NGW) tjob_run(j_, it_, scr, F.lane); base += n_; } while (0)
    RUN_JOB((TJob{INP(I_L0_WIN), WSP(bf16_t, WS_WIN0), N_IN0, N_IN0, N_IN0P, DM, DM, 0}));
    RUN_JOB((TJob{INP(I_CK_W1), WSP(bf16_t, WS_WC1), 256, 256, 256, 1024, 1024, 0}));
    RUN_JOB((TJob{INP(I_CK_W1) + 1024 * 256, WSP(bf16_t, WS_WC1) + 256 * 1024, 256, 256, 256, 1024, 1024, 0}));
    RUN_JOB((TJob{INP(I_CV_W1), WSP(bf16_t, WS_WC1) + 512 * 1024, 256, 256, 256, 1024, 1024, 0}));
    RUN_JOB((TJob{INP(I_CV_W1) + 1024 * 256, WSP(bf16_t, WS_WC1) + 768 * 1024, 256, 256, 256, 1024, 1024, 0}));
    RUN_JOB((TJob{INP(I_L0_WOUT), WSP(bf16_t, WS_WOUT0), DM, DM, DM, DM, DM, 0}));
    RUN_JOB((TJob{INP(I_L0_GATE), WSP(bf16_t, WS_WGU0), DFF, DFF, DFF, DM, DM, 1}));
    RUN_JOB((TJob{INP(I_L0_UP), WSP(bf16_t, WS_WGU0), DFF, DFF, DFF, DM, DM, 2}));
    RUN_JOB((TJob{INP(I_L0_DOWN), WSP(bf16_t, WS_WDN0), DM, DM, DM, DFF, DFF, 0}));
    RUN_JOB((TJob{INP(I_L1_WIN), WSP(bf16_t, WS_WIN1), N_IN1, N_IN1, N_IN1P, DM, DM, 0}));
    RUN_JOB((TJob{INP(I_L1_WOUT), WSP(bf16_t, WS_WOUT1), DM, DM, DM, DM, DM, 0}));
    for (int e = 0; e < NEXP; ++e) {
        RUN_JOB((TJob{INP(I_L1_EGATE) + (size_t)e * DM * DFF, WSP(bf16_t, WS_WGU1) + (size_t)e * 2 * DFF * DM, DFF, DFF, DFF, DM, DM, 1}));
        RUN_JOB((TJob{INP(I_L1_EUP) + (size_t)e * DM * DFF, WSP(bf16_t, WS_WGU1) + (size_t)e * 2 * DFF * DM, DFF, DFF, DFF, DM, DM, 2}));
        RUN_JOB((TJob{INP(I_L1_EDOWN) + (size_t)e * DFF * DM, WSP(bf16_t, WS_WDN1) + (size_t)e * DM * DFF, DM, DM, DM, DFF, DFF, 0}));
    }
#undef RUN_JOB
    {   const float* xin = INP(I_X);
        for (int m = 4 * gw; m < T; m += 4 * NGW) {
            f32x4 v[4][4];
#pragma unroll
            for (int r = 0; r < 4; ++r)
#pragma unroll
                for (int j = 0; j < 4; ++j) v[r][j] = *((const f32x4*)(xin + (size_t)(m + r) * DM) + F.lane + 64 * j);
#pragma unroll
            for (int r = 0; r < 4; ++r)
#pragma unroll
                for (int j = 0; j < 4; ++j) { u32x2 w; w.x = cvt_pk_bf16(v[r][j][0], v[r][j][1]); w.y = cvt_pk_bf16(v[r][j][2], v[r][j][3]); *((u32x2*)(WSP(bf16_t, WS_XB) + (size_t)(m + r) * DM) + F.lane + 64 * j) = w; }
        }
    }
    for (int it = F.bid; it < 32; it += F.G) {
        const int which = it >> 4, sl = it & 15;
        if (F.tid < 256) {
            const float* pos = INP(which ? I_CV_POS : I_CK_POS) + sl * 128; const float* w1 = INP(which ? I_CV_W1 : I_CK_W1) + (size_t)sl * 128 * 256 + F.tid;
            float s = 0.f;
#pragma unroll 8
            for (int r = 0; r < 128; ++r) s += pos[r] * w1[(size_t)r * 256];
            WSP(float, WS_POSW)[(which * 16 + sl) * 256 + F.tid] = s;
        }
    }
}

__device__ __forceinline__ void p2b_compress_tail(Frame& F, const Args& A) {
    LAS float* hid = (LAS float*)(F.lds + F.wave * 1024);
    const int gw = F.bid * 8 + F.wave, NGW = F.G * 8;
    const float* H = WSP(float, WS_HCMP); const float* PW = WSP(float, WS_POSW);
    for (int it = gw; it < 2 * 16 * 256; it += NGW) {
        const int which = it >> 12, bg = (it >> 8) & 15, n = it & 255;
        bf16_t* dst = WSP(bf16_t, WS_KC) + ((size_t)(which * 16 + bg) * 256 + n) * 64;
        if (n == 255) { dst[F.lane] = 0; continue; }
        const size_t r0 = (size_t)(which * 4096 + bg * 256 + n) * 512;
        const f32x4 a = *(const f32x4*)(H + r0 + 4 * F.lane), b = *(const f32x4*)(H + r0 + 512 + 256 + 4 * F.lane);
        f32x4 pw = {0.f, 0.f, 0.f, 0.f};
#pragma unroll
        for (int s = 0; s < 16; ++s) pw += *(const f32x4*)(PW + (which * 16 + s) * 256 + 4 * F.lane);
        const f32x4 v = a + b + pw; f32x4 g;
#pragma unroll
        for (int i = 0; i < 4; ++i) { const float x = v[i], u = 0.7978845608028654f * (x + 0.044715f * x * x * x); const float th = 1.f - 2.f / (1.f + __expf(2.f * u)); g[i] = 0.5f * x * (1.f + th); }
        *(LAS f32x4*)(hid + 4 * F.lane) = g;
        asm volatile("s_waitcnt lgkmcnt(0)" ::: "memory");
        const float* w2 = INP(which ? I_CV_W2 : I_CK_W2) + F.lane; float acc = 0.f;
#pragma unroll 8
        for (int j = 0; j < 256; ++j) acc += hid[j] * w2[(size_t)j * 64];
        dst[F.lane] = (bf16_t)(cvt_pk_bf16(acc, 0.f) & 0xffffu);
        asm volatile("s_waitcnt lgkmcnt(0)" ::: "memory");
    }
}

__device__ __forceinline__ f32x4 ld_bf4(const bf16_t* p) { const u32x2 w = *(const u32x2*)p; return (f32x4){bf_lo(w.x), bf_hi(w.x), bf_lo(w.y), bf_hi(w.y)}; }
__device__ __forceinline__ void ln_row(const bf16_t* y, const float* g, const float* b, int lane, f32x4 (&v)[4]) {
    float s = 0.f;
#pragma unroll
    for (int j = 0; j < 4; ++j) { v[j] = ld_bf4(y + 4 * (lane + 64 * j)); s += (v[j][0] + v[j][1]) + (v[j][2] + v[j][3]); }
    const float mean = wave_sum(s) * (1.f / DM); float s2 = 0.f;
#pragma unroll
    for (int j = 0; j < 4; ++j) { v[j] = v[j] - mean; s2 += (v[j][0] * v[j][0] + v[j][1] * v[j][1]) + (v[j][2] * v[j][2] + v[j][3] * v[j][3]); }
    const float rstd = 1.f / sqrtf(wave_sum(s2) * (1.f / DM) + LN_EPS);
#pragma unroll
    for (int j = 0; j < 4; ++j) { const f32x4 gg = *((const f32x4*)g + lane + 64 * j), bb = *((const f32x4*)b + lane + 64 * j); v[j] = v[j] * rstd * gg + bb; }
}
__device__ __forceinline__ void ln_row2(const bf16_t* y0, const bf16_t* y1, const float* g, const float* b, int lane, f32x4 (&v)[4], f32x4 (&w)[4]) {
    float s = 0.f, t = 0.f;
#pragma unroll
    for (int j = 0; j < 4; ++j) { v[j] = ld_bf4(y0 + 4 * (lane + 64 * j)); w[j] = ld_bf4(y1 + 4 * (lane + 64 * j)); }
#pragma unroll
    for (int j = 0; j < 4; ++j) { s += (v[j][0] + v[j][1]) + (v[j][2] + v[j][3]); t += (w[j][0] + w[j][1]) + (w[j][2] + w[j][3]); }
#pragma unroll
    for (int o = 1; o < 64; o <<= 1) { s += __shfl_xor(s, o); t += __shfl_xor(t, o); }
    const float m0 = s * (1.f / DM), m1 = t * (1.f / DM); float s2 = 0.f, t2 = 0.f;
#pragma unroll
    for (int j = 0; j < 4; ++j) { v[j] = v[j] - m0; w[j] = w[j] - m1; s2 += (v[j][0] * v[j][0] + v[j][1] * v[j][1]) + (v[j][2] * v[j][2] + v[j][3] * v[j][3]); t2 += (w[j][0] * w[j][0] + w[j][1] * w[j][1]) + (w[j][2] * w[j][2] + w[j][3] * w[j][3]); }
#pragma unroll
    for (int o = 1; o < 64; o <<= 1) { s2 += __shfl_xor(s2, o); t2 += __shfl_xor(t2, o); }
    const float r0 = 1.f / sqrtf(s2 * (1.f / DM) + LN_EPS), r1 = 1.f / sqrtf(t2 * (1.f / DM) + LN_EPS);
#pragma unroll
    for (int j = 0; j < 4; ++j) { const f32x4 gg = *((const f32x4*)g + lane + 64 * j), bb = *((const f32x4*)b + lane + 64 * j); v[j] = v[j] * r0 * gg + bb; w[j] = w[j] * r1 * gg + bb; }
}
template <int N>
__device__ __forceinline__ void ln_rowsN(const bf16_t* y, const float* g, const float* b, int lane, f32x4 (&v)[N][4]) {
    float s[N], s2[N];
#pragma unroll
    for (int r = 0; r < N; ++r)
#pragma unroll
        for (int j = 0; j < 4; ++j) v[r][j] = ld_bf4(y + (size_t)r * DM + 4 * (lane + 64 * j));
#pragma unroll
    for (int r = 0; r < N; ++r) { s[r] = 0.f;
#pragma unroll
        for (int j = 0; j < 4; ++j) s[r] += (v[r][j][0] + v[r][j][1]) + (v[r][j][2] + v[r][j][3]); }
#pragma unroll
    for (int o = 1; o < 64; o <<= 1)
#pragma unroll
        for (int r = 0; r < N; ++r) s[r] += __shfl_xor(s[r], o);
#pragma unroll
    for (int r = 0; r < N; ++r) { const float m0 = s[r] * (1.f / DM); s2[r] = 0.f;
#pragma unroll
        for (int j = 0; j < 4; ++j) { v[r][j] = v[r][j] - m0; s2[r] += (v[r][j][0] * v[r][j][0] + v[r][j][1] * v[r][j][1]) + (v[r][j][2] * v[r][j][2] + v[r][j][3] * v[r][j][3]); } }
#pragma unroll
    for (int o = 1; o < 64; o <<= 1)
#pragma unroll
        for (int r = 0; r < N; ++r) s2[r] += __shfl_xor(s2[r], o);
#pragma unroll
    for (int j = 0; j < 4; ++j) { const f32x4 gg = *((const f32x4*)g + lane + 64 * j), bb = *((const f32x4*)b + lane + 64 * j);
#pragma unroll
        for (int r = 0; r < N; ++r) { const float rs = 1.f / sqrtf(s2[r] * (1.f / DM) + LN_EPS); v[r][j] = v[r][j] * rs * gg + bb; } }
}
__device__ __forceinline__ void p_layernorm(Frame& F, const bf16_t* y, const float* g, const float* b, bf16_t* ob) {
    const int gw = F.bid * 8 + F.wave, NGW = F.G * 8;
    for (int m = 4 * gw; m < T; m += 4 * NGW) {
        f32x4 v[4][4]; ln_rowsN<4>(y + (size_t)m * DM, g, b, F.lane, v);
#pragma unroll
        for (int r = 0; r < 4; ++r) { u32x2* o = (u32x2*)(ob + (size_t)(m + r) * DM) + F.lane;
#pragma unroll
            for (int j = 0; j < 4; ++j) { u32x2 q; q.x = cvt_pk_bf16(v[r][j][0], v[r][j][1]); q.y = cvt_pk_bf16(v[r][j][2], v[r][j][3]); o[64 * j] = q; } }
    }
}
struct TokInfo { int p0, p1; float g0, g1; };
__device__ __forceinline__ void p12_ln_router(Frame& F, const Args& A) {
    LAS float* rt = (LAS float*)F.lds;
    LAS int* cnt = (LAS int*)(F.lds + 32768);
    { const float* rg = INP(I_L1_ROUTER); for (int i = F.tid; i < DM * NEXP; i += 512) rt[(i & 7) * DM + (i >> 3)] = rg[i]; }
    if (F.tid < 8) cnt[F.tid] = 0;
    for (int i = F.bid * 512 + F.tid; i < 264 * 256; i += F.G * 512) WSP(int, WS_ROWTOK)[i] = 0;
    __syncthreads();
    const bf16_t* y = WSP(bf16_t, WS_Y3); bf16_t* xb = (bf16_t*)F.out + 1024; TokInfo* ti = WSP(TokInfo, WS_TOKINFO);
    for (int blk = F.bid; blk < T / 128; blk += F.G) {
        constexpr int NTK = 4;
        for (int i = 0; i < 16; i += NTK) {
            const int m = blk * 128 + F.wave * 16 + i;
            f32x4 v[NTK][4]; ln_rowsN<NTK>(y + (size_t)m * DM, INP(I_L1_LN1G), INP(I_L1_LN1B), F.lane, v);
            float lg[NTK][8];
#pragma unroll
            for (int q = 0; q < NTK; ++q) {
                u32x2* o = (u32x2*)(xb + (size_t)(m + q) * 2048) + F.lane;
#pragma unroll
                for (int j = 0; j < 4; ++j) { u32x2 w; w.x = cvt_pk_bf16(v[q][j][0], v[q][j][1]); w.y = cvt_pk_bf16(v[q][j][2], v[q][j][3]); o[64 * j] = w; }
            }
#pragma unroll
            for (int e = 0; e < 8; ++e) { float s[NTK];
#pragma unroll
                for (int q = 0; q < NTK; ++q) s[q] = 0.f;
#pragma unroll
                for (int j = 0; j < 4; ++j) { const f32x4 r = *(const LAS f32x4*)(rt + e * DM + 4 * (F.lane + 64 * j));
#pragma unroll
                    for (int q = 0; q < NTK; ++q) s[q] += (v[q][j][0] * r[0] + v[q][j][1] * r[1]) + (v[q][j][2] * r[2] + v[q][j][3] * r[3]); }
#pragma unroll
                for (int q = 0; q < NTK; ++q) lg[q][e] = s[q]; }
            {
                const bool b0 = F.lane & 1, b1 = F.lane & 2, b2 = F.lane & 4;
                float r4[NTK][4], r2[NTK][2], r1[NTK];
#pragma unroll
                for (int q = 0; q < NTK; ++q)
#pragma unroll
                    for (int k = 0; k < 4; ++k) { const float send = b0 ? lg[q][k] : lg[q][k + 4], keep = b0 ? lg[q][k + 4] : lg[q][k]; r4[q][k] = keep + __shfl_xor(send, 1); }
#pragma unroll
                for (int q = 0; q < NTK; ++q)
#pragma unroll
                    for (int k = 0; k < 2; ++k) { const float send = b1 ? r4[q][k] : r4[q][k + 2], keep = b1 ? r4[q][k + 2] : r4[q][k]; r2[q][k] = keep + __shfl_xor(send, 2); }
#pragma unroll
                for (int q = 0; q < NTK; ++q) { const float send = b2 ? r2[q][0] : r2[q][1], keep = b2 ? r2[q][1] : r2[q][0]; r1[q] = keep + __shfl_xor(send, 4); }
#pragma unroll
                for (int o_ = 8; o_ < 64; o_ <<= 1)
#pragma unroll
                    for (int q = 0; q < NTK; ++q) r1[q] += __shfl_xor(r1[q], o_);
#pragma unroll
                for (int q = 0; q < NTK; ++q) { const int ri = __float_as_int(r1[q]);
                    lg[q][0] = __int_as_float(__builtin_amdgcn_readlane(ri, 0)); lg[q][1] = __int_as_float(__builtin_amdgcn_readlane(ri, 4)); lg[q][2] = __int_as_float(__builtin_amdgcn_readlane(ri, 2)); lg[q][3] = __int_as_float(__builtin_amdgcn_readlane(ri, 6));
                    lg[q][4] = __int_as_float(__builtin_amdgcn_readlane(ri, 1)); lg[q][5] = __int_as_float(__builtin_amdgcn_readlane(ri, 5)); lg[q][6] = __int_as_float(__builtin_amdgcn_readlane(ri, 3)); lg[q][7] = __int_as_float(__builtin_amdgcn_readlane(ri, 7)); }
            }
#pragma unroll
            for (int q = 0; q < NTK; ++q) {
                int e0 = 0; float v0 = lg[q][0];
#pragma unroll
                for (int e = 1; e < 8; ++e) if (lg[q][e] > v0) { v0 = lg[q][e]; e0 = e; }
                int e1 = -1; float v1 = -3.0e38f;
#pragma unroll
                for (int e = 0; e < 8; ++e) if (e != e0 && lg[q][e] > v1) { v1 = lg[q][e]; e1 = e; }
                const float g1 = 1.f / (1.f + __expf(v0 - v1)), g0 = 1.f - g1;
                if (F.lane == 0) { ti[m + q] = TokInfo{e0, e1, g0, g1}; atomicAdd((int*)&cnt[e0], 1); atomicAdd((int*)&cnt[e1], 1); }
            }
        }
        __syncthreads();
        if (F.tid < 8) { WSP(int, WS_MOECNT)[blk * 8 + F.tid] = cnt[F.tid]; cnt[F.tid] = 0; }
        __syncthreads();
    }
}
__device__ __forceinline__ void p13_moe_dispatch(Frame& F, const Args& A) {
    LAS int* call = (LAS int*)F.lds;
    LAS int* base = (LAS int*)(F.lds + 8192);
    LAS int* segs = (LAS int*)(F.lds + 8192 + 64);
    LAS int* pos = (LAS int*)(F.lds + 8192 + 128);
    for (int i = F.tid; i < 2048; i += 512) call[i] = WSP(int, WS_MOECNT)[i];
    __syncthreads();
    TokInfo* ti = WSP(TokInfo, WS_TOKINFO);
    for (int blk = F.bid; blk < T / 128; blk += F.G) {
        if (F.tid < 8) { int tot = 0, pre = 0; for (int w = 0; w < 256; ++w) { const int c = call[w * 8 + F.tid]; if (w < blk) pre += c; tot += c; } base[F.tid] = pre; segs[F.tid] = (tot + 255) & ~255; }
        __syncthreads();
        if (F.tid == 0) { int s = 0; for (int e = 0; e < 8; ++e) { const int p = segs[e]; segs[e] = s; base[e] += s; s += p; } segs[8] = s;
            if (blk == 0) { int* meta = WSP(int, WS_MOEMETA); meta[0] = s / 256; for (int e = 0; e <= 8; ++e) meta[1 + e] = segs[e] / 256; } }
        __syncthreads();
        if (F.wave == 0) {
            int run[8];
#pragma unroll
            for (int e = 0; e < 8; ++e) run[e] = base[e];
            for (int st = 0; st < 4; ++st) {
                const int tk = (st >> 1) * 64 + F.lane, slot = st & 1; const TokInfo t = ti[blk * 128 + tk]; const int me = slot ? t.p1 : t.p0; int p = 0;
#pragma unroll
                for (int e = 0; e < 8; ++e) { const unsigned long long mk = __ballot(me == e); if (me == e) p = run[e] + __popcll(mk & ((1ull << F.lane) - 1ull)); run[e] += __popcll(mk); }
                pos[tk * 2 + slot] = p;
            }
        }
        __syncthreads();
        if (F.tid < 128) { TokInfo t = ti[blk * 128 + F.tid]; t.p0 = pos[F.tid * 2]; t.p1 = pos[F.tid * 2 + 1]; ti[blk * 128 + F.tid] = t; }
        if (F.tid < 256) WSP(int, WS_ROWTOK)[pos[F.tid]] = blk * 128 + (F.tid >> 1);
        __syncthreads();
    }
}
__device__ __forceinline__ int moe_tile_table(Frame& F, LAS int* tile_e) {
    const int* meta = WSP(int, WS_MOEMETA); const int NT = meta[0];
    for (int t = F.tid; t < MOE_MAX_TILES; t += 512) { int e = 0;
#pragma unroll
        for (int k = 1; k < 8; ++k) e += (t >= meta[1 + k]) ? 1 : 0;
        tile_e[t] = e; }
    __syncthreads();
    return NT;
}
__device__ __forceinline__ void p_final(Frame& F, const Args& A) {
    const int gw = F.bid * 8 + F.wave, NGW = F.G * 8; const TokInfo* ti = WSP(TokInfo, WS_TOKINFO); const bf16_t* O = WSP(bf16_t, WS_XG);
    const float* lg = INP(I_L1_LN2G); const float* lb = INP(I_L1_LN2B);
    for (int m = 2 * gw; m < T; m += 2 * NGW) {
        f32x4 v[2][4]; float s[2], s2[2];
#pragma unroll
        for (int q = 0; q < 2; ++q) {
            const TokInfo t = ti[m + q]; const bf16_t* xs = (const bf16_t*)F.out + (size_t)(m + q) * 2048 + 1024;
            const u32x2* o0 = (const u32x2*)(O + (size_t)t.p0 * DM) + F.lane; const u32x2* o1 = (const u32x2*)(O + (size_t)t.p1 * DM) + F.lane;
            s[q] = 0.f;
#pragma unroll
            for (int j = 0; j < 4; ++j) { const f32x4 x = ld_bf4(xs + 4 * (F.lane + 64 * j)); const u32x2 a = o0[64 * j], b = o1[64 * j];
                const f32x4 fa = {bf_lo(a.x), bf_hi(a.x), bf_lo(a.y), bf_hi(a.y)}, fb = {bf_lo(b.x), bf_hi(b.x), bf_lo(b.y), bf_hi(b.y)};
                v[q][j] = x * ALPHA + (fa * t.g0 + fb * t.g1); s[q] += (v[q][j][0] + v[q][j][1]) + (v[q][j][2] + v[q][j][3]); }
        }
#pragma unroll
        for (int o = 1; o < 64; o <<= 1) { s[0] += __shfl_xor(s[0], o); s[1] += __shfl_xor(s[1], o); }
#pragma unroll
        for (int q = 0; q < 2; ++q) { const float mean = s[q] * (1.f / DM); s2[q] = 0.f;
#pragma unroll
            for (int j = 0; j < 4; ++j) { v[q][j] = v[q][j] - mean; s2[q] += (v[q][j][0] * v[q][j][0] + v[q][j][1] * v[q][j][1]) + (v[q][j][2] * v[q][j][2] + v[q][j][3] * v[q][j][3]); } }
#pragma unroll
        for (int o = 1; o < 64; o <<= 1) { s2[0] += __shfl_xor(s2[0], o); s2[1] += __shfl_xor(s2[1], o); }
#pragma unroll
        for (int q = 0; q < 2; ++q) { const float rstd = 1.f / sqrtf(s2[q] * (1.f / DM) + LN_EPS); f32x4* yr = (f32x4*)(F.out + (size_t)(m + q) * DM) + F.lane;
#pragma unroll
            for (int j = 0; j < 4; ++j) { const f32x4 gg = *((const f32x4*)lg + F.lane + 64 * j), bb = *((const f32x4*)lb + F.lane + 64 * j); yr[64 * j] = v[q][j] * rstd * gg + bb; } }
    }
}
namespace att {
constexpr int KROW = 144;
constexpr int TILE_B = 64 * KROW;
constexpr int L_K = 0, L_V = 2 * TILE_B, L_OV = 4 * TILE_B;
constexpr int L_LUT = 6 * TILE_B;
constexpr int L_IMP = L_LUT + 2048;
constexpr int L_SELM = L_IMP + 4 * 64 * 65 * 4;
constexpr int L_END = L_SELM + 512;
static_assert(L_END <= RING_BYTES, "attention LDS map");
constexpr float NEG_INF = -__builtin_huge_valf();
constexpr int L_LUT2 = LDS_EXTRA_OFF, LUT2_N = 704, LUT2_K = 639;
constexpr int L_LUT3 = LDS_EXTRA_OFF + 4 * LUT2_N * 4, LUT3_N = 320, LUT3_K = 255;
static_assert(L_LUT3 + 4 * LUT3_N * 4 <= LDS_MISC_OFF, "attention LUT map");
constexpr float RESC_THR = 8.f;

__device__ __forceinline__ s16x4 vtr(const LAS char* p) { return __builtin_bit_cast(s16x4, __builtin_amdgcn_ds_read_tr16_b64_v4i16((LAS s16x4*)p)); }

template <int MODE, int NDB>
__device__ __forceinline__ void attn_tile(const LAS char* Kt, const LAS char* Vt, const LAS char* OVt, const bf16x8 (&qf)[4], f32x16 (&o)[NDB], float& m, float& l,
                                          int tq, int key0, int W, bool lanesel, const LAS float* lut, int lane) {
    const int r32 = lane & 31, h = lane >> 5;
    f32x16 s0, s1;
#pragma unroll
    for (int r = 0; r < 16; ++r) { s0[r] = 0.f; s1[r] = 0.f; }
#pragma unroll
    for (int ks = 0; ks < 4; ++ks) {
        const bf16x8 k0 = *(const LAS bf16x8*)(Kt + r32 * KROW + (16 * ks + 8 * h) * 2);
        const bf16x8 k1 = *(const LAS bf16x8*)(Kt + (32 + r32) * KROW + (16 * ks + 8 * h) * 2);
        s0 = __builtin_amdgcn_mfma_f32_32x32x16_bf16(k0, qf[ks], s0, 0, 0, 0);
        s1 = __builtin_amdgcn_mfma_f32_32x32x16_bf16(k1, qf[ks], s1, 0, 0, 0);
    }
    float mx = NEG_INF;
    asm volatile("" ::: "memory");
#pragma unroll
    for (int kb = 0; kb < 2; ++kb) {
#pragma unroll
        for (int r = 0; r < 16; ++r) {
            const int key = key0 + 32 * kb + (r & 3) + 8 * (r >> 2) + 4 * h;
            const int dist = (MODE == 2) ? (tq - 16 * key - 31) : (tq - key);
            const int idx = dist < 0 ? 0 : (dist > 113 ? 113 : dist);
            bool valid;
            if (MODE == 0) valid = (unsigned)dist < (unsigned)W;
            else if (MODE == 1) valid = lanesel && dist >= 0;
            else valid = dist >= 0 && key < 255;
            float v = (kb ? s1[r] : s0[r]) + lut[idx];
            v = valid ? v : NEG_INF;
            if (kb) s1[r] = v; else s0[r] = v;
            mx = fmaxf(mx, v);
        }
        asm volatile("" ::: "memory");
    }
    mx = swap_max(mx);
    const float mnew = fmaxf(m, mx), alpha = __builtin_amdgcn_exp2f(m - mnew);
    float rs = 0.f;
#pragma unroll
    for (int r = 0; r < 16; ++r) { s0[r] = __builtin_amdgcn_exp2f(s0[r] - mnew); s1[r] = __builtin_amdgcn_exp2f(s1[r] - mnew); rs += s0[r] + s1[r]; }
    rs = swap_sum(rs);
    l = l * alpha + rs; m = mnew;
#pragma unroll
    for (int db = 0; db < NDB; ++db)
#pragma unroll
        for (int r = 0; r < 16; ++r) o[db][r] *= alpha;
    const int q4 = (lane & 15) >> 2, p4 = lane & 3, g2 = (lane >> 4) & 1;
#pragma unroll
    for (int kb = 0; kb < 2; ++kb)
#pragma unroll
        for (int s = 0; s < 2; ++s) {
            u32x4 pw;
            if (kb == 0) { pw.x = cvt_pk_bf16(s0[8 * s + 0], s0[8 * s + 1]); pw.y = cvt_pk_bf16(s0[8 * s + 2], s0[8 * s + 3]); pw.z = cvt_pk_bf16(s0[8 * s + 4], s0[8 * s + 5]); pw.w = cvt_pk_bf16(s0[8 * s + 6], s0[8 * s + 7]); }
            else { pw.x = cvt_pk_bf16(s1[8 * s + 0], s1[8 * s + 1]); pw.y = cvt_pk_bf16(s1[8 * s + 2], s1[8 * s + 3]); pw.z = cvt_pk_bf16(s1[8 * s + 4], s1[8 * s + 5]); pw.w = cvt_pk_bf16(s1[8 * s + 6], s1[8 * s + 7]); }
            const bf16x8 pb = __builtin_bit_cast(bf16x8, pw);
            const int rowoff = (32 * kb + 16 * s + 4 * h + q4) * KROW;
#pragma unroll
            for (int db = 0; db < NDB; ++db) {
                const LAS char* base = (db < 2 ? Vt : OVt) + rowoff + (32 * (db & 1) + 16 * g2 + 4 * p4) * 2;
                const s16x4 lo = vtr(base), hi = vtr(base + 8 * KROW);
                const bf16x8 vf = {lo[0], lo[1], lo[2], lo[3], hi[0], hi[1], hi[2], hi[3]};
                o[db] = __builtin_amdgcn_mfma_f32_32x32x16_bf16(vf, pb, o[db], 0, 0, 0);
            }
            asm volatile("" ::: "memory");
        }
}


template <int MODE>
__device__ __forceinline__ void attn_tile_fast(const LAS char* Kt, const LAS char* Vt, const bf16x8 (&qf)[4], f32x16 (&o)[2], float& m, float& l,
                                               bool lanesel, bool use_lut, const LAS float* lutp, float cfar, int lane) {
    const int r32 = lane & 31, h = lane >> 5;
    float ci = use_lut ? -m : (cfar - m);
    if (MODE == 1) ci = lanesel ? ci : NEG_INF;
    f32x16 s0, s1;
#pragma unroll
    for (int r = 0; r < 16; ++r) { s0[r] = ci; s1[r] = ci; }
#pragma unroll
    for (int ks = 0; ks < 4; ++ks) {
        const bf16x8 k0 = *(const LAS bf16x8*)(Kt + r32 * KROW + (16 * ks + 8 * h) * 2);
        const bf16x8 k1 = *(const LAS bf16x8*)(Kt + (32 + r32) * KROW + (16 * ks + 8 * h) * 2);
        s0 = __builtin_amdgcn_mfma_f32_32x32x16_bf16(k0, qf[ks], s0, 0, 0, 0);
        s1 = __builtin_amdgcn_mfma_f32_32x32x16_bf16(k1, qf[ks], s1, 0, 0, 0);
    }
    if (use_lut) {
#pragma unroll
        for (int r = 0; r < 16; ++r) { s0[r] += lutp[(r & 3) + 8 * (r >> 2)]; s1[r] += lutp[32 + (r & 3) + 8 * (r >> 2)]; }
    }
    float mx = fmaxf(s0[0], s1[0]);
#pragma unroll
    for (int r = 1; r < 16; ++r) mx = fmaxf(fmaxf(mx, s0[r]), s1[r]);
    mx = swap_max(mx);
    if (__any(mx > RESC_THR)) {
        const float dl = fmaxf(mx, 0.f), f = __builtin_amdgcn_exp2f(-dl);
        m += dl; l *= f;
#pragma unroll
        for (int r = 0; r < 16; ++r) { s0[r] -= dl; s1[r] -= dl; o[0][r] *= f; o[1][r] *= f; }
    }
    const int q4 = (lane & 15) >> 2, p4 = lane & 3, g2 = (lane >> 4) & 1;
    float rs = 0.f;
#pragma unroll
    for (int kb = 0; kb < 2; ++kb)
#pragma unroll
        for (int s = 0; s < 2; ++s) {
            float e[8];
#pragma unroll
            for (int i = 0; i < 8; ++i) { e[i] = __builtin_amdgcn_exp2f(kb ? s1[8 * s + i] : s0[8 * s + i]); rs += e[i]; }
            u32x4 pw; pw.x = cvt_pk_bf16(e[0], e[1]); pw.y = cvt_pk_bf16(e[2], e[3]); pw.z = cvt_pk_bf16(e[4], e[5]); pw.w = cvt_pk_bf16(e[6], e[7]);
            const bf16x8 pb = __builtin_bit_cast(bf16x8, pw);
            const int rowoff = (32 * kb + 16 * s + 4 * h + q4) * KROW;
#pragma unroll
            for (int db = 0; db < 2; ++db) {
                const LAS char* base = Vt + rowoff + (32 * db + 16 * g2 + 4 * p4) * 2;
                const s16x4 lo = vtr(base), hi = vtr(base + 8 * KROW);
                const bf16x8 vf = {lo[0], lo[1], lo[2], lo[3], hi[0], hi[1], hi[2], hi[3]};
                o[db] = __builtin_amdgcn_mfma_f32_32x32x16_bf16(vf, pb, o[db], 0, 0, 0);
            }
            __builtin_amdgcn_sched_barrier(0);
        }
    l += swap_sum(rs);
}

template <int MODE, int NDB>
__device__ __forceinline__ void run_branch(LAS unsigned char* lds, const bf16_t* Kg, const bf16_t* Vg, int pitch, unsigned long long tiles, const bf16x8 (&qf)[4], f32x16 (&o)[NDB], float& m, float& l,
                                           int tq, int W, unsigned long long selm, const LAS float* lut, int tid, int lane) {
    const int lrow = tid >> 3, lch = tid & 7;
    if (tiles == 0ull) return;
    int j = __builtin_ctzll(tiles); tiles &= tiles - 1ull;
    auto gen_ov = [&](int tile, int b) {
        const int n = 64 * tile + lrow; unsigned short e[8];
#pragma unroll
        for (int i = 0; i < 8; ++i) { const int d = n - 4 * (8 * lch + i); e[i] = (n < 255 && d >= -1 && d <= 3) ? ((d == -1 || d == 3) ? (unsigned short)0x3f00 : (unsigned short)0x3f80) : (unsigned short)0; }
        u32x4 w; w.x = e[0] | ((unsigned)e[1] << 16); w.y = e[2] | ((unsigned)e[3] << 16); w.z = e[4] | ((unsigned)e[5] << 16); w.w = e[6] | ((unsigned)e[7] << 16);
        *(LAS u32x4*)(lds + L_OV + b * TILE_B + lrow * KROW + lch * 16) = w;
    };
#define ATT_LD(K_, V_, t_) do { K_ = *(const u32x4*)(Kg + (size_t)((t_) * 64 + lrow) * pitch + lch * 8); V_ = *(const u32x4*)(Vg + (size_t)((t_) * 64 + lrow) * pitch + lch * 8); } while (0)
#define ATT_ST(K_, V_, b_) do { *(LAS u32x4*)(lds + L_K + (b_) * TILE_B + lrow * KROW + lch * 16) = K_; *(LAS u32x4*)(lds + L_V + (b_) * TILE_B + lrow * KROW + lch * 16) = V_; } while (0)
    u32x4 kra, vra, krb, vrb;
    ATT_LD(kra, vra, j);
    int jn = -1;
    if (tiles != 0ull) { jn = __builtin_ctzll(tiles); tiles &= tiles - 1ull; }
    ATT_LD(krb, vrb, (jn < 0 ? j : jn));
    ATT_ST(kra, vra, 0);
    if (MODE == 2) gen_ov(j, 0);
    __syncthreads();
    for (;;) {
        int jnn = -1;
        if (tiles != 0ull) { jnn = __builtin_ctzll(tiles); tiles &= tiles - 1ull; }
        ATT_LD(kra, vra, (jnn < 0 ? j : jnn));
        {
        const bool lanesel = (MODE == 1) ? ((selm >> j) & 1ull) != 0ull : true;
        if constexpr (MODE == 2) {
            attn_tile<MODE, NDB>((const LAS char*)(lds + L_K + 0 * TILE_B), (const LAS char*)(lds + L_V + 0 * TILE_B), (const LAS char*)(lds + L_OV + 0 * TILE_B), qf, o, m, l, tq, 64 * j, W, lanesel, lut, lane);
        } else if (MODE != 1 || __ballot(lanesel) != 0ull) {
            const int tq0w = tq - (lane & 31);
            const int dmin = tq0w - 64 * j - 63, dmax = tq0w + 31 - 64 * j;
            const bool use_lut = (MODE == 0) ? !(dmin >= 113 && dmax < W) : !(dmin >= 113);
            const int r_ = (tid >> 6) & 3;
            const LAS float* lutp = (MODE == 0) ? (const LAS float*)(lds + L_LUT2) + r_ * LUT2_N + (64 * j + 4 * (lane >> 5) - tq + LUT2_K)
                                               : (const LAS float*)(lds + L_LUT3) + r_ * LUT3_N + (64 * j + 4 * (lane >> 5) - tq + LUT3_K);
            attn_tile_fast<MODE>((const LAS char*)(lds + L_K + 0 * TILE_B), (const LAS char*)(lds + L_V + 0 * TILE_B), qf, o, m, l, lanesel, use_lut, lutp, lut[113], lane);
        }
        }
        if (jn < 0) break;
        ATT_ST(krb, vrb, 1);
        if (MODE == 2) gen_ov(jn, 1);
        __syncthreads();
        int jn3 = -1;
        if (tiles != 0ull) { jn3 = __builtin_ctzll(tiles); tiles &= tiles - 1ull; }
        ATT_LD(krb, vrb, (jn3 < 0 ? jn : jn3));
        {
        const bool lanesel = (MODE == 1) ? ((selm >> jn) & 1ull) != 0ull : true;
        if constexpr (MODE == 2) {
            attn_tile<MODE, NDB>((const LAS char*)(lds + L_K + 1 * TILE_B), (const LAS char*)(lds + L_V + 1 * TILE_B), (const LAS char*)(lds + L_OV + 1 * TILE_B), qf, o, m, l, tq, 64 * jn, W, lanesel, lut, lane);
        } else if (MODE != 1 || __ballot(lanesel) != 0ull) {
            const int tq0w = tq - (lane & 31);
            const int dmin = tq0w - 64 * jn - 63, dmax = tq0w + 31 - 64 * jn;
            const bool use_lut = (MODE == 0) ? !(dmin >= 113 && dmax < W) : !(dmin >= 113);
            const int r_ = (tid >> 6) & 3;
            const LAS float* lutp = (MODE == 0) ? (const LAS float*)(lds + L_LUT2) + r_ * LUT2_N + (64 * jn + 4 * (lane >> 5) - tq + LUT2_K)
                                               : (const LAS float*)(lds + L_LUT3) + r_ * LUT3_N + (64 * jn + 4 * (lane >> 5) - tq + LUT3_K);
            attn_tile_fast<MODE>((const LAS char*)(lds + L_K + 1 * TILE_B), (const LAS char*)(lds + L_V + 1 * TILE_B), qf, o, m, l, lanesel, use_lut, lutp, lut[113], lane);
        }
        }
        if (jnn < 0) break;
        ATT_ST(kra, vra, 0);
        if (MODE == 2) gen_ov(jnn, 0);
        __syncthreads();
        j = jnn; jn = jn3;
    }
#undef ATT_LD
#undef ATT_ST
    __syncthreads();
}

__device__ __forceinline__ unsigned long long tile_range(int lo, int hi) {
    const unsigned long long a = (hi >= 63) ? ~0ull : ((1ull << (hi + 1)) - 1ull);
    return a & ~((1ull << lo) - 1ull);
}

__device__ __forceinline__ void build_lut(LAS unsigned char* lds, const float* relb, int head0, int tid) {
    LAS float* lut = (LAS float*)(lds + L_LUT);
    const int r = tid >> 7, d = tid & 127;
    lut[r * 128 + d] = relb[t5_bucket(d) * 16 + head0 + r] * LOG2E;
}

__device__ __forceinline__ void build_lut23(LAS unsigned char* lds, int W, bool want3, int tid) {
    const LAS float* lut = (const LAS float*)(lds + L_LUT);
    LAS float* l2 = (LAS float*)(lds + L_LUT2); LAS float* l3 = (LAS float*)(lds + L_LUT3);
    for (int i = tid; i < 4 * LUT2_N; i += 512) { const int r = i / LUT2_N, jj = i - r * LUT2_N, d = LUT2_K - jj; l2[i] = (d < 0 || d >= W) ? NEG_INF : lut[r * 128 + (d > 113 ? 113 : d)]; }
    if (want3) for (int i = tid; i < 4 * LUT3_N; i += 512) { const int r = i / LUT3_N, jj = i - r * LUT3_N, d = LUT3_K - jj; l3[i] = (d < 0) ? NEG_INF : lut[r * 128 + (d > 113 ? 113 : d)]; }
}

__device__ __forceinline__ void unit_swa(Frame& F, const Args& A, int b, int g, int qt) {
    LAS unsigned char* lds = F.lds;
    const int lane = F.lane, wave = F.wave, r = wave & 3, th = wave >> 2, r32 = lane & 31, h = lane >> 5;
    const int head = g * 4 + r, tq = qt * 64 + 32 * th + r32;
    build_lut(lds, INP(I_RELB), g * 4, F.tid);
    const bf16_t* qrow = WSP(bf16_t, WS_QA) + ((size_t)(b * SEQ + tq)) * 512 + head * 64;
    bf16x8 qf[4];
#pragma unroll
    for (int ks = 0; ks < 4; ++ks) qf[ks] = *(const bf16x8*)(qrow + 16 * ks + 8 * h);
    f32x16 o[2];
#pragma unroll
    for (int db = 0; db < 2; ++db)
#pragma unroll
        for (int i = 0; i < 16; ++i) o[db][i] = 0.f;
    float m = INP(I_L0_SINKS)[head] * LOG2E, l = 1.f;
    __syncthreads();
    build_lut23(lds, 128, false, F.tid);
    __syncthreads();
    const LAS float* lut = (const LAS float*)(lds + L_LUT) + r * 128;
    const bf16_t* Kg = WSP(bf16_t, WS_KA) + (size_t)b * SEQ * 128 + g * 64; const bf16_t* Vg = WSP(bf16_t, WS_VA) + (size_t)b * SEQ * 128 + g * 64;
    run_branch<0, 2>(lds, Kg, Vg, 128, tile_range(qt - 2 < 0 ? 0 : qt - 2, qt), qf, o, m, l, tq, 128, 0ull, lut, F.tid, lane);
    const float inv = 1.f / l;
    bf16_t* orow = WSP(bf16_t, WS_MIX0) + ((size_t)(b * SEQ + tq)) * DM + head * 64;
#pragma unroll
    for (int db = 0; db < 2; ++db)
#pragma unroll
        for (int rg = 0; rg < 4; ++rg) { u32x2 w; w.x = cvt_pk_bf16(o[db][4 * rg] * inv, o[db][4 * rg + 1] * inv); w.y = cvt_pk_bf16(o[db][4 * rg + 2] * inv, o[db][4 * rg + 3] * inv);
            *(u32x2*)(orow + 32 * db + 8 * rg + 4 * h) = w; }
}

__device__ __forceinline__ void unit_nsa(Frame& F, const Args& A, int b, int g, int qt) {
    LAS unsigned char* lds = F.lds;
    const int lane = F.lane, wave = F.wave, r = wave & 3, th = wave >> 2, r32 = lane & 31, h = lane >> 5;
    const int hb = g * 4 + r, tq = qt * 64 + 32 * th + r32, tok = 32 * th + r32, bg = b * 2 + g;
    build_lut(lds, INP(I_RELB), 8 + g * 4, F.tid);
    const bf16_t* qrow = WSP(bf16_t, WS_QB) + ((size_t)(b * SEQ + tq)) * 512 + hb * 64;
    bf16x8 qf[4];
#pragma unroll
    for (int ks = 0; ks < 4; ++ks) qf[ks] = *(const bf16x8*)(qrow + 16 * ks + 8 * h);
    const float* gp = WSP(float, WS_GATES) + ((size_t)(b * SEQ + tq)) * 24 + hb;
    const float g_cmp = gp[0], g_slc = gp[8], g_win = gp[16];
    f32x16 acc[2];
    __syncthreads();
    build_lut23(lds, 512, true, F.tid);
    __syncthreads();
    const LAS float* lut = (const LAS float*)(lds + L_LUT) + r * 128;
    LAS float* imp = (LAS float*)(lds + L_IMP);
    LAS unsigned long long* selm = (LAS unsigned long long*)(lds + L_SELM);
    {
        f32x16 o[4];
#pragma unroll
        for (int db = 0; db < 4; ++db)
#pragma unroll
            for (int i = 0; i < 16; ++i) o[db][i] = 0.f;
        float m = -1e30f, l = 0.f;
        const int tmax = qt * 64 + 63;
        unsigned long long tiles = 0ull;
        if (tmax >= 31) { const int nmax = (tmax - 31) >> 4; tiles = tile_range(0, (nmax > 254 ? 254 : nmax) >> 6); }
        const bf16_t* Kc = WSP(bf16_t, WS_KC) + (size_t)bg * 256 * 64; const bf16_t* Vc = WSP(bf16_t, WS_KC) + (size_t)(16 + bg) * 256 * 64;
        run_branch<2, 4>(lds, Kc, Vc, 64, tiles, qf, o, m, l, tq, 0, 0ull, lut, F.tid, lane);
        const float inv = l > 0.f ? 1.f / l : 0.f;
#pragma unroll
        for (int db = 0; db < 2; ++db)
#pragma unroll
            for (int i = 0; i < 16; ++i) acc[db][i] = o[db][i] * (inv * g_cmp);
        if (qt >= 16) {
#pragma unroll
            for (int db = 0; db < 2; ++db)
#pragma unroll
                for (int i = 0; i < 16; ++i) { const int jj = 32 * db + (i & 3) + 8 * (i >> 2) + 4 * h; imp[(r * 64 + jj) * 65 + tok] = o[2 + db][i] * inv; }
        }
    }
    __syncthreads();
    {
        const unsigned long long adm = tile_range(0, qt);
        for (int i = 0; i < 8; ++i) {
            const int tk = wave * 8 + i; unsigned long long mk = adm;
            if (qt >= 16) {
                int j = lane; asm volatile("" : "+v"(j));
                const float iv = ((imp[(0 * 64 + j) * 65 + tk] + imp[(1 * 64 + j) * 65 + tk]) + imp[(2 * 64 + j) * 65 + tk]) + imp[(3 * 64 + j) * 65 + tk];
                const bool forced = (j == 0) || (j == qt) || (j == qt - 1);
                const float sc = forced ? 1e30f : (j <= qt ? iv : -1e30f);
                int rank = 0;
#pragma unroll
                for (int k = 0; k < 64; ++k) { const float sk = __int_as_float(__builtin_amdgcn_readlane(__float_as_int(sc), k)); rank += (sk > sc || (sk == sc && k < j)) ? 1 : 0; }
                mk = __ballot(rank < 16) & adm;
            }
            if (lane == 0) selm[tk] = mk;
        }
    }
    __syncthreads();
    const unsigned long long myselm = selm[tok];
    unsigned long long uni = selm[lane];
#pragma unroll
    for (int o_ = 1; o_ < 64; o_ <<= 1) { const unsigned lo = __shfl_xor((unsigned)uni, o_), hi = __shfl_xor((unsigned)(uni >> 32), o_); uni |= ((unsigned long long)hi << 32) | lo; }
    uni = ((unsigned long long)(unsigned)__builtin_amdgcn_readfirstlane((unsigned)(uni >> 32)) << 32) | (unsigned)__builtin_amdgcn_readfirstlane((unsigned)uni);
    {
        f32x16 o[2];
#pragma unroll
        for (int db = 0; db < 2; ++db)
#pragma unroll
            for (int i = 0; i < 16; ++i) o[db][i] = 0.f;
        float m = 0.f, l = 0.f;
        const bf16_t* Kg = WSP(bf16_t, WS_KSLC) + (size_t)b * SEQ * 128 + g * 64; const bf16_t* Vg = WSP(bf16_t, WS_VSLC) + (size_t)b * SEQ * 128 + g * 64;
        run_branch<1, 2>(lds, Kg, Vg, 128, uni, qf, o, m, l, tq, 0, myselm, lut, F.tid, lane);
        const float inv = g_slc / l;
#pragma unroll
        for (int db = 0; db < 2; ++db)
#pragma unroll
            for (int i = 0; i < 16; ++i) acc[db][i] += o[db][i] * inv;
    }
    {
        f32x16 o[2];
#pragma unroll
        for (int db = 0; db < 2; ++db)
#pragma unroll
            for (int i = 0; i < 16; ++i) o[db][i] = 0.f;
        float m = 0.f, l = 0.f;
        const bf16_t* Kg = WSP(bf16_t, WS_KWIN) + (size_t)b * SEQ * 128 + g * 64; const bf16_t* Vg = WSP(bf16_t, WS_VWIN) + (size_t)b * SEQ * 128 + g * 64;
        run_branch<0, 2>(lds, Kg, Vg, 128, tile_range(qt - 8 < 0 ? 0 : qt - 8, qt), qf, o, m, l, tq, 512, 0ull, lut, F.tid, lane);
        const float inv = g_win / l;
#pragma unroll
        for (int db = 0; db < 2; ++db)
#pragma unroll
            for (int i = 0; i < 16; ++i) acc[db][i] += o[db][i] * inv;
    }
    bf16_t* orow = WSP(bf16_t, WS_MIX0) + ((size_t)(b * SEQ + tq)) * DM + 512 + hb * 64;
#pragma unroll
    for (int db = 0; db < 2; ++db)
#pragma unroll
        for (int rg = 0; rg < 4; ++rg) { u32x2 w; w.x = cvt_pk_bf16(acc[db][4 * rg], acc[db][4 * rg + 1]); w.y = cvt_pk_bf16(acc[db][4 * rg + 2], acc[db][4 * rg + 3]);
            *(u32x2*)(orow + 32 * db + 8 * rg + 4 * h) = w; }
}

#ifndef PROBE_NSA_REP
#define PROBE_NSA_REP 1
#endif
#ifndef PROBE_SWA_REP
#define PROBE_SWA_REP 1
#endif
__device__ __forceinline__ void attn0_phase(Frame& F, const Args& A) {
    for (int rep = 0; rep < PROBE_NSA_REP; ++rep)
    for (int U = F.bid; U < 1024; U += F.G) {
        const int c = U & 255, i = U >> 8, bg = c >> 4, s = c & 15;
        const int qt = (i == 0) ? 63 - s : (i == 1) ? 32 + s : (i == 2) ? 31 - s : s;
        unit_nsa(F, A, bg >> 1, bg & 1, qt);
        __syncthreads();
    }
    for (int rep = 0; rep < PROBE_SWA_REP; ++rep)
    for (int U = F.bid; U < 1024; U += F.G) {
        const int c = U & 255, i = U >> 8, bg = c >> 4, s = c & 15;
        unit_swa(F, A, bg >> 1, bg & 1, 16 * i + s);
        __syncthreads();
    }
}
}
namespace dsa {
constexpr int L_SC = 0;
constexpr int L_LIST = LDS_EXTRA_OFF;
constexpr int L_LUTD = L_LIST + 4096;
constexpr int L_WT = L_LUTD + 114 * 16 * 4;
static_assert(L_WT + 256 <= LDS_MISC_OFF, "dsa LDS map");
constexpr int VROW = 160;
constexpr float NEG_INF = -__builtin_huge_valf();
typedef float f32x4_t __attribute__((ext_vector_type(4)));


__device__ __forceinline__ int count_ge8(unsigned a0, unsigned a1, unsigned a2, unsigned a3, unsigned a4, unsigned a5, unsigned a6, unsigned a7, unsigned cand) {
    int c, t; unsigned long long m0, m1, m2, m3, m4, m5, m6, m7;
    asm volatile(
        "v_cmp_ge_u32_e64 %[m0], %[a0], %[cd]\n\tv_cmp_ge_u32_e64 %[m1], %[a1], %[cd]\n\tv_cmp_ge_u32_e64 %[m2], %[a2], %[cd]\n\tv_cmp_ge_u32_e64 %[m3], %[a3], %[cd]\n\t"
        "v_cmp_ge_u32_e64 %[m4], %[a4], %[cd]\n\tv_cmp_ge_u32_e64 %[m5], %[a5], %[cd]\n\tv_cmp_ge_u32_e64 %[m6], %[a6], %[cd]\n\tv_cmp_ge_u32_e64 %[m7], %[a7], %[cd]\n\t"
        "s_bcnt1_i32_b64 %[c], %[m0]\n\ts_bcnt1_i32_b64 %[t], %[m1]\n\ts_add_i32 %[c], %[c], %[t]\n\ts_bcnt1_i32_b64 %[t], %[m2]\n\ts_add_i32 %[c], %[c], %[t]\n\t"
        "s_bcnt1_i32_b64 %[t], %[m3]\n\ts_add_i32 %[c], %[c], %[t]\n\ts_bcnt1_i32_b64 %[t], %[m4]\n\ts_add_i32 %[c], %[c], %[t]\n\ts_bcnt1_i32_b64 %[t], %[m5]\n\ts_add_i32 %[c], %[c], %[t]\n\t"
        "s_bcnt1_i32_b64 %[t], %[m6]\n\ts_add_i32 %[c], %[c], %[t]\n\ts_bcnt1_i32_b64 %[t], %[m7]\n\ts_add_i32 %[c], %[c], %[t]"
        : [c] "=&s"(c), [t] "=&s"(t), [m0] "=&s"(m0), [m1] "=&s"(m1), [m2] "=&s"(m2), [m3] "=&s"(m3), [m4] "=&s"(m4), [m5] "=&s"(m5), [m6] "=&s"(m6), [m7] "=&s"(m7)
        : [a0] "v"(a0), [a1] "v"(a1), [a2] "v"(a2), [a3] "v"(a3), [a4] "v"(a4), [a5] "v"(a5), [a6] "v"(a6), [a7] "v"(a7), [cd] "s"(cand)
        : "scc");
    return c;
}

__device__ __forceinline__ void unit_dsa(Frame& F, const Args& A, int b, int t0) {
    LAS unsigned char* lds = F.lds;
    const int tid = F.tid, lane = F.lane, wave = F.wave, r32 = lane & 31, h = lane >> 5;
    const size_t tb = (size_t)b * SEQ;
    LAS float* sc = (LAS float*)(lds + L_SC);
    LAS unsigned short* list = (LAS unsigned short*)(lds + L_LIST) + wave * 256;
    const LAS float* lutd = (const LAS float*)(lds + L_LUTD);
    LAS float* wt = (LAS float*)(lds + L_WT);
    if (tid < 64) wt[tid] = WSP(float, WS_WI)[(tb + t0) * 8 + tid];
    __syncthreads();
#ifndef PROBE_DSA_A
#define PROBE_DSA_A 1
#endif
#ifndef PROBE_DSA_B
#define PROBE_DSA_B 1
#endif
#ifndef PROBE_DSA_C
#define PROBE_DSA_C 1
#endif
    for (int repa = 0; repa < PROBE_DSA_A; ++repa)
    if (t0 + 8 > 256) {
        const int nkb = ((t0 + 8 + 63) >> 6) << 1;
        const int hh_r = (r32 >> 2) & 1, reg_r = (r32 & 3) | ((r32 >> 3) << 2), qi4 = 2 * hh_r + (reg_r >> 3), hd = reg_r & 7;
        bf16x8 qaf[2][2]; float wv[2][16];
#pragma unroll
        for (int rb = 0; rb < 2; ++rb) {
            const bf16_t* qp = WSP(bf16_t, WS_QI) + (tb + t0 + 4 * rb + qi4) * 256 + hd * 32 + 8 * h;
            qaf[rb][0] = *(const bf16x8*)qp; qaf[rb][1] = *(const bf16x8*)(qp + 16);
#pragma unroll
            for (int rg = 0; rg < 16; ++rg) wv[rb][rg] = wt[(4 * rb + 2 * h + (rg >> 3)) * 8 + (rg & 7)];
        }
        int kb = wave;
        bf16x8 bk0 = {0, 0, 0, 0, 0, 0, 0, 0}, bk1 = {0, 0, 0, 0, 0, 0, 0, 0};
        if (kb < nkb) { const bf16_t* kp = WSP(bf16_t, WS_KI) + (tb + 32 * kb + r32) * 32 + 8 * h; bk0 = *(const bf16x8*)kp; bk1 = *(const bf16x8*)(kp + 16); }
        while (kb < nkb) {
            const int kn = kb + 8; bf16x8 nb0 = bk0, nb1 = bk1;
            if (kn < nkb) { const bf16_t* kp = WSP(bf16_t, WS_KI) + (tb + 32 * kn + r32) * 32 + 8 * h; nb0 = *(const bf16x8*)kp; nb1 = *(const bf16x8*)(kp + 16); }
            const int key = 32 * kb + r32;
#pragma unroll
            for (int rb = 0; rb < 2; ++rb) {
                f32x16 c;
#pragma unroll
                for (int i = 0; i < 16; ++i) c[i] = 0.f;
                c = __builtin_amdgcn_mfma_f32_32x32x16_bf16(qaf[rb][0], bk0, c, 0, 0, 0);
                c = __builtin_amdgcn_mfma_f32_32x32x16_bf16(qaf[rb][1], bk1, c, 0, 0, 0);
                float sA = 0.f, sB = 0.f;
#pragma unroll
                for (int i = 0; i < 8; ++i) { sA += wv[rb][i] * fmaxf(c[i], 0.f); sB += wv[rb][8 + i] * fmaxf(c[8 + i], 0.f); }
                const int qA = 4 * rb + 2 * h;
                sc[qA * 4096 + key] = (key <= t0 + qA) ? sA : NEG_INF;
                sc[(qA + 1) * 4096 + key] = (key <= t0 + qA + 1) ? sB : NEG_INF;
            }
            bk0 = nb0; bk1 = nb1; kb = kn;
        }
    }
    __syncthreads();
    const int t = t0 + wave, n = t + 1;
    int cnt;
    for (int repb = 0; repb < PROBE_DSA_B; ++repb)
    if (n <= 256) {
#pragma unroll
        for (int i = 0; i < 4; ++i) { const int k = lane + 64 * i; list[k] = (unsigned short)(k < n ? k : 0); }
        cnt = n;
    } else {
        const int nreg = (n + 63) >> 6, ngrp = (nreg + 7) >> 3;
        LAS float* my = sc + wave * 4096;
        float f[64];
#pragma unroll
        for (int g8 = 0; g8 < 8; ++g8) {
#pragma unroll
            for (int k = 0; k < 8; ++k) f[g8 * 8 + k] = NEG_INF;
            if (g8 < ngrp) {
#pragma unroll
                for (int k = 0; k < 8; ++k) if (g8 * 8 + k < nreg) f[g8 * 8 + k] = my[64 * (g8 * 8 + k) + lane];
            }
        }
        float ta = NEG_INF, tb_ = NEG_INF, tc = NEG_INF, td = NEG_INF;
#pragma unroll
        for (int g8 = 0; g8 < 8; ++g8) if (g8 < ngrp) {
#pragma unroll
            for (int k = 0; k < 8; ++k) { const float x = f[g8 * 8 + k]; td = __builtin_amdgcn_fmed3f(tc, td, x); tc = __builtin_amdgcn_fmed3f(tb_, tc, x); tb_ = __builtin_amdgcn_fmed3f(ta, tb_, x); ta = fmaxf(ta, x); }
        }
        float L = td;
#pragma unroll
        for (int o_ = 1; o_ < 64; o_ <<= 1) L = fminf(L, __shfl_xor(L, o_));
        LAS unsigned* cval = (LAS unsigned*)my; LAS unsigned short* ckey = (LAS unsigned short*)(my + 1024);
        const unsigned long long ltmask = (1ull << lane) - 1ull;
        int ns = 0;
#pragma unroll
        for (int g8 = 0; g8 < 8; ++g8) if (g8 < ngrp) {
#pragma unroll
            for (int k = 0; k < 8; ++k) { const int i = g8 * 8 + k; const bool keep = f[i] >= L; const unsigned long long mk = __ballot(keep); const int pos = ns + __popcll(mk & ltmask);
                if (keep && pos < 1024) { const unsigned bits = __float_as_uint(f[i]); cval[pos] = bits ^ ((bits >> 31) ? 0xffffffffu : 0x80000000u); ckey[pos] = (unsigned short)(64 * i + lane); }
                ns += __popcll(mk); }
        }
        if (ns <= 1024) {
            unsigned w[16];
#pragma unroll
            for (int j = 0; j < 16; ++j) w[j] = (64 * j + lane < ns) ? cval[64 * j + lane] : 0u;
            const bool two = ns > 512;
            float Mx = ta;
#pragma unroll
            for (int o_ = 1; o_ < 64; o_ <<= 1) Mx = fmaxf(Mx, __shfl_xor(Mx, o_));
            const unsigned Lb = __float_as_uint(L), Mb = __float_as_uint(Mx);
            const unsigned Lk = __builtin_amdgcn_readfirstlane(Lb ^ ((Lb >> 31) ? 0xffffffffu : 0x80000000u)), Mk = __builtin_amdgcn_readfirstlane(Mb ^ ((Mb >> 31) ? 0xffffffffu : 0x80000000u));
            const int hb = (Lk == Mk) ? -1 : 31 - __builtin_clz(Lk ^ Mk);
            unsigned tau = (hb >= 31) ? 0u : (hb < 0 ? Mk : (Mk & ~((2u << hb) - 1u)));
            for (int bit = hb; bit >= 0; --bit) {
                const unsigned cand = tau | (1u << bit);
                int c = count_ge8(w[0], w[1], w[2], w[3], w[4], w[5], w[6], w[7], cand);
                if (two) c += count_ge8(w[8], w[9], w[10], w[11], w[12], w[13], w[14], w[15], cand);
                if (c >= 256) { tau = cand; if (c == 256) break; }
            }
            int cgt = count_ge8(w[0], w[1], w[2], w[3], w[4], w[5], w[6], w[7], tau + 1u);
            if (two) cgt += count_ge8(w[8], w[9], w[10], w[11], w[12], w[13], w[14], w[15], tau + 1u);
            const int need = 256 - cgt; int base = 0, eqseen = 0;
#pragma unroll
            for (int j = 0; j < 16; ++j) if (64 * j < ns) {
                const bool gt = w[j] > tau, eq = w[j] == tau;
                const unsigned long long meq = __ballot(eq);
                const bool sel = gt || (eq && (eqseen + __popcll(meq & ltmask)) < need);
                const unsigned long long msel = __ballot(sel);
                if (sel) list[base + __popcll(msel & ltmask)] = ckey[64 * j + lane];
                base += __popcll(msel); eqseen += __popcll(meq);
            }
        } else {
#pragma unroll
            for (int i = 0; i < 64; ++i) { const unsigned bits = __float_as_uint(f[i]); f[i] = __uint_as_float((i < nreg) ? (bits ^ ((bits >> 31) ? 0xffffffffu : 0x80000000u)) : 0u); }
#define u_(i) __float_as_uint(f[i])
            unsigned tau = 0u;
            for (int bit = 31; bit >= 0; --bit) {
                const unsigned cand = tau | (1u << bit); int c = 0;
#pragma unroll
                for (int g8 = 0; g8 < 8; ++g8) if (g8 < ngrp)
                    c += count_ge8(u_(g8 * 8 + 0), u_(g8 * 8 + 1), u_(g8 * 8 + 2), u_(g8 * 8 + 3), u_(g8 * 8 + 4), u_(g8 * 8 + 5), u_(g8 * 8 + 6), u_(g8 * 8 + 7), cand);
                if (c >= 256) { tau = cand; if (c == 256) break; }
            }
            int cgt = 0;
#pragma unroll
            for (int g8 = 0; g8 < 8; ++g8) if (g8 < ngrp)
                cgt += count_ge8(u_(g8 * 8 + 0), u_(g8 * 8 + 1), u_(g8 * 8 + 2), u_(g8 * 8 + 3), u_(g8 * 8 + 4), u_(g8 * 8 + 5), u_(g8 * 8 + 6), u_(g8 * 8 + 7), tau + 1u);
            const int need = 256 - cgt; int base = 0, eqseen = 0;
#pragma unroll
            for (int g8 = 0; g8 < 8; ++g8) if (g8 < ngrp) {
#pragma unroll
                for (int k = 0; k < 8; ++k) { const int i = g8 * 8 + k;
                    const bool gt = u_(i) > tau, eq = u_(i) == tau;
                    const unsigned long long meq = __ballot(eq);
                    const bool sel = gt || (eq && (eqseen + __popcll(meq & ltmask)) < need);
                    const unsigned long long msel = __ballot(sel);
                    if (sel) list[base + __popcll(msel & ltmask)] = (unsigned short)(64 * i + lane);
                    base += __popcll(msel); eqseen += __popcll(meq); } }
        }
#undef u_
        cnt = 256;
    }
    __syncthreads();
    for (int repc = 0; repc < PROBE_DSA_C; ++repc)
    {
        const int head = lane & 15, g4 = lane >> 4, q4 = (lane & 15) >> 2, p4 = lane & 3;
        const bf16_t* qp = WSP(bf16_t, WS_Q1) + (tb + t) * 1024 + head * 64 + 8 * g4;
        const bf16x8 qf0 = *(const bf16x8*)qp, qf1 = *(const bf16x8*)(qp + 32);
        const bf16_t* K1 = WSP(bf16_t, WS_K1) + tb * 64; const bf16_t* V1 = WSP(bf16_t, WS_V1) + tb * 64;
        f32x4_t sA[8], sB[8];
        float mx = NEG_INF;
        const float cfar = lutd[113 * 16 + head];
        LAS unsigned char* kst = lds + wave * (96 * VROW);
        {
            u32x4 kr[8][4];
#pragma unroll
            for (int c = 0; c < 8; ++c) {
#pragma unroll
                for (int i = 0; i < 4; ++i) { const unsigned key = list[32 * c + 8 * i + (lane >> 3)]; kr[c][i] = *(const u32x4*)((const char*)K1 + (key * 128u + (unsigned)(lane & 7) * 16u)); }
            }
#pragma unroll
            for (int c = 0; c < 8; ++c) {
#pragma unroll
                for (int i = 0; i < 4; ++i) *(LAS u32x4*)(kst + (8 * i + (lane >> 3)) * VROW + (lane & 7) * 16) = kr[c][i];
                const LAS unsigned char* ka = kst + (lane & 15) * VROW + 16 * g4;
                const bf16x8 kA0 = *(const LAS bf16x8*)ka, kA1 = *(const LAS bf16x8*)(ka + 64), kB0 = *(const LAS bf16x8*)(ka + 16 * VROW), kB1 = *(const LAS bf16x8*)(ka + 16 * VROW + 64);
                const int kmax = __builtin_amdgcn_readfirstlane((int)list[32 * c + 31]);
                if (cnt == 256 && t - kmax >= 113) {
                    f32x4_t a = {cfar, cfar, cfar, cfar}, bb = {cfar, cfar, cfar, cfar};
                    a = __builtin_amdgcn_mfma_f32_16x16x32_bf16(kA0, qf0, a, 0, 0, 0); a = __builtin_amdgcn_mfma_f32_16x16x32_bf16(kA1, qf1, a, 0, 0, 0);
                    bb = __builtin_amdgcn_mfma_f32_16x16x32_bf16(kB0, qf0, bb, 0, 0, 0); bb = __builtin_amdgcn_mfma_f32_16x16x32_bf16(kB1, qf1, bb, 0, 0, 0);
                    sA[c] = a; sB[c] = bb;
                    mx = fmaxf(mx, fmaxf(fmaxf(fmaxf(a[0], a[1]), fmaxf(a[2], a[3])), fmaxf(fmaxf(bb[0], bb[1]), fmaxf(bb[2], bb[3]))));
                } else {
                    f32x4_t a = {0.f, 0.f, 0.f, 0.f}, bb = {0.f, 0.f, 0.f, 0.f};
                    a = __builtin_amdgcn_mfma_f32_16x16x32_bf16(kA0, qf0, a, 0, 0, 0); a = __builtin_amdgcn_mfma_f32_16x16x32_bf16(kA1, qf1, a, 0, 0, 0);
                    bb = __builtin_amdgcn_mfma_f32_16x16x32_bf16(kB0, qf0, bb, 0, 0, 0); bb = __builtin_amdgcn_mfma_f32_16x16x32_bf16(kB1, qf1, bb, 0, 0, 0);
                    const u32x2 ia = *(const LAS u32x2*)(list + 32 * c + 4 * g4), ib = *(const LAS u32x2*)(list + 32 * c + 16 + 4 * g4);
#pragma unroll
                    for (int i = 0; i < 4; ++i) {
                        const int keyA = (int)(((i < 2 ? ia.x : ia.y) >> (16 * (i & 1))) & 0xffffu), keyB = (int)(((i < 2 ? ib.x : ib.y) >> (16 * (i & 1))) & 0xffffu);
                        const int dA = t - keyA, dB = t - keyB;
                        const float bA = lutd[(dA > 113 ? 113 : (dA < 0 ? 0 : dA)) * 16 + head], bB = lutd[(dB > 113 ? 113 : (dB < 0 ? 0 : dB)) * 16 + head];
                        const int slotA = 32 * c + 4 * g4 + i, slotB = slotA + 16;
                        sA[c][i] = slotA < cnt ? a[i] + bA : NEG_INF; sB[c][i] = slotB < cnt ? bb[i] + bB : NEG_INF;
                        mx = fmaxf(mx, fmaxf(sA[c][i], sB[c][i]));
                    }
                }
            }
        }
        asm volatile("" ::: "memory");
        u32x4 vr[4][4];
#pragma unroll
        for (int c = 0; c < 4; ++c) {
#pragma unroll
            for (int i = 0; i < 4; ++i) { const unsigned key = list[32 * c + 8 * i + (lane >> 3)]; vr[c][i] = *(const u32x4*)((const char*)V1 + (key * 128u + (unsigned)(lane & 7) * 16u)); }
        }
        mx = fmaxf(mx, __shfl_xor(mx, 16)); mx = fmaxf(mx, __shfl_xor(mx, 32));
        float l = 0.f;
#pragma unroll
        for (int c = 0; c < 8; ++c)
#pragma unroll
            for (int i = 0; i < 4; ++i) { sA[c][i] = __builtin_amdgcn_exp2f(sA[c][i] - mx); sB[c][i] = __builtin_amdgcn_exp2f(sB[c][i] - mx); l += sA[c][i] + sB[c][i]; }
        l += __shfl_xor(l, 16); l += __shfl_xor(l, 32);
        f32x4_t o[4];
#pragma unroll
        for (int d = 0; d < 4; ++d) o[d] = (f32x4_t){0.f, 0.f, 0.f, 0.f};
#pragma unroll
        for (int c = 0; c < 8; ++c) {
            {
                LAS unsigned char* vst = kst + (32 + 32 * (c & 1)) * VROW;
#pragma unroll
                for (int i = 0; i < 4; ++i) *(LAS u32x4*)(vst + (8 * i + (lane >> 3)) * VROW + (lane & 7) * 16) = vr[c & 3][i];
                if (c + 4 < 8) {
#pragma unroll
                    for (int i = 0; i < 4; ++i) { const unsigned key = list[32 * (c + 4) + 8 * i + (lane >> 3)]; vr[c & 3][i] = *(const u32x4*)((const char*)V1 + (key * 128u + (unsigned)(lane & 7) * 16u)); }
                }
                u32x4 pw; pw.x = cvt_pk_bf16(sA[c][0], sA[c][1]); pw.y = cvt_pk_bf16(sA[c][2], sA[c][3]); pw.z = cvt_pk_bf16(sB[c][0], sB[c][1]); pw.w = cvt_pk_bf16(sB[c][2], sB[c][3]);
                const bf16x8 pb = __builtin_bit_cast(bf16x8, pw);
#pragma unroll
                for (int d = 0; d < 4; ++d) {
                    const LAS char* base = (const LAS char*)(vst + (4 * g4 + q4) * VROW + (16 * d + 4 * p4) * 2);
                    const s16x4 lo = att::vtr(base), hi = att::vtr(base + 16 * VROW);
                    const bf16x8 vf = {lo[0], lo[1], lo[2], lo[3], hi[0], hi[1], hi[2], hi[3]};
                    o[d] = __builtin_amdgcn_mfma_f32_16x16x32_bf16(vf, pb, o[d], 0, 0, 0);
                }
            }
        }
        const float inv = 1.f / l;
        bf16_t* orow = WSP(bf16_t, WS_MIX1) + (tb + t) * 1024 + head * 64 + 4 * g4;
#pragma unroll
        for (int d = 0; d < 4; ++d) { u32x2 w; w.x = cvt_pk_bf16(o[d][0] * inv, o[d][1] * inv); w.y = cvt_pk_bf16(o[d][2] * inv, o[d][3] * inv); *(u32x2*)(orow + 16 * d) = w; }
    }
    __syncthreads();
}

__device__ __forceinline__ void dsa_phase(Frame& F, const Args& A) {
    LAS float* lutd = (LAS float*)(F.lds + L_LUTD);
    for (int i = F.tid; i < 114 * 16; i += 512) lutd[i] = INP(I_RELB)[t5_bucket(i >> 4) * 16 + (i & 15)] * LOG2E;
    __syncthreads();
#ifndef PROBE_DSA_REP
#define PROBE_DSA_REP 1
#endif
    const int nround = (4096 + F.G - 1) / F.G;
    for (int ii = 0; ii < nround * PROBE_DSA_REP; ++ii) {
        const int i = ii % nround;
        const int cc = (i & 1) ? (F.G - 1 - F.bid) : F.bid; const int I = i * F.G + cc;
        if (I < 4096) unit_dsa(F, A, I & 7, 8 * (511 - (I >> 3)));
    }
}
}
constexpr int NPHASE = 19;
__global__ void __launch_bounds__(512, 2) mk_fwd(Args args) {
    extern __shared__ __attribute__((aligned(16))) unsigned char lds_raw[];
    Frame F;
    F.lds = (LAS unsigned char*)lds_raw;
    F.tid = threadIdx.x; F.lane = F.tid & 63; F.wave = __builtin_amdgcn_readfirstlane(F.tid >> 6);
    F.G = gridDim.x; F.bid = blockIdx.x; F.ws = args.ws; F.out = args.out;
    volatile LAS unsigned* MISC = (volatile LAS unsigned*)(F.lds + LDS_MISC_OFF);
    if (F.tid < 64) MISC[F.tid] = 0u;
    __syncthreads();
    if (F.tid < 28) *(LAS unsigned long long*)(F.lds + LDS_PTR_OFF + 8 * F.tid) = (unsigned long long)args.in[F.tid];
    __syncthreads();
    const int lo = args.ph_lo, hi = args.ph_hi;
    const bool use_bar = (hi - lo) > 1;
    XcdBarrier bar; bar.bar = (unsigned*)(F.ws + WS_CTL) + CW_BAR; bar.x = 0; bar.st = nullptr;
    if (use_bar) bar = xcd_barrier_post((unsigned*)(F.ws + WS_CTL) + CW_BAR, MISC);
#ifdef PH_ONLY
#define IN(k) ((k) == PH_ONLY && lo <= (k) && (k) < hi)
#else
#define IN(k) (lo <= (k) && (k) < hi)
#endif
#ifndef PROBE_PH
#define PROBE_PH -1
#endif
#define REP(k) for (int rep_ = 0; rep_ < ((k) == PROBE_PH ? 2 : 1); ++rep_)
#define SEAM(k) do { if (IN(k) && IN((k) + 1)) xcd_barrier(bar); } while (0)
    LAS unsigned char* ring = F.lds;
    const Args& A = args;

    if (IN(0)) REP(0) { p0_prologue(F, A); } SEAM(0);
    if (IN(1)) REP(1) {
        pg8::Gemm g{WSP(bf16_t, WS_XB), WSP(bf16_t, WS_WIN0), DM}; pg8::Proj0OrderA S{F.G, F.bid};
        pg8::EpiProj0 E{F.ws};
        pg8::gemm_phase<pg8::EpiProj0, pg8::Proj0OrderA, true, true>(ring, g, S, E);
    } SEAM(1);
    if (IN(2)) REP(2) {
        pg8::Gemm g{WSP(bf16_t, WS_XB), WSP(bf16_t, WS_WIN0), DM}; pg8::Proj0OrderB S; S.so.init(T / 256, 7, F.G, F.bid); S.G = F.G; S.c = F.bid;
        pg8::EpiProj0 E{F.ws};
        pg8::gemm_phase<pg8::EpiProj0, pg8::Proj0OrderB, true, true>(ring, g, S, E);
    } SEAM(2);
    if (IN(3)) REP(3) { p2b_compress_tail(F, A); } SEAM(3);
    if (IN(4)) REP(4) { att::attn0_phase(F, A); } SEAM(4);
    if (IN(5)) REP(5) {
        pg8::Gemm g{WSP(bf16_t, WS_MIX0), WSP(bf16_t, WS_WOUT0), DM}; pg8::StaticOrder S; S.init(T / 256, DM / 256, F.G, F.bid);
        pg8::EpiRes E{INP(I_X), nullptr, (bf16_t*)F.out};
        pg8::gemm_phase<pg8::EpiRes, pg8::StaticOrder, true, true>(ring, g, S, E);
    } SEAM(5);
    if (IN(6)) REP(6) { p_layernorm(F, (const bf16_t*)F.out, INP(I_L0_LN1G), INP(I_L0_LN1B), WSP(bf16_t, WS_X1B)); } SEAM(6);
    if (IN(7)) REP(7) {
        pg8::Gemm g{WSP(bf16_t, WS_X1B), WSP(bf16_t, WS_WGU0), DM}; pg8::StaticOrder S; S.init(T / 256, 2 * DFF / 256, F.G, F.bid);
        pg8::EpiSwiglu E{WSP(bf16_t, WS_H0), 0};
        pg8::gemm_phase<pg8::EpiSwiglu, pg8::StaticOrder, true, true>(ring, g, S, E);
    } SEAM(7);
    if (IN(8)) REP(8) {
        pg8::Gemm g{WSP(bf16_t, WS_H0), WSP(bf16_t, WS_WDN0), DFF}; pg8::StaticOrder S; S.init(T / 256, DM / 256, F.G, F.bid);
        pg8::EpiRes E{nullptr, WSP(bf16_t, WS_X1B), (bf16_t*)F.out};
        pg8::gemm_phase<pg8::EpiRes, pg8::StaticOrder, true, true>(ring, g, S, E);
    } SEAM(8);
    if (IN(9)) REP(9) { p_layernorm(F, (const bf16_t*)F.out, INP(I_L0_LN2G), INP(I_L0_LN2B), WSP(bf16_t, WS_X2B)); } SEAM(9);
    if (IN(10)) REP(10) {
        pg8::Gemm g{WSP(bf16_t, WS_X2B), WSP(bf16_t, WS_WIN1), DM}; pg8::StaticOrder S; S.init(T / 256, N_IN1P / 256, F.G, F.bid);
        pg8::EpiProj1 E{F.ws};
        pg8::gemm_phase<pg8::EpiProj1, pg8::StaticOrder, true, true>(ring, g, S, E);
    } SEAM(10);
    if (IN(11)) REP(11) { dsa::dsa_phase(F, A); } SEAM(11);
    if (IN(12)) REP(12) {
        pg8::Gemm g{WSP(bf16_t, WS_MIX1), WSP(bf16_t, WS_WOUT1), DM}; pg8::StaticOrder S; S.init(T / 256, DM / 256, F.G, F.bid);
        pg8::EpiRes E{nullptr, WSP(bf16_t, WS_X2B), WSP(bf16_t, WS_Y3)};
        pg8::gemm_phase<pg8::EpiRes, pg8::StaticOrder, true, true>(ring, g, S, E);
    } SEAM(12);
    if (IN(13)) REP(13) { p12_ln_router(F, A); } SEAM(13);
    if (IN(14)) REP(14) { p13_moe_dispatch(F, A); } SEAM(14);
#define MOE_PASS(pidx, ph1, ph2) \
    if (IN(ph1)) REP(ph1) { LAS int* tile_e = (LAS int*)(F.lds + LDS_EXTRA_OFF); const int NT = moe_tile_table(F, tile_e); const int t0_ = (pidx) * MOE_PASS_TILES; int nM_ = NT - t0_; if ((pidx) == 0 && nM_ > MOE_PASS_TILES) nM_ = MOE_PASS_TILES; \
        if (nM_ > 0) { pg8::Gemm g{(const bf16_t*)F.out + 1024, WSP(bf16_t, WS_WGU1), DM}; pg8::MoeOrder S; S.gpitch = 2048;     S.so.init(nM_, 2 * DFF / 256, F.G, F.bid); S.tile0 = t0_; S.nN = 2 * DFF / 256; S.a_local = 0; S.tile_e = tile_e; S.rowlist = WSP(int, WS_ROWTOK); \
            pg8::EpiSwiglu E{WSP(bf16_t, WS_H1), t0_}; pg8::gemm_phase<pg8::EpiSwiglu, pg8::MoeOrder, true, true, true>(ring, g, S, E); } } SEAM(ph1); \
    if (IN(ph2)) REP(ph2) { LAS int* tile_e = (LAS int*)(F.lds + LDS_EXTRA_OFF); const int NT = moe_tile_table(F, tile_e); const int t0_ = (pidx) * MOE_PASS_TILES; int nM_ = NT - t0_; if ((pidx) == 0 && nM_ > MOE_PASS_TILES) nM_ = MOE_PASS_TILES; \
        if (nM_ > 0) { pg8::Gemm g{WSP(bf16_t, WS_H1), WSP(bf16_t, WS_WDN1), DFF}; pg8::MoeOrder S; S.so.init(nM_, DM / 256, F.G, F.bid); S.tile0 = t0_; S.nN = DM / 256; S.a_local = 1; S.tile_e = tile_e; S.rowlist = nullptr; S.gpitch = 0; \
            pg8::EpiBf16 E{WSP(bf16_t, WS_XG)}; pg8::gemm_phase<pg8::EpiBf16, pg8::MoeOrder, true, true>(ring, g, S, E); } } SEAM(ph2);
    MOE_PASS(0, 15, 16)
    MOE_PASS(1, 17, 18)
#undef MOE_PASS
    if (IN(19)) REP(19) { p_final(F, A); }
#undef IN
#undef SEAM
}

extern "C" void kernel_launch(void* const* d_in, const int* in_sizes, int n_in, void* d_out, int out_size, void* d_ws, size_t ws_size, hipStream_t stream) {
    static int grid = 0;
    if (grid == 0) {
        if (n_in != 28 || in_sizes[0] != T * DM || out_size != T * DM || ws_size < WS_END) {
            fprintf(stderr, "kernel_launch: unexpected problem (n_in %d, in0 %d, out %d, ws %zu); nothing launched\n", n_in, n_in > 0 ? in_sizes[0] : -1, out_size, ws_size); grid = -1; return; }
        int dev = 0, cus = 0, per_cu = 0;
        if (hipGetDevice(&dev) != hipSuccess || hipDeviceGetAttribute(&cus, hipDeviceAttributeMultiprocessorCount, dev) != hipSuccess) { grid = -1; return; }
        if (hipFuncSetAttribute((const void*)mk_fwd, hipFuncAttributeMaxDynamicSharedMemorySize, LDS_BYTES) != hipSuccess) { fprintf(stderr, "kernel_launch: hipFuncSetAttribute failed\n"); grid = -1; return; }
        if (hipOccupancyMaxActiveBlocksPerMultiprocessor(&per_cu, (const void*)mk_fwd, 512, LDS_BYTES) != hipSuccess || per_cu < 1) { fprintf(stderr, "kernel_launch: occupancy query says %d blocks per CU\n", per_cu); }
        (void)hipGetLastError();
        grid = cus;
    }
    if (grid < 0) return;
    (void)hipMemsetAsync((char*)d_ws + WS_CTL, 0, CTL_ZERO_BYTES, stream);
    Args a{};
    for (int i = 0; i < 28; ++i) a.in[i] = (const float*)d_in[i];
    a.out = (float*)d_out; a.ws = (unsigned char*)d_ws;
    constexpr int NPH = 20;
#if MK_N_LAUNCHES == 1
    a.ph_lo = 0; a.ph_hi = NPH;
    hipLaunchKernelGGL(mk_fwd, dim3(grid), dim3(512), LDS_BYTES, stream, a);
#else
    for (int p = 0; p < NPH; ++p) { a.ph_lo = p; a.ph_hi = p + 1; hipLaunchKernelGGL(mk_fwd, dim3(grid), dim3(512), LDS_BYTES, stream, a); }
#endif
}
```

```cpp
#include <hip/hip_runtime.h>
#include <cstdio>
#include <cstdint>

#ifndef MK_N_LAUNCHES
#define MK_N_LAUNCHES 1
#endif

#define LAS __attribute__((address_space(3)))
#define GAS __attribute__((address_space(1)))
typedef unsigned short bf16_t;
typedef short bf16x8 __attribute__((ext_vector_type(8)));
typedef short s16x4 __attribute__((ext_vector_type(4)));
typedef float f32x2 __attribute__((ext_vector_type(2)));
typedef float f32x4 __attribute__((ext_vector_type(4)));
typedef float f32x16 __attribute__((ext_vector_type(16)));
typedef unsigned u32x2 __attribute__((ext_vector_type(2)));
typedef unsigned u32x4 __attribute__((ext_vector_type(4)));

constexpr int NBATCH = 8, SEQ = 4096, T = NBATCH * SEQ, DM = 1024, DFF = 2816, NEXP = 8;
constexpr int N_IN0 = 2072, N_IN0P = 2304, N_IN1 = 1448, N_IN1P = 1536;
constexpr float ALPHA = 1.41421356237309515f;
constexpr float LN_EPS = 1e-5f;
constexpr float LOG2E = 1.4426950408889634f;
constexpr float QSCALE = 0.125f * LOG2E;

constexpr size_t MiB = 1u << 20;
constexpr size_t WS_CTL = 0, CTL_ZERO_BYTES = 1 * MiB;
constexpr size_t WS_KC = 1 * MiB;
constexpr size_t WS_POSW = 2 * MiB;
constexpr size_t WS_MOECNT = 2 * MiB + 64 * 1024;
constexpr size_t WS_MOEMETA = 2 * MiB + 128 * 1024;
constexpr size_t WS_TOKINFO = 2 * MiB + 256 * 1024;
constexpr size_t WS_WGU1 = 4 * MiB;
constexpr size_t WS_WDN1 = 92 * MiB;
constexpr size_t WS_WIN0 = 136 * MiB;
constexpr size_t WS_WC1 = 141 * MiB;
constexpr size_t WS_WOUT0 = 143 * MiB;
constexpr size_t WS_WGU0 = 145 * MiB;
constexpr size_t WS_WDN0 = 156 * MiB;
constexpr size_t WS_WIN1 = 162 * MiB;
constexpr size_t WS_WOUT1 = 165 * MiB;
constexpr size_t WS_XB = 168 * MiB;
constexpr size_t WS_QA = 232 * MiB;
constexpr size_t WS_QB = 264 * MiB;
constexpr size_t WS_KA = 296 * MiB;
constexpr size_t WS_VA = 304 * MiB;
constexpr size_t WS_KCMP = 312 * MiB;
constexpr size_t WS_VCMP = 320 * MiB;
constexpr size_t WS_KSLC = 328 * MiB;
constexpr size_t WS_VSLC = 336 * MiB;
constexpr size_t WS_KWIN = 344 * MiB;
constexpr size_t WS_VWIN = 352 * MiB;
constexpr size_t WS_GATES = 360 * MiB;
constexpr size_t WS_HCMP = 364 * MiB;
constexpr size_t WS_MIX0 = WS_XB;
constexpr size_t WS_X1B = 232 * MiB;
constexpr size_t WS_H0 = 296 * MiB;
constexpr size_t WS_X2B = WS_XB;
constexpr size_t WS_Q1 = 232 * MiB;
constexpr size_t WS_K1 = 296 * MiB;
constexpr size_t WS_V1 = 300 * MiB;
constexpr size_t WS_QI = 304 * MiB;
constexpr size_t WS_KI = 320 * MiB;
constexpr size_t WS_WI = 322 * MiB;
constexpr size_t WS_MIX1 = 328 * MiB;
constexpr size_t WS_Y3 = 392 * MiB;
constexpr size_t WS_X3B = 200 * MiB;
constexpr size_t WS_ROWTOK = 3 * MiB;
constexpr size_t WS_XG = 136 * MiB;
constexpr size_t WS_H1 = 268 * MiB;
constexpr size_t WS_END = 512 * MiB;
constexpr int MOE_PASS_TILES = 128;
constexpr int MOE_MAX_TILES = 264;

constexpr int CW_BAR = 4096;

constexpr int RING_BYTES = 131072;
constexpr int LDS_EXTRA_OFF = RING_BYTES;
constexpr int LDS_MISC_OFF = RING_BYTES + 16384;
constexpr int LDS_BYTES = RING_BYTES + 16384 + 512;

typedef __bf16 bf16x2_t __attribute__((ext_vector_type(2)));
__device__ __forceinline__ unsigned cvt_pk_bf16(float lo, float hi) { const f32x2 v = {lo, hi}; const bf16x2_t b = __builtin_convertvector(v, bf16x2_t); return __builtin_bit_cast(unsigned, b); }
__device__ __forceinline__ float bf_lo(unsigned w) { return __uint_as_float(w << 16); }
__device__ __forceinline__ float bf_hi(unsigned w) { return __uint_as_float(w & 0xffff0000u); }
__device__ __forceinline__ float wave_sum(float v) {
#pragma unroll
    for (int o = 1; o < 64; o <<= 1) v += __shfl_xor(v, o);
    return v;
}
__device__ __forceinline__ float swap_max(float m) { auto rr = __builtin_amdgcn_permlane32_swap(__float_as_uint(m), __float_as_uint(m), false, false); return fmaxf(__uint_as_float(rr[0]), __uint_as_float(rr[1])); }
__device__ __forceinline__ float swap_sum(float m) { auto rr = __builtin_amdgcn_permlane32_swap(__float_as_uint(m), __float_as_uint(m), false, false); return __uint_as_float(rr[0]) + __uint_as_float(rr[1]); }
__device__ __forceinline__ int t5_bucket(int n) {
    if (n < 16) return n;
    int b = 16;
    b += (n >= 19); b += (n >= 21); b += (n >= 24); b += (n >= 27); b += (n >= 31); b += (n >= 35); b += (n >= 40); b += (n >= 46);
    b += (n >= 52); b += (n >= 59); b += (n >= 67); b += (n >= 77); b += (n >= 87); b += (n >= 99); b += (n >= 113);
    return b;
}
namespace pg8 {
#define PG8_LAS __attribute__((address_space(3)))
constexpr int BM = 256, BK = 64, HALF = 128, HTB = HALF * BK * 2  , STAGE_BYTES = 8 * HTB, NXCD = 8, WGM = 8;
__host__ __device__ __forceinline__ int lds_byte(int r, int c) { const int st = (r >> 4) * 2 + (c >> 5), rr = r & 15, cc = c & 31, ob = rr * 64 + cc * 2; return st * 1024 + (ob ^ (((ob >> 9) & 1) << 5)); }
__host__ __device__ __forceinline__ void stage_rc(int b, int& R, int& C) { const int st = b / 1024, sb = b % 1024, swz = sb ^ (((sb >> 9) & 1) << 5); R = (st >> 1) * 16 + swz / 64; C = (st & 1) * 32 + (swz % 64) / 2; }
__host__ __device__ __forceinline__ int perm32(int rho) { const int n = rho >> 4, i = rho & 15; return 8 * (i >> 2) + 4 * n + (i & 3); }

struct Unit { int pa, pb, pm, pn; };
struct Gemm { const bf16_t* A; const bf16_t* Bt; int K; };

struct StaticOrder {
    int nM, nN, nwg, G, c; const int* rowlist; int gpitch;
    __host__ __device__ void init(int nM_, int nN_, int G_, int c_) { nM = nM_; nN = nN_; nwg = nM * nN; G = G_; c = c_; }
    __host__ __device__ bool next(int i, Unit& u) const {
        const long L = (long)i * G + c; if (L >= nwg) return false;
        int wgid = (int)L; { const int q = nwg / NXCD, r = nwg % NXCD, xcd = wgid % NXCD, off = wgid / NXCD; wgid = (xcd < r ? xcd * (q + 1) : r * (q + 1) + (xcd - r) * q) + off; }
        const int nig = WGM * nN, gid = wgid / nig, fm = gid * WGM, gsz = (nM - fm) < WGM ? (nM - fm) : WGM;
        u.pm = fm + ((wgid % nig) % gsz); u.pn = (wgid % nig) / gsz; u.pa = u.pm; u.pb = u.pn; return true;
    }
    __device__ __forceinline__ void a_ready(const Unit&) const {}
    __device__ __forceinline__ void done(const Unit&) const {}
};
template <class Epi, class Sched, bool ALIGN_EPI = false, bool SP2 = false, bool GATHER = false>
__device__ __forceinline__ void gemm_phase(PG8_LAS unsigned char* lds, const Gemm g, const Sched& S, const Epi& E) {
    const int tid = threadIdx.x, wid = __builtin_amdgcn_readfirstlane(tid >> 6), lane = tid & 63, wr = wid >> 2, wc = wid & 3, fr = lane & 15, fq = lane >> 4;
    const int K = g.K, nt = K / BK;
    unsigned voffA[2], voffB[2]; int rA[2], cA2[2];
#pragma unroll
    for (int i = 0; i < 2; ++i) { int R, C; stage_rc(tid * 16 + i * 8192, R, C); const int Rb = Epi::PERM ? ((R & ~31) + perm32(R & 31)) : R;
        voffA[i] = (unsigned)(R * K + C) * 2u; voffB[i] = (unsigned)(Rb * K + C) * 2u; rA[i] = R; cA2[i] = C; }
    unsigned vofC[2][2], vofN[2][2];
#define PG8_GOFF(dst, unit) do { if constexpr (GATHER) { _Pragma("unroll") for (int h_ = 0; h_ < 2; ++h_) _Pragma("unroll") for (int i_ = 0; i_ < 2; ++i_) \
        dst[h_][i_] = ((unsigned)S.rowlist[(unit).pm * BM + h_ * HALF + rA[i_]] * (unsigned)S.gpitch + (unsigned)cA2[i_]) * 2u; } } while (0)
    const size_t kstep = (size_t)(BK * 2);
    const size_t hstep = (size_t)HALF * K * 2;
    const size_t tstep = 2 * hstep;
    const unsigned ldsw = (unsigned)wid * 1024u;
    const int aoff = lds_byte(wr * 64 + fr, fq * 8), boff = lds_byte(wc * 32 + fr, fq * 8);
#define PG8_SA(b, h) (((b) * 2 + (h)) * HTB)
#define PG8_SB(b, h) ((4 + (b) * 2 + (h)) * HTB)
#define PG8_STAGE(bufoff, gbase, voff) do { _Pragma("unroll") for (int _i = 0; _i < 2; ++_i) \
        __builtin_amdgcn_global_load_lds((const unsigned*)((const char*)(gbase) + (voff)[_i]), (PG8_LAS unsigned*)(lds + (bufoff) + ldsw + _i * 8192), 16, 0, 0); } while (0)
#define PG8_STAGE_A(bufoff, gbase, h, VO) do { if constexpr (GATHER) PG8_STAGE(bufoff, gbase, VO[h]); else PG8_STAGE(bufoff, (gbase) + (h) * hstep, voffA); } while (0)
#define PG8_LDA(dst, b, h) do { _Pragma("unroll") for (int m = 0; m < 4; ++m) _Pragma("unroll") for (int k = 0; k < 2; ++k) dst[m][k] = *(const PG8_LAS bf16x8*)(lds + PG8_SA(b, h) + aoff + m * 2048 + k * 1024); } while (0)
#define PG8_LDB(dst, b, h) do { _Pragma("unroll") for (int n = 0; n < 2; ++n) _Pragma("unroll") for (int k = 0; k < 2; ++k) dst[n][k] = *(const PG8_LAS bf16x8*)(lds + PG8_SB(b, h) + boff + n * 2048 + k * 1024); } while (0)
#define PG8_MMA(ai, bj, At, Bt) do { __builtin_amdgcn_s_setprio(1); _Pragma("unroll") for (int m = 0; m < 4; ++m) _Pragma("unroll") for (int n = 0; n < 2; ++n) _Pragma("unroll") for (int k = 0; k < 2; ++k) \
        acc[ai][bj][m][n] = __builtin_amdgcn_mfma_f32_16x16x32_bf16(Bt[n][k], At[m][k], acc[ai][bj][m][n], 0, 0, 0); __builtin_amdgcn_s_setprio(0); } while (0)
#define PG8_WAIT_V(n) asm volatile("s_waitcnt vmcnt(" #n ")" ::: "memory")
#define PG8_WAIT_L(n) asm volatile("s_waitcnt lgkmcnt(" #n ")" ::: "memory")
#define PG8_BAR __builtin_amdgcn_s_barrier()
#define PG8_SCHED __builtin_amdgcn_sched_barrier(0)
    Unit cur, nxt; int ui = 0;
    if (!S.next(0, cur)) return;
    f32x4 acc[2][2][4][2];
#pragma unroll
    for (int a = 0; a < 2; ++a)
#pragma unroll
        for (int b = 0; b < 2; ++b)
#pragma unroll
            for (int m = 0; m < 4; ++m)
#pragma unroll
                for (int n = 0; n < 2; ++n) acc[a][b][m][n] = (f32x4){0.f, 0.f, 0.f, 0.f};
    bf16x8 At[4][2], B0[2][2], B1[2][2];
    const char* cA = (const char*)g.A + (size_t)cur.pa * tstep; const char* cB = (const char*)g.Bt + (size_t)cur.pb * tstep;
    S.a_ready(cur);
    PG8_GOFF(vofC, cur);
#pragma unroll
    for (int h_ = 0; h_ < 2; ++h_)
#pragma unroll
        for (int i_ = 0; i_ < 2; ++i_) { if constexpr (!GATHER) vofC[h_][i_] = 0u; vofN[h_][i_] = vofC[h_][i_]; }
    if constexpr (SP2) {
        PG8_STAGE(PG8_SB(0, 0), cB, voffB); PG8_STAGE(PG8_SB(0, 1), cB + hstep, voffB); PG8_STAGE_A(PG8_SA(0, 0), cA, 0, vofC); PG8_STAGE_A(PG8_SA(0, 1), cA, 1, vofC);
        if (wr == 1) PG8_BAR;
        PG8_WAIT_V(2); PG8_BAR;
        PG8_STAGE(PG8_SB(1, 0), cB + kstep, voffB); PG8_STAGE_A(PG8_SA(1, 0), cA + kstep, 0, vofC); PG8_STAGE(PG8_SB(1, 1), cB + hstep + kstep, voffB);
        PG8_WAIT_V(6); PG8_BAR;
    } else {
        PG8_STAGE(PG8_SB(0, 0), cB, voffB); PG8_STAGE_A(PG8_SA(0, 0), cA, 0, vofC); PG8_STAGE(PG8_SB(0, 1), cB + hstep, voffB); PG8_STAGE_A(PG8_SA(0, 1), cA, 1, vofC);
        if (wr == 1) PG8_BAR;
        PG8_WAIT_V(4); PG8_BAR;
        PG8_STAGE(PG8_SB(1, 0), cB + kstep, voffB); PG8_STAGE_A(PG8_SA(1, 0), cA + kstep, 0, vofC); PG8_STAGE(PG8_SB(1, 1), cB + hstep + kstep, voffB);
        PG8_WAIT_V(6); PG8_BAR;
    }
    for (;;) {
        const bool has_next = S.next(ui + 1, nxt);
        if constexpr (GATHER) { if (has_next) PG8_GOFF(vofN, nxt); }
        const char* nA = has_next ? (const char*)g.A + (size_t)nxt.pa * tstep : cA; const char* nB = has_next ? (const char*)g.Bt + (size_t)nxt.pb * tstep : cB;
        for (int t = 0; t < nt; t += 2) {
            const bool last = (t == nt - 2);
            unsigned vsel[2][2];
#pragma unroll
            for (int h_ = 0; h_ < 2; ++h_)
#pragma unroll
                for (int i_ = 0; i_ < 2; ++i_) vsel[h_][i_] = last ? vofN[h_][i_] : vofC[h_][i_];
            const char* a1 = cA + (size_t)(t + 1) * kstep;
            const char* a2 = last ? nA : cA + (size_t)(t + 2) * kstep; const char* b2 = last ? nB : cB + (size_t)(t + 2) * kstep;
            const char* a3 = a2 + kstep; const char* b3 = b2 + kstep;
            if (last && has_next) S.a_ready(nxt);
            if constexpr (SP2) {
            PG8_LDB(B0, 0, 0); PG8_LDB(B1, 0, 1); PG8_SCHED; PG8_LDA(At, 0, 0); PG8_STAGE_A(PG8_SA(1, 1), a1, 1, vofC);
            PG8_WAIT_V(8); PG8_WAIT_L(0); PG8_BAR; PG8_MMA(0, 0, At, B0); PG8_MMA(0, 1, At, B1); PG8_BAR; PG8_SCHED;
            PG8_LDA(At, 0, 1); PG8_STAGE(PG8_SB(0, 0), b2, voffB); PG8_STAGE(PG8_SB(0, 1), b2 + hstep, voffB); PG8_STAGE_A(PG8_SA(0, 0), a2, 0, vsel);
            PG8_WAIT_V(8); PG8_WAIT_L(0); PG8_BAR; PG8_MMA(1, 0, At, B0); PG8_MMA(1, 1, At, B1); PG8_BAR; PG8_SCHED;
            PG8_LDB(B0, 1, 0); PG8_LDB(B1, 1, 1); PG8_SCHED; PG8_LDA(At, 1, 0); PG8_STAGE_A(PG8_SA(0, 1), a2, 1, vsel);
            PG8_WAIT_V(8); PG8_WAIT_L(0); PG8_BAR; PG8_MMA(0, 0, At, B0); PG8_MMA(0, 1, At, B1); PG8_BAR; PG8_SCHED;
            PG8_LDA(At, 1, 1); PG8_STAGE(PG8_SB(1, 0), b3, voffB); PG8_STAGE(PG8_SB(1, 1), b3 + hstep, voffB); PG8_STAGE_A(PG8_SA(1, 0), a3, 0, vsel);
            PG8_WAIT_V(8); PG8_WAIT_L(0); PG8_BAR; PG8_MMA(1, 0, At, B0); PG8_MMA(1, 1, At, B1); PG8_BAR; PG8_SCHED;
            } else {
            PG8_LDB(B0, 0, 0); PG8_SCHED; PG8_LDA(At, 0, 0); PG8_STAGE_A(PG8_SA(1, 1), a1, 1, vofC);
            PG8_WAIT_L(8); PG8_BAR; PG8_WAIT_L(0); PG8_MMA(0, 0, At, B0); PG8_BAR; PG8_SCHED;
            PG8_LDB(B1, 0, 1); PG8_STAGE(PG8_SB(0, 0), b2, voffB);
            PG8_BAR; PG8_WAIT_L(0); PG8_MMA(0, 1, At, B1); PG8_BAR;
            PG8_LDA(At, 0, 1); PG8_STAGE_A(PG8_SA(0, 0), a2, 0, vsel);
            PG8_BAR; PG8_WAIT_L(0); PG8_MMA(1, 0, At, B0); PG8_BAR; PG8_SCHED;
            PG8_STAGE(PG8_SB(0, 1), b2 + hstep, voffB);
            PG8_WAIT_V(6); PG8_BAR; PG8_MMA(1, 1, At, B1); PG8_BAR;
            PG8_LDB(B0, 1, 0); PG8_SCHED; PG8_LDA(At, 1, 0); PG8_STAGE_A(PG8_SA(0, 1), a2, 1, vsel);
            PG8_WAIT_L(8); PG8_BAR; PG8_WAIT_L(0); PG8_MMA(0, 0, At, B0); PG8_BAR; PG8_SCHED;
            PG8_LDB(B1, 1, 1); PG8_STAGE(PG8_SB(1, 0), b3, voffB);
            PG8_BAR; PG8_WAIT_L(0); PG8_MMA(0, 1, At, B1); PG8_BAR;
            PG8_LDA(At, 1, 1); PG8_STAGE_A(PG8_SA(1, 0), a3, 0, vsel);
            PG8_BAR; PG8_WAIT_L(0); PG8_MMA(1, 0, At, B0); PG8_BAR; PG8_SCHED;
            PG8_STAGE(PG8_SB(1, 1), b3 + hstep, voffB);
            PG8_WAIT_V(6); PG8_BAR; PG8_MMA(1, 1, At, B1); PG8_BAR;
            }
        }
        if constexpr (ALIGN_EPI) { if (wr == 0) PG8_BAR; }
        if constexpr (!Epi::AFTER_DRAIN) { E(acc, cur, wr, wc, fr, fq); S.done(cur); }
        if (!has_next) break;
#pragma unroll
        for (int a = 0; a < 2; ++a)
#pragma unroll
            for (int b = 0; b < 2; ++b)
#pragma unroll
                for (int m = 0; m < 4; ++m)
#pragma unroll
                    for (int n = 0; n < 2; ++n) acc[a][b][m][n] = (f32x4){0.f, 0.f, 0.f, 0.f};
        cur = nxt; cA = nA; cB = nB; ++ui;
#pragma unroll
        for (int h_ = 0; h_ < 2; ++h_)
#pragma unroll
            for (int i_ = 0; i_ < 2; ++i_) vofC[h_][i_] = vofN[h_][i_];
        if constexpr (ALIGN_EPI) { if (wr == 1) PG8_BAR; }
    }
    PG8_WAIT_V(0);
    if constexpr (!ALIGN_EPI) { if (wr == 0) PG8_BAR; }
    PG8_BAR;
    if constexpr (Epi::AFTER_DRAIN) { E.fused(acc, cur, wr, wc, fr, fq, lds, wid, lane); S.done(cur); }
#undef PG8_SA
#undef PG8_SB
#undef PG8_STAGE
#undef PG8_STAGE_A
#undef PG8_GOFF
#undef PG8_LDA
#undef PG8_LDB
#undef PG8_MMA
#undef PG8_WAIT_V
#undef PG8_WAIT_L
#undef PG8_BAR
#undef PG8_SCHED
}
}
#define XB_TMO      128
#define XB_XCNT(j)  (256  + 64 * (j))
#define XB_XSUB(j)  (1280 + 64 * (j))
#define XB_XGEN(j)  (2304 + 64 * (j))
#define XB_TOP      3328
#define XB_TOPGEN   3392
#define XCD_BAR_WORDS 3456
#define XB_SPIN_CAP (1u << 18)

__device__ __forceinline__ unsigned xb_ld(unsigned* p)              { return __hip_atomic_load(p, __ATOMIC_RELAXED, __HIP_MEMORY_SCOPE_AGENT); }
__device__ __forceinline__ unsigned xb_add(unsigned* p, unsigned v) { return __hip_atomic_fetch_add(p, v, __ATOMIC_RELAXED, __HIP_MEMORY_SCOPE_AGENT); }
__device__ __forceinline__ unsigned xb_xcc_id() { return (unsigned)__builtin_amdgcn_s_getreg((3 << 11) | 20) & 0xFu; }
#define XB_SPIN(cond, bar) do { unsigned _sp = 0; while (cond) { __builtin_amdgcn_s_sleep(1); \
    if ((++_sp & 255u) == 0u) { if (xb_ld(&(bar)[XB_TMO])) break; if (_sp > XB_SPIN_CAP) { atomicAdd(&(bar)[XB_TMO], 1u); break; } } } } while (0)

struct XcdBarrier {
    unsigned* bar; unsigned x;
    volatile LAS unsigned* st;
};

__device__ __forceinline__ XcdBarrier xcd_barrier_post(unsigned* bar, volatile LAS unsigned* st) {
    XcdBarrier b; b.bar = bar; b.x = xb_xcc_id(); b.st = st;
    if (threadIdx.x == 0) (void)xb_add(&bar[XB_XCNT(b.x)], 1u);
    return b;
}
__device__ __forceinline__ void xcd_barrier_complete(unsigned* bar, unsigned x, unsigned& nloc, unsigned& nx) {
    const unsigned G = gridDim.x * gridDim.y * gridDim.z;
    unsigned sum, cnt, mine, sp = 0u;
    for (;;) {
        sum = 0u; cnt = 0u; mine = 0u;
#pragma unroll
        for (unsigned j = 0; j < 16; ++j) { const unsigned c = xb_ld(&bar[XB_XCNT(j)]); sum += c; cnt += (c > 0u) ? 1u : 0u; mine = (j == x) ? c : mine; }
        if (sum == G) break;
        __builtin_amdgcn_s_sleep(1);
        if ((++sp & 255u) == 0u) { if (xb_ld(&bar[XB_TMO])) break; if (sp > XB_SPIN_CAP) { atomicAdd(&bar[XB_TMO], 1u); break; } }
    }
    nloc = mine > 0u ? mine : 1u; nx = cnt > 0u ? cnt : 1u;
}

__device__ __forceinline__ void xcd_barrier(const XcdBarrier& b) {
    asm volatile("s_waitcnt vmcnt(0)" ::: "memory");
    __syncthreads();
    if (threadIdx.x == 0) {
        unsigned* bar = b.bar;
        __builtin_amdgcn_s_waitcnt(0);
        unsigned nloc = b.st[0], nx = b.st[1];
        if (nloc == 0u) { xcd_barrier_complete(bar, b.x, nloc, nx); b.st[0] = nloc; b.st[1] = nx; }
        const unsigned old = xb_add(&bar[XB_XSUB(b.x)], 1u);
        const unsigned gen = old / nloc;
        if (old + 1u == (gen + 1u) * nloc) {
            __builtin_amdgcn_fence(__ATOMIC_RELEASE, "agent");
            asm volatile("s_waitcnt vmcnt(0)" ::: "memory");
            const unsigned og = xb_add(&bar[XB_TOP], 1u);
            const unsigned tg = og / nx;
            if (og + 1u == (tg + 1u) * nx) xb_add(&bar[XB_TOPGEN], 1u);
            else XB_SPIN(xb_ld(&bar[XB_TOPGEN]) == tg, bar);
            __builtin_amdgcn_fence(__ATOMIC_ACQUIRE, "agent");
            xb_add(&bar[XB_XGEN(b.x)], 1u);
            asm volatile("s_waitcnt vmcnt(0)" ::: "memory");
        } else {
            XB_SPIN(xb_ld(&bar[XB_XGEN(b.x)]) == gen, bar);
            __builtin_amdgcn_fence(__ATOMIC_ACQUIRE, "agent");
            asm volatile("s_waitcnt vmcnt(0)" ::: "memory");
        }
    }
    __syncthreads();
}
struct Args {
    const float* in[28];
    float* out; unsigned char* ws;
    int ph_lo, ph_hi;
};
struct Frame {
    LAS unsigned char* lds;
    int tid, lane, wave, G, bid;
    unsigned char* ws; float* out;
};
#define WSP(type, off) ((type*)(F.ws + (off)))
constexpr int LDS_PTR_OFF = LDS_MISC_OFF + 16;
__device__ __forceinline__ const float* in_ptr(LAS unsigned char* lds, int k) {
    const unsigned long long v = *(volatile LAS unsigned long long*)(lds + LDS_PTR_OFF + 8 * k);
    const unsigned lo = __builtin_amdgcn_readfirstlane((unsigned)v), hi = __builtin_amdgcn_readfirstlane((unsigned)(v >> 32));
    return (const float*)(((unsigned long long)hi << 32) | lo);
}
#define INP(k) in_ptr(F.lds, (k))

namespace pg8 {
struct EpiProj0 {
    static constexpr bool PERM = true, AFTER_DRAIN = false;
    unsigned char* ws;
    __device__ __forceinline__ void operator()(const f32x4 (&acc)[2][2][4][2], const Unit& u, int wr, int wc, int fr, int fq) const {
        const int row0 = u.pm * BM + wr * 64 + fr, cl = wc * 32 + 8 * fq;
        if (u.pn >= 16) {
            float* H = (float*)(ws + WS_HCMP);
#pragma unroll
            for (int ai = 0; ai < 2; ++ai)
#pragma unroll
                for (int m = 0; m < 4; ++m) { float* rp = H + (size_t)(row0 + ai * HALF + m * 16) * 512 + (u.pn - 16) * BM + cl;
#pragma unroll
                    for (int bj = 0; bj < 2; ++bj) { *(f32x4*)(rp + bj * HALF) = acc[ai][bj][m][0]; *(f32x4*)(rp + bj * HALF + 4) = acc[ai][bj][m][1]; } }
            return;
        }
#pragma unroll
        for (int bj = 0; bj < 2; ++bj) {
            const int hb = 2 * u.pn + bj;
            bf16_t* dst = nullptr; int pitch = 128, cb = cl, mode = 0; float sc = 1.f;
            if (hb < 4) { dst = (bf16_t*)(ws + WS_QA); pitch = 512; cb = hb * 128 + cl; sc = QSCALE; }
            else if (hb == 4) dst = (bf16_t*)(ws + WS_KA);
            else if (hb == 5) dst = (bf16_t*)(ws + WS_VA);
            else if (hb < 10) { dst = (bf16_t*)(ws + WS_QB); pitch = 512; cb = (hb - 6) * 128 + cl; sc = QSCALE; }
            else if (hb == 10) { dst = (bf16_t*)(ws + WS_KCMP); mode = 1; }
            else if (hb == 11) { dst = (bf16_t*)(ws + WS_VCMP); mode = 1; }
            else if (hb == 12) dst = (bf16_t*)(ws + WS_KSLC);
            else if (hb == 13) dst = (bf16_t*)(ws + WS_VSLC);
            else if (hb == 14) dst = (bf16_t*)(ws + WS_KWIN);
            else if (hb == 15) dst = (bf16_t*)(ws + WS_VWIN);
            else if (hb == 16) mode = (cl < 24) ? 2 : 3;
            else mode = 3;
            if (mode == 3) continue;
#pragma unroll
            for (int ai = 0; ai < 2; ++ai)
#pragma unroll
                for (int m = 0; m < 4; ++m) {
                    const int row = row0 + ai * HALF + m * 16;
                    const f32x4 v0 = acc[ai][bj][m][0], v1 = acc[ai][bj][m][1];
                    if (mode == 2) {
                        float* gp = (float*)(ws + WS_GATES) + (size_t)row * 24 + cl;
                        f32x4 a, b;
#pragma unroll
                        for (int i = 0; i < 4; ++i) { a[i] = 1.f / (1.f + __expf(-v0[i])); b[i] = 1.f / (1.f + __expf(-v1[i])); }
                        *(f32x4*)gp = a; *(f32x4*)(gp + 4) = b;
                    } else {
                        u32x4 w; w.x = cvt_pk_bf16(v0[0] * sc, v0[1] * sc); w.y = cvt_pk_bf16(v0[2] * sc, v0[3] * sc); w.z = cvt_pk_bf16(v1[0] * sc, v1[1] * sc); w.w = cvt_pk_bf16(v1[2] * sc, v1[3] * sc);
                        size_t off;
                        if (mode == 1) { const int b = row >> 12, t = row & 4095, g = cb >> 6, d = cb & 63; off = ((size_t)((b * 2 + g) * 4096 + t)) * 64 + d; }
                        else off = (size_t)row * pitch + cb;
                        *(u32x4*)(dst + off) = w;
                    }
                }
        }
    }
};
struct EpiProj1 {
    static constexpr bool PERM = true, AFTER_DRAIN = false;
    unsigned char* ws;
    __device__ __forceinline__ void operator()(const f32x4 (&acc)[2][2][4][2], const Unit& u, int wr, int wc, int fr, int fq) const {
        const int row0 = u.pm * BM + wr * 64 + fr, cl = wc * 32 + 8 * fq;
#pragma unroll
        for (int bj = 0; bj < 2; ++bj) {
            const int hb = 2 * u.pn + bj;
            bf16_t* dst = nullptr; int pitch = 1024, cb = cl, mode = 0; float sc = 1.f;
            if (hb < 8) { dst = (bf16_t*)(ws + WS_Q1); cb = hb * 128 + cl; sc = QSCALE; }
            else if (hb == 8) { if (cl < 64) { dst = (bf16_t*)(ws + WS_K1); pitch = 64; } else { dst = (bf16_t*)(ws + WS_V1); pitch = 64; cb = cl - 64; } }
            else if (hb < 11) { dst = (bf16_t*)(ws + WS_QI); pitch = 256; cb = (hb - 9) * 128 + cl; }
            else if (hb == 11) { if (cl < 32) { dst = (bf16_t*)(ws + WS_KI); pitch = 32; } else if (cl < 40) mode = 2; else mode = 3; }
            else mode = 3;
            if (mode == 3) continue;
#pragma unroll
            for (int ai = 0; ai < 2; ++ai)
#pragma unroll
                for (int m = 0; m < 4; ++m) {
                    const int row = row0 + ai * HALF + m * 16;
                    const f32x4 v0 = acc[ai][bj][m][0], v1 = acc[ai][bj][m][1];
                    if (mode == 2) { float* gp = (float*)(ws + WS_WI) + (size_t)row * 8; *(f32x4*)gp = v0; *(f32x4*)(gp + 4) = v1; }
                    else { u32x4 w; w.x = cvt_pk_bf16(v0[0] * sc, v0[1] * sc); w.y = cvt_pk_bf16(v0[2] * sc, v0[3] * sc); w.z = cvt_pk_bf16(v1[0] * sc, v1[1] * sc); w.w = cvt_pk_bf16(v1[2] * sc, v1[3] * sc);
                        *(u32x4*)(dst + (size_t)row * pitch + cb) = w; }
                }
        }
    }
};
struct EpiF32 {
    static constexpr bool PERM = false, AFTER_DRAIN = false;
    float* out; int ldc;
    __device__ __forceinline__ void operator()(const f32x4 (&acc)[2][2][4][2], const Unit& u, int wr, int wc, int fr, int fq) const {
#pragma unroll
        for (int ai = 0; ai < 2; ++ai)
#pragma unroll
            for (int m = 0; m < 4; ++m) { float* rp = out + (size_t)(u.pm * BM + ai * HALF + wr * 64 + m * 16 + fr) * ldc + u.pn * BM + wc * 32 + 4 * fq;
#pragma unroll
                for (int bj = 0; bj < 2; ++bj)
#pragma unroll
                    for (int n = 0; n < 2; ++n) *(f32x4*)(rp + bj * HALF + n * 16) = acc[ai][bj][m][n]; }
    }
};
struct EpiRes {
    static constexpr bool PERM = true, AFTER_DRAIN = false;
    const float* resf; const bf16_t* resb; bf16_t* out;
    __device__ __forceinline__ void operator()(const f32x4 (&acc)[2][2][4][2], const Unit& u, int wr, int wc, int fr, int fq) const {
#pragma unroll
        for (int ai = 0; ai < 2; ++ai)
#pragma unroll
            for (int m = 0; m < 4; ++m) { const size_t ro = (size_t)(u.pm * BM + ai * HALF + wr * 64 + m * 16 + fr) * DM + u.pn * BM + wc * 32 + 8 * fq;
#pragma unroll
                for (int bj = 0; bj < 2; ++bj) { const size_t o = ro + bj * HALF; f32x4 r0, r1;
                    if (resf) { r0 = *(const f32x4*)(resf + o); r1 = *(const f32x4*)(resf + o + 4); }
                    else { const u32x4 w = *(const u32x4*)(resb + o); r0 = (f32x4){bf_lo(w.x), bf_hi(w.x), bf_lo(w.y), bf_hi(w.y)}; r1 = (f32x4){bf_lo(w.z), bf_hi(w.z), bf_lo(w.w), bf_hi(w.w)}; }
                    const f32x4 v0 = r0 * ALPHA + acc[ai][bj][m][0], v1 = r1 * ALPHA + acc[ai][bj][m][1];
                    u32x4 q; q.x = cvt_pk_bf16(v0[0], v0[1]); q.y = cvt_pk_bf16(v0[2], v0[3]); q.z = cvt_pk_bf16(v1[0], v1[1]); q.w = cvt_pk_bf16(v1[2], v1[3]);
                    *(u32x4*)(out + o) = q; } }
    }
};
struct EpiSwiglu {
    static constexpr bool PERM = true, AFTER_DRAIN = false;
    bf16_t* H; int row_tile0;
    __device__ __forceinline__ void operator()(const f32x4 (&acc)[2][2][4][2], const Unit& u, int wr, int wc, int fr, int fq) const {
        const int row0 = (u.pm - row_tile0) * BM + wr * 64 + fr, col = u.pn * HALF + wc * 32 + 8 * fq;
#pragma unroll
        for (int ai = 0; ai < 2; ++ai)
#pragma unroll
            for (int m = 0; m < 4; ++m) {
                float h[8];
#pragma unroll
                for (int n = 0; n < 2; ++n)
#pragma unroll
                    for (int i = 0; i < 4; ++i) { const float g = acc[ai][0][m][n][i], up = acc[ai][1][m][n][i];
                        h[n * 4 + i] = g * __builtin_amdgcn_rcpf(1.f + __builtin_amdgcn_exp2f(-g * LOG2E)) * up; }
                u32x4 w; w.x = cvt_pk_bf16(h[0], h[1]); w.y = cvt_pk_bf16(h[2], h[3]); w.z = cvt_pk_bf16(h[4], h[5]); w.w = cvt_pk_bf16(h[6], h[7]);
                *(u32x4*)(H + (size_t)(row0 + ai * HALF + m * 16) * DFF + col) = w;
            }
    }
};
struct EpiBf16 {
    static constexpr bool PERM = true, AFTER_DRAIN = false;
    bf16_t* O;
    __device__ __forceinline__ void operator()(const f32x4 (&acc)[2][2][4][2], const Unit& u, int wr, int wc, int fr, int fq) const {
        const int row0 = u.pm * BM + wr * 64 + fr, col0 = u.pn * BM + wc * 32 + 8 * fq;
#pragma unroll
        for (int ai = 0; ai < 2; ++ai)
#pragma unroll
            for (int m = 0; m < 4; ++m) { bf16_t* rowp = O + (size_t)(row0 + ai * HALF + m * 16) * DM + col0;
#pragma unroll
                for (int bj = 0; bj < 2; ++bj) { const f32x4 v0 = acc[ai][bj][m][0], v1 = acc[ai][bj][m][1];
                    u32x4 w; w.x = cvt_pk_bf16(v0[0], v0[1]); w.y = cvt_pk_bf16(v0[2], v0[3]); w.z = cvt_pk_bf16(v1[0], v1[1]); w.w = cvt_pk_bf16(v1[2], v1[3]);
                    *(u32x4*)(rowp + bj * HALF) = w; } }
    }
};
struct Proj0OrderA {
    int G, c; const int* rowlist; int gpitch;
    __device__ bool next(int i, Unit& u) const { const int L = i * G + c; if (L >= 256) return false; u.pm = L >> 1; u.pa = u.pm; u.pn = (L & 1) ? 8 : 5; u.pb = u.pn; return true; }
    __device__ __forceinline__ void a_ready(const Unit&) const {}
    __device__ __forceinline__ void done(const Unit&) const {}
};
struct Proj0OrderB {
    StaticOrder so; int G, c; const int* rowlist; int gpitch;
    __device__ bool next(int i, Unit& u) const {
        if (so.next(i, u)) { u.pn = u.pn < 5 ? u.pn : u.pn + 1; u.pb = u.pn; return true; }
        const int L = i * G + c - 896; if (L < 0 || L >= 64) return false;
        const int ct = L >> 1; u.pm = ct; u.pa = (int)((WS_KCMP - WS_XB) / (512 * 1024)) + ct; u.pn = 16 + (L & 1); u.pb = (int)((WS_WC1 - WS_WIN0) / (512 * 1024)) + (ct >> 4) * 2 + (L & 1); return true;
    }
    __device__ __forceinline__ void a_ready(const Unit&) const {}
    __device__ __forceinline__ void done(const Unit&) const {}
};
struct MoeOrder {
    StaticOrder so; int tile0, nN, a_local, gpitch; const LAS int* tile_e; const int* rowlist;
    __device__ bool next(int i, Unit& u) const {
        if (!so.next(i, u)) return false;
        const int tile = tile0 + u.pm; u.pa = a_local ? u.pm : 0; u.pb = tile_e[tile] * nN + u.pn; u.pm = tile; return true;
    }
    __device__ __forceinline__ void a_ready(const Unit&) const {}
    __device__ __forceinline__ void done(const Unit&) const {}
};
}
enum { I_X = 0, I_RELB, I_L0_WIN, I_L0_SINKS, I_CK_POS, I_CK_W1, I_CK_W2, I_CV_POS, I_CV_W1, I_CV_W2, I_L0_WOUT, I_L0_LN1G, I_L0_LN1B, I_L0_GATE, I_L0_UP, I_L0_DOWN, I_L0_LN2G, I_L0_LN2B,
       I_L1_WIN, I_L1_WOUT, I_L1_LN1G, I_L1_LN1B, I_L1_ROUTER, I_L1_EGATE, I_L1_EUP, I_L1_EDOWN, I_L1_LN2G, I_L1_LN2B };

__device__ __forceinline__ void p0_transpose_item(const float* W, int ldw, int ncols, bf16_t* WT, int dk, int k0, int n0, int drow0, LAS float* scr, int lane) {
    const int cn = n0 + (lane & 31); const bool okc = cn < ncols;
    float tv[32];
#pragma unroll
    for (int i = 0; i < 32; ++i) { const int kk = 2 * i + (lane >> 5); tv[i] = okc ? W[(size_t)(k0 + kk) * ldw + cn] : 0.f; }
#pragma unroll
    for (int i = 0; i < 32; ++i) { const int kk = 2 * i + (lane >> 5); scr[kk * 33 + (lane & 31)] = tv[i]; }
    asm volatile("s_waitcnt lgkmcnt(0)" ::: "memory");
    const int c = lane & 7;
#pragma unroll
    for (int j = 0; j < 4; ++j) { const int n = (lane >> 3) + 8 * j; const LAS float* s = scr + (8 * c) * 33 + n;
        u32x4 o; o.x = cvt_pk_bf16(s[0 * 33], s[1 * 33]); o.y = cvt_pk_bf16(s[2 * 33], s[3 * 33]); o.z = cvt_pk_bf16(s[4 * 33], s[5 * 33]); o.w = cvt_pk_bf16(s[6 * 33], s[7 * 33]);
        *(u32x4*)(WT + (size_t)(drow0 + n) * dk + k0 + 8 * c) = o; }
    asm volatile("s_waitcnt lgkmcnt(0)" ::: "memory");
}
struct TJob { const float* W; bf16_t* WT; int ldw, ncols, npad, ksrc, dk, map; };
__device__ __forceinline__ int tjob_items(const TJob& j) { return (j.ksrc / 64) * (j.npad / 32); }
__device__ __forceinline__ void tjob_run(const TJob& j, int item, LAS float* scr, int lane) {
    const int nblk = j.npad / 32, kb = item / nblk, nb = item % nblk, n0 = nb * 32;
    int drow0 = n0; if (j.map) drow0 = 256 * (n0 >> 7) + (n0 & 127) + (j.map == 2 ? 128 : 0);
    p0_transpose_item(j.W, j.ldw, j.ncols, j.WT, j.dk, kb * 64, n0, drow0, scr, lane);
}
__device__ __forceinline__ void p0_prologue(Frame& F, const Args& A) {
    LAS float* scr = (LAS float*)(F.lds + F.wave * 16384);
    const int gw = F.bid * 8 + F.wave, NGW = F.G * 8;
    int base = 0;
#define RUN_JOB(jb) do { const TJob j_ = (jb); const int n_ = tjob_items(j_); \
        int it_ = gw - (base % NGW); if (it_ < 0) it_ += NGW; for (; it_ < n_; it_ += NGW) tjob_run(j_, it_, scr, F.lane); base += n_; } while (0)
    RUN_JOB((TJob{INP(I_L0_WIN), WSP(bf16_t, WS_WIN0), N_IN0, N_IN0, N_IN0P, DM, DM, 0}));
    RUN_JOB((TJob{INP(I_CK_W1), WSP(bf16_t, WS_WC1), 256, 256, 256, 1024, 1024, 0}));
    RUN_JOB((TJob{INP(I_CK_W1) + 1024 * 256, WSP(bf16_t, WS_WC1) + 256 * 1024, 256, 256, 256, 1024, 1024, 0}));
    RUN_JOB((TJob{INP(I_CV_W1), WSP(bf16_t, WS_WC1) + 512 * 1024, 256, 256, 256, 1024, 1024, 0}));
    RUN_JOB((TJob{INP(I_CV_W1) + 1024 * 256, WSP(bf16_t, WS_WC1) + 768 * 1024, 256, 256, 256, 1024, 1024, 0}));
    RUN_JOB((TJob{INP(I_L0_WOUT), WSP(bf16_t, WS_WOUT0), DM, DM, DM, DM, DM, 0}));
    RUN_JOB((TJob{INP(I_L0_GATE), WSP(bf16_t, WS_WGU0), DFF, DFF, DFF, DM, DM, 1}));
    RUN_JOB((TJob{INP(I_L0_UP), WSP(bf16_t, WS_WGU0), DFF, DFF, DFF, DM, DM, 2}));
    RUN_JOB((TJob{INP(I_L0_DOWN), WSP(bf16_t, WS_WDN0), DM, DM, DM, DFF, DFF, 0}));
    RUN_JOB((TJob{INP(I_L1_WIN), WSP(bf16_t, WS_WIN1), N_IN1, N_IN1, N_IN1P, DM, DM, 0}));
    RUN_JOB((TJob{INP(I_L1_WOUT), WSP(bf16_t, WS_WOUT1), DM, DM, DM, DM, DM, 0}));
    for (int e = 0; e < NEXP; ++e) {
        RUN_JOB((TJob{INP(I_L1_EGATE) + (size_t)e * DM * DFF, WSP(bf16_t, WS_WGU1) + (size_t)e * 2 * DFF * DM, DFF, DFF, DFF, DM, DM, 1}));
        RUN_JOB((TJob{INP(I_L1_EUP) + (size_t)e * DM * DFF, WSP(bf16_t, WS_WGU1) + (size_t)e * 2 * DFF * DM, DFF, DFF, DFF, DM, DM, 2}));
        RUN_JOB((TJob{INP(I_L1_EDOWN) + (size_t)e * DFF * DM, WSP(bf16_t, WS_WDN1) + (size_t)e * DM * DFF, DM, DM, DM, DFF, DFF, 0}));
    }
#undef RUN_JOB
    {   const float* xin = INP(I_X);
        for (int m = 4 * gw; m < T; m += 4 * NGW) {
            f32x4 v[4][4];
#pragma unroll
            for (int r = 0; r < 4; ++r)
#pragma unroll
                for (int j = 0; j < 4; ++j) v[r][j] = *((const f32x4*)(xin + (size_t)(m + r) * DM) + F.lane + 64 * j);
#pragma unroll
            for (int r = 0; r < 4; ++r)
#pragma unroll
                for (int j = 0; j < 4; ++j) { u32x2 w; w.x = cvt_pk_bf16(v[r][j][0], v[r][j][1]); w.y = cvt_pk_bf16(v[r][j][2], v[r][j][3]); *((u32x2*)(WSP(bf16_t, WS_XB) + (size_t)(m + r) * DM) + F.lane + 64 * j) = w; }
        }
    }
    for (int it = F.bid; it < 32; it += F.G) {
        const int which = it >> 4, sl = it & 15;
        if (F.tid < 256) {
            const float* pos = INP(which ? I_CV_POS : I_CK_POS) + sl * 128; const float* w1 = INP(which ? I_CV_W1 : I_CK_W1) + (size_t)sl * 128 * 256 + F.tid;
            float s = 0.f;
#pragma unroll 8
            for (int r = 0; r < 128; ++r) s += pos[r] * w1[(size_t)r * 256];
            WSP(float, WS_POSW)[(which * 16 + sl) * 256 + F.tid] = s;
        }
    }
}

__device__ __forceinline__ void p2b_compress_tail(Frame& F, const Args& A) {
    LAS float* hid = (LAS float*)(F.lds + F.wave * 1024);
    const int gw = F.bid * 8 + F.wave, NGW = F.G * 8;
    const float* H = WSP(float, WS_HCMP); const float* PW = WSP(float, WS_POSW);
    for (int it = gw; it < 2 * 16 * 256; it += NGW) {
        const int which = it >> 12, bg = (it >> 8) & 15, n = it & 255;
        bf16_t* dst = WSP(bf16_t, WS_KC) + ((size_t)(which * 16 + bg) * 256 + n) * 64;
        if (n == 255) { dst[F.lane] = 0; continue; }
        const size_t r0 = (size_t)(which * 4096 + bg * 256 + n) * 512;
        const f32x4 a = *(const f32x4*)(H + r0 + 4 * F.lane), b = *(const f32x4*)(H + r0 + 512 + 256 + 4 * F.lane);
        f32x4 pw = {0.f, 0.f, 0.f, 0.f};
#pragma unroll
        for (int s = 0; s < 16; ++s) pw += *(const f32x4*)(PW + (which * 16 + s) * 256 + 4 * F.lane);
        const f32x4 v = a + b + pw; f32x4 g;
#pragma unroll
        for (int i = 0; i < 4; ++i) { const float x = v[i], u = 0.7978845608028654f * (x + 0.044715f * x * x * x); const float th = 1.f - 2.f / (1.f + __expf(2.f * u)); g[i] = 0.5f * x * (1.f + th); }
        *(LAS f32x4*)(hid + 4 * F.lane) = g;
        asm volatile("s_waitcnt lgkmcnt(0)" ::: "memory");
        const float* w2 = INP(which ? I_CV_W2 : I_CK_W2) + F.lane; float acc = 0.f;
#pragma unroll 8
        for (int j = 0; j < 256; ++j) acc += hid[j] * w2[(size_t)j * 64];
        dst[F.lane] = (bf16_t)(cvt_pk_bf16(acc, 0.f) & 0xffffu);
        asm volatile("s_waitcnt lgkmcnt(0)" ::: "memory");
    }
}

__device__ __forceinline__ f32x4 ld_bf4(const bf16_t* p) { const u32x2 w = *(const u32x2*)p; return (f32x4){bf_lo(w.x), bf_hi(w.x), bf_lo(w.y), bf_hi(w.y)}; }
__device__ __forceinline__ void ln_row(const bf16_t* y, const float* g, const float* b, int lane, f32x4 (&v)[4]) {
    float s = 0.f;
#pragma unroll
    for (int j = 0; j < 4; ++j) { v[j] = ld_bf4(y + 4 * (lane + 64 * j)); s += (v[j][0] + v[j][1]) + (v[j][2] + v[j][3]); }
    const float mean = wave_sum(s) * (1.f / DM); float s2 = 0.f;
#pragma unroll
    for (int j = 0; j < 4; ++j) { v[j] = v[j] - mean; s2 += (v[j][0] * v[j][0] + v[j][1] * v[j][1]) + (v[j][2] * v[j][2] + v[j][3] * v[j][3]); }
    const float rstd = 1.f / sqrtf(wave_sum(s2) * (1.f / DM) + LN_EPS);
#pragma unroll
    for (int j = 0; j < 4; ++j) { const f32x4 gg = *((const f32x4*)g + lane + 64 * j), bb = *((const f32x4*)b + lane + 64 * j); v[j] = v[j] * rstd * gg + bb; }
}
__device__ __forceinline__ void ln_row2(const bf16_t* y0, const bf16_t* y1, const float* g, const float* b, int lane, f32x4 (&v)[4], f32x4 (&w)[4]) {
    float s = 0.f, t = 0.f;
#pragma unroll
    for (int j = 0; j < 4; ++j) { v[j] = ld_bf4(y0 + 4 * (lane + 64 * j)); w[j] = ld_bf4(y1 + 4 * (lane + 64 * j)); }
#pragma unroll
    for (int j = 0; j < 4; ++j) { s += (v[j][0] + v[j][1]) + (v[j][2] + v[j][3]); t += (w[j][0] + w[j][1]) + (w[j][2] + w[j][3]); }
#pragma unroll
    for (int o = 1; o < 64; o <<= 1) { s += __shfl_xor(s, o); t += __shfl_xor(t, o); }
    const float m0 = s * (1.f / DM), m1 = t * (1.f / DM); float s2 = 0.f, t2 = 0.f;
#pragma unroll
    for (int j = 0; j < 4; ++j) { v[j] = v[j] - m0; w[j] = w[j] - m1; s2 += (v[j][0] * v[j][0] + v[j][1] * v[j][1]) + (v[j][2] * v[j][2] + v[j][3] * v[j][3]); t2 += (w[j][0] * w[j][0] + w[j][1] * w[j][1]) + (w[j][2] * w[j][2] + w[j][3] * w[j][3]); }
#pragma unroll
    for (int o = 1; o < 64; o <<= 1) { s2 += __shfl_xor(s2, o); t2 += __shfl_xor(t2, o); }
    const float r0 = 1.f / sqrtf(s2 * (1.f / DM) + LN_EPS), r1 = 1.f / sqrtf(t2 * (1.f / DM) + LN_EPS);
#pragma unroll
    for (int j = 0; j < 4; ++j) { const f32x4 gg = *((const f32x4*)g + lane + 64 * j), bb = *((const f32x4*)b + lane + 64 * j); v[j] = v[j] * r0 * gg + bb; w[j] = w[j] * r1 * gg + bb; }
}
template <int N>
__device__ __forceinline__ void ln_rowsN(const bf16_t* y, const float* g, const float* b, int lane, f32x4 (&v)[N][4]) {
    float s[N], s2[N];
#pragma unroll
    for (int r = 0; r < N; ++r)
#pragma unroll
        for (int j = 0; j < 4; ++j) v[r][j] = ld_bf4(y + (size_t)r * DM + 4 * (lane + 64 * j));
#pragma unroll
    for (int r = 0; r < N; ++r) { s[r] = 0.f;
#pragma unroll
        for (int j = 0; j < 4; ++j) s[r] += (v[r][j][0] + v[r][j][1]) + (v[r][j][2] + v[r][j][3]); }
#pragma unroll
    for (int o = 1; o < 64; o <<= 1)
#pragma unroll
        for (int r = 0; r < N; ++r) s[r] += __shfl_xor(s[r], o);
#pragma unroll
    for (int r = 0; r < N; ++r) { const float m0 = s[r] * (1.f / DM); s2[r] = 0.f;
#pragma unroll
        for (int j = 0; j < 4; ++j) { v[r][j] = v[r][j] - m0; s2[r] += (v[r][j][0] * v[r][j][0] + v[r][j][1] * v[r][j][1]) + (v[r][j][2] * v[r][j][2] + v[r][j][3] * v[r][j][3]); } }
#pragma unroll
    for (int o = 1; o < 64; o <<= 1)
#pragma unroll
        for (int r = 0; r < N; ++r) s2[r] += __shfl_xor(s2[r], o);
#pragma unroll
    for (int j = 0; j < 4; ++j) { const f32x4 gg = *((const f32x4*)g + lane + 64 * j), bb = *((const f32x4*)b + lane + 64 * j);
#pragma unroll
        for (int r = 0; r < N; ++r) { const float rs = 1.f / sqrtf(s2[r] * (1.f / DM) + LN_EPS); v[r][j] = v[r][j] * rs * gg + bb; } }
}
__device__ __forceinline__ void p_layernorm(Frame& F, const bf16_t* y, const float* g, const float* b, bf16_t* ob) {
    const int gw = F.bid * 8 + F.wave, NGW = F.G * 8;
    for (int m = 4 * gw; m < T; m += 4 * NGW) {
        f32x4 v[4][4]; ln_rowsN<4>(y + (size_t)m * DM, g, b, F.lane, v);
#pragma unroll
        for (int r = 0; r < 4; ++r) { u32x2* o = (u32x2*)(ob + (size_t)(m + r) * DM) + F.lane;
#pragma unroll
            for (int j = 0; j < 4; ++j) { u32x2 q; q.x = cvt_pk_bf16(v[r][j][0], v[r][j][1]); q.y = cvt_pk_bf16(v[r][j][2], v[r][j][3]); o[64 * j] = q; } }
    }
}
struct TokInfo { int p0, p1; float g0, g1; };
__device__ __forceinline__ void p12_ln_router(Frame& F, const Args& A) {
    LAS float* rt = (LAS float*)F.lds;
    LAS int* cnt = (LAS int*)(F.lds + 32768);
    { const float* rg = INP(I_L1_ROUTER); for (int i = F.tid; i < DM * NEXP; i += 512) rt[(i & 7) * DM + (i >> 3)] = rg[i]; }
    if (F.tid < 8) cnt[F.tid] = 0;
    for (int i = F.bid * 512 + F.tid; i < 264 * 256; i += F.G * 512) WSP(int, WS_ROWTOK)[i] = 0;
    __syncthreads();
    const bf16_t* y = WSP(bf16_t, WS_Y3); bf16_t* xb = (bf16_t*)F.out + 1024; TokInfo* ti = WSP(TokInfo, WS_TOKINFO);
    for (int blk = F.bid; blk < T / 128; blk += F.G) {
        for (int i = 0; i < 16; i += 2) {
            const int m = blk * 128 + F.wave * 16 + i;
            f32x4 v[2][4]; ln_row2(y + (size_t)m * DM, y + (size_t)(m + 1) * DM, INP(I_L1_LN1G), INP(I_L1_LN1B), F.lane, v[0], v[1]);
            float lg[2][8];
#pragma unroll
            for (int q = 0; q < 2; ++q) {
                u32x2* o = (u32x2*)(xb + (size_t)(m + q) * 2048) + F.lane;
#pragma unroll
                for (int j = 0; j < 4; ++j) { u32x2 w; w.x = cvt_pk_bf16(v[q][j][0], v[q][j][1]); w.y = cvt_pk_bf16(v[q][j][2], v[q][j][3]); o[64 * j] = w; }
            }
#pragma unroll
            for (int e = 0; e < 8; ++e) { float s0 = 0.f, s1 = 0.f;
#pragma unroll
                for (int j = 0; j < 4; ++j) { const f32x4 r = *(const LAS f32x4*)(rt + e * DM + 4 * (F.lane + 64 * j));
                    s0 += (v[0][j][0] * r[0] + v[0][j][1] * r[1]) + (v[0][j][2] * r[2] + v[0][j][3] * r[3]); s1 += (v[1][j][0] * r[0] + v[1][j][1] * r[1]) + (v[1][j][2] * r[2] + v[1][j][3] * r[3]); }
                lg[0][e] = s0; lg[1][e] = s1; }
            {
                const bool b0 = F.lane & 1, b1 = F.lane & 2, b2 = F.lane & 4;
                float r4[2][4], r2[2][2], r1[2];
#pragma unroll
                for (int q = 0; q < 2; ++q)
#pragma unroll
                    for (int k = 0; k < 4; ++k) { const float send = b0 ? lg[q][k] : lg[q][k + 4], keep = b0 ? lg[q][k + 4] : lg[q][k]; r4[q][k] = keep + __shfl_xor(send, 1); }
#pragma unroll
                for (int q = 0; q < 2; ++q)
#pragma unroll
                    for (int k = 0; k < 2; ++k) { const float send = b1 ? r4[q][k] : r4[q][k + 2], keep = b1 ? r4[q][k + 2] : r4[q][k]; r2[q][k] = keep + __shfl_xor(send, 2); }
#pragma unroll
                for (int q = 0; q < 2; ++q) { const float send = b2 ? r2[q][0] : r2[q][1], keep = b2 ? r2[q][1] : r2[q][0]; r1[q] = keep + __shfl_xor(send, 4); }
#pragma unroll
                for (int o_ = 8; o_ < 64; o_ <<= 1) { r1[0] += __shfl_xor(r1[0], o_); r1[1] += __shfl_xor(r1[1], o_); }
#pragma unroll
                for (int q = 0; q < 2; ++q) { const int ri = __float_as_int(r1[q]);
                    lg[q][0] = __int_as_float(__builtin_amdgcn_readlane(ri, 0)); lg[q][1] = __int_as_float(__builtin_amdgcn_readlane(ri, 4)); lg[q][2] = __int_as_float(__builtin_amdgcn_readlane(ri, 2)); lg[q][3] = __int_as_float(__builtin_amdgcn_readlane(ri, 6));
                    lg[q][4] = __int_as_float(__builtin_amdgcn_readlane(ri, 1)); lg[q][5] = __int_as_float(__builtin_amdgcn_readlane(ri, 5)); lg[q][6] = __int_as_float(__builtin_amdgcn_readlane(ri, 3)); lg[q][7] = __int_as_float(__builtin_amdgcn_readlane(ri, 7)); }
            }
#pragma unroll
            for (int q = 0; q < 2; ++q) {
                int e0 = 0; float v0 = lg[q][0];
#pragma unroll
                for (int e = 1; e < 8; ++e) if (lg[q][e] > v0) { v0 = lg[q][e]; e0 = e; }
                int e1 = -1; float v1 = -3.0e38f;
#pragma unroll
                for (int e = 0; e < 8; ++e) if (e != e0 && lg[q][e] > v1) { v1 = lg[q][e]; e1 = e; }
                const float g1 = 1.f / (1.f + __expf(v0 - v1)), g0 = 1.f - g1;
                if (F.lane == 0) { ti[m + q] = TokInfo{e0, e1, g0, g1}; atomicAdd((int*)&cnt[e0], 1); atomicAdd((int*)&cnt[e1], 1); }
            }
        }
        __syncthreads();
        if (F.tid < 8) { WSP(int, WS_MOECNT)[blk * 8 + F.tid] = cnt[F.tid]; cnt[F.tid] = 0; }
        __syncthreads();
    }
}
__device__ __forceinline__ void p13_moe_dispatch(Frame& F, const Args& A) {
    LAS int* call = (LAS int*)F.lds;
    LAS int* base = (LAS int*)(F.lds + 8192);
    LAS int* segs = (LAS int*)(F.lds + 8192 + 64);
    LAS int* pos = (LAS int*)(F.lds + 8192 + 128);
    for (int i = F.tid; i < 2048; i += 512) call[i] = WSP(int, WS_MOECNT)[i];
    __syncthreads();
    TokInfo* ti = WSP(TokInfo, WS_TOKINFO);
    for (int blk = F.bid; blk < T / 128; blk += F.G) {
        if (F.tid < 8) { int tot = 0, pre = 0; for (int w = 0; w < 256; ++w) { const int c = call[w * 8 + F.tid]; if (w < blk) pre += c; tot += c; } base[F.tid] = pre; segs[F.tid] = (tot + 255) & ~255; }
        __syncthreads();
        if (F.tid == 0) { int s = 0; for (int e = 0; e < 8; ++e) { const int p = segs[e]; segs[e] = s; base[e] += s; s += p; } segs[8] = s;
            if (blk == 0) { int* meta = WSP(int, WS_MOEMETA); meta[0] = s / 256; for (int e = 0; e <= 8; ++e) meta[1 + e] = segs[e] / 256; } }
        __syncthreads();
        if (F.wave == 0) {
            int run[8];
#pragma unroll
            for (int e = 0; e < 8; ++e) run[e] = base[e];
            for (int st = 0; st < 4; ++st) {
                const int tk = (st >> 1) * 64 + F.lane, slot = st & 1; const TokInfo t = ti[blk * 128 + tk]; const int me = slot ? t.p1 : t.p0; int p = 0;
#pragma unroll
                for (int e = 0; e < 8; ++e) { const unsigned long long mk = __ballot(me == e); if (me == e) p = run[e] + __popcll(mk & ((1ull << F.lane) - 1ull)); run[e] += __popcll(mk); }
                pos[tk * 2 + slot] = p;
            }
        }
        __syncthreads();
        if (F.tid < 128) { TokInfo t = ti[blk * 128 + F.tid]; t.p0 = pos[F.tid * 2]; t.p1 = pos[F.tid * 2 + 1]; ti[blk * 128 + F.tid] = t; }
        if (F.tid < 256) WSP(int, WS_ROWTOK)[pos[F.tid]] = blk * 128 + (F.tid >> 1);
        __syncthreads();
    }
}
__device__ __forceinline__ int moe_tile_table(Frame& F, LAS int* tile_e) {
    const int* meta = WSP(int, WS_MOEMETA); const int NT = meta[0];
    for (int t = F.tid; t < MOE_MAX_TILES; t += 512) { int e = 0;
#pragma unroll
        for (int k = 1; k < 8; ++k) e += (t >= meta[1 + k]) ? 1 : 0;
        tile_e[t] = e; }
    __syncthreads();
    return NT;
}
__device__ __forceinline__ void p_final(Frame& F, const Args& A) {
    const int gw = F.bid * 8 + F.wave, NGW = F.G * 8; const TokInfo* ti = WSP(TokInfo, WS_TOKINFO); const bf16_t* O = WSP(bf16_t, WS_XG);
    const float* lg = INP(I_L1_LN2G); const float* lb = INP(I_L1_LN2B);
    for (int m = 2 * gw; m < T; m += 2 * NGW) {
        f32x4 v[2][4]; float s[2], s2[2];
#pragma unroll
        for (int q = 0; q < 2; ++q) {
            const TokInfo t = ti[m + q]; const bf16_t* xs = (const bf16_t*)F.out + (size_t)(m + q) * 2048 + 1024;
            const u32x2* o0 = (const u32x2*)(O + (size_t)t.p0 * DM) + F.lane; const u32x2* o1 = (const u32x2*)(O + (size_t)t.p1 * DM) + F.lane;
            s[q] = 0.f;
#pragma unroll
            for (int j = 0; j < 4; ++j) { const f32x4 x = ld_bf4(xs + 4 * (F.lane + 64 * j)); const u32x2 a = o0[64 * j], b = o1[64 * j];
                const f32x4 fa = {bf_lo(a.x), bf_hi(a.x), bf_lo(a.y), bf_hi(a.y)}, fb = {bf_lo(b.x), bf_hi(b.x), bf_lo(b.y), bf_hi(b.y)};
                v[q][j] = x * ALPHA + (fa * t.g0 + fb * t.g1); s[q] += (v[q][j][0] + v[q][j][1]) + (v[q][j][2] + v[q][j][3]); }
        }
#pragma unroll
        for (int o = 1; o < 64; o <<= 1) { s[0] += __shfl_xor(s[0], o); s[1] += __shfl_xor(s[1], o); }
#pragma unroll
        for (int q = 0; q < 2; ++q) { const float mean = s[q] * (1.f / DM); s2[q] = 0.f;
#pragma unroll
            for (int j = 0; j < 4; ++j) { v[q][j] = v[q][j] - mean; s2[q] += (v[q][j][0] * v[q][j][0] + v[q][j][1] * v[q][j][1]) + (v[q][j][2] * v[q][j][2] + v[q][j][3] * v[q][j][3]); } }
#pragma unroll
        for (int o = 1; o < 64; o <<= 1) { s2[0] += __shfl_xor(s2[0], o); s2[1] += __shfl_xor(s2[1], o); }
#pragma unroll
        for (int q = 0; q < 2; ++q) { const float rstd = 1.f / sqrtf(s2[q] * (1.f / DM) + LN_EPS); f32x4* yr = (f32x4*)(F.out + (size_t)(m + q) * DM) + F.lane;
#pragma unroll
            for (int j = 0; j < 4; ++j) { const f32x4 gg = *((const f32x4*)lg + F.lane + 64 * j), bb = *((const f32x4*)lb + F.lane + 64 * j); yr[64 * j] = v[q][j] * rstd * gg + bb; } }
    }
}
namespace att {
constexpr int KROW = 144;
constexpr int TILE_B = 64 * KROW;
constexpr int L_K = 0, L_V = 2 * TILE_B, L_OV = 4 * TILE_B;
constexpr int L_LUT = 6 * TILE_B;
constexpr int L_IMP = L_LUT + 2048;
constexpr int L_SELM = L_IMP + 4 * 64 * 65 * 4;
constexpr int L_END = L_SELM + 512;
static_assert(L_END <= RING_BYTES, "attention LDS map");
constexpr float NEG_INF = -__builtin_huge_valf();
constexpr int L_LUT2 = LDS_EXTRA_OFF, LUT2_N = 704, LUT2_K = 639;
constexpr int L_LUT3 = LDS_EXTRA_OFF + 4 * LUT2_N * 4, LUT3_N = 320, LUT3_K = 255;
static_assert(L_LUT3 + 4 * LUT3_N * 4 <= LDS_MISC_OFF, "attention LUT map");
constexpr float RESC_THR = 8.f;

__device__ __forceinline__ s16x4 vtr(const LAS char* p) { return __builtin_bit_cast(s16x4, __builtin_amdgcn_ds_read_tr16_b64_v4i16((LAS s16x4*)p)); }

template <int MODE, int NDB>
__device__ __forceinline__ void attn_tile(const LAS char* Kt, const LAS char* Vt, const LAS char* OVt, const bf16x8 (&qf)[4], f32x16 (&o)[NDB], float& m, float& l,
                                          int tq, int key0, int W, bool lanesel, const LAS float* lut, int lane) {
    const int r32 = lane & 31, h = lane >> 5;
    f32x16 s0, s1;
#pragma unroll
    for (int r = 0; r < 16; ++r) { s0[r] = 0.f; s1[r] = 0.f; }
#pragma unroll
    for (int ks = 0; ks < 4; ++ks) {
        const bf16x8 k0 = *(const LAS bf16x8*)(Kt + r32 * KROW + (16 * ks + 8 * h) * 2);
        const bf16x8 k1 = *(const LAS bf16x8*)(Kt + (32 + r32) * KROW + (16 * ks + 8 * h) * 2);
        s0 = __builtin_amdgcn_mfma_f32_32x32x16_bf16(k0, qf[ks], s0, 0, 0, 0);
        s1 = __builtin_amdgcn_mfma_f32_32x32x16_bf16(k1, qf[ks], s1, 0, 0, 0);
    }
    float mx = NEG_INF;
    asm volatile("" ::: "memory");
#pragma unroll
    for (int kb = 0; kb < 2; ++kb) {
#pragma unroll
        for (int r = 0; r < 16; ++r) {
            const int key = key0 + 32 * kb + (r & 3) + 8 * (r >> 2) + 4 * h;
            const int dist = (MODE == 2) ? (tq - 16 * key - 31) : (tq - key);
            const int idx = dist < 0 ? 0 : (dist > 113 ? 113 : dist);
            bool valid;
            if (MODE == 0) valid = (unsigned)dist < (unsigned)W;
            else if (MODE == 1) valid = lanesel && dist >= 0;
            else valid = dist >= 0 && key < 255;
            float v = (kb ? s1[r] : s0[r]) + lut[idx];
            v = valid ? v : NEG_INF;
            if (kb) s1[r] = v; else s0[r] = v;
            mx = fmaxf(mx, v);
        }
        asm volatile("" ::: "memory");
    }
    mx = swap_max(mx);
    const float mnew = fmaxf(m, mx), alpha = __builtin_amdgcn_exp2f(m - mnew);
    float rs = 0.f;
#pragma unroll
    for (int r = 0; r < 16; ++r) { s0[r] = __builtin_amdgcn_exp2f(s0[r] - mnew); s1[r] = __builtin_amdgcn_exp2f(s1[r] - mnew); rs += s0[r] + s1[r]; }
    rs = swap_sum(rs);
    l = l * alpha + rs; m = mnew;
#pragma unroll
    for (int db = 0; db < NDB; ++db)
#pragma unroll
        for (int r = 0; r < 16; ++r) o[db][r] *= alpha;
    const int q4 = (lane & 15) >> 2, p4 = lane & 3, g2 = (lane >> 4) & 1;
#pragma unroll
    for (int kb = 0; kb < 2; ++kb)
#pragma unroll
        for (int s = 0; s < 2; ++s) {
            u32x4 pw;
            if (kb == 0) { pw.x = cvt_pk_bf16(s0[8 * s + 0], s0[8 * s + 1]); pw.y = cvt_pk_bf16(s0[8 * s + 2], s0[8 * s + 3]); pw.z = cvt_pk_bf16(s0[8 * s + 4], s0[8 * s + 5]); pw.w = cvt_pk_bf16(s0[8 * s + 6], s0[8 * s + 7]); }
            else { pw.x = cvt_pk_bf16(s1[8 * s + 0], s1[8 * s + 1]); pw.y = cvt_pk_bf16(s1[8 * s + 2], s1[8 * s + 3]); pw.z = cvt_pk_bf16(s1[8 * s + 4], s1[8 * s + 5]); pw.w = cvt_pk_bf16(s1[8 * s + 6], s1[8 * s + 7]); }
            const bf16x8 pb = __builtin_bit_cast(bf16x8, pw);
            const int rowoff = (32 * kb + 16 * s + 4 * h + q4) * KROW;
#pragma unroll
            for (int db = 0; db < NDB; ++db) {
                const LAS char* base = (db < 2 ? Vt : OVt) + rowoff + (32 * (db & 1) + 16 * g2 + 4 * p4) * 2;
                const s16x4 lo = vtr(base), hi = vtr(base + 8 * KROW);
                const bf16x8 vf = {lo[0], lo[1], lo[2], lo[3], hi[0], hi[1], hi[2], hi[3]};
                o[db] = __builtin_amdgcn_mfma_f32_32x32x16_bf16(vf, pb, o[db], 0, 0, 0);
            }
            asm volatile("" ::: "memory");
        }
}


template <int MODE>
__device__ __forceinline__ void attn_tile_fast(const LAS char* Kt, const LAS char* Vt, const bf16x8 (&qf)[4], f32x16 (&o)[2], float& m, float& l,
                                               bool lanesel, bool use_lut, const LAS float* lutp, float cfar, int lane) {
    const int r32 = lane & 31, h = lane >> 5;
    float ci = use_lut ? -m : (cfar - m);
    if (MODE == 1) ci = lanesel ? ci : NEG_INF;
    f32x16 s0, s1;
#pragma unroll
    for (int r = 0; r < 16; ++r) { s0[r] = ci; s1[r] = ci; }
#pragma unroll
    for (int ks = 0; ks < 4; ++ks) {
        const bf16x8 k0 = *(const LAS bf16x8*)(Kt + r32 * KROW + (16 * ks + 8 * h) * 2);
        const bf16x8 k1 = *(const LAS bf16x8*)(Kt + (32 + r32) * KROW + (16 * ks + 8 * h) * 2);
        s0 = __builtin_amdgcn_mfma_f32_32x32x16_bf16(k0, qf[ks], s0, 0, 0, 0);
        s1 = __builtin_amdgcn_mfma_f32_32x32x16_bf16(k1, qf[ks], s1, 0, 0, 0);
    }
    if (use_lut) {
#pragma unroll
        for (int r = 0; r < 16; ++r) { s0[r] += lutp[(r & 3) + 8 * (r >> 2)]; s1[r] += lutp[32 + (r & 3) + 8 * (r >> 2)]; }
    }
    float mx = fmaxf(s0[0], s1[0]);
#pragma unroll
    for (int r = 1; r < 16; ++r) mx = fmaxf(fmaxf(mx, s0[r]), s1[r]);
    mx = swap_max(mx);
    if (__any(mx > RESC_THR)) {
        const float dl = fmaxf(mx, 0.f), f = __builtin_amdgcn_exp2f(-dl);
        m += dl; l *= f;
#pragma unroll
        for (int r = 0; r < 16; ++r) { s0[r] -= dl; s1[r] -= dl; o[0][r] *= f; o[1][r] *= f; }
    }
    const int q4 = (lane & 15) >> 2, p4 = lane & 3, g2 = (lane >> 4) & 1;
    float rs = 0.f;
#pragma unroll
    for (int kb = 0; kb < 2; ++kb)
#pragma unroll
        for (int s = 0; s < 2; ++s) {
            float e[8];
#pragma unroll
            for (int i = 0; i < 8; ++i) { e[i] = __builtin_amdgcn_exp2f(kb ? s1[8 * s + i] : s0[8 * s + i]); rs += e[i]; }
            u32x4 pw; pw.x = cvt_pk_bf16(e[0], e[1]); pw.y = cvt_pk_bf16(e[2], e[3]); pw.z = cvt_pk_bf16(e[4], e[5]); pw.w = cvt_pk_bf16(e[6], e[7]);
            const bf16x8 pb = __builtin_bit_cast(bf16x8, pw);
            const int rowoff = (32 * kb + 16 * s + 4 * h + q4) * KROW;
#pragma unroll
            for (int db = 0; db < 2; ++db) {
                const LAS char* base = Vt + rowoff + (32 * db + 16 * g2 + 4 * p4) * 2;
                const s16x4 lo = vtr(base), hi = vtr(base + 8 * KROW);
                const bf16x8 vf = {lo[0], lo[1], lo[2], lo[3], hi[0], hi[1], hi[2], hi[3]};
                o[db] = __builtin_amdgcn_mfma_f32_32x32x16_bf16(vf, pb, o[db], 0, 0, 0);
            }
            __builtin_amdgcn_sched_barrier(0);
        }
    l += swap_sum(rs);
}

template <int MODE, int NDB>
__device__ __forceinline__ void run_branch(LAS unsigned char* lds, const bf16_t* Kg, const bf16_t* Vg, int pitch, unsigned long long tiles, const bf16x8 (&qf)[4], f32x16 (&o)[NDB], float& m, float& l,
                                           int tq, int W, unsigned long long selm, const LAS float* lut, int tid, int lane) {
    const int lrow = tid >> 3, lch = tid & 7;
    if (tiles == 0ull) return;
    int j = __builtin_ctzll(tiles); tiles &= tiles - 1ull;
    auto gen_ov = [&](int tile, int b) {
        const int n = 64 * tile + lrow; unsigned short e[8];
#pragma unroll
        for (int i = 0; i < 8; ++i) { const int d = n - 4 * (8 * lch + i); e[i] = (n < 255 && d >= -1 && d <= 3) ? ((d == -1 || d == 3) ? (unsigned short)0x3f00 : (unsigned short)0x3f80) : (unsigned short)0; }
        u32x4 w; w.x = e[0] | ((unsigned)e[1] << 16); w.y = e[2] | ((unsigned)e[3] << 16); w.z = e[4] | ((unsigned)e[5] << 16); w.w = e[6] | ((unsigned)e[7] << 16);
        *(LAS u32x4*)(lds + L_OV + b * TILE_B + lrow * KROW + lch * 16) = w;
    };
#define ATT_LD(K_, V_, t_) do { K_ = *(const u32x4*)(Kg + (size_t)((t_) * 64 + lrow) * pitch + lch * 8); V_ = *(const u32x4*)(Vg + (size_t)((t_) * 64 + lrow) * pitch + lch * 8); } while (0)
#define ATT_ST(K_, V_, b_) do { *(LAS u32x4*)(lds + L_K + (b_) * TILE_B + lrow * KROW + lch * 16) = K_; *(LAS u32x4*)(lds + L_V + (b_) * TILE_B + lrow * KROW + lch * 16) = V_; } while (0)
    u32x4 kra, vra, krb, vrb;
    ATT_LD(kra, vra, j);
    int jn = -1;
    if (tiles != 0ull) { jn = __builtin_ctzll(tiles); tiles &= tiles - 1ull; }
    ATT_LD(krb, vrb, (jn < 0 ? j : jn));
    ATT_ST(kra, vra, 0);
    if (MODE == 2) gen_ov(j, 0);
    __syncthreads();
    for (;;) {
        int jnn = -1;
        if (tiles != 0ull) { jnn = __builtin_ctzll(tiles); tiles &= tiles - 1ull; }
        ATT_LD(kra, vra, (jnn < 0 ? j : jnn));
        {
        const bool lanesel = (MODE == 1) ? ((selm >> j) & 1ull) != 0ull : true;
        if constexpr (MODE == 2) {
            attn_tile<MODE, NDB>((const LAS char*)(lds + L_K + 0 * TILE_B), (const LAS char*)(lds + L_V + 0 * TILE_B), (const LAS char*)(lds + L_OV + 0 * TILE_B), qf, o, m, l, tq, 64 * j, W, lanesel, lut, lane);
        } else if (MODE != 1 || __ballot(lanesel) != 0ull) {
            const int tq0w = tq - (lane & 31);
            const int dmin = tq0w - 64 * j - 63, dmax = tq0w + 31 - 64 * j;
            const bool use_lut = (MODE == 0) ? !(dmin >= 113 && dmax < W) : !(dmin >= 113);
            const int r_ = (tid >> 6) & 3;
            const LAS float* lutp = (MODE == 0) ? (const LAS float*)(lds + L_LUT2) + r_ * LUT2_N + (64 * j + 4 * (lane >> 5) - tq + LUT2_K)
                                               : (const LAS float*)(lds + L_LUT3) + r_ * LUT3_N + (64 * j + 4 * (lane >> 5) - tq + LUT3_K);
            attn_tile_fast<MODE>((const LAS char*)(lds + L_K + 0 * TILE_B), (const LAS char*)(lds + L_V + 0 * TILE_B), qf, o, m, l, lanesel, use_lut, lutp, lut[113], lane);
        }
        }
        if (jn < 0) break;
        ATT_ST(krb, vrb, 1);
        if (MODE == 2) gen_ov(jn, 1);
        __syncthreads();
        int jn3 = -1;
        if (tiles != 0ull) { jn3 = __builtin_ctzll(tiles); tiles &= tiles - 1ull; }
        ATT_LD(krb, vrb, (jn3 < 0 ? jn : jn3));
        {
        const bool lanesel = (MODE == 1) ? ((selm >> jn) & 1ull) != 0ull : true;
        if constexpr (MODE == 2) {
            attn_tile<MODE, NDB>((const LAS char*)(lds + L_K + 1 * TILE_B), (const LAS char*)(lds + L_V + 1 * TILE_B), (const LAS char*)(lds + L_OV + 1 * TILE_B), qf, o, m, l, tq, 64 * jn, W, lanesel, lut, lane);
        } else if (MODE != 1 || __ballot(lanesel) != 0ull) {
            const int tq0w = tq - (lane & 31);
            const int dmin = tq0w - 64 * jn - 63, dmax = tq0w + 31 - 64 * jn;
            const bool use_lut = (MODE == 0) ? !(dmin >= 113 && dmax < W) : !(dmin >= 113);
            const int r_ = (tid >> 6) & 3;
            const LAS float* lutp = (MODE == 0) ? (const LAS float*)(lds + L_LUT2) + r_ * LUT2_N + (64 * jn + 4 * (lane >> 5) - tq + LUT2_K)
                                               : (const LAS float*)(lds + L_LUT3) + r_ * LUT3_N + (64 * jn + 4 * (lane >> 5) - tq + LUT3_K);
            attn_tile_fast<MODE>((const LAS char*)(lds + L_K + 1 * TILE_B), (const LAS char*)(lds + L_V + 1 * TILE_B), qf, o, m, l, lanesel, use_lut, lutp, lut[113], lane);
        }
        }
        if (jnn < 0) break;
        ATT_ST(kra, vra, 0);
        if (MODE == 2) gen_ov(jnn, 0);
        __syncthreads();
        j = jnn; jn = jn3;
    }
#undef ATT_LD
#undef ATT_ST
    __syncthreads();
}

__device__ __forceinline__ unsigned long long tile_range(int lo, int hi) {
    const unsigned long long a = (hi >= 63) ? ~0ull : ((1ull << (hi + 1)) - 1ull);
    return a & ~((1ull << lo) - 1ull);
}

__device__ __forceinline__ void build_lut(LAS unsigned char* lds, const float* relb, int head0, int tid) {
    LAS float* lut = (LAS float*)(lds + L_LUT);
    const int r = tid >> 7, d = tid & 127;
    lut[r * 128 + d] = relb[t5_bucket(d) * 16 + head0 + r] * LOG2E;
}

__device__ __forceinline__ void build_lut23(LAS unsigned char* lds, int W, bool want3, int tid) {
    const LAS float* lut = (const LAS float*)(lds + L_LUT);
    LAS float* l2 = (LAS float*)(lds + L_LUT2); LAS float* l3 = (LAS float*)(lds + L_LUT3);
    for (int i = tid; i < 4 * LUT2_N; i += 512) { const int r = i / LUT2_N, jj = i - r * LUT2_N, d = LUT2_K - jj; l2[i] = (d < 0 || d >= W) ? NEG_INF : lut[r * 128 + (d > 113 ? 113 : d)]; }
    if (want3) for (int i = tid; i < 4 * LUT3_N; i += 512) { const int r = i / LUT3_N, jj = i - r * LUT3_N, d = LUT3_K - jj; l3[i] = (d < 0) ? NEG_INF : lut[r * 128 + (d > 113 ? 113 : d)]; }
}

__device__ __forceinline__ void unit_swa(Frame& F, const Args& A, int b, int g, int qt) {
    LAS unsigned char* lds = F.lds;
    const int lane = F.lane, wave = F.wave, r = wave & 3, th = wave >> 2, r32 = lane & 31, h = lane >> 5;
    const int head = g * 4 + r, tq = qt * 64 + 32 * th + r32;
    build_lut(lds, INP(I_RELB), g * 4, F.tid);
    const bf16_t* qrow = WSP(bf16_t, WS_QA) + ((size_t)(b * SEQ + tq)) * 512 + head * 64;
    bf16x8 qf[4];
#pragma unroll
    for (int ks = 0; ks < 4; ++ks) qf[ks] = *(const bf16x8*)(qrow + 16 * ks + 8 * h);
    f32x16 o[2];
#pragma unroll
    for (int db = 0; db < 2; ++db)
#pragma unroll
        for (int i = 0; i < 16; ++i) o[db][i] = 0.f;
    float m = INP(I_L0_SINKS)[head] * LOG2E, l = 1.f;
    __syncthreads();
    build_lut23(lds, 128, false, F.tid);
    __syncthreads();
    const LAS float* lut = (const LAS float*)(lds + L_LUT) + r * 128;
    const bf16_t* Kg = WSP(bf16_t, WS_KA) + (size_t)b * SEQ * 128 + g * 64; const bf16_t* Vg = WSP(bf16_t, WS_VA) + (size_t)b * SEQ * 128 + g * 64;
    run_branch<0, 2>(lds, Kg, Vg, 128, tile_range(qt - 2 < 0 ? 0 : qt - 2, qt), qf, o, m, l, tq, 128, 0ull, lut, F.tid, lane);
    const float inv = 1.f / l;
    bf16_t* orow = WSP(bf16_t, WS_MIX0) + ((size_t)(b * SEQ + tq)) * DM + head * 64;
#pragma unroll
    for (int db = 0; db < 2; ++db)
#pragma unroll
        for (int rg = 0; rg < 4; ++rg) { u32x2 w; w.x = cvt_pk_bf16(o[db][4 * rg] * inv, o[db][4 * rg + 1] * inv); w.y = cvt_pk_bf16(o[db][4 * rg + 2] * inv, o[db][4 * rg + 3] * inv);
            *(u32x2*)(orow + 32 * db + 8 * rg + 4 * h) = w; }
}

__device__ __forceinline__ void unit_nsa(Frame& F, const Args& A, int b, int g, int qt) {
    LAS unsigned char* lds = F.lds;
    const int lane = F.lane, wave = F.wave, r = wave & 3, th = wave >> 2, r32 = lane & 31, h = lane >> 5;
    const int hb = g * 4 + r, tq = qt * 64 + 32 * th + r32, tok = 32 * th + r32, bg = b * 2 + g;
    build_lut(lds, INP(I_RELB), 8 + g * 4, F.tid);
    const bf16_t* qrow = WSP(bf16_t, WS_QB) + ((size_t)(b * SEQ + tq)) * 512 + hb * 64;
    bf16x8 qf[4];
#pragma unroll
    for (int ks = 0; ks < 4; ++ks) qf[ks] = *(const bf16x8*)(qrow + 16 * ks + 8 * h);
    const float* gp = WSP(float, WS_GATES) + ((size_t)(b * SEQ + tq)) * 24 + hb;
    const float g_cmp = gp[0], g_slc = gp[8], g_win = gp[16];
    f32x16 acc[2];
    __syncthreads();
    build_lut23(lds, 512, true, F.tid);
    __syncthreads();
    const LAS float* lut = (const LAS float*)(lds + L_LUT) + r * 128;
    LAS float* imp = (LAS float*)(lds + L_IMP);
    LAS unsigned long long* selm = (LAS unsigned long long*)(lds + L_SELM);
    {
        f32x16 o[4];
#pragma unroll
        for (int db = 0; db < 4; ++db)
#pragma unroll
            for (int i = 0; i < 16; ++i) o[db][i] = 0.f;
        float m = -1e30f, l = 0.f;
        const int tmax = qt * 64 + 63;
        unsigned long long tiles = 0ull;
        if (tmax >= 31) { const int nmax = (tmax - 31) >> 4; tiles = tile_range(0, (nmax > 254 ? 254 : nmax) >> 6); }
        const bf16_t* Kc = WSP(bf16_t, WS_KC) + (size_t)bg * 256 * 64; const bf16_t* Vc = WSP(bf16_t, WS_KC) + (size_t)(16 + bg) * 256 * 64;
        run_branch<2, 4>(lds, Kc, Vc, 64, tiles, qf, o, m, l, tq, 0, 0ull, lut, F.tid, lane);
        const float inv = l > 0.f ? 1.f / l : 0.f;
#pragma unroll
        for (int db = 0; db < 2; ++db)
#pragma unroll
            for (int i = 0; i < 16; ++i) acc[db][i] = o[db][i] * (inv * g_cmp);
        if (qt >= 16) {
#pragma unroll
            for (int db = 0; db < 2; ++db)
#pragma unroll
                for (int i = 0; i < 16; ++i) { const int jj = 32 * db + (i & 3) + 8 * (i >> 2) + 4 * h; imp[(r * 64 + jj) * 65 + tok] = o[2 + db][i] * inv; }
        }
    }
    __syncthreads();
    {
        const unsigned long long adm = tile_range(0, qt);
        for (int i = 0; i < 8; ++i) {
            const int tk = wave * 8 + i; unsigned long long mk = adm;
            if (qt >= 16) {
                int j = lane; asm volatile("" : "+v"(j));
                const float iv = ((imp[(0 * 64 + j) * 65 + tk] + imp[(1 * 64 + j) * 65 + tk]) + imp[(2 * 64 + j) * 65 + tk]) + imp[(3 * 64 + j) * 65 + tk];
                const bool forced = (j == 0) || (j == qt) || (j == qt - 1);
                const float sc = forced ? 1e30f : (j <= qt ? iv : -1e30f);
                int rank = 0;
#pragma unroll
                for (int k = 0; k < 64; ++k) { const float sk = __int_as_float(__builtin_amdgcn_readlane(__float_as_int(sc), k)); rank += (sk > sc || (sk == sc && k < j)) ? 1 : 0; }
                mk = __ballot(rank < 16) & adm;
            }
            if (lane == 0) selm[tk] = mk;
        }
    }
    __syncthreads();
    const unsigned long long myselm = selm[tok];
    unsigned long long uni = selm[lane];
#pragma unroll
    for (int o_ = 1; o_ < 64; o_ <<= 1) { const unsigned lo = __shfl_xor((unsigned)uni, o_), hi = __shfl_xor((unsigned)(uni >> 32), o_); uni |= ((unsigned long long)hi << 32) | lo; }
    uni = ((unsigned long long)(unsigned)__builtin_amdgcn_readfirstlane((unsigned)(uni >> 32)) << 32) | (unsigned)__builtin_amdgcn_readfirstlane((unsigned)uni);
    {
        f32x16 o[2];
#pragma unroll
        for (int db = 0; db < 2; ++db)
#pragma unroll
            for (int i = 0; i < 16; ++i) o[db][i] = 0.f;
        float m = 0.f, l = 0.f;
        const bf16_t* Kg = WSP(bf16_t, WS_KSLC) + (size_t)b * SEQ * 128 + g * 64; const bf16_t* Vg = WSP(bf16_t, WS_VSLC) + (size_t)b * SEQ * 128 + g * 64;
        run_branch<1, 2>(lds, Kg, Vg, 128, uni, qf, o, m, l, tq, 0, myselm, lut, F.tid, lane);
        const float inv = g_slc / l;
#pragma unroll
        for (int db = 0; db < 2; ++db)
#pragma unroll
            for (int i = 0; i < 16; ++i) acc[db][i] += o[db][i] * inv;
    }
    {
        f32x16 o[2];
#pragma unroll
        for (int db = 0; db < 2; ++db)
#pragma unroll
            for (int i = 0; i < 16; ++i) o[db][i] = 0.f;
        float m = 0.f, l = 0.f;
        const bf16_t* Kg = WSP(bf16_t, WS_KWIN) + (size_t)b * SEQ * 128 + g * 64; const bf16_t* Vg = WSP(bf16_t, WS_VWIN) + (size_t)b * SEQ * 128 + g * 64;
        run_branch<0, 2>(lds, Kg, Vg, 128, tile_range(qt - 8 < 0 ? 0 : qt - 8, qt), qf, o, m, l, tq, 512, 0ull, lut, F.tid, lane);
        const float inv = g_win / l;
#pragma unroll
        for (int db = 0; db < 2; ++db)
#pragma unroll
            for (int i = 0; i < 16; ++i) acc[db][i] += o[db][i] * inv;
    }
    bf16_t* orow = WSP(bf16_t, WS_MIX0) + ((size_t)(b * SEQ + tq)) * DM + 512 + hb * 64;
#pragma unroll
    for (int db = 0; db < 2; ++db)
#pragma unroll
        for (int rg = 0; rg < 4; ++rg) { u32x2 w; w.x = cvt_pk_bf16(acc[db][4 * rg], acc[db][4 * rg + 1]); w.y = cvt_pk_bf16(acc[db][4 * rg + 2], acc[db][4 * rg + 3]);
            *(u32x2*)(orow + 32 * db + 8 * rg + 4 * h) = w; }
}

#ifndef PROBE_NSA_REP
#define PROBE_NSA_REP 1
#endif
#ifndef PROBE_SWA_REP
#define PROBE_SWA_REP 1
#endif
__device__ __forceinline__ void attn0_phase(Frame& F, const Args& A) {
    const int vcu = (F.G % 8 == 0) ? (F.bid % 8) * (F.G / 8) + F.bid / 8 : F.bid;
    for (int rep = 0; rep < PROBE_NSA_REP; ++rep)
    for (int U = vcu; U < 1024; U += F.G) {
        const int c = U & 255, i = U >> 8, bg = c >> 4, s = c & 15;
        const int qt = (i == 0) ? 63 - s : (i == 1) ? 32 + s : (i == 2) ? 31 - s : s;
        unit_nsa(F, A, bg >> 1, bg & 1, qt);
        __syncthreads();
    }
    for (int rep = 0; rep < PROBE_SWA_REP; ++rep)
    for (int U = vcu; U < 1024; U += F.G) {
        const int c = U & 255, i = U >> 8, bg = c >> 4, s = c & 15;
        unit_swa(F, A, bg >> 1, bg & 1, 16 * i + s);
        __syncthreads();
    }
}
}
namespace dsa {
constexpr int L_SC = 0;
constexpr int L_LIST = LDS_EXTRA_OFF;
constexpr int L_LUTD = L_LIST + 4096;
constexpr int L_WT = L_LUTD + 114 * 16 * 4;
static_assert(L_WT + 256 <= LDS_MISC_OFF, "dsa LDS map");
constexpr int VROW = 160;
constexpr float NEG_INF = -__builtin_huge_valf();
typedef float f32x4_t __attribute__((ext_vector_type(4)));


__device__ __forceinline__ int count_ge8(unsigned a0, unsigned a1, unsigned a2, unsigned a3, unsigned a4, unsigned a5, unsigned a6, unsigned a7, unsigned cand) {
    int c, t; unsigned long long m0, m1, m2, m3, m4, m5, m6, m7;
    asm volatile(
        "v_cmp_ge_u32_e64 %[m0], %[a0], %[cd]\n\tv_cmp_ge_u32_e64 %[m1], %[a1], %[cd]\n\tv_cmp_ge_u32_e64 %[m2], %[a2], %[cd]\n\tv_cmp_ge_u32_e64 %[m3], %[a3], %[cd]\n\t"
        "v_cmp_ge_u32_e64 %[m4], %[a4], %[cd]\n\tv_cmp_ge_u32_e64 %[m5], %[a5], %[cd]\n\tv_cmp_ge_u32_e64 %[m6], %[a6], %[cd]\n\tv_cmp_ge_u32_e64 %[m7], %[a7], %[cd]\n\t"
        "s_bcnt1_i32_b64 %[c], %[m0]\n\ts_bcnt1_i32_b64 %[t], %[m1]\n\ts_add_i32 %[c], %[c], %[t]\n\ts_bcnt1_i32_b64 %[t], %[m2]\n\ts_add_i32 %[c], %[c], %[t]\n\t"
        "s_bcnt1_i32_b64 %[t], %[m3]\n\ts_add_i32 %[c], %[c], %[t]\n\ts_bcnt1_i32_b64 %[t], %[m4]\n\ts_add_i32 %[c], %[c], %[t]\n\ts_bcnt1_i32_b64 %[t], %[m5]\n\ts_add_i32 %[c], %[c], %[t]\n\t"
        "s_bcnt1_i32_b64 %[t], %[m6]\n\ts_add_i32 %[c], %[c], %[t]\n\ts_bcnt1_i32_b64 %[t], %[m7]\n\ts_add_i32 %[c], %[c], %[t]"
        : [c] "=&s"(c), [t] "=&s"(t), [m0] "=&s"(m0), [m1] "=&s"(m1), [m2] "=&s"(m2), [m3] "=&s"(m3), [m4] "=&s"(m4), [m5] "=&s"(m5), [m6] "=&s"(m6), [m7] "=&s"(m7)
        : [a0] "v"(a0), [a1] "v"(a1), [a2] "v"(a2), [a3] "v"(a3), [a4] "v"(a4), [a5] "v"(a5), [a6] "v"(a6), [a7] "v"(a7), [cd] "s"(cand)
        : "scc");
    return c;
}

__device__ __forceinline__ void unit_dsa(Frame& F, const Args& A, int b, int t0) {
    LAS unsigned char* lds = F.lds;
    const int tid = F.tid, lane = F.lane, wave = F.wave, r32 = lane & 31, h = lane >> 5;
    const size_t tb = (size_t)b * SEQ;
    LAS float* sc = (LAS float*)(lds + L_SC);
    LAS unsigned short* list = (LAS unsigned short*)(lds + L_LIST) + wave * 256;
    const LAS float* lutd = (const LAS float*)(lds + L_LUTD);
    LAS float* wt = (LAS float*)(lds + L_WT);
    if (tid < 64) wt[tid] = WSP(float, WS_WI)[(tb + t0) * 8 + tid];
    __syncthreads();
#ifndef PROBE_DSA_A
#define PROBE_DSA_A 1
#endif
#ifndef PROBE_DSA_B
#define PROBE_DSA_B 1
#endif
#ifndef PROBE_DSA_C
#define PROBE_DSA_C 1
#endif
    for (int repa = 0; repa < PROBE_DSA_A; ++repa)
    if (t0 + 8 > 256) {
        const int nkb = ((t0 + 8 + 63) >> 6) << 1;
        const int hh_r = (r32 >> 2) & 1, reg_r = (r32 & 3) | ((r32 >> 3) << 2), qi4 = 2 * hh_r + (reg_r >> 3), hd = reg_r & 7;
        bf16x8 qaf[2][2]; float wv[2][16];
#pragma unroll
        for (int rb = 0; rb < 2; ++rb) {
            const bf16_t* qp = WSP(bf16_t, WS_QI) + (tb + t0 + 4 * rb + qi4) * 256 + hd * 32 + 8 * h;
            qaf[rb][0] = *(const bf16x8*)qp; qaf[rb][1] = *(const bf16x8*)(qp + 16);
#pragma unroll
            for (int rg = 0; rg < 16; ++rg) wv[rb][rg] = wt[(4 * rb + 2 * h + (rg >> 3)) * 8 + (rg & 7)];
        }
        int kb = wave;
        bf16x8 bk0 = {0, 0, 0, 0, 0, 0, 0, 0}, bk1 = {0, 0, 0, 0, 0, 0, 0, 0};
        if (kb < nkb) { const bf16_t* kp = WSP(bf16_t, WS_KI) + (tb + 32 * kb + r32) * 32 + 8 * h; bk0 = *(const bf16x8*)kp; bk1 = *(const bf16x8*)(kp + 16); }
        while (kb < nkb) {
            const int kn = kb + 8; bf16x8 nb0 = bk0, nb1 = bk1;
            if (kn < nkb) { const bf16_t* kp = WSP(bf16_t, WS_KI) + (tb + 32 * kn + r32) * 32 + 8 * h; nb0 = *(const bf16x8*)kp; nb1 = *(const bf16x8*)(kp + 16); }
            const int key = 32 * kb + r32;
#pragma unroll
            for (int rb = 0; rb < 2; ++rb) {
                f32x16 c;
#pragma unroll
                for (int i = 0; i < 16; ++i) c[i] = 0.f;
                c = __builtin_amdgcn_mfma_f32_32x32x16_bf16(qaf[rb][0], bk0, c, 0, 0, 0);
                c = __builtin_amdgcn_mfma_f32_32x32x16_bf16(qaf[rb][1], bk1, c, 0, 0, 0);
                float sA = 0.f, sB = 0.f;
#pragma unroll
                for (int i = 0; i < 8; ++i) { sA += wv[rb][i] * fmaxf(c[i], 0.f); sB += wv[rb][8 + i] * fmaxf(c[8 + i], 0.f); }
                const int qA = 4 * rb + 2 * h;
                sc[qA * 4096 + key] = (key <= t0 + qA) ? sA : NEG_INF;
                sc[(qA + 1) * 4096 + key] = (key <= t0 + qA + 1) ? sB : NEG_INF;
            }
            bk0 = nb0; bk1 = nb1; kb = kn;
        }
    }
    __syncthreads();
    const int t = t0 + wave, n = t + 1;
    int cnt;
    for (int repb = 0; repb < PROBE_DSA_B; ++repb)
    if (n <= 256) {
#pragma unroll
        for (int i = 0; i < 4; ++i) { const int k = lane + 64 * i; list[k] = (unsigned short)(k < n ? k : 0); }
        cnt = n;
    } else {
        const int nreg = (n + 63) >> 6, ngrp = (nreg + 7) >> 3;
        LAS float* my = sc + wave * 4096;
        float f[64];
#pragma unroll
        for (int g8 = 0; g8 < 8; ++g8) {
#pragma unroll
            for (int k = 0; k < 8; ++k) f[g8 * 8 + k] = NEG_INF;
            if (g8 < ngrp) {
#pragma unroll
                for (int k = 0; k < 8; ++k) if (g8 * 8 + k < nreg) f[g8 * 8 + k] = my[64 * (g8 * 8 + k) + lane];
            }
        }
        float ta = NEG_INF, tb_ = NEG_INF, tc = NEG_INF, td = NEG_INF;
#pragma unroll
        for (int g8 = 0; g8 < 8; ++g8) if (g8 < ngrp) {
#pragma unroll
            for (int k = 0; k < 8; ++k) { const float x = f[g8 * 8 + k]; td = __builtin_amdgcn_fmed3f(tc, td, x); tc = __builtin_amdgcn_fmed3f(tb_, tc, x); tb_ = __builtin_amdgcn_fmed3f(ta, tb_, x); ta = fmaxf(ta, x); }
        }
        float L = td;
#pragma unroll
        for (int o_ = 1; o_ < 64; o_ <<= 1) L = fminf(L, __shfl_xor(L, o_));
        LAS unsigned* cval = (LAS unsigned*)my; LAS unsigned short* ckey = (LAS unsigned short*)(my + 1024);
        const unsigned long long ltmask = (1ull << lane) - 1ull;
        int ns = 0;
#pragma unroll
        for (int g8 = 0; g8 < 8; ++g8) if (g8 < ngrp) {
#pragma unroll
            for (int k = 0; k < 8; ++k) { const int i = g8 * 8 + k; const bool keep = f[i] >= L; const unsigned long long mk = __ballot(keep); const int pos = ns + __popcll(mk & ltmask);
                if (keep && pos < 1024) { const unsigned bits = __float_as_uint(f[i]); cval[pos] = bits ^ ((bits >> 31) ? 0xffffffffu : 0x80000000u); ckey[pos] = (unsigned short)(64 * i + lane); }
                ns += __popcll(mk); }
        }
        if (ns <= 1024) {
            unsigned w[16];
#pragma unroll
            for (int j = 0; j < 16; ++j) w[j] = (64 * j + lane < ns) ? cval[64 * j + lane] : 0u;
            const bool two = ns > 512;
            float Mx = ta;
#pragma unroll
            for (int o_ = 1; o_ < 64; o_ <<= 1) Mx = fmaxf(Mx, __shfl_xor(Mx, o_));
            const unsigned Lb = __float_as_uint(L), Mb = __float_as_uint(Mx);
            const unsigned Lk = __builtin_amdgcn_readfirstlane(Lb ^ ((Lb >> 31) ? 0xffffffffu : 0x80000000u)), Mk = __builtin_amdgcn_readfirstlane(Mb ^ ((Mb >> 31) ? 0xffffffffu : 0x80000000u));
            const int hb = (Lk == Mk) ? -1 : 31 - __builtin_clz(Lk ^ Mk);
            unsigned tau = (hb >= 31) ? 0u : (hb < 0 ? Mk : (Mk & ~((2u << hb) - 1u)));
            for (int bit = hb; bit >= 0; --bit) {
                const unsigned cand = tau | (1u << bit);
                int c = count_ge8(w[0], w[1], w[2], w[3], w[4], w[5], w[6], w[7], cand);
                if (two) c += count_ge8(w[8], w[9], w[10], w[11], w[12], w[13], w[14], w[15], cand);
                if (c >= 256) { tau = cand; if (c == 256) break; }
            }
            int cgt = count_ge8(w[0], w[1], w[2], w[3], w[4], w[5], w[6], w[7], tau + 1u);
            if (two) cgt += count_ge8(w[8], w[9], w[10], w[11], w[12], w[13], w[14], w[15], tau + 1u);
            const int need = 256 - cgt; int base = 0, eqseen = 0;
#pragma unroll
            for (int j = 0; j < 16; ++j) if (64 * j < ns) {
                const bool gt = w[j] > tau, eq = w[j] == tau;
                const unsigned long long meq = __ballot(eq);
                const bool sel = gt || (eq && (eqseen + __popcll(meq & ltmask)) < need);
                const unsigned long long msel = __ballot(sel);
                if (sel) list[base + __popcll(msel & ltmask)] = ckey[64 * j + lane];
                base += __popcll(msel); eqseen += __popcll(meq);
            }
        } else {
#pragma unroll
            for (int i = 0; i < 64; ++i) { const unsigned bits = __float_as_uint(f[i]); f[i] = __uint_as_float((i < nreg) ? (bits ^ ((bits >> 31) ? 0xffffffffu : 0x80000000u)) : 0u); }
#define u_(i) __float_as_uint(f[i])
            unsigned tau = 0u;
            for (int bit = 31; bit >= 0; --bit) {
                const unsigned cand = tau | (1u << bit); int c = 0;
#pragma unroll
                for (int g8 = 0; g8 < 8; ++g8) if (g8 < ngrp)
                    c += count_ge8(u_(g8 * 8 + 0), u_(g8 * 8 + 1), u_(g8 * 8 + 2), u_(g8 * 8 + 3), u_(g8 * 8 + 4), u_(g8 * 8 + 5), u_(g8 * 8 + 6), u_(g8 * 8 + 7), cand);
                if (c >= 256) { tau = cand; if (c == 256) break; }
            }
            int cgt = 0;
#pragma unroll
            for (int g8 = 0; g8 < 8; ++g8) if (g8 < ngrp)
                cgt += count_ge8(u_(g8 * 8 + 0), u_(g8 * 8 + 1), u_(g8 * 8 + 2), u_(g8 * 8 + 3), u_(g8 * 8 + 4), u_(g8 * 8 + 5), u_(g8 * 8 + 6), u_(g8 * 8 + 7), tau + 1u);
            const int need = 256 - cgt; int base = 0, eqseen = 0;
#pragma unroll
            for (int g8 = 0; g8 < 8; ++g8) if (g8 < ngrp) {
#pragma unroll
                for (int k = 0; k < 8; ++k) { const int i = g8 * 8 + k;
                    const bool gt = u_(i) > tau, eq = u_(i) == tau;
                    const unsigned long long meq = __ballot(eq);
                    const bool sel = gt || (eq && (eqseen + __popcll(meq & ltmask)) < need);
                    const unsigned long long msel = __ballot(sel);
                    if (sel) list[base + __popcll(msel & ltmask)] = (unsigned short)(64 * i + lane);
                    base += __popcll(msel); eqseen += __popcll(meq); } }
        }
#undef u_
        cnt = 256;
    }
    __syncthreads();
    for (int repc = 0; repc < PROBE_DSA_C; ++repc)
    {
        const int head = lane & 15, g4 = lane >> 4, q4 = (lane & 15) >> 2, p4 = lane & 3;
        const bf16_t* qp = WSP(bf16_t, WS_Q1) + (tb + t) * 1024 + head * 64 + 8 * g4;
        const bf16x8 qf0 = *(const bf16x8*)qp, qf1 = *(const bf16x8*)(qp + 32);
        const bf16_t* K1 = WSP(bf16_t, WS_K1) + tb * 64; const bf16_t* V1 = WSP(bf16_t, WS_V1) + tb * 64;
        f32x4_t sA[8], sB[8];
        float mx = NEG_INF;
        const float cfar = lutd[113 * 16 + head];
        LAS unsigned char* kst = lds + wave * (96 * VROW);
        {
            u32x4 kr[8][4];
#pragma unroll
            for (int c = 0; c < 8; ++c) {
#pragma unroll
                for (int i = 0; i < 4; ++i) { const unsigned key = list[32 * c + 8 * i + (lane >> 3)]; kr[c][i] = *(const u32x4*)((const char*)K1 + (key * 128u + (unsigned)(lane & 7) * 16u)); }
            }
#pragma unroll
            for (int c = 0; c < 8; ++c) {
#pragma unroll
                for (int i = 0; i < 4; ++i) *(LAS u32x4*)(kst + (8 * i + (lane >> 3)) * VROW + (lane & 7) * 16) = kr[c][i];
                const LAS unsigned char* ka = kst + (lane & 15) * VROW + 16 * g4;
                const bf16x8 kA0 = *(const LAS bf16x8*)ka, kA1 = *(const LAS bf16x8*)(ka + 64), kB0 = *(const LAS bf16x8*)(ka + 16 * VROW), kB1 = *(const LAS bf16x8*)(ka + 16 * VROW + 64);
                const int kmax = __builtin_amdgcn_readfirstlane((int)list[32 * c + 31]);
                if (cnt == 256 && t - kmax >= 113) {
                    f32x4_t a = {cfar, cfar, cfar, cfar}, bb = {cfar, cfar, cfar, cfar};
                    a = __builtin_amdgcn_mfma_f32_16x16x32_bf16(kA0, qf0, a, 0, 0, 0); a = __builtin_amdgcn_mfma_f32_16x16x32_bf16(kA1, qf1, a, 0, 0, 0);
                    bb = __builtin_amdgcn_mfma_f32_16x16x32_bf16(kB0, qf0, bb, 0, 0, 0); bb = __builtin_amdgcn_mfma_f32_16x16x32_bf16(kB1, qf1, bb, 0, 0, 0);
                    sA[c] = a; sB[c] = bb;
                    mx = fmaxf(mx, fmaxf(fmaxf(fmaxf(a[0], a[1]), fmaxf(a[2], a[3])), fmaxf(fmaxf(bb[0], bb[1]), fmaxf(bb[2], bb[3]))));
                } else {
                    f32x4_t a = {0.f, 0.f, 0.f, 0.f}, bb = {0.f, 0.f, 0.f, 0.f};
                    a = __builtin_amdgcn_mfma_f32_16x16x32_bf16(kA0, qf0, a, 0, 0, 0); a = __builtin_amdgcn_mfma_f32_16x16x32_bf16(kA1, qf1, a, 0, 0, 0);
                    bb = __builtin_amdgcn_mfma_f32_16x16x32_bf16(kB0, qf0, bb, 0, 0, 0); bb = __builtin_amdgcn_mfma_f32_16x16x32_bf16(kB1, qf1, bb, 0, 0, 0);
                    const u32x2 ia = *(const LAS u32x2*)(list + 32 * c + 4 * g4), ib = *(const LAS u32x2*)(list + 32 * c + 16 + 4 * g4);
#pragma unroll
                    for (int i = 0; i < 4; ++i) {
                        const int keyA = (int)(((i < 2 ? ia.x : ia.y) >> (16 * (i & 1))) & 0xffffu), keyB = (int)(((i < 2 ? ib.x : ib.y) >> (16 * (i & 1))) & 0xffffu);
                        const int dA = t - keyA, dB = t - keyB;
                        const float bA = lutd[(dA > 113 ? 113 : (dA < 0 ? 0 : dA)) * 16 + head], bB = lutd[(dB > 113 ? 113 : (dB < 0 ? 0 : dB)) * 16 + head];
                        const int slotA = 32 * c + 4 * g4 + i, slotB = slotA + 16;
                        sA[c][i] = slotA < cnt ? a[i] + bA : NEG_INF; sB[c][i] = slotB < cnt ? bb[i] + bB : NEG_INF;
                        mx = fmaxf(mx, fmaxf(sA[c][i], sB[c][i]));
                    }
                }
            }
        }
        asm volatile("" ::: "memory");
        u32x4 vr[4][4];
#pragma unroll
        for (int c = 0; c < 4; ++c) {
#pragma unroll
            for (int i = 0; i < 4; ++i) { const unsigned key = list[32 * c + 8 * i + (lane >> 3)]; vr[c][i] = *(const u32x4*)((const char*)V1 + (key * 128u + (unsigned)(lane & 7) * 16u)); }
        }
        mx = fmaxf(mx, __shfl_xor(mx, 16)); mx = fmaxf(mx, __shfl_xor(mx, 32));
        float l = 0.f;
#pragma unroll
        for (int c = 0; c < 8; ++c)
#pragma unroll
            for (int i = 0; i < 4; ++i) { sA[c][i] = __builtin_amdgcn_exp2f(sA[c][i] - mx); sB[c][i] = __builtin_amdgcn_exp2f(sB[c][i] - mx); l += sA[c][i] + sB[c][i]; }
        l += __shfl_xor(l, 16); l += __shfl_xor(l, 32);
        f32x4_t o[4];
#pragma unroll
        for (int d = 0; d < 4; ++d) o[d] = (f32x4_t){0.f, 0.f, 0.f, 0.f};
#pragma unroll
        for (int c = 0; c < 8; ++c) {
            {
                LAS unsigned char* vst = kst + (32 + 32 * (c & 1)) * VROW;
#pragma unroll
                for (int i = 0; i < 4; ++i) *(LAS u32x4*)(vst + (8 * i + (lane >> 3)) * VROW + (lane & 7) * 16) = vr[c & 3][i];
                if (c + 4 < 8) {
#pragma unroll
                    for (int i = 0; i < 4; ++i) { const unsigned key = list[32 * (c + 4) + 8 * i + (lane >> 3)]; vr[c & 3][i] = *(const u32x4*)((const char*)V1 + (key * 128u + (unsigned)(lane & 7) * 16u)); }
                }
                u32x4 pw; pw.x = cvt_pk_bf16(sA[c][0], sA[c][1]); pw.y = cvt_pk_bf16(sA[c][2], sA[c][3]); pw.z = cvt_pk_bf16(sB[c][0], sB[c][1]); pw.w = cvt_pk_bf16(sB[c][2], sB[c][3]);
                const bf16x8 pb = __builtin_bit_cast(bf16x8, pw);
#pragma unroll
                for (int d = 0; d < 4; ++d) {
                    const LAS char* base = (const LAS char*)(vst + (4 * g4 + q4) * VROW + (16 * d + 4 * p4) * 2);
                    const s16x4 lo = att::vtr(base), hi = att::vtr(base + 16 * VROW);
                    const bf16x8 vf = {lo[0], lo[1], lo[2], lo[3], hi[0], hi[1], hi[2], hi[3]};
                    o[d] = __builtin_amdgcn_mfma_f32_16x16x32_bf16(vf, pb, o[d], 0, 0, 0);
                }
            }
        }
        const float inv = 1.f / l;
        bf16_t* orow = WSP(bf16_t, WS_MIX1) + (tb + t) * 1024 + head * 64 + 4 * g4;
#pragma unroll
        for (int d = 0; d < 4; ++d) { u32x2 w; w.x = cvt_pk_bf16(o[d][0] * inv, o[d][1] * inv); w.y = cvt_pk_bf16(o[d][2] * inv, o[d][3] * inv); *(u32x2*)(orow + 16 * d) = w; }
    }
    __syncthreads();
}

__device__ __forceinline__ void dsa_phase(Frame& F, const Args& A) {
    LAS float* lutd = (LAS float*)(F.lds + L_LUTD);
    for (int i = F.tid; i < 114 * 16; i += 512) lutd[i] = INP(I_RELB)[t5_bucket(i >> 4) * 16 + (i & 15)] * LOG2E;
    __syncthreads();
#ifndef PROBE_DSA_REP
#define PROBE_DSA_REP 1
#endif
    const bool xa = (F.G == 256);
    const int nround = xa ? 16 : (4096 + F.G - 1) / F.G;
    for (int ii = 0; ii < nround * PROBE_DSA_REP; ++ii) {
        const int i = ii % nround; int b, tb; bool ok = true;
        if (xa) { const int r = F.bid >> 3; b = F.bid & 7; tb = 511 - (i * 32 + ((i & 1) ? 31 - r : r)); }
        else { const int cc = (i & 1) ? (F.G - 1 - F.bid) : F.bid; const int I = i * F.G + cc; ok = I < 4096; b = I & 7; tb = 511 - (I >> 3); }
        if (ok) unit_dsa(F, A, b, 8 * tb);
    }
}
}
constexpr int NPHASE = 19;
__global__ void __launch_bounds__(512, 2) mk_fwd(Args args) {
    extern __shared__ __attribute__((aligned(16))) unsigned char lds_raw[];
    Frame F;
    F.lds = (LAS unsigned char*)lds_raw;
    F.tid = threadIdx.x; F.lane = F.tid & 63; F.wave = __builtin_amdgcn_readfirstlane(F.tid >> 6);
    F.G = gridDim.x; F.bid = blockIdx.x; F.ws = args.ws; F.out = args.out;
    volatile LAS unsigned* MISC = (volatile LAS unsigned*)(F.lds + LDS_MISC_OFF);
    if (F.tid < 64) MISC[F.tid] = 0u;
    __syncthreads();
    if (F.tid < 28) *(LAS unsigned long long*)(F.lds + LDS_PTR_OFF + 8 * F.tid) = (unsigned long long)args.in[F.tid];
    __syncthreads();
    const int lo = args.ph_lo, hi = args.ph_hi;
    const bool use_bar = (hi - lo) > 1;
    XcdBarrier bar; bar.bar = (unsigned*)(F.ws + WS_CTL) + CW_BAR; bar.x = 0; bar.st = nullptr;
    if (use_bar) bar = xcd_barrier_post((unsigned*)(F.ws + WS_CTL) + CW_BAR, MISC);
#ifdef PH_ONLY
#define IN(k) ((k) == PH_ONLY && lo <= (k) && (k) < hi)
#else
#define IN(k) (lo <= (k) && (k) < hi)
#endif
#ifndef PROBE_PH
#define PROBE_PH -1
#endif
#define REP(k) for (int rep_ = 0; rep_ < ((k) == PROBE_PH ? 2 : 1); ++rep_)
#define SEAM(k) do { if (IN(k) && IN((k) + 1)) xcd_barrier(bar); } while (0)
    LAS unsigned char* ring = F.lds;
    const Args& A = args;

    if (IN(0)) REP(0) { p0_prologue(F, A); } SEAM(0);
    if (IN(1)) REP(1) {
        pg8::Gemm g{WSP(bf16_t, WS_XB), WSP(bf16_t, WS_WIN0), DM}; pg8::Proj0OrderA S{F.G, F.bid};
        pg8::EpiProj0 E{F.ws};
        pg8::gemm_phase<pg8::EpiProj0, pg8::Proj0OrderA, true, true>(ring, g, S, E);
    } SEAM(1);
    if (IN(2)) REP(2) {
        pg8::Gemm g{WSP(bf16_t, WS_XB), WSP(bf16_t, WS_WIN0), DM}; pg8::Proj0OrderB S; S.so.init(T / 256, 7, F.G, F.bid); S.G = F.G; S.c = F.bid;
        pg8::EpiProj0 E{F.ws};
        pg8::gemm_phase<pg8::EpiProj0, pg8::Proj0OrderB, true, true>(ring, g, S, E);
    } SEAM(2);
    if (IN(3)) REP(3) { p2b_compress_tail(F, A); } SEAM(3);
    if (IN(4)) REP(4) { att::attn0_phase(F, A); } SEAM(4);
    if (IN(5)) REP(5) {
        pg8::Gemm g{WSP(bf16_t, WS_MIX0), WSP(bf16_t, WS_WOUT0), DM}; pg8::StaticOrder S; S.init(T / 256, DM / 256, F.G, F.bid);
        pg8::EpiRes E{INP(I_X), nullptr, (bf16_t*)F.out};
        pg8::gemm_phase<pg8::EpiRes, pg8::StaticOrder, true, true>(ring, g, S, E);
    } SEAM(5);
    if (IN(6)) REP(6) { p_layernorm(F, (const bf16_t*)F.out, INP(I_L0_LN1G), INP(I_L0_LN1B), WSP(bf16_t, WS_X1B)); } SEAM(6);
    if (IN(7)) REP(7) {
        pg8::Gemm g{WSP(bf16_t, WS_X1B), WSP(bf16_t, WS_WGU0), DM}; pg8::StaticOrder S; S.init(T / 256, 2 * DFF / 256, F.G, F.bid);
        pg8::EpiSwiglu E{WSP(bf16_t, WS_H0), 0};
        pg8::gemm_phase<pg8::EpiSwiglu, pg8::StaticOrder, true, true>(ring, g, S, E);
    } SEAM(7);
    if (IN(8)) REP(8) {
        pg8::Gemm g{WSP(bf16_t, WS_H0), WSP(bf16_t, WS_WDN0), DFF}; pg8::StaticOrder S; S.init(T / 256, DM / 256, F.G, F.bid);
        pg8::EpiRes E{nullptr, WSP(bf16_t, WS_X1B), (bf16_t*)F.out};
        pg8::gemm_phase<pg8::EpiRes, pg8::StaticOrder, true, true>(ring, g, S, E);
    } SEAM(8);
    if (IN(9)) REP(9) { p_layernorm(F, (const bf16_t*)F.out, INP(I_L0_LN2G), INP(I_L0_LN2B), WSP(bf16_t, WS_X2B)); } SEAM(9);
    if (IN(10)) REP(10) {
        pg8::Gemm g{WSP(bf16_t, WS_X2B), WSP(bf16_t, WS_WIN1), DM}; pg8::StaticOrder S; S.init(T / 256, N_IN1P / 256, F.G, F.bid);
        pg8::EpiProj1 E{F.ws};
        pg8::gemm_phase<pg8::EpiProj1, pg8::StaticOrder, true, true>(ring, g, S, E);
    } SEAM(10);
    if (IN(11)) REP(11) { dsa::dsa_phase(F, A); } SEAM(11);
    if (IN(12)) REP(12) {
        pg8::Gemm g{WSP(bf16_t, WS_MIX1), WSP(bf16_t, WS_WOUT1), DM}; pg8::StaticOrder S; S.init(T / 256, DM / 256, F.G, F.bid);
        pg8::EpiRes E{nullptr, WSP(bf16_t, WS_X2B), WSP(bf16_t, WS_Y3)};
        pg8::gemm_phase<pg8::EpiRes, pg8::StaticOrder, true, true>(ring, g, S, E);
    } SEAM(12);
    if (IN(13)) REP(13) { p12_ln_router(F, A); } SEAM(13);
    if (IN(14)) REP(14) { p13_moe_dispatch(F, A); } SEAM(14);
#define MOE_PASS(pidx, ph1, ph2) \
    if (IN(ph1)) REP(ph1) { LAS int* tile_e = (LAS int*)(F.lds + LDS_EXTRA_OFF); const int NT = moe_tile_table(F, tile_e); const int t0_ = (pidx) * MOE_PASS_TILES; int nM_ = NT - t0_; if ((pidx) == 0 && nM_ > MOE_PASS_TILES) nM_ = MOE_PASS_TILES; \
        if (nM_ > 0) { pg8::Gemm g{(const bf16_t*)F.out + 1024, WSP(bf16_t, WS_WGU1), DM}; pg8::MoeOrder S; S.gpitch = 2048;     S.so.init(nM_, 2 * DFF / 256, F.G, F.bid); S.tile0 = t0_; S.nN = 2 * DFF / 256; S.a_local = 0; S.tile_e = tile_e; S.rowlist = WSP(int, WS_ROWTOK); \
            pg8::EpiSwiglu E{WSP(bf16_t, WS_H1), t0_}; pg8::gemm_phase<pg8::EpiSwiglu, pg8::MoeOrder, true, true, true>(ring, g, S, E); } } SEAM(ph1); \
    if (IN(ph2)) REP(ph2) { LAS int* tile_e = (LAS int*)(F.lds + LDS_EXTRA_OFF); const int NT = moe_tile_table(F, tile_e); const int t0_ = (pidx) * MOE_PASS_TILES; int nM_ = NT - t0_; if ((pidx) == 0 && nM_ > MOE_PASS_TILES) nM_ = MOE_PASS_TILES; \
        if (nM_ > 0) { pg8::Gemm g{WSP(bf16_t, WS_H1), WSP(bf16_t, WS_WDN1), DFF}; pg8::MoeOrder S; S.so.init(nM_, DM / 256, F.G, F.bid); S.tile0 = t0_; S.nN = DM / 256; S.a_local = 1; S.tile_e = tile_e; S.rowlist = nullptr; S.gpitch = 0; \
            pg8::EpiBf16 E{WSP(bf16_t, WS_XG)}; pg8::gemm_phase<pg8::EpiBf16, pg8::MoeOrder, true, true>(ring, g, S, E); } } SEAM(ph2);
    MOE_PASS(0, 15, 16)
    MOE_PASS(1, 17, 18)
#undef MOE_PASS
    if (IN(19)) REP(19) { p_final(F, A); }
#undef IN
#undef SEAM
}

extern "C" void kernel_launch(void* const* d_in, const int* in_sizes, int n_in, void* d_out, int out_size, void* d_ws, size_t ws_size, hipStream_t stream) {
    static int grid = 0;
    if (grid == 0) {
        if (n_in != 28 || in_sizes[0] != T * DM || out_size != T * DM || ws_size < WS_END) {
            fprintf(stderr, "kernel_launch: unexpected problem (n_in %d, in0 %d, out %d, ws %zu); nothing launched\n", n_in, n_in > 0 ? in_sizes[0] : -1, out_size, ws_size); grid = -1; return; }
        int dev = 0, cus = 0, per_cu = 0;
        if (hipGetDevice(&dev) != hipSuccess || hipDeviceGetAttribute(&cus, hipDeviceAttributeMultiprocessorCount, dev) != hipSuccess) { grid = -1; return; }
        if (hipFuncSetAttribute((const void*)mk_fwd, hipFuncAttributeMaxDynamicSharedMemorySize, LDS_BYTES) != hipSuccess) { fprintf(stderr, "kernel_launch: hipFuncSetAttribute failed\n"); grid = -1; return; }
        if (hipOccupancyMaxActiveBlocksPerMultiprocessor(&per_cu, (const void*)mk_fwd, 512, LDS_BYTES) != hipSuccess || per_cu < 1) { fprintf(stderr, "kernel_launch: occupancy query says %d blocks per CU\n", per_cu); }
        (void)hipGetLastError();
        grid = cus;
    }
    if (grid < 0) return;
    (void)hipMemsetAsync((char*)d_ws + WS_CTL, 0, CTL_ZERO_BYTES, stream);
    Args a{};
    for (int i = 0; i < 28; ++i) a.in[i] = (const float*)d_in[i];
    a.out = (float*)d_out; a.ws = (unsigned char*)d_ws;
    constexpr int NPH = 20;
#if MK_N_LAUNCHES == 1
    a.ph_lo = 0; a.ph_hi = NPH;
    hipLaunchKernelGGL(mk_fwd, dim3(grid), dim3(512), LDS_BYTES, stream, a);
#else
    for (int p = 0; p < NPH; ++p) { a.ph_lo = p; a.ph_hi = p + 1; hipLaunchKernelGGL(mk_fwd, dim3(grid), dim3(512), LDS_BYTES, stream, a); }
#endif
}
```

```cpp
#include <hip/hip_runtime.h>
#include <cstdio>
#include <cstdint>

#ifndef MK_N_LAUNCHES
#define MK_N_LAUNCHES 1
#endif

#define LAS __attribute__((address_space(3)))
#define GAS __attribute__((address_space(1)))
typedef unsigned short bf16_t;
typedef short bf16x8 __attribute__((ext_vector_type(8)));
typedef short s16x4 __attribute__((ext_vector_type(4)));
typedef float f32x2 __attribute__((ext_vector_type(2)));
typedef float f32x4 __attribute__((ext_vector_type(4)));
typedef float f32x16 __attribute__((ext_vector_type(16)));
typedef unsigned u32x2 __attribute__((ext_vector_type(2)));
typedef unsigned u32x4 __attribute__((ext_vector_type(4)));

constexpr int NBATCH = 8, SEQ = 4096, T = NBATCH * SEQ, DM = 1024, DFF = 2816, NEXP = 8;
constexpr int N_IN0 = 2072, N_IN0P = 2304, N_IN1 = 1448, N_IN1P = 1536;
constexpr float ALPHA = 1.41421356237309515f;
constexpr float LN_EPS = 1e-5f;
constexpr float LOG2E = 1.4426950408889634f;
constexpr float QSCALE = 0.125f * LOG2E;

constexpr size_t MiB = 1u << 20;
constexpr size_t WS_CTL = 0, CTL_ZERO_BYTES = 1 * MiB;
constexpr size_t WS_KC = 1 * MiB;
constexpr size_t WS_POSW = 2 * MiB;
constexpr size_t WS_MOECNT = 2 * MiB + 64 * 1024;
constexpr size_t WS_MOEMETA = 2 * MiB + 128 * 1024;
constexpr size_t WS_TOKINFO = 2 * MiB + 256 * 1024;
constexpr size_t WS_WGU1 = 4 * MiB;
constexpr size_t WS_WDN1 = 92 * MiB;
constexpr size_t WS_WIN0 = 136 * MiB;
constexpr size_t WS_WC1 = 141 * MiB;
constexpr size_t WS_WOUT0 = 143 * MiB;
constexpr size_t WS_WGU0 = 145 * MiB;
constexpr size_t WS_WDN0 = 156 * MiB;
constexpr size_t WS_WIN1 = 162 * MiB;
constexpr size_t WS_WOUT1 = 165 * MiB;
constexpr size_t WS_XB = 168 * MiB;
constexpr size_t WS_QA = 232 * MiB;
constexpr size_t WS_QB = 264 * MiB;
constexpr size_t WS_KA = 296 * MiB;
constexpr size_t WS_VA = 304 * MiB;
constexpr size_t WS_KCMP = 312 * MiB;
constexpr size_t WS_VCMP = 320 * MiB;
constexpr size_t WS_KSLC = 328 * MiB;
constexpr size_t WS_VSLC = 336 * MiB;
constexpr size_t WS_KWIN = 344 * MiB;
constexpr size_t WS_VWIN = 352 * MiB;
constexpr size_t WS_GATES = 360 * MiB;
constexpr size_t WS_HCMP = 364 * MiB;
constexpr size_t WS_MIX0 = WS_XB;
constexpr size_t WS_X1B = 232 * MiB;
constexpr size_t WS_H0 = 296 * MiB;
constexpr size_t WS_X2B = WS_XB;
constexpr size_t WS_Q1 = 232 * MiB;
constexpr size_t WS_K1 = 296 * MiB;
constexpr size_t WS_V1 = 300 * MiB;
constexpr size_t WS_QI = 304 * MiB;
constexpr size_t WS_KI = 320 * MiB;
constexpr size_t WS_WI = 322 * MiB;
constexpr size_t WS_MIX1 = 328 * MiB;
constexpr size_t WS_Y3 = 392 * MiB;
constexpr size_t WS_X3B = 200 * MiB;
constexpr size_t WS_ROWTOK = 3 * MiB;
constexpr size_t WS_XG = 136 * MiB;
constexpr size_t WS_H1 = 268 * MiB;
constexpr size_t WS_END = 512 * MiB;
constexpr int MOE_PASS_TILES = 128;
constexpr int MOE_MAX_TILES = 264;

constexpr int CW_BAR = 4096;

constexpr int RING_BYTES = 131072;
constexpr int LDS_EXTRA_OFF = RING_BYTES;
constexpr int LDS_MISC_OFF = RING_BYTES + 16384;
constexpr int LDS_BYTES = RING_BYTES + 16384 + 512;

typedef __bf16 bf16x2_t __attribute__((ext_vector_type(2)));
__device__ __forceinline__ unsigned cvt_pk_bf16(float lo, float hi) { const f32x2 v = {lo, hi}; const bf16x2_t b = __builtin_convertvector(v, bf16x2_t); return __builtin_bit_cast(unsigned, b); }
__device__ __forceinline__ float bf_lo(unsigned w) { return __uint_as_float(w << 16); }
__device__ __forceinline__ float bf_hi(unsigned w) { return __uint_as_float(w & 0xffff0000u); }
__device__ __forceinline__ float wave_sum(float v) {
#pragma unroll
    for (int o = 1; o < 64; o <<= 1) v += __shfl_xor(v, o);
    return v;
}
__device__ __forceinline__ float swap_max(float m) { auto rr = __builtin_amdgcn_permlane32_swap(__float_as_uint(m), __float_as_uint(m), false, false); return fmaxf(__uint_as_float(rr[0]), __uint_as_float(rr[1])); }
__device__ __forceinline__ float swap_sum(float m) { auto rr = __builtin_amdgcn_permlane32_swap(__float_as_uint(m), __float_as_uint(m), false, false); return __uint_as_float(rr[0]) + __uint_as_float(rr[1]); }
__device__ __forceinline__ int t5_bucket(int n) {
    if (n < 16) return n;
    int b = 16;
    b += (n >= 19); b += (n >= 21); b += (n >= 24); b += (n >= 27); b += (n >= 31); b += (n >= 35); b += (n >= 40); b += (n >= 46);
    b += (n >= 52); b += (n >= 59); b += (n >= 67); b += (n >= 77); b += (n >= 87); b += (n >= 99); b += (n >= 113);
    return b;
}
namespace pg8 {
#define PG8_LAS __attribute__((address_space(3)))
constexpr int BM = 256, BK = 64, HALF = 128, HTB = HALF * BK * 2  , STAGE_BYTES = 8 * HTB, NXCD = 8, WGM = 8;
__host__ __device__ __forceinline__ int lds_byte(int r, int c) { const int st = (r >> 4) * 2 + (c >> 5), rr = r & 15, cc = c & 31, ob = rr * 64 + cc * 2; return st * 1024 + (ob ^ (((ob >> 9) & 1) << 5)); }
__host__ __device__ __forceinline__ void stage_rc(int b, int& R, int& C) { const int st = b / 1024, sb = b % 1024, swz = sb ^ (((sb >> 9) & 1) << 5); R = (st >> 1) * 16 + swz / 64; C = (st & 1) * 32 + (swz % 64) / 2; }
__host__ __device__ __forceinline__ int perm32(int rho) { const int n = rho >> 4, i = rho & 15; return 8 * (i >> 2) + 4 * n + (i & 3); }

struct Unit { int pa, pb, pm, pn; };
struct Gemm { const bf16_t* A; const bf16_t* Bt; int K; };

struct StaticOrder {
    int nM, nN, nwg, G, c; const int* rowlist; int gpitch;
    __host__ __device__ void init(int nM_, int nN_, int G_, int c_) { nM = nM_; nN = nN_; nwg = nM * nN; G = G_; c = c_; }
    __host__ __device__ bool next(int i, Unit& u) const {
        const long L = (long)i * G + c; if (L >= nwg) return false;
        int wgid = (int)L; { const int q = nwg / NXCD, r = nwg % NXCD, xcd = wgid % NXCD, off = wgid / NXCD; wgid = (xcd < r ? xcd * (q + 1) : r * (q + 1) + (xcd - r) * q) + off; }
        const int nig = WGM * nN, gid = wgid / nig, fm = gid * WGM, gsz = (nM - fm) < WGM ? (nM - fm) : WGM;
        u.pm = fm + ((wgid % nig) % gsz); u.pn = (wgid % nig) / gsz; u.pa = u.pm; u.pb = u.pn; return true;
    }
    __device__ __forceinline__ void a_ready(const Unit&) const {}
    __device__ __forceinline__ void done(const Unit&) const {}
};
template <class Epi, class Sched, bool ALIGN_EPI = false, bool SP2 = false, bool GATHER = false>
__device__ __forceinline__ void gemm_phase(PG8_LAS unsigned char* lds, const Gemm g, const Sched& S, const Epi& E) {
    const int tid = threadIdx.x, wid = __builtin_amdgcn_readfirstlane(tid >> 6), lane = tid & 63, wr = wid >> 2, wc = wid & 3, fr = lane & 15, fq = lane >> 4;
    const int K = g.K, nt = K / BK;
    unsigned voffA[2], voffB[2]; int rA[2], cA2[2];
#pragma unroll
    for (int i = 0; i < 2; ++i) { int R, C; stage_rc(tid * 16 + i * 8192, R, C); const int Rb = Epi::PERM ? ((R & ~31) + perm32(R & 31)) : R;
        voffA[i] = (unsigned)(R * K + C) * 2u; voffB[i] = (unsigned)(Rb * K + C) * 2u; rA[i] = R; cA2[i] = C; }
    unsigned vofC[2][2], vofN[2][2];
#define PG8_GOFF(dst, unit) do { if constexpr (GATHER) { _Pragma("unroll") for (int h_ = 0; h_ < 2; ++h_) _Pragma("unroll") for (int i_ = 0; i_ < 2; ++i_) \
        dst[h_][i_] = ((unsigned)S.rowlist[(unit).pm * BM + h_ * HALF + rA[i_]] * (unsigned)S.gpitch + (unsigned)cA2[i_]) * 2u; } } while (0)
    const size_t kstep = (size_t)(BK * 2);
    const size_t hstep = (size_t)HALF * K * 2;
    const size_t tstep = 2 * hstep;
    const unsigned ldsw = (unsigned)wid * 1024u;
    const int aoff = lds_byte(wr * 64 + fr, fq * 8), boff = lds_byte(wc * 32 + fr, fq * 8);
#define PG8_SA(b, h) (((b) * 2 + (h)) * HTB)
#define PG8_SB(b, h) ((4 + (b) * 2 + (h)) * HTB)
#define PG8_STAGE(bufoff, gbase, voff) do { _Pragma("unroll") for (int _i = 0; _i < 2; ++_i) \
        __builtin_amdgcn_global_load_lds((const unsigned*)((const char*)(gbase) + (voff)[_i]), (PG8_LAS unsigned*)(lds + (bufoff) + ldsw + _i * 8192), 16, 0, 0); } while (0)
#define PG8_STAGE_A(bufoff, gbase, h, VO) do { if constexpr (GATHER) PG8_STAGE(bufoff, gbase, VO[h]); else PG8_STAGE(bufoff, (gbase) + (h) * hstep, voffA); } while (0)
#define PG8_LDA(dst, b, h) do { _Pragma("unroll") for (int m = 0; m < 4; ++m) _Pragma("unroll") for (int k = 0; k < 2; ++k) dst[m][k] = *(const PG8_LAS bf16x8*)(lds + PG8_SA(b, h) + aoff + m * 2048 + k * 1024); } while (0)
#define PG8_LDB(dst, b, h) do { _Pragma("unroll") for (int n = 0; n < 2; ++n) _Pragma("unroll") for (int k = 0; k < 2; ++k) dst[n][k] = *(const PG8_LAS bf16x8*)(lds + PG8_SB(b, h) + boff + n * 2048 + k * 1024); } while (0)
#define PG8_MMA(ai, bj, At, Bt) do { __builtin_amdgcn_s_setprio(1); _Pragma("unroll") for (int m = 0; m < 4; ++m) _Pragma("unroll") for (int n = 0; n < 2; ++n) _Pragma("unroll") for (int k = 0; k < 2; ++k) \
        acc[ai][bj][m][n] = __builtin_amdgcn_mfma_f32_16x16x32_bf16(Bt[n][k], At[m][k], acc[ai][bj][m][n], 0, 0, 0); __builtin_amdgcn_s_setprio(0); } while (0)
#define PG8_WAIT_V(n) asm volatile("s_waitcnt vmcnt(" #n ")" ::: "memory")
#define PG8_WAIT_L(n) asm volatile("s_waitcnt lgkmcnt(" #n ")" ::: "memory")
#define PG8_BAR __builtin_amdgcn_s_barrier()
#define PG8_SCHED __builtin_amdgcn_sched_barrier(0)
    Unit cur, nxt; int ui = 0;
    if (!S.next(0, cur)) return;
    f32x4 acc[2][2][4][2];
#pragma unroll
    for (int a = 0; a < 2; ++a)
#pragma unroll
        for (int b = 0; b < 2; ++b)
#pragma unroll
            for (int m = 0; m < 4; ++m)
#pragma unroll
                for (int n = 0; n < 2; ++n) acc[a][b][m][n] = (f32x4){0.f, 0.f, 0.f, 0.f};
    bf16x8 At[4][2], B0[2][2], B1[2][2];
    const char* cA = (const char*)g.A + (size_t)cur.pa * tstep; const char* cB = (const char*)g.Bt + (size_t)cur.pb * tstep;
    S.a_ready(cur);
    PG8_GOFF(vofC, cur);
#pragma unroll
    for (int h_ = 0; h_ < 2; ++h_)
#pragma unroll
        for (int i_ = 0; i_ < 2; ++i_) { if constexpr (!GATHER) vofC[h_][i_] = 0u; vofN[h_][i_] = vofC[h_][i_]; }
    if constexpr (SP2) {
        PG8_STAGE(PG8_SB(0, 0), cB, voffB); PG8_STAGE(PG8_SB(0, 1), cB + hstep, voffB); PG8_STAGE_A(PG8_SA(0, 0), cA, 0, vofC); PG8_STAGE_A(PG8_SA(0, 1), cA, 1, vofC);
        if (wr == 1) PG8_BAR;
        PG8_WAIT_V(2); PG8_BAR;
        PG8_STAGE(PG8_SB(1, 0), cB + kstep, voffB); PG8_STAGE_A(PG8_SA(1, 0), cA + kstep, 0, vofC); PG8_STAGE(PG8_SB(1, 1), cB + hstep + kstep, voffB);
        PG8_WAIT_V(6); PG8_BAR;
    } else {
        PG8_STAGE(PG8_SB(0, 0), cB, voffB); PG8_STAGE_A(PG8_SA(0, 0), cA, 0, vofC); PG8_STAGE(PG8_SB(0, 1), cB + hstep, voffB); PG8_STAGE_A(PG8_SA(0, 1), cA, 1, vofC);
        if (wr == 1) PG8_BAR;
        PG8_WAIT_V(4); PG8_BAR;
        PG8_STAGE(PG8_SB(1, 0), cB + kstep, voffB); PG8_STAGE_A(PG8_SA(1, 0), cA + kstep, 0, vofC); PG8_STAGE(PG8_SB(1, 1), cB + hstep + kstep, voffB);
        PG8_WAIT_V(6); PG8_BAR;
    }
    for (;;) {
        const bool has_next = S.next(ui + 1, nxt);
        if constexpr (GATHER) { if (has_next) PG8_GOFF(vofN, nxt); }
        const char* nA = has_next ? (const char*)g.A + (size_t)nxt.pa * tstep : cA; const char* nB = has_next ? (const char*)g.Bt + (size_t)nxt.pb * tstep : cB;
        for (int t = 0; t < nt; t += 2) {
            const bool last = (t == nt - 2);
            unsigned vsel[2][2];
#pragma unroll
            for (int h_ = 0; h_ < 2; ++h_)
#pragma unroll
                for (int i_ = 0; i_ < 2; ++i_) vsel[h_][i_] = last ? vofN[h_][i_] : vofC[h_][i_];
            const char* a1 = cA + (size_t)(t + 1) * kstep;
            const char* a2 = last ? nA : cA + (size_t)(t + 2) * kstep; const char* b2 = last ? nB : cB + (size_t)(t + 2) * kstep;
            const char* a3 = a2 + kstep; const char* b3 = b2 + kstep;
            if (last && has_next) S.a_ready(nxt);
            if constexpr (SP2) {
            PG8_LDB(B0, 0, 0); PG8_LDB(B1, 0, 1); PG8_SCHED; PG8_LDA(At, 0, 0); PG8_STAGE_A(PG8_SA(1, 1), a1, 1, vofC);
            PG8_WAIT_V(8); PG8_WAIT_L(0); PG8_BAR; PG8_MMA(0, 0, At, B0); PG8_MMA(0, 1, At, B1); PG8_BAR; PG8_SCHED;
            PG8_LDA(At, 0, 1); PG8_STAGE(PG8_SB(0, 0), b2, voffB); PG8_STAGE(PG8_SB(0, 1), b2 + hstep, voffB); PG8_STAGE_A(PG8_SA(0, 0), a2, 0, vsel);
            PG8_WAIT_V(8); PG8_WAIT_L(0); PG8_BAR; PG8_MMA(1, 0, At, B0); PG8_MMA(1, 1, At, B1); PG8_BAR; PG8_SCHED;
            PG8_LDB(B0, 1, 0); PG8_LDB(B1, 1, 1); PG8_SCHED; PG8_LDA(At, 1, 0); PG8_STAGE_A(PG8_SA(0, 1), a2, 1, vsel);
            PG8_WAIT_V(8); PG8_WAIT_L(0); PG8_BAR; PG8_MMA(0, 0, At, B0); PG8_MMA(0, 1, At, B1); PG8_BAR; PG8_SCHED;
            PG8_LDA(At, 1, 1); PG8_STAGE(PG8_SB(1, 0), b3, voffB); PG8_STAGE(PG8_SB(1, 1), b3 + hstep, voffB); PG8_STAGE_A(PG8_SA(1, 0), a3, 0, vsel);
            PG8_WAIT_V(8); PG8_WAIT_L(0); PG8_BAR; PG8_MMA(1, 0, At, B0); PG8_MMA(1, 1, At, B1); PG8_BAR; PG8_SCHED;
            } else {
            PG8_LDB(B0, 0, 0); PG8_SCHED; PG8_LDA(At, 0, 0); PG8_STAGE_A(PG8_SA(1, 1), a1, 1, vofC);
            PG8_WAIT_L(8); PG8_BAR; PG8_WAIT_L(0); PG8_MMA(0, 0, At, B0); PG8_BAR; PG8_SCHED;
            PG8_LDB(B1, 0, 1); PG8_STAGE(PG8_SB(0, 0), b2, voffB);
            PG8_BAR; PG8_WAIT_L(0); PG8_MMA(0, 1, At, B1); PG8_BAR;
            PG8_LDA(At, 0, 1); PG8_STAGE_A(PG8_SA(0, 0), a2, 0, vsel);
            PG8_BAR; PG8_WAIT_L(0); PG8_MMA(1, 0, At, B0); PG8_BAR; PG8_SCHED;
            PG8_STAGE(PG8_SB(0, 1), b2 + hstep, voffB);
            PG8_WAIT_V(6); PG8_BAR; PG8_MMA(1, 1, At, B1); PG8_BAR;
            PG8_LDB(B0, 1, 0); PG8_SCHED; PG8_LDA(At, 1, 0); PG8_STAGE_A(PG8_SA(0, 1), a2, 1, vsel);
            PG8_WAIT_L(8); PG8_BAR; PG8_WAIT_L(0); PG8_MMA(0, 0, At, B0); PG8_BAR; PG8_SCHED;
            PG8_LDB(B1, 1, 1); PG8_STAGE(PG8_SB(1, 0), b3, voffB);
            PG8_BAR; PG8_WAIT_L(0); PG8_MMA(0, 1, At, B1); PG8_BAR;
            PG8_LDA(At, 1, 1); PG8_STAGE_A(PG8_SA(1, 0), a3, 0, vsel);
            PG8_BAR; PG8_WAIT_L(0); PG8_MMA(1, 0, At, B0); PG8_BAR; PG8_SCHED;
            PG8_STAGE(PG8_SB(1, 1), b3 + hstep, voffB);
            PG8_WAIT_V(6); PG8_BAR; PG8_MMA(1, 1, At, B1); PG8_BAR;
            }
        }
        if constexpr (ALIGN_EPI) { if (wr == 0) PG8_BAR; }
        if constexpr (!Epi::AFTER_DRAIN) { E(acc, cur, wr, wc, fr, fq); S.done(cur); }
        if (!has_next) break;
#pragma unroll
        for (int a = 0; a < 2; ++a)
#pragma unroll
            for (int b = 0; b < 2; ++b)
#pragma unroll
                for (int m = 0; m < 4; ++m)
#pragma unroll
                    for (int n = 0; n < 2; ++n) acc[a][b][m][n] = (f32x4){0.f, 0.f, 0.f, 0.f};
        cur = nxt; cA = nA; cB = nB; ++ui;
#pragma unroll
        for (int h_ = 0; h_ < 2; ++h_)
#pragma unroll
            for (int i_ = 0; i_ < 2; ++i_) vofC[h_][i_] = vofN[h_][i_];
        if constexpr (ALIGN_EPI) { if (wr == 1) PG8_BAR; }
    }
    PG8_WAIT_V(0);
    if constexpr (!ALIGN_EPI) { if (wr == 0) PG8_BAR; }
    PG8_BAR;
    if constexpr (Epi::AFTER_DRAIN) { E.fused(acc, cur, wr, wc, fr, fq, lds, wid, lane); S.done(cur); }
#undef PG8_SA
#undef PG8_SB
#undef PG8_STAGE
#undef PG8_STAGE_A
#undef PG8_GOFF
#undef PG8_LDA
#undef PG8_LDB
#undef PG8_MMA
#undef PG8_WAIT_V
#undef PG8_WAIT_L
#undef PG8_BAR
#undef PG8_SCHED
}
}
#define XB_TMO      128
#define XB_XCNT(j)  (256  + 64 * (j))
#define XB_XSUB(j)  (1280 + 64 * (j))
#define XB_XGEN(j)  (2304 + 64 * (j))
#define XB_TOP      3328
#define XB_TOPGEN   3392
#define XCD_BAR_WORDS 3456
#define XB_SPIN_CAP (1u << 18)

__device__ __forceinline__ unsigned xb_ld(unsigned* p)              { return __hip_atomic_load(p, __ATOMIC_RELAXED, __HIP_MEMORY_SCOPE_AGENT); }
__device__ __forceinline__ unsigned xb_add(unsigned* p, unsigned v) { return __hip_atomic_fetch_add(p, v, __ATOMIC_RELAXED, __HIP_MEMORY_SCOPE_AGENT); }
__device__ __forceinline__ unsigned xb_xcc_id() { return (unsigned)__builtin_amdgcn_s_getreg((3 << 11) | 20) & 0xFu; }
#define XB_SPIN(cond, bar) do { unsigned _sp = 0; while (cond) { __builtin_amdgcn_s_sleep(1); \
    if ((++_sp & 255u) == 0u) { if (xb_ld(&(bar)[XB_TMO])) break; if (_sp > XB_SPIN_CAP) { atomicAdd(&(bar)[XB_TMO], 1u); break; } } } } while (0)

struct XcdBarrier {
    unsigned* bar; unsigned x;
    volatile LAS unsigned* st;
};

__device__ __forceinline__ XcdBarrier xcd_barrier_post(unsigned* bar, volatile LAS unsigned* st) {
    XcdBarrier b; b.bar = bar; b.x = xb_xcc_id(); b.st = st;
    if (threadIdx.x == 0) (void)xb_add(&bar[XB_XCNT(b.x)], 1u);
    return b;
}
__device__ __forceinline__ void xcd_barrier_complete(unsigned* bar, unsigned x, unsigned& nloc, unsigned& nx) {
    const unsigned G = gridDim.x * gridDim.y * gridDim.z;
    unsigned sum, cnt, mine, sp = 0u;
    for (;;) {
        sum = 0u; cnt = 0u; mine = 0u;
#pragma unroll
        for (unsigned j = 0; j < 16; ++j) { const unsigned c = xb_ld(&bar[XB_XCNT(j)]); sum += c; cnt += (c > 0u) ? 1u : 0u; mine = (j == x) ? c : mine; }
        if (sum == G) break;
        __builtin_amdgcn_s_sleep(1);
        if ((++sp & 255u) == 0u) { if (xb_ld(&bar[XB_TMO])) break; if (sp > XB_SPIN_CAP) { atomicAdd(&bar[XB_TMO], 1u); break; } }
    }
    nloc = mine > 0u ? mine : 1u; nx = cnt > 0u ? cnt : 1u;
}

__device__ __forceinline__ void xcd_barrier(const XcdBarrier& b) {
    asm volatile("s_waitcnt vmcnt(0)" ::: "memory");
    __syncthreads();
    if (threadIdx.x == 0) {
        unsigned* bar = b.bar;
        __builtin_amdgcn_s_waitcnt(0);
        unsigned nloc = b.st[0], nx = b.st[1];
        if (nloc == 0u) { xcd_barrier_complete(bar, b.x, nloc, nx); b.st[0] = nloc; b.st[1] = nx; }
        const unsigned old = xb_add(&bar[XB_XSUB(b.x)], 1u);
        const unsigned gen = old / nloc;
        if (old + 1u == (gen + 1u) * nloc) {
            __builtin_amdgcn_fence(__ATOMIC_RELEASE, "agent");
            asm volatile("s_waitcnt vmcnt(0)" ::: "memory");
            const unsigned og = xb_add(&bar[XB_TOP], 1u);
            const unsigned tg = og / nx;
            if (og + 1u == (tg + 1u) * nx) xb_add(&bar[XB_TOPGEN], 1u);
            else XB_SPIN(xb_ld(&bar[XB_TOPGEN]) == tg, bar);
            __builtin_amdgcn_fence(__ATOMIC_ACQUIRE, "agent");
            xb_add(&bar[XB_XGEN(b.x)], 1u);
            asm volatile("s_waitcnt vmcnt(0)" ::: "memory");
        } else {
            XB_SPIN(xb_ld(&bar[XB_XGEN(b.x)]) == gen, bar);
            __builtin_amdgcn_fence(__ATOMIC_ACQUIRE, "agent");
            asm volatile("s_waitcnt vmcnt(0)" ::: "memory");
        }
    }
    __syncthreads();
}
struct Args {
    const float* in[28];
    float* out; unsigned char* ws;
    int ph_lo, ph_hi;
};
struct Frame {
    LAS unsigned char* lds;
    int tid, lane, wave, G, bid;
    unsigned char* ws; float* out;
};
#define WSP(type, off) ((type*)(F.ws + (off)))
constexpr int LDS_PTR_OFF = LDS_MISC_OFF + 16;
__device__ __forceinline__ const float* in_ptr(LAS unsigned char* lds, int k) {
    const unsigned long long v = *(volatile LAS unsigned long long*)(lds + LDS_PTR_OFF + 8 * k);
    const unsigned lo = __builtin_amdgcn_readfirstlane((unsigned)v), hi = __builtin_amdgcn_readfirstlane((unsigned)(v >> 32));
    return (const float*)(((unsigned long long)hi << 32) | lo);
}
#define INP(k) in_ptr(F.lds, (k))

namespace pg8 {
struct EpiProj0 {
    static constexpr bool PERM = true, AFTER_DRAIN = false;
    unsigned char* ws;
    __device__ __forceinline__ void operator()(const f32x4 (&acc)[2][2][4][2], const Unit& u, int wr, int wc, int fr, int fq) const {
        const int row0 = u.pm * BM + wr * 64 + fr, cl = wc * 32 + 8 * fq;
        if (u.pn >= 16) {
            float* H = (float*)(ws + WS_HCMP);
#pragma unroll
            for (int ai = 0; ai < 2; ++ai)
#pragma unroll
                for (int m = 0; m < 4; ++m) { float* rp = H + (size_t)(row0 + ai * HALF + m * 16) * 512 + (u.pn - 16) * BM + cl;
#pragma unroll
                    for (int bj = 0; bj < 2; ++bj) { *(f32x4*)(rp + bj * HALF) = acc[ai][bj][m][0]; *(f32x4*)(rp + bj * HALF + 4) = acc[ai][bj][m][1]; } }
            return;
        }
#pragma unroll
        for (int bj = 0; bj < 2; ++bj) {
            const int hb = 2 * u.pn + bj;
            bf16_t* dst = nullptr; int pitch = 128, cb = cl, mode = 0; float sc = 1.f;
            if (hb < 4) { dst = (bf16_t*)(ws + WS_QA); pitch = 512; cb = hb * 128 + cl; sc = QSCALE; }
            else if (hb == 4) dst = (bf16_t*)(ws + WS_KA);
            else if (hb == 5) dst = (bf16_t*)(ws + WS_VA);
            else if (hb < 10) { dst = (bf16_t*)(ws + WS_QB); pitch = 512; cb = (hb - 6) * 128 + cl; sc = QSCALE; }
            else if (hb == 10) { dst = (bf16_t*)(ws + WS_KCMP); mode = 1; }
            else if (hb == 11) { dst = (bf16_t*)(ws + WS_VCMP); mode = 1; }
            else if (hb == 12) dst = (bf16_t*)(ws + WS_KSLC);
            else if (hb == 13) dst = (bf16_t*)(ws + WS_VSLC);
            else if (hb == 14) dst = (bf16_t*)(ws + WS_KWIN);
            else if (hb == 15) dst = (bf16_t*)(ws + WS_VWIN);
            else if (hb == 16) mode = (cl < 24) ? 2 : 3;
            else mode = 3;
            if (mode == 3) continue;
#pragma unroll
            for (int ai = 0; ai < 2; ++ai)
#pragma unroll
                for (int m = 0; m < 4; ++m) {
                    const int row = row0 + ai * HALF + m * 16;
                    const f32x4 v0 = acc[ai][bj][m][0], v1 = acc[ai][bj][m][1];
                    if (mode == 2) {
                        float* gp = (float*)(ws + WS_GATES) + (size_t)row * 24 + cl;
                        f32x4 a, b;
#pragma unroll
                        for (int i = 0; i < 4; ++i) { a[i] = 1.f / (1.f + __expf(-v0[i])); b[i] = 1.f / (1.f + __expf(-v1[i])); }
                        *(f32x4*)gp = a; *(f32x4*)(gp + 4) = b;
                    } else {
                        u32x4 w; w.x = cvt_pk_bf16(v0[0] * sc, v0[1] * sc); w.y = cvt_pk_bf16(v0[2] * sc, v0[3] * sc); w.z = cvt_pk_bf16(v1[0] * sc, v1[1] * sc); w.w = cvt_pk_bf16(v1[2] * sc, v1[3] * sc);
                        size_t off;
                        if (mode == 1) { const int b = row >> 12, t = row & 4095, g = cb >> 6, d = cb & 63; off = ((size_t)((b * 2 + g) * 4096 + t)) * 64 + d; }
                        else off = (size_t)row * pitch + cb;
                        *(u32x4*)(dst + off) = w;
                    }
                }
        }
    }
};
struct EpiProj1 {
    static constexpr bool PERM = true, AFTER_DRAIN = false;
    unsigned char* ws;
    __device__ __forceinline__ void operator()(const f32x4 (&acc)[2][2][4][2], const Unit& u, int wr, int wc, int fr, int fq) const {
        const int row0 = u.pm * BM + wr * 64 + fr, cl = wc * 32 + 8 * fq;
#pragma unroll
        for (int bj = 0; bj < 2; ++bj) {
            const int hb = 2 * u.pn + bj;
            bf16_t* dst = nullptr; int pitch = 1024, cb = cl, mode = 0; float sc = 1.f;
            if (hb < 8) { dst = (bf16_t*)(ws + WS_Q1); cb = hb * 128 + cl; sc = QSCALE; }
            else if (hb == 8) { if (cl < 64) { dst = (bf16_t*)(ws + WS_K1); pitch = 64; } else { dst = (bf16_t*)(ws + WS_V1); pitch = 64; cb = cl - 64; } }
            else if (hb < 11) { dst = (bf16_t*)(ws + WS_QI); pitch = 256; cb = (hb - 9) * 128 + cl; }
            else if (hb == 11) { if (cl < 32) { dst = (bf16_t*)(ws + WS_KI); pitch = 32; } else if (cl < 40) mode = 2; else mode = 3; }
            else mode = 3;
            if (mode == 3) continue;
#pragma unroll
            for (int ai = 0; ai < 2; ++ai)
#pragma unroll
                for (int m = 0; m < 4; ++m) {
                    const int row = row0 + ai * HALF + m * 16;
                    const f32x4 v0 = acc[ai][bj][m][0], v1 = acc[ai][bj][m][1];
                    if (mode == 2) { float* gp = (float*)(ws + WS_WI) + (size_t)row * 8; *(f32x4*)gp = v0; *(f32x4*)(gp + 4) = v1; }
                    else { u32x4 w; w.x = cvt_pk_bf16(v0[0] * sc, v0[1] * sc); w.y = cvt_pk_bf16(v0[2] * sc, v0[3] * sc); w.z = cvt_pk_bf16(v1[0] * sc, v1[1] * sc); w.w = cvt_pk_bf16(v1[2] * sc, v1[3] * sc);
                        *(u32x4*)(dst + (size_t)row * pitch + cb) = w; }
                }
        }
    }
};
struct EpiF32 {
    static constexpr bool PERM = false, AFTER_DRAIN = false;
    float* out; int ldc;
    __device__ __forceinline__ void operator()(const f32x4 (&acc)[2][2][4][2], const Unit& u, int wr, int wc, int fr, int fq) const {
#pragma unroll
        for (int ai = 0; ai < 2; ++ai)
#pragma unroll
            for (int m = 0; m < 4; ++m) { float* rp = out + (size_t)(u.pm * BM + ai * HALF + wr * 64 + m * 16 + fr) * ldc + u.pn * BM + wc * 32 + 4 * fq;
#pragma unroll
                for (int bj = 0; bj < 2; ++bj)
#pragma unroll
                    for (int n = 0; n < 2; ++n) *(f32x4*)(rp + bj * HALF + n * 16) = acc[ai][bj][m][n]; }
    }
};
struct EpiRes {
    static constexpr bool PERM = true, AFTER_DRAIN = false;
    const float* resf; const bf16_t* resb; bf16_t* out;
    __device__ __forceinline__ void operator()(const f32x4 (&acc)[2][2][4][2], const Unit& u, int wr, int wc, int fr, int fq) const {
#pragma unroll
        for (int ai = 0; ai < 2; ++ai)
#pragma unroll
            for (int m = 0; m < 4; ++m) { const size_t ro = (size_t)(u.pm * BM + ai * HALF + wr * 64 + m * 16 + fr) * DM + u.pn * BM + wc * 32 + 8 * fq;
#pragma unroll
                for (int bj = 0; bj < 2; ++bj) { const size_t o = ro + bj * HALF; f32x4 r0, r1;
                    if (resf) { r0 = *(const f32x4*)(resf + o); r1 = *(const f32x4*)(resf + o + 4); }
                    else { const u32x4 w = *(const u32x4*)(resb + o); r0 = (f32x4){bf_lo(w.x), bf_hi(w.x), bf_lo(w.y), bf_hi(w.y)}; r1 = (f32x4){bf_lo(w.z), bf_hi(w.z), bf_lo(w.w), bf_hi(w.w)}; }
                    const f32x4 v0 = r0 * ALPHA + acc[ai][bj][m][0], v1 = r1 * ALPHA + acc[ai][bj][m][1];
                    u32x4 q; q.x = cvt_pk_bf16(v0[0], v0[1]); q.y = cvt_pk_bf16(v0[2], v0[3]); q.z = cvt_pk_bf16(v1[0], v1[1]); q.w = cvt_pk_bf16(v1[2], v1[3]);
                    *(u32x4*)(out + o) = q; } }
    }
};
struct EpiSwiglu {
    static constexpr bool PERM = true, AFTER_DRAIN = false;
    bf16_t* H; int row_tile0;
    __device__ __forceinline__ void operator()(const f32x4 (&acc)[2][2][4][2], const Unit& u, int wr, int wc, int fr, int fq) const {
        const int row0 = (u.pm - row_tile0) * BM + wr * 64 + fr, col = u.pn * HALF + wc * 32 + 8 * fq;
#pragma unroll
        for (int ai = 0; ai < 2; ++ai)
#pragma unroll
            for (int m = 0; m < 4; ++m) {
                float h[8];
#pragma unroll
                for (int n = 0; n < 2; ++n)
#pragma unroll
                    for (int i = 0; i < 4; ++i) { const float g = acc[ai][0][m][n][i], up = acc[ai][1][m][n][i];
                        h[n * 4 + i] = g * __builtin_amdgcn_rcpf(1.f + __builtin_amdgcn_exp2f(-g * LOG2E)) * up; }
                u32x4 w; w.x = cvt_pk_bf16(h[0], h[1]); w.y = cvt_pk_bf16(h[2], h[3]); w.z = cvt_pk_bf16(h[4], h[5]); w.w = cvt_pk_bf16(h[6], h[7]);
                *(u32x4*)(H + (size_t)(row0 + ai * HALF + m * 16) * DFF + col) = w;
            }
    }
};
struct EpiBf16 {
    static constexpr bool PERM = true, AFTER_DRAIN = false;
    bf16_t* O;
    __device__ __forceinline__ void operator()(const f32x4 (&acc)[2][2][4][2], const Unit& u, int wr, int wc, int fr, int fq) const {
        const int row0 = u.pm * BM + wr * 64 + fr, col0 = u.pn * BM + wc * 32 + 8 * fq;
#pragma unroll
        for (int ai = 0; ai < 2; ++ai)
#pragma unroll
            for (int m = 0; m < 4; ++m) { bf16_t* rowp = O + (size_t)(row0 + ai * HALF + m * 16) * DM + col0;
#pragma unroll
                for (int bj = 0; bj < 2; ++bj) { const f32x4 v0 = acc[ai][bj][m][0], v1 = acc[ai][bj][m][1];
                    u32x4 w; w.x = cvt_pk_bf16(v0[0], v0[1]); w.y = cvt_pk_bf16(v0[2], v0[3]); w.z = cvt_pk_bf16(v1[0], v1[1]); w.w = cvt_pk_bf16(v1[2], v1[3]);
                    *(u32x4*)(rowp + bj * HALF) = w; } }
    }
};
struct Proj0OrderA {
    int G, c; const int* rowlist; int gpitch;
    __device__ bool next(int i, Unit& u) const { const int L = i * G + c; if (L >= 256) return false; u.pm = L >> 1; u.pa = u.pm; u.pn = (L & 1) ? 8 : 5; u.pb = u.pn; return true; }
    __device__ __forceinline__ void a_ready(const Unit&) const {}
    __device__ __forceinline__ void done(const Unit&) const {}
};
struct Proj0OrderB {
    StaticOrder so; int G, c; const int* rowlist; int gpitch;
    __device__ bool next(int i, Unit& u) const {
        if (so.next(i, u)) { u.pn = u.pn < 5 ? u.pn : u.pn + 1; u.pb = u.pn; return true; }
        const int L = i * G + c - 896; if (L < 0 || L >= 64) return false;
        const int ct = L >> 1; u.pm = ct; u.pa = (int)((WS_KCMP - WS_XB) / (512 * 1024)) + ct; u.pn = 16 + (L & 1); u.pb = (int)((WS_WC1 - WS_WIN0) / (512 * 1024)) + (ct >> 4) * 2 + (L & 1); return true;
    }
    __device__ __forceinline__ void a_ready(const Unit&) const {}
    __device__ __forceinline__ void done(const Unit&) const {}
};
struct MoeOrder {
    StaticOrder so; int tile0, nN, a_local, gpitch; const LAS int* tile_e; const int* rowlist;
    __device__ bool next(int i, Unit& u) const {
        if (!so.next(i, u)) return false;
        const int tile = tile0 + u.pm; u.pa = a_local ? u.pm : 0; u.pb = tile_e[tile] * nN + u.pn; u.pm = tile; return true;
    }
    __device__ __forceinline__ void a_ready(const Unit&) const {}
    __device__ __forceinline__ void done(const Unit&) const {}
};
}
enum { I_X = 0, I_RELB, I_L0_WIN, I_L0_SINKS, I_CK_POS, I_CK_W1, I_CK_W2, I_CV_POS, I_CV_W1, I_CV_W2, I_L0_WOUT, I_L0_LN1G, I_L0_LN1B, I_L0_GATE, I_L0_UP, I_L0_DOWN, I_L0_LN2G, I_L0_LN2B,
       I_L1_WIN, I_L1_WOUT, I_L1_LN1G, I_L1_LN1B, I_L1_ROUTER, I_L1_EGATE, I_L1_EUP, I_L1_EDOWN, I_L1_LN2G, I_L1_LN2B };

__device__ __forceinline__ void p0_transpose_item(const float* W, int ldw, int ncols, bf16_t* WT, int dk, int k0, int n0, int drow0, LAS float* scr, int lane) {
    const int cn = n0 + (lane & 31); const bool okc = cn < ncols;
    float tv[32];
#pragma unroll
    for (int i = 0; i < 32; ++i) { const int kk = 2 * i + (lane >> 5); tv[i] = okc ? W[(size_t)(k0 + kk) * ldw + cn] : 0.f; }
#pragma unroll
    for (int i = 0; i < 32; ++i) { const int kk = 2 * i + (lane >> 5); scr[kk * 33 + (lane & 31)] = tv[i]; }
    asm volatile("s_waitcnt lgkmcnt(0)" ::: "memory");
    const int c = lane & 7;
#pragma unroll
    for (int j = 0; j < 4; ++j) { const int n = (lane >> 3) + 8 * j; const LAS float* s = scr + (8 * c) * 33 + n;
        u32x4 o; o.x = cvt_pk_bf16(s[0 * 33], s[1 * 33]); o.y = cvt_pk_bf16(s[2 * 33], s[3 * 33]); o.z = cvt_pk_bf16(s[4 * 33], s[5 * 33]); o.w = cvt_pk_bf16(s[6 * 33], s[7 * 33]);
        *(u32x4*)(WT + (size_t)(drow0 + n) * dk + k0 + 8 * c) = o; }
    asm volatile("s_waitcnt lgkmcnt(0)" ::: "memory");
}
struct TJob { const float* W; bf16_t* WT; int ldw, ncols, npad, ksrc, dk, map; };
__device__ __forceinline__ int tjob_items(const TJob& j) { return (j.ksrc / 64) * (j.npad / 32); }
__device__ __forceinline__ void tjob_run(const TJob& j, int item, LAS float* scr, int lane) {
    const int nblk = j.npad / 32, kb = item / nblk, nb = item % nblk, n0 = nb * 32;
    int drow0 = n0; if (j.map) drow0 = 256 * (n0 >> 7) + (n0 & 127) + (j.map == 2 ? 128 : 0);
    p0_transpose_item(j.W, j.ldw, j.ncols, j.WT, j.dk, kb * 64, n0, drow0, scr, lane);
}
__device__ __forceinline__ void p0_prologue(Frame& F, const Args& A) {
    LAS float* scr = (LAS float*)(F.lds + F.wave * 16384);
    const int gw = F.bid * 8 + F.wave, NGW = F.G * 8;
    int base = 0;
#define RUN_JOB(jb) do { const TJob j_ = (jb); const int n_ = tjob_items(j_); \
        int it_ = gw - (base % NGW); if (it_ < 0) it_ += NGW; for (; it_ < n_; it_ += NGW) tjob_run(j_, it_, scr, F.lane); base += n_; } while (0)
    RUN_JOB((TJob{INP(I_L0_WIN), WSP(bf16_t, WS_WIN0), N_IN0, N_IN0, N_IN0P, DM, DM, 0}));
    RUN_JOB((TJob{INP(I_CK_W1), WSP(bf16_t, WS_WC1), 256, 256, 256, 1024, 1024, 0}));
    RUN_JOB((TJob{INP(I_CK_W1) + 1024 * 256, WSP(bf16_t, WS_WC1) + 256 * 1024, 256, 256, 256, 1024, 1024, 0}));
    RUN_JOB((TJob{INP(I_CV_W1), WSP(bf16_t, WS_WC1) + 512 * 1024, 256, 256, 256, 1024, 1024, 0}));
    RUN_JOB((TJob{INP(I_CV_W1) + 1024 * 256, WSP(bf16_t, WS_WC1) + 768 * 1024, 256, 256, 256, 1024, 1024, 0}));
    RUN_JOB((TJob{INP(I_L0_WOUT), WSP(bf16_t, WS_WOUT0), DM, DM, DM, DM, DM, 0}));
    RUN_JOB((TJob{INP(I_L0_GATE), WSP(bf16_t, WS_WGU0), DFF, DFF, DFF, DM, DM, 1}));
    RUN_JOB((TJob{INP(I_L0_UP), WSP(bf16_t, WS_WGU0), DFF, DFF, DFF, DM, DM, 2}));
    RUN_JOB((TJob{INP(I_L0_DOWN), WSP(bf16_t, WS_WDN0), DM, DM, DM, DFF, DFF, 0}));
    RUN_JOB((TJob{INP(I_L1_WIN), WSP(bf16_t, WS_WIN1), N_IN1, N_IN1, N_IN1P, DM, DM, 0}));
    RUN_JOB((TJob{INP(I_L1_WOUT), WSP(bf16_t, WS_WOUT1), DM, DM, DM, DM, DM, 0}));
    for (int e = 0; e < NEXP; ++e) {
        RUN_JOB((TJob{INP(I_L1_EGATE) + (size_t)e * DM * DFF, WSP(bf16_t, WS_WGU1) + (size_t)e * 2 * DFF * DM, DFF, DFF, DFF, DM, DM, 1}));
        RUN_JOB((TJob{INP(I_L1_EUP) + (size_t)e * DM * DFF, WSP(bf16_t, WS_WGU1) + (size_t)e * 2 * DFF * DM, DFF, DFF, DFF, DM, DM, 2}));
        RUN_JOB((TJob{INP(I_L1_EDOWN) + (size_t)e * DFF * DM, WSP(bf16_t, WS_WDN1) + (size_t)e * DM * DFF, DM, DM, DM, DFF, DFF, 0}));
    }
#undef RUN_JOB
    {   const float* xin = INP(I_X);
        for (int m = 4 * gw; m < T; m += 4 * NGW) {
            f32x4 v[4][4];
#pragma unroll
            for (int r = 0; r < 4; ++r)
#pragma unroll
                for (int j = 0; j < 4; ++j) v[r][j] = *((const f32x4*)(xin + (size_t)(m + r) * DM) + F.lane + 64 * j);
#pragma unroll
            for (int r = 0; r < 4; ++r)
#pragma unroll
                for (int j = 0; j < 4; ++j) { u32x2 w; w.x = cvt_pk_bf16(v[r][j][0], v[r][j][1]); w.y = cvt_pk_bf16(v[r][j][2], v[r][j][3]); *((u32x2*)(WSP(bf16_t, WS_XB) + (size_t)(m + r) * DM) + F.lane + 64 * j) = w; }
        }
    }
    for (int it = F.bid; it < 32; it += F.G) {
        const int which = it >> 4, sl = it & 15;
        if (F.tid < 256) {
            const float* pos = INP(which ? I_CV_POS : I_CK_POS) + sl * 128; const float* w1 = INP(which ? I_CV_W1 : I_CK_W1) + (size_t)sl * 128 * 256 + F.tid;
            float s = 0.f;
#pragma unroll 8
            for (int r = 0; r < 128; ++r) s += pos[r] * w1[(size_t)r * 256];
            WSP(float, WS_POSW)[(which * 16 + sl) * 256 + F.tid] = s;
        }
    }
}

__device__ __forceinline__ void p2b_compress_tail(Frame& F, const Args& A) {
    LAS float* hid = (LAS float*)(F.lds + F.wave * 1024);
    const int gw = F.bid * 8 + F.wave, NGW = F.G * 8;
    const float* H = WSP(float, WS_HCMP); const float* PW = WSP(float, WS_POSW);
    for (int it = gw; it < 2 * 16 * 256; it += NGW) {
        const int which = it >> 12, bg = (it >> 8) & 15, n = it & 255;
        bf16_t* dst = WSP(bf16_t, WS_KC) + ((size_t)(which * 16 + bg) * 256 + n) * 64;
        if (n == 255) { dst[F.lane] = 0; continue; }
        const size_t r0 = (size_t)(which * 4096 + bg * 256 + n) * 512;
        const f32x4 a = *(const f32x4*)(H + r0 + 4 * F.lane), b = *(const f32x4*)(H + r0 + 512 + 256 + 4 * F.lane);
        f32x4 pw = {0.f, 0.f, 0.f, 0.f};
#pragma unroll
        for (int s = 0; s < 16; ++s) pw += *(const f32x4*)(PW + (which * 16 + s) * 256 + 4 * F.lane);
        const f32x4 v = a + b + pw; f32x4 g;
#pragma unroll
        for (int i = 0; i < 4; ++i) { const float x = v[i], u = 0.7978845608028654f * (x + 0.044715f * x * x * x); const float th = 1.f - 2.f / (1.f + __expf(2.f * u)); g[i] = 0.5f * x * (1.f + th); }
        *(LAS f32x4*)(hid + 4 * F.lane) = g;
        asm volatile("s_waitcnt lgkmcnt(0)" ::: "memory");
        const float* w2 = INP(which ? I_CV_W2 : I_CK_W2) + F.lane; float acc = 0.f;
#pragma unroll 8
        for (int j = 0; j < 256; ++j) acc += hid[j] * w2[(size_t)j * 64];
        dst[F.lane] = (bf16_t)(cvt_pk_bf16(acc, 0.f) & 0xffffu);
        asm volatile("s_waitcnt lgkmcnt(0)" ::: "memory");
    }
}

__device__ __forceinline__ f32x4 ld_bf4(const bf16_t* p) { const u32x2 w = *(const u32x2*)p; return (f32x4){bf_lo(w.x), bf_hi(w.x), bf_lo(w.y), bf_hi(w.y)}; }
__device__ __forceinline__ void ln_row(const bf16_t* y, const float* g, const float* b, int lane, f32x4 (&v)[4]) {
    float s = 0.f;
#pragma unroll
    for (int j = 0; j < 4; ++j) { v[j] = ld_bf4(y + 4 * (lane + 64 * j)); s += (v[j][0] + v[j][1]) + (v[j][2] + v[j][3]); }
    const float mean = wave_sum(s) * (1.f / DM); float s2 = 0.f;
#pragma unroll
    for (int j = 0; j < 4; ++j) { v[j] = v[j] - mean; s2 += (v[j][0] * v[j][0] + v[j][1] * v[j][1]) + (v[j][2] * v[j][2] + v[j][3] * v[j][3]); }
    const float rstd = 1.f / sqrtf(wave_sum(s2) * (1.f / DM) + LN_EPS);
#pragma unroll
    for (int j = 0; j < 4; ++j) { const f32x4 gg = *((const f32x4*)g + lane + 64 * j), bb = *((const f32x4*)b + lane + 64 * j); v[j] = v[j] * rstd * gg + bb; }
}
__device__ __forceinline__ void ln_row2(const bf16_t* y0, const bf16_t* y1, const float* g, const float* b, int lane, f32x4 (&v)[4], f32x4 (&w)[4]) {
    float s = 0.f, t = 0.f;
#pragma unroll
    for (int j = 0; j < 4; ++j) { v[j] = ld_bf4(y0 + 4 * (lane + 64 * j)); w[j] = ld_bf4(y1 + 4 * (lane + 64 * j)); }
#pragma unroll
    for (int j = 0; j < 4; ++j) { s += (v[j][0] + v[j][1]) + (v[j][2] + v[j][3]); t += (w[j][0] + w[j][1]) + (w[j][2] + w[j][3]); }
#pragma unroll
    for (int o = 1; o < 64; o <<= 1) { s += __shfl_xor(s, o); t += __shfl_xor(t, o); }
    const float m0 = s * (1.f / DM), m1 = t * (1.f / DM); float s2 = 0.f, t2 = 0.f;
#pragma unroll
    for (int j = 0; j < 4; ++j) { v[j] = v[j] - m0; w[j] = w[j] - m1; s2 += (v[j][0] * v[j][0] + v[j][1] * v[j][1]) + (v[j][2] * v[j][2] + v[j][3] * v[j][3]); t2 += (w[j][0] * w[j][0] + w[j][1] * w[j][1]) + (w[j][2] * w[j][2] + w[j][3] * w[j][3]); }
#pragma unroll
    for (int o = 1; o < 64; o <<= 1) { s2 += __shfl_xor(s2, o); t2 += __shfl_xor(t2, o); }
    const float r0 = 1.f / sqrtf(s2 * (1.f / DM) + LN_EPS), r1 = 1.f / sqrtf(t2 * (1.f / DM) + LN_EPS);
#pragma unroll
    for (int j = 0; j < 4; ++j) { const f32x4 gg = *((const f32x4*)g + lane + 64 * j), bb = *((const f32x4*)b + lane + 64 * j); v[j] = v[j] * r0 * gg + bb; w[j] = w[j] * r1 * gg + bb; }
}
template <int N>
__device__ __forceinline__ void ln_rowsN(const bf16_t* y, const float* g, const float* b, int lane, f32x4 (&v)[N][4]) {
    float s[N], s2[N];
#pragma unroll
    for (int r = 0; r < N; ++r)
#pragma unroll
        for (int j = 0; j < 4; ++j) v[r][j] = ld_bf4(y + (size_t)r * DM + 4 * (lane + 64 * j));
#pragma unroll
    for (int r = 0; r < N; ++r) { s[r] = 0.f;
#pragma unroll
        for (int j = 0; j < 4; ++j) s[r] += (v[r][j][0] + v[r][j][1]) + (v[r][j][2] + v[r][j][3]); }
#pragma unroll
    for (int o = 1; o < 64; o <<= 1)
#pragma unroll
        for (int r = 0; r < N; ++r) s[r] += __shfl_xor(s[r], o);
#pragma unroll
    for (int r = 0; r < N; ++r) { const float m0 = s[r] * (1.f / DM); s2[r] = 0.f;
#pragma unroll
        for (int j = 0; j < 4; ++j) { v[r][j] = v[r][j] - m0; s2[r] += (v[r][j][0] * v[r][j][0] + v[r][j][1] * v[r][j][1]) + (v[r][j][2] * v[r][j][2] + v[r][j][3] * v[r][j][3]); } }
#pragma unroll
    for (int o = 1; o < 64; o <<= 1)
#pragma unroll
        for (int r = 0; r < N; ++r) s2[r] += __shfl_xor(s2[r], o);
#pragma unroll
    for (int j = 0; j < 4; ++j) { const f32x4 gg = *((const f32x4*)g + lane + 64 * j), bb = *((const f32x4*)b + lane + 64 * j);
#pragma unroll
        for (int r = 0; r < N; ++r) { const float rs = 1.f / sqrtf(s2[r] * (1.f / DM) + LN_EPS); v[r][j] = v[r][j] * rs * gg + bb; } }
}
__device__ __forceinline__ void p_layernorm(Frame& F, const bf16_t* y, const float* g, const float* b, bf16_t* ob) {
    const int gw = F.bid * 8 + F.wave, NGW = F.G * 8;
    for (int m = 4 * gw; m < T; m += 4 * NGW) {
        f32x4 v[4][4]; ln_rowsN<4>(y + (size_t)m * DM, g, b, F.lane, v);
#pragma unroll
        for (int r = 0; r < 4; ++r) { u32x2* o = (u32x2*)(ob + (size_t)(m + r) * DM) + F.lane;
#pragma unroll
            for (int j = 0; j < 4; ++j) { u32x2 q; q.x = cvt_pk_bf16(v[r][j][0], v[r][j][1]); q.y = cvt_pk_bf16(v[r][j][2], v[r][j][3]); o[64 * j] = q; } }
    }
}
struct TokInfo { int p0, p1; float g0, g1; };
__device__ __forceinline__ void p12_ln_router(Frame& F, const Args& A) {
    LAS float* rt = (LAS float*)F.lds;
    LAS int* cnt = (LAS int*)(F.lds + 32768);
    { const float* rg = INP(I_L1_ROUTER); for (int i = F.tid; i < DM * NEXP; i += 512) rt[(i & 7) * DM + (i >> 3)] = rg[i]; }
    if (F.tid < 8) cnt[F.tid] = 0;
    for (int i = F.bid * 512 + F.tid; i < 264 * 256; i += F.G * 512) WSP(int, WS_ROWTOK)[i] = 0;
    __syncthreads();
    const bf16_t* y = WSP(bf16_t, WS_Y3); bf16_t* xb = (bf16_t*)F.out + 1024; TokInfo* ti = WSP(TokInfo, WS_TOKINFO);
    for (int blk = F.bid; blk < T / 128; blk += F.G) {
        for (int i = 0; i < 16; i += 2) {
            const int m = blk * 128 + F.wave * 16 + i;
            f32x4 v[2][4]; ln_row2(y + (size_t)m * DM, y + (size_t)(m + 1) * DM, INP(I_L1_LN1G), INP(I_L1_LN1B), F.lane, v[0], v[1]);
            float lg[2][8];
#pragma unroll
            for (int q = 0; q < 2; ++q) {
                u32x2* o = (u32x2*)(xb + (size_t)(m + q) * 2048) + F.lane;
#pragma unroll
                for (int j = 0; j < 4; ++j) { u32x2 w; w.x = cvt_pk_bf16(v[q][j][0], v[q][j][1]); w.y = cvt_pk_bf16(v[q][j][2], v[q][j][3]); o[64 * j] = w; }
            }
#pragma unroll
            for (int e = 0; e < 8; ++e) { float s0 = 0.f, s1 = 0.f;
#pragma unroll
                for (int j = 0; j < 4; ++j) { const f32x4 r = *(const LAS f32x4*)(rt + e * DM + 4 * (F.lane + 64 * j));
                    s0 += (v[0][j][0] * r[0] + v[0][j][1] * r[1]) + (v[0][j][2] * r[2] + v[0][j][3] * r[3]); s1 += (v[1][j][0] * r[0] + v[1][j][1] * r[1]) + (v[1][j][2] * r[2] + v[1][j][3] * r[3]); }
                lg[0][e] = s0; lg[1][e] = s1; }
            {
                const bool b0 = F.lane & 1, b1 = F.lane & 2, b2 = F.lane & 4;
                float r4[2][4], r2[2][2], r1[2];
#pragma unroll
                for (int q = 0; q < 2; ++q)
#pragma unroll
                    for (int k = 0; k < 4; ++k) { const float send = b0 ? lg[q][k] : lg[q][k + 4], keep = b0 ? lg[q][k + 4] : lg[q][k]; r4[q][k] = keep + __shfl_xor(send, 1); }
#pragma unroll
                for (int q = 0; q < 2; ++q)
#pragma unroll
                    for (int k = 0; k < 2; ++k) { const float send = b1 ? r4[q][k] : r4[q][k + 2], keep = b1 ? r4[q][k + 2] : r4[q][k]; r2[q][k] = keep + __shfl_xor(send, 2); }
#pragma unroll
                for (int q = 0; q < 2; ++q) { const float send = b2 ? r2[q][0] : r2[q][1], keep = b2 ? r2[q][1] : r2[q][0]; r1[q] = keep + __shfl_xor(send, 4); }
#pragma unroll
                for (int o_ = 8; o_ < 64; o_ <<= 1) { r1[0] += __shfl_xor(r1[0], o_); r1[1] += __shfl_xor(r1[1], o_); }
#pragma unroll
                for (int q = 0; q < 2; ++q) { const int ri = __float_as_int(r1[q]);
                    lg[q][0] = __int_as_float(__builtin_amdgcn_readlane(ri, 0)); lg[q][1] = __int_as_float(__builtin_amdgcn_readlane(ri, 4)); lg[q][2] = __int_as_float(__builtin_amdgcn_readlane(ri, 2)); lg[q][3] = __int_as_float(__builtin_amdgcn_readlane(ri, 6));
                    lg[q][4] = __int_as_float(__builtin_amdgcn_readlane(ri, 1)); lg[q][5] = __int_as_float(__builtin_amdgcn_readlane(ri, 5)); lg[q][6] = __int_as_float(__builtin_amdgcn_readlane(ri, 3)); lg[q][7] = __int_as_float(__builtin_amdgcn_readlane(ri, 7)); }
            }
#pragma unroll
            for (int q = 0; q < 2; ++q) {
                int e0 = 0; float v0 = lg[q][0];
#pragma unroll
                for (int e = 1; e < 8; ++e) if (lg[q][e] > v0) { v0 = lg[q][e]; e0 = e; }
                int e1 = -1; float v1 = -3.0e38f;
#pragma unroll
                for (int e = 0; e < 8; ++e) if (e != e0 && lg[q][e] > v1) { v1 = lg[q][e]; e1 = e; }
                const float g1 = 1.f / (1.f + __expf(v0 - v1)), g0 = 1.f - g1;
                if (F.lane == 0) { ti[m + q] = TokInfo{e0, e1, g0, g1}; atomicAdd((int*)&cnt[e0], 1); atomicAdd((int*)&cnt[e1], 1); }
            }
        }
        __syncthreads();
        if (F.tid < 8) { WSP(int, WS_MOECNT)[blk * 8 + F.tid] = cnt[F.tid]; cnt[F.tid] = 0; }
        __syncthreads();
    }
}
__device__ __forceinline__ void p13_moe_dispatch(Frame& F, const Args& A) {
    LAS int* call = (LAS int*)F.lds;
    LAS int* base = (LAS int*)(F.lds + 8192);
    LAS int* segs = (LAS int*)(F.lds + 8192 + 64);
    LAS int* pos = (LAS int*)(F.lds + 8192 + 128);
    for (int i = F.tid; i < 2048; i += 512) call[i] = WSP(int, WS_MOECNT)[i];
    __syncthreads();
    TokInfo* ti = WSP(TokInfo, WS_TOKINFO);
    for (int blk = F.bid; blk < T / 128; blk += F.G) {
        if (F.tid < 8) { int tot = 0, pre = 0; for (int w = 0; w < 256; ++w) { const int c = call[w * 8 + F.tid]; if (w < blk) pre += c; tot += c; } base[F.tid] = pre; segs[F.tid] = (tot + 255) & ~255; }
        __syncthreads();
        if (F.tid == 0) { int s = 0; for (int e = 0; e < 8; ++e) { const int p = segs[e]; segs[e] = s; base[e] += s; s += p; } segs[8] = s;
            if (blk == 0) { int* meta = WSP(int, WS_MOEMETA); meta[0] = s / 256; for (int e = 0; e <= 8; ++e) meta[1 + e] = segs[e] / 256; } }
        __syncthreads();
        if (F.wave == 0) {
            int run[8];
#pragma unroll
            for (int e = 0; e < 8; ++e) run[e] = base[e];
            for (int st = 0; st < 4; ++st) {
                const int tk = (st >> 1) * 64 + F.lane, slot = st & 1; const TokInfo t = ti[blk * 128 + tk]; const int me = slot ? t.p1 : t.p0; int p = 0;
#pragma unroll
                for (int e = 0; e < 8; ++e) { const unsigned long long mk = __ballot(me == e); if (me == e) p = run[e] + __popcll(mk & ((1ull << F.lane) - 1ull)); run[e] += __popcll(mk); }
                pos[tk * 2 + slot] = p;
            }
        }
        __syncthreads();
        if (F.tid < 128) { TokInfo t = ti[blk * 128 + F.tid]; t.p0 = pos[F.tid * 2]; t.p1 = pos[F.tid * 2 + 1]; ti[blk * 128 + F.tid] = t; }
        if (F.tid < 256) WSP(int, WS_ROWTOK)[pos[F.tid]] = blk * 128 + (F.tid >> 1);
        __syncthreads();
    }
}
__device__ __forceinline__ int moe_tile_table(Frame& F, LAS int* tile_e) {
    const int* meta = WSP(int, WS_MOEMETA); const int NT = meta[0];
    for (int t = F.tid; t < MOE_MAX_TILES; t += 512) { int e = 0;
#pragma unroll
        for (int k = 1; k < 8; ++k) e += (t >= meta[1 + k]) ? 1 : 0;
        tile_e[t] = e; }
    __syncthreads();
    return NT;
}
__device__ __forceinline__ void p_final(Frame& F, const Args& A) {
    const int gw = F.bid * 8 + F.wave, NGW = F.G * 8; const TokInfo* ti = WSP(TokInfo, WS_TOKINFO); const bf16_t* O = WSP(bf16_t, WS_XG);
    const float* lg = INP(I_L1_LN2G); const float* lb = INP(I_L1_LN2B);
    for (int m = 4 * gw; m < T; m += 4 * NGW) {
        f32x4 v[4][4]; float s[4], s2[4];
#pragma unroll
        for (int q = 0; q < 4; ++q) {
            const TokInfo t = ti[m + q]; const bf16_t* xs = (const bf16_t*)F.out + (size_t)(m + q) * 2048 + 1024;
            const u32x2* o0 = (const u32x2*)(O + (size_t)t.p0 * DM) + F.lane; const u32x2* o1 = (const u32x2*)(O + (size_t)t.p1 * DM) + F.lane;
            s[q] = 0.f;
#pragma unroll
            for (int j = 0; j < 4; ++j) { const f32x4 x = ld_bf4(xs + 4 * (F.lane + 64 * j)); const u32x2 a = o0[64 * j], b = o1[64 * j];
                const f32x4 fa = {bf_lo(a.x), bf_hi(a.x), bf_lo(a.y), bf_hi(a.y)}, fb = {bf_lo(b.x), bf_hi(b.x), bf_lo(b.y), bf_hi(b.y)};
                v[q][j] = x * ALPHA + (fa * t.g0 + fb * t.g1); s[q] += (v[q][j][0] + v[q][j][1]) + (v[q][j][2] + v[q][j][3]); }
        }
#pragma unroll
        for (int o = 1; o < 64; o <<= 1) { s[0] += __shfl_xor(s[0], o); s[1] += __shfl_xor(s[1], o); s[2] += __shfl_xor(s[2], o); s[3] += __shfl_xor(s[3], o); }
#pragma unroll
        for (int q = 0; q < 4; ++q) { const float mean = s[q] * (1.f / DM); s2[q] = 0.f;
#pragma unroll
            for (int j = 0; j < 4; ++j) { v[q][j] = v[q][j] - mean; s2[q] += (v[q][j][0] * v[q][j][0] + v[q][j][1] * v[q][j][1]) + (v[q][j][2] * v[q][j][2] + v[q][j][3] * v[q][j][3]); } }
#pragma unroll
        for (int o = 1; o < 64; o <<= 1) { s2[0] += __shfl_xor(s2[0], o); s2[1] += __shfl_xor(s2[1], o); s2[2] += __shfl_xor(s2[2], o); s2[3] += __shfl_xor(s2[3], o); }
#pragma unroll
        for (int q = 0; q < 4; ++q) { const float rstd = 1.f / sqrtf(s2[q] * (1.f / DM) + LN_EPS); f32x4* yr = (f32x4*)(F.out + (size_t)(m + q) * DM) + F.lane;
#pragma unroll
            for (int j = 0; j < 4; ++j) { const f32x4 gg = *((const f32x4*)lg + F.lane + 64 * j), bb = *((const f32x4*)lb + F.lane + 64 * j); yr[64 * j] = v[q][j] * rstd * gg + bb; } }
    }
}
namespace att {
constexpr int KROW = 144;
constexpr int TILE_B = 64 * KROW;
constexpr int L_K = 0, L_V = 2 * TILE_B, L_OV = 4 * TILE_B;
constexpr int L_LUT = 6 * TILE_B;
constexpr int L_IMP = L_LUT + 2048;
constexpr int L_SELM = L_IMP + 4 * 64 * 65 * 4;
constexpr int L_END = L_SELM + 512;
static_assert(L_END <= RING_BYTES, "attention LDS map");
constexpr float NEG_INF = -__builtin_huge_valf();
constexpr int L_LUT2 = LDS_EXTRA_OFF, LUT2_N = 704, LUT2_K = 639;
constexpr int L_LUT3 = LDS_EXTRA_OFF + 4 * LUT2_N * 4, LUT3_N = 320, LUT3_K = 255;
static_assert(L_LUT3 + 4 * LUT3_N * 4 <= LDS_MISC_OFF, "attention LUT map");
constexpr float RESC_THR = 8.f;

__device__ __forceinline__ s16x4 vtr(const LAS char* p) { return __builtin_bit_cast(s16x4, __builtin_amdgcn_ds_read_tr16_b64_v4i16((LAS s16x4*)p)); }

template <int MODE, int NDB>
__device__ __forceinline__ void attn_tile(const LAS char* Kt, const LAS char* Vt, const LAS char* OVt, const bf16x8 (&qf)[4], f32x16 (&o)[NDB], float& m, float& l,
                                          int tq, int key0, int W, bool lanesel, const LAS float* lut, int lane) {
    const int r32 = lane & 31, h = lane >> 5;
    f32x16 s0, s1;
#pragma unroll
    for (int r = 0; r < 16; ++r) { s0[r] = 0.f; s1[r] = 0.f; }
#pragma unroll
    for (int ks = 0; ks < 4; ++ks) {
        const bf16x8 k0 = *(const LAS bf16x8*)(Kt + r32 * KROW + (16 * ks + 8 * h) * 2);
        const bf16x8 k1 = *(const LAS bf16x8*)(Kt + (32 + r32) * KROW + (16 * ks + 8 * h) * 2);
        s0 = __builtin_amdgcn_mfma_f32_32x32x16_bf16(k0, qf[ks], s0, 0, 0, 0);
        s1 = __builtin_amdgcn_mfma_f32_32x32x16_bf16(k1, qf[ks], s1, 0, 0, 0);
    }
    float mx = NEG_INF;
    asm volatile("" ::: "memory");
#pragma unroll
    for (int kb = 0; kb < 2; ++kb) {
#pragma unroll
        for (int r = 0; r < 16; ++r) {
            const int key = key0 + 32 * kb + (r & 3) + 8 * (r >> 2) + 4 * h;
            const int dist = (MODE == 2) ? (tq - 16 * key - 31) : (tq - key);
            const int idx = dist < 0 ? 0 : (dist > 113 ? 113 : dist);
            bool valid;
            if (MODE == 0) valid = (unsigned)dist < (unsigned)W;
            else if (MODE == 1) valid = lanesel && dist >= 0;
            else valid = dist >= 0 && key < 255;
            float v = (kb ? s1[r] : s0[r]) + lut[idx];
            v = valid ? v : NEG_INF;
            if (kb) s1[r] = v; else s0[r] = v;
            mx = fmaxf(mx, v);
        }
        asm volatile("" ::: "memory");
    }
    mx = swap_max(mx);
    const float mnew = fmaxf(m, mx), alpha = __builtin_amdgcn_exp2f(m - mnew);
    float rs = 0.f;
#pragma unroll
    for (int r = 0; r < 16; ++r) { s0[r] = __builtin_amdgcn_exp2f(s0[r] - mnew); s1[r] = __builtin_amdgcn_exp2f(s1[r] - mnew); rs += s0[r] + s1[r]; }
    rs = swap_sum(rs);
    l = l * alpha + rs; m = mnew;
#pragma unroll
    for (int db = 0; db < NDB; ++db)
#pragma unroll
        for (int r = 0; r < 16; ++r) o[db][r] *= alpha;
    const int q4 = (lane & 15) >> 2, p4 = lane & 3, g2 = (lane >> 4) & 1;
#pragma unroll
    for (int kb = 0; kb < 2; ++kb)
#pragma unroll
        for (int s = 0; s < 2; ++s) {
            u32x4 pw;
            if (kb == 0) { pw.x = cvt_pk_bf16(s0[8 * s + 0], s0[8 * s + 1]); pw.y = cvt_pk_bf16(s0[8 * s + 2], s0[8 * s + 3]); pw.z = cvt_pk_bf16(s0[8 * s + 4], s0[8 * s + 5]); pw.w = cvt_pk_bf16(s0[8 * s + 6], s0[8 * s + 7]); }
            else { pw.x = cvt_pk_bf16(s1[8 * s + 0], s1[8 * s + 1]); pw.y = cvt_pk_bf16(s1[8 * s + 2], s1[8 * s + 3]); pw.z = cvt_pk_bf16(s1[8 * s + 4], s1[8 * s + 5]); pw.w = cvt_pk_bf16(s1[8 * s + 6], s1[8 * s + 7]); }
            const bf16x8 pb = __builtin_bit_cast(bf16x8, pw);
            const int rowoff = (32 * kb + 16 * s + 4 * h + q4) * KROW;
#pragma unroll
            for (int db = 0; db < NDB; ++db) {
                const LAS char* base = (db < 2 ? Vt : OVt) + rowoff + (32 * (db & 1) + 16 * g2 + 4 * p4) * 2;
                const s16x4 lo = vtr(base), hi = vtr(base + 8 * KROW);
                const bf16x8 vf = {lo[0], lo[1], lo[2], lo[3], hi[0], hi[1], hi[2], hi[3]};
                o[db] = __builtin_amdgcn_mfma_f32_32x32x16_bf16(vf, pb, o[db], 0, 0, 0);
            }
            asm volatile("" ::: "memory");
        }
}


template <int MODE>
__device__ __forceinline__ void attn_tile_fast(const LAS char* Kt, const LAS char* Vt, const bf16x8 (&qf)[4], f32x16 (&o)[2], float& m, float& l,
                                               bool lanesel, bool use_lut, const LAS float* lutp, float cfar, int lane) {
    const int r32 = lane & 31, h = lane >> 5;
    float ci = use_lut ? -m : (cfar - m);
    if (MODE == 1) ci = lanesel ? ci : NEG_INF;
    f32x16 s0, s1;
#pragma unroll
    for (int r = 0; r < 16; ++r) { s0[r] = ci; s1[r] = ci; }
#pragma unroll
    for (int ks = 0; ks < 4; ++ks) {
        const bf16x8 k0 = *(const LAS bf16x8*)(Kt + r32 * KROW + (16 * ks + 8 * h) * 2);
        const bf16x8 k1 = *(const LAS bf16x8*)(Kt + (32 + r32) * KROW + (16 * ks + 8 * h) * 2);
        s0 = __builtin_amdgcn_mfma_f32_32x32x16_bf16(k0, qf[ks], s0, 0, 0, 0);
        s1 = __builtin_amdgcn_mfma_f32_32x32x16_bf16(k1, qf[ks], s1, 0, 0, 0);
    }
    if (use_lut) {
#pragma unroll
        for (int r = 0; r < 16; ++r) { s0[r] += lutp[(r & 3) + 8 * (r >> 2)]; s1[r] += lutp[32 + (r & 3) + 8 * (r >> 2)]; }
    }
    float mx = fmaxf(s0[0], s1[0]);
#pragma unroll
    for (int r = 1; r < 16; ++r) mx = fmaxf(fmaxf(mx, s0[r]), s1[r]);
    mx = swap_max(mx);
    if (__any(mx > RESC_THR)) {
        const float dl = fmaxf(mx, 0.f), f = __builtin_amdgcn_exp2f(-dl);
        m += dl; l *= f;
#pragma unroll
        for (int r = 0; r < 16; ++r) { s0[r] -= dl; s1[r] -= dl; o[0][r] *= f; o[1][r] *= f; }
    }
    const int q4 = (lane & 15) >> 2, p4 = lane & 3, g2 = (lane >> 4) & 1;
    float rs = 0.f;
#pragma unroll
    for (int kb = 0; kb < 2; ++kb)
#pragma unroll
        for (int s = 0; s < 2; ++s) {
            float e[8];
#pragma unroll
            for (int i = 0; i < 8; ++i) { e[i] = __builtin_amdgcn_exp2f(kb ? s1[8 * s + i] : s0[8 * s + i]); rs += e[i]; }
            u32x4 pw; pw.x = cvt_pk_bf16(e[0], e[1]); pw.y = cvt_pk_bf16(e[2], e[3]); pw.z = cvt_pk_bf16(e[4], e[5]); pw.w = cvt_pk_bf16(e[6], e[7]);
            const bf16x8 pb = __builtin_bit_cast(bf16x8, pw);
            const int rowoff = (32 * kb + 16 * s + 4 * h + q4) * KROW;
#pragma unroll
            for (int db = 0; db < 2; ++db) {
                const LAS char* base = Vt + rowoff + (32 * db + 16 * g2 + 4 * p4) * 2;
                const s16x4 lo = vtr(base), hi = vtr(base + 8 * KROW);
                const bf16x8 vf = {lo[0], lo[1], lo[2], lo[3], hi[0], hi[1], hi[2], hi[3]};
                o[db] = __builtin_amdgcn_mfma_f32_32x32x16_bf16(vf, pb, o[db], 0, 0, 0);
            }
            __builtin_amdgcn_sched_barrier(0);
        }
    l += swap_sum(rs);
}

template <int MODE, int NDB>
__device__ __forceinline__ void run_branch(LAS unsigned char* lds, const bf16_t* Kg, const bf16_t* Vg, int pitch, unsigned long long tiles, const bf16x8 (&qf)[4], f32x16 (&o)[NDB], float& m, float& l,
                                           int tq, int W, unsigned long long selm, const LAS float* lut, int tid, int lane) {
    const int lrow = tid >> 3, lch = tid & 7;
    if (tiles == 0ull) return;
    int j = __builtin_ctzll(tiles); tiles &= tiles - 1ull;
    auto gen_ov = [&](int tile, int b) {
        const int n = 64 * tile + lrow; unsigned short e[8];
#pragma unroll
        for (int i = 0; i < 8; ++i) { const int d = n - 4 * (8 * lch + i); e[i] = (n < 255 && d >= -1 && d <= 3) ? ((d == -1 || d == 3) ? (unsigned short)0x3f00 : (unsigned short)0x3f80) : (unsigned short)0; }
        u32x4 w; w.x = e[0] | ((unsigned)e[1] << 16); w.y = e[2] | ((unsigned)e[3] << 16); w.z = e[4] | ((unsigned)e[5] << 16); w.w = e[6] | ((unsigned)e[7] << 16);
        *(LAS u32x4*)(lds + L_OV + b * TILE_B + lrow * KROW + lch * 16) = w;
    };
#define ATT_LD(K_, V_, t_) do { K_ = *(const u32x4*)(Kg + (size_t)((t_) * 64 + lrow) * pitch + lch * 8); V_ = *(const u32x4*)(Vg + (size_t)((t_) * 64 + lrow) * pitch + lch * 8); } while (0)
#define ATT_ST(K_, V_, b_) do { *(LAS u32x4*)(lds + L_K + (b_) * TILE_B + lrow * KROW + lch * 16) = K_; *(LAS u32x4*)(lds + L_V + (b_) * TILE_B + lrow * KROW + lch * 16) = V_; } while (0)
    u32x4 kra, vra, krb, vrb;
    ATT_LD(kra, vra, j);
    int jn = -1;
    if (tiles != 0ull) { jn = __builtin_ctzll(tiles); tiles &= tiles - 1ull; }
    ATT_LD(krb, vrb, (jn < 0 ? j : jn));
    ATT_ST(kra, vra, 0);
    if (MODE == 2) gen_ov(j, 0);
    __syncthreads();
    for (;;) {
        int jnn = -1;
        if (tiles != 0ull) { jnn = __builtin_ctzll(tiles); tiles &= tiles - 1ull; }
        ATT_LD(kra, vra, (jnn < 0 ? j : jnn));
        {
        const bool lanesel = (MODE == 1) ? ((selm >> j) & 1ull) != 0ull : true;
        if constexpr (MODE == 2) {
            attn_tile<MODE, NDB>((const LAS char*)(lds + L_K + 0 * TILE_B), (const LAS char*)(lds + L_V + 0 * TILE_B), (const LAS char*)(lds + L_OV + 0 * TILE_B), qf, o, m, l, tq, 64 * j, W, lanesel, lut, lane);
        } else if (MODE != 1 || __ballot(lanesel) != 0ull) {
            const int tq0w = tq - (lane & 31);
            const int dmin = tq0w - 64 * j - 63, dmax = tq0w + 31 - 64 * j;
            const bool use_lut = (MODE == 0) ? !(dmin >= 113 && dmax < W) : !(dmin >= 113);
            const int r_ = (tid >> 6) & 3;
            const LAS float* lutp = (MODE == 0) ? (const LAS float*)(lds + L_LUT2) + r_ * LUT2_N + (64 * j + 4 * (lane >> 5) - tq + LUT2_K)
                                               : (const LAS float*)(lds + L_LUT3) + r_ * LUT3_N + (64 * j + 4 * (lane >> 5) - tq + LUT3_K);
            attn_tile_fast<MODE>((const LAS char*)(lds + L_K + 0 * TILE_B), (const LAS char*)(lds + L_V + 0 * TILE_B), qf, o, m, l, lanesel, use_lut, lutp, lut[113], lane);
        }
        }
        if (jn < 0) break;
        ATT_ST(krb, vrb, 1);
        if (MODE == 2) gen_ov(jn, 1);
        __syncthreads();
        int jn3 = -1;
        if (tiles != 0ull) { jn3 = __builtin_ctzll(tiles); tiles &= tiles - 1ull; }
        ATT_LD(krb, vrb, (jn3 < 0 ? jn : jn3));
        {
        const bool lanesel = (MODE == 1) ? ((selm >> jn) & 1ull) != 0ull : true;
        if constexpr (MODE == 2) {
            attn_tile<MODE, NDB>((const LAS char*)(lds + L_K + 1 * TILE_B), (const LAS char*)(lds + L_V + 1 * TILE_B), (const LAS char*)(lds + L_OV + 1 * TILE_B), qf, o, m, l, tq, 64 * jn, W, lanesel, lut, lane);
        } else if (MODE != 1 || __ballot(lanesel) != 0ull) {
            const int tq0w = tq - (lane & 31);
            const int dmin = tq0w - 64 * jn - 63, dmax = tq0w + 31 - 64 * jn;
            const bool use_lut = (MODE == 0) ? !(dmin >= 113 && dmax < W) : !(dmin >= 113);
            const int r_ = (tid >> 6) & 3;
            const LAS float* lutp = (MODE == 0) ? (const LAS float*)(lds + L_LUT2) + r_ * LUT2_N + (64 * jn + 4 * (lane >> 5) - tq + LUT2_K)
                                               : (const LAS float*)(lds + L_LUT3) + r_ * LUT3_N + (64 * jn + 4 * (lane >> 5) - tq + LUT3_K);
            attn_tile_fast<MODE>((const LAS char*)(lds + L_K + 1 * TILE_B), (const LAS char*)(lds + L_V + 1 * TILE_B), qf, o, m, l, lanesel, use_lut, lutp, lut[113], lane);
        }
        }
        if (jnn < 0) break;
        ATT_ST(kra, vra, 0);
        if (MODE == 2) gen_ov(jnn, 0);
        __syncthreads();
        j = jnn; jn = jn3;
    }
#undef ATT_LD
#undef ATT_ST
    __syncthreads();
}

__device__ __forceinline__ unsigned long long tile_range(int lo, int hi) {
    const unsigned long long a = (hi >= 63) ? ~0ull : ((1ull << (hi + 1)) - 1ull);
    return a & ~((1ull << lo) - 1ull);
}

__device__ __forceinline__ void build_lut(LAS unsigned char* lds, const float* relb, int head0, int tid) {
    LAS float* lut = (LAS float*)(lds + L_LUT);
    const int r = tid >> 7, d = tid & 127;
    lut[r * 128 + d] = relb[t5_bucket(d) * 16 + head0 + r] * LOG2E;
}

__device__ __forceinline__ void build_lut23(LAS unsigned char* lds, int W, bool want3, int tid) {
    const LAS float* lut = (const LAS float*)(lds + L_LUT);
    LAS float* l2 = (LAS float*)(lds + L_LUT2); LAS float* l3 = (LAS float*)(lds + L_LUT3);
    for (int i = tid; i < 4 * LUT2_N; i += 512) { const int r = i / LUT2_N, jj = i - r * LUT2_N, d = LUT2_K - jj; l2[i] = (d < 0 || d >= W) ? NEG_INF : lut[r * 128 + (d > 113 ? 113 : d)]; }
    if (want3) for (int i = tid; i < 4 * LUT3_N; i += 512) { const int r = i / LUT3_N, jj = i - r * LUT3_N, d = LUT3_K - jj; l3[i] = (d < 0) ? NEG_INF : lut[r * 128 + (d > 113 ? 113 : d)]; }
}

__device__ __forceinline__ void unit_swa(Frame& F, const Args& A, int b, int g, int qt) {
    LAS unsigned char* lds = F.lds;
    const int lane = F.lane, wave = F.wave, r = wave & 3, th = wave >> 2, r32 = lane & 31, h = lane >> 5;
    const int head = g * 4 + r, tq = qt * 64 + 32 * th + r32;
    build_lut(lds, INP(I_RELB), g * 4, F.tid);
    const bf16_t* qrow = WSP(bf16_t, WS_QA) + ((size_t)(b * SEQ + tq)) * 512 + head * 64;
    bf16x8 qf[4];
#pragma unroll
    for (int ks = 0; ks < 4; ++ks) qf[ks] = *(const bf16x8*)(qrow + 16 * ks + 8 * h);
    f32x16 o[2];
#pragma unroll
    for (int db = 0; db < 2; ++db)
#pragma unroll
        for (int i = 0; i < 16; ++i) o[db][i] = 0.f;
    float m = INP(I_L0_SINKS)[head] * LOG2E, l = 1.f;
    __syncthreads();
    build_lut23(lds, 128, false, F.tid);
    __syncthreads();
    const LAS float* lut = (const LAS float*)(lds + L_LUT) + r * 128;
    const bf16_t* Kg = WSP(bf16_t, WS_KA) + (size_t)b * SEQ * 128 + g * 64; const bf16_t* Vg = WSP(bf16_t, WS_VA) + (size_t)b * SEQ * 128 + g * 64;
    run_branch<0, 2>(lds, Kg, Vg, 128, tile_range(qt - 2 < 0 ? 0 : qt - 2, qt), qf, o, m, l, tq, 128, 0ull, lut, F.tid, lane);
    const float inv = 1.f / l;
    bf16_t* orow = WSP(bf16_t, WS_MIX0) + ((size_t)(b * SEQ + tq)) * DM + head * 64;
#pragma unroll
    for (int db = 0; db < 2; ++db)
#pragma unroll
        for (int rg = 0; rg < 4; ++rg) { u32x2 w; w.x = cvt_pk_bf16(o[db][4 * rg] * inv, o[db][4 * rg + 1] * inv); w.y = cvt_pk_bf16(o[db][4 * rg + 2] * inv, o[db][4 * rg + 3] * inv);
            *(u32x2*)(orow + 32 * db + 8 * rg + 4 * h) = w; }
}

__device__ __forceinline__ void unit_nsa(Frame& F, const Args& A, int b, int g, int qt) {
    LAS unsigned char* lds = F.lds;
    const int lane = F.lane, wave = F.wave, r = wave & 3, th = wave >> 2, r32 = lane & 31, h = lane >> 5;
    const int hb = g * 4 + r, tq = qt * 64 + 32 * th + r32, tok = 32 * th + r32, bg = b * 2 + g;
    build_lut(lds, INP(I_RELB), 8 + g * 4, F.tid);
    const bf16_t* qrow = WSP(bf16_t, WS_QB) + ((size_t)(b * SEQ + tq)) * 512 + hb * 64;
    bf16x8 qf[4];
#pragma unroll
    for (int ks = 0; ks < 4; ++ks) qf[ks] = *(const bf16x8*)(qrow + 16 * ks + 8 * h);
    const float* gp = WSP(float, WS_GATES) + ((size_t)(b * SEQ + tq)) * 24 + hb;
    const float g_cmp = gp[0], g_slc = gp[8], g_win = gp[16];
    f32x16 acc[2];
    __syncthreads();
    build_lut23(lds, 512, true, F.tid);
    __syncthreads();
    const LAS float* lut = (const LAS float*)(lds + L_LUT) + r * 128;
    LAS float* imp = (LAS float*)(lds + L_IMP);
    LAS unsigned long long* selm = (LAS unsigned long long*)(lds + L_SELM);
    {
        f32x16 o[4];
#pragma unroll
        for (int db = 0; db < 4; ++db)
#pragma unroll
            for (int i = 0; i < 16; ++i) o[db][i] = 0.f;
        float m = -1e30f, l = 0.f;
        const int tmax = qt * 64 + 63;
        unsigned long long tiles = 0ull;
        if (tmax >= 31) { const int nmax = (tmax - 31) >> 4; tiles = tile_range(0, (nmax > 254 ? 254 : nmax) >> 6); }
        const bf16_t* Kc = WSP(bf16_t, WS_KC) + (size_t)bg * 256 * 64; const bf16_t* Vc = WSP(bf16_t, WS_KC) + (size_t)(16 + bg) * 256 * 64;
        run_branch<2, 4>(lds, Kc, Vc, 64, tiles, qf, o, m, l, tq, 0, 0ull, lut, F.tid, lane);
        const float inv = l > 0.f ? 1.f / l : 0.f;
#pragma unroll
        for (int db = 0; db < 2; ++db)
#pragma unroll
            for (int i = 0; i < 16; ++i) acc[db][i] = o[db][i] * (inv * g_cmp);
        if (qt >= 16) {
#pragma unroll
            for (int db = 0; db < 2; ++db)
#pragma unroll
                for (int i = 0; i < 16; ++i) { const int jj = 32 * db + (i & 3) + 8 * (i >> 2) + 4 * h; imp[(r * 64 + jj) * 65 + tok] = o[2 + db][i] * inv; }
        }
    }
    __syncthreads();
    {
        const unsigned long long adm = tile_range(0, qt);
        for (int i = 0; i < 8; ++i) {
            const int tk = wave * 8 + i; unsigned long long mk = adm;
            if (qt >= 16) {
                int j = lane; asm volatile("" : "+v"(j));
                const float iv = ((imp[(0 * 64 + j) * 65 + tk] + imp[(1 * 64 + j) * 65 + tk]) + imp[(2 * 64 + j) * 65 + tk]) + imp[(3 * 64 + j) * 65 + tk];
                const bool forced = (j == 0) || (j == qt) || (j == qt - 1);
                const float sc = forced ? 1e30f : (j <= qt ? iv : -1e30f);
                int rank = 0;
#pragma unroll
                for (int k = 0; k < 64; ++k) { const float sk = __int_as_float(__builtin_amdgcn_readlane(__float_as_int(sc), k)); rank += (sk > sc || (sk == sc && k < j)) ? 1 : 0; }
                mk = __ballot(rank < 16) & adm;
            }
            if (lane == 0) selm[tk] = mk;
        }
    }
    __syncthreads();
    const unsigned long long myselm = selm[tok];
    unsigned long long uni = selm[lane];
#pragma unroll
    for (int o_ = 1; o_ < 64; o_ <<= 1) { const unsigned lo = __shfl_xor((unsigned)uni, o_), hi = __shfl_xor((unsigned)(uni >> 32), o_); uni |= ((unsigned long long)hi << 32) | lo; }
    uni = ((unsigned long long)(unsigned)__builtin_amdgcn_readfirstlane((unsigned)(uni >> 32)) << 32) | (unsigned)__builtin_amdgcn_readfirstlane((unsigned)uni);
    {
        f32x16 o[2];
#pragma unroll
        for (int db = 0; db < 2; ++db)
#pragma unroll
            for (int i = 0; i < 16; ++i) o[db][i] = 0.f;
        float m = 0.f, l = 0.f;
        const bf16_t* Kg = WSP(bf16_t, WS_KSLC) + (size_t)b * SEQ * 128 + g * 64; const bf16_t* Vg = WSP(bf16_t, WS_VSLC) + (size_t)b * SEQ * 128 + g * 64;
        run_branch<1, 2>(lds, Kg, Vg, 128, uni, qf, o, m, l, tq, 0, myselm, lut, F.tid, lane);
        const float inv = g_slc / l;
#pragma unroll
        for (int db = 0; db < 2; ++db)
#pragma unroll
            for (int i = 0; i < 16; ++i) acc[db][i] += o[db][i] * inv;
    }
    {
        f32x16 o[2];
#pragma unroll
        for (int db = 0; db < 2; ++db)
#pragma unroll
            for (int i = 0; i < 16; ++i) o[db][i] = 0.f;
        float m = 0.f, l = 0.f;
        const bf16_t* Kg = WSP(bf16_t, WS_KWIN) + (size_t)b * SEQ * 128 + g * 64; const bf16_t* Vg = WSP(bf16_t, WS_VWIN) + (size_t)b * SEQ * 128 + g * 64;
        run_branch<0, 2>(lds, Kg, Vg, 128, tile_range(qt - 8 < 0 ? 0 : qt - 8, qt), qf, o, m, l, tq, 512, 0ull, lut, F.tid, lane);
        const float inv = g_win / l;
#pragma unroll
        for (int db = 0; db < 2; ++db)
#pragma unroll
            for (int i = 0; i < 16; ++i) acc[db][i] += o[db][i] * inv;
    }
    bf16_t* orow = WSP(bf16_t, WS_MIX0) + ((size_t)(b * SEQ + tq)) * DM + 512 + hb * 64;
#pragma unroll
    for (int db = 0; db < 2; ++db)
#pragma unroll
        for (int rg = 0; rg < 4; ++rg) { u32x2 w; w.x = cvt_pk_bf16(acc[db][4 * rg], acc[db][4 * rg + 1]); w.y = cvt_pk_bf16(acc[db][4 * rg + 2], acc[db][4 * rg + 3]);
            *(u32x2*)(orow + 32 * db + 8 * rg + 4 * h) = w; }
}

#ifndef PROBE_NSA_REP
#define PROBE_NSA_REP 1
#endif
#ifndef PROBE_SWA_REP
#define PROBE_SWA_REP 1
#endif
__device__ __forceinline__ void attn0_phase(Frame& F, const Args& A) {
    const int vcu = (F.G % 8 == 0) ? (F.bid % 8) * (F.G / 8) + F.bid / 8 : F.bid;
    for (int rep = 0; rep < PROBE_NSA_REP; ++rep)
    for (int U = vcu; U < 1024; U += F.G) {
        const int c = U & 255, i = U >> 8, bg = c >> 4, s = c & 15;
        const int qt = (i == 0) ? 63 - s : (i == 1) ? 32 + s : (i == 2) ? 31 - s : s;
        unit_nsa(F, A, bg >> 1, bg & 1, qt);
        __syncthreads();
    }
    for (int rep = 0; rep < PROBE_SWA_REP; ++rep)
    for (int U = vcu; U < 1024; U += F.G) {
        const int c = U & 255, i = U >> 8, bg = c >> 4, s = c & 15;
        unit_swa(F, A, bg >> 1, bg & 1, 16 * i + s);
        __syncthreads();
    }
}
}
namespace dsa {
constexpr int L_SC = 0;
constexpr int L_LIST = LDS_EXTRA_OFF;
constexpr int L_LUTD = L_LIST + 4096;
constexpr int L_WT = L_LUTD + 114 * 16 * 4;
static_assert(L_WT + 256 <= LDS_MISC_OFF, "dsa LDS map");
constexpr int VROW = 160;
constexpr float NEG_INF = -__builtin_huge_valf();
typedef float f32x4_t __attribute__((ext_vector_type(4)));


__device__ __forceinline__ int count_ge8(unsigned a0, unsigned a1, unsigned a2, unsigned a3, unsigned a4, unsigned a5, unsigned a6, unsigned a7, unsigned cand) {
    int c, t; unsigned long long m0, m1, m2, m3, m4, m5, m6, m7;
    asm volatile(
        "v_cmp_ge_u32_e64 %[m0], %[a0], %[cd]\n\tv_cmp_ge_u32_e64 %[m1], %[a1], %[cd]\n\tv_cmp_ge_u32_e64 %[m2], %[a2], %[cd]\n\tv_cmp_ge_u32_e64 %[m3], %[a3], %[cd]\n\t"
        "v_cmp_ge_u32_e64 %[m4], %[a4], %[cd]\n\tv_cmp_ge_u32_e64 %[m5], %[a5], %[cd]\n\tv_cmp_ge_u32_e64 %[m6], %[a6], %[cd]\n\tv_cmp_ge_u32_e64 %[m7], %[a7], %[cd]\n\t"
        "s_bcnt1_i32_b64 %[c], %[m0]\n\ts_bcnt1_i32_b64 %[t], %[m1]\n\ts_add_i32 %[c], %[c], %[t]\n\ts_bcnt1_i32_b64 %[t], %[m2]\n\ts_add_i32 %[c], %[c], %[t]\n\t"
        "s_bcnt1_i32_b64 %[t], %[m3]\n\ts_add_i32 %[c], %[c], %[t]\n\ts_bcnt1_i32_b64 %[t], %[m4]\n\ts_add_i32 %[c], %[c], %[t]\n\ts_bcnt1_i32_b64 %[t], %[m5]\n\ts_add_i32 %[c], %[c], %[t]\n\t"
        "s_bcnt1_i32_b64 %[t], %[m6]\n\ts_add_i32 %[c], %[c], %[t]\n\ts_bcnt1_i32_b64 %[t], %[m7]\n\ts_add_i32 %[c], %[c], %[t]"
        : [c] "=&s"(c), [t] "=&s"(t), [m0] "=&s"(m0), [m1] "=&s"(m1), [m2] "=&s"(m2), [m3] "=&s"(m3), [m4] "=&s"(m4), [m5] "=&s"(m5), [m6] "=&s"(m6), [m7] "=&s"(m7)
        : [a0] "v"(a0), [a1] "v"(a1), [a2] "v"(a2), [a3] "v"(a3), [a4] "v"(a4), [a5] "v"(a5), [a6] "v"(a6), [a7] "v"(a7), [cd] "s"(cand)
        : "scc");
    return c;
}

__device__ __forceinline__ void unit_dsa(Frame& F, const Args& A, int b, int t0) {
    LAS unsigned char* lds = F.lds;
    const int tid = F.tid, lane = F.lane, wave = F.wave, r32 = lane & 31, h = lane >> 5;
    const size_t tb = (size_t)b * SEQ;
    LAS float* sc = (LAS float*)(lds + L_SC);
    LAS unsigned short* list = (LAS unsigned short*)(lds + L_LIST) + wave * 256;
    const LAS float* lutd = (const LAS float*)(lds + L_LUTD);
    LAS float* wt = (LAS float*)(lds + L_WT);
    if (tid < 64) wt[tid] = WSP(float, WS_WI)[(tb + t0) * 8 + tid];
    __syncthreads();
#ifndef PROBE_DSA_A
#define PROBE_DSA_A 1
#endif
#ifndef PROBE_DSA_B
#define PROBE_DSA_B 1
#endif
#ifndef PROBE_DSA_C
#define PROBE_DSA_C 1
#endif
    for (int repa = 0; repa < PROBE_DSA_A; ++repa)
    if (t0 + 8 > 256) {
        const int nkb = ((t0 + 8 + 63) >> 6) << 1;
        const int hh_r = (r32 >> 2) & 1, reg_r = (r32 & 3) | ((r32 >> 3) << 2), qi4 = 2 * hh_r + (reg_r >> 3), hd = reg_r & 7;
        bf16x8 qaf[2][2]; float wv[2][16];
#pragma unroll
        for (int rb = 0; rb < 2; ++rb) {
            const bf16_t* qp = WSP(bf16_t, WS_QI) + (tb + t0 + 4 * rb + qi4) * 256 + hd * 32 + 8 * h;
            qaf[rb][0] = *(const bf16x8*)qp; qaf[rb][1] = *(const bf16x8*)(qp + 16);
#pragma unroll
            for (int rg = 0; rg < 16; ++rg) wv[rb][rg] = wt[(4 * rb + 2 * h + (rg >> 3)) * 8 + (rg & 7)];
        }
        int kb = wave;
        bf16x8 bk0 = {0, 0, 0, 0, 0, 0, 0, 0}, bk1 = {0, 0, 0, 0, 0, 0, 0, 0};
        if (kb < nkb) { const bf16_t* kp = WSP(bf16_t, WS_KI) + (tb + 32 * kb + r32) * 32 + 8 * h; bk0 = *(const bf16x8*)kp; bk1 = *(const bf16x8*)(kp + 16); }
        while (kb < nkb) {
            const int kn = kb + 8; bf16x8 nb0 = bk0, nb1 = bk1;
            if (kn < nkb) { const bf16_t* kp = WSP(bf16_t, WS_KI) + (tb + 32 * kn + r32) * 32 + 8 * h; nb0 = *(const bf16x8*)kp; nb1 = *(const bf16x8*)(kp + 16); }
            const int key = 32 * kb + r32;
#pragma unroll
            for (int rb = 0; rb < 2; ++rb) {
                f32x16 c;
#pragma unroll
                for (int i = 0; i < 16; ++i) c[i] = 0.f;
                c = __builtin_amdgcn_mfma_f32_32x32x16_bf16(qaf[rb][0], bk0, c, 0, 0, 0);
                c = __builtin_amdgcn_mfma_f32_32x32x16_bf16(qaf[rb][1], bk1, c, 0, 0, 0);
                float sA = 0.f, sB = 0.f;
#pragma unroll
                for (int i = 0; i < 8; ++i) { sA += wv[rb][i] * fmaxf(c[i], 0.f); sB += wv[rb][8 + i] * fmaxf(c[8 + i], 0.f); }
                const int qA = 4 * rb + 2 * h;
                sc[qA * 4096 + key] = (key <= t0 + qA) ? sA : NEG_INF;
                sc[(qA + 1) * 4096 + key] = (key <= t0 + qA + 1) ? sB : NEG_INF;
            }
            bk0 = nb0; bk1 = nb1; kb = kn;
        }
    }
    __syncthreads();
    const int t = t0 + wave, n = t + 1;
    int cnt;
    for (int repb = 0; repb < PROBE_DSA_B; ++repb)
    if (n <= 256) {
#pragma unroll
        for (int i = 0; i < 4; ++i) { const int k = lane + 64 * i; list[k] = (unsigned short)(k < n ? k : 0); }
        cnt = n;
    } else {
        const int nreg = (n + 63) >> 6, ngrp = (nreg + 7) >> 3;
        LAS float* my = sc + wave * 4096;
        float f[64];
#pragma unroll
        for (int g8 = 0; g8 < 8; ++g8) {
#pragma unroll
            for (int k = 0; k < 8; ++k) f[g8 * 8 + k] = NEG_INF;
            if (g8 < ngrp) {
#pragma unroll
                for (int k = 0; k < 8; ++k) if (g8 * 8 + k < nreg) f[g8 * 8 + k] = my[64 * (g8 * 8 + k) + lane];
            }
        }
        float ta = NEG_INF, tb_ = NEG_INF, tc = NEG_INF, td = NEG_INF;
#pragma unroll
        for (int g8 = 0; g8 < 8; ++g8) if (g8 < ngrp) {
#pragma unroll
            for (int k = 0; k < 8; ++k) { const float x = f[g8 * 8 + k]; td = __builtin_amdgcn_fmed3f(tc, td, x); tc = __builtin_amdgcn_fmed3f(tb_, tc, x); tb_ = __builtin_amdgcn_fmed3f(ta, tb_, x); ta = fmaxf(ta, x); }
        }
        float L = td;
#pragma unroll
        for (int o_ = 1; o_ < 64; o_ <<= 1) L = fminf(L, __shfl_xor(L, o_));
        LAS unsigned* cval = (LAS unsigned*)my; LAS unsigned short* ckey = (LAS unsigned short*)(my + 1024);
        const unsigned long long ltmask = (1ull << lane) - 1ull;
        int ns = 0;
#pragma unroll
        for (int g8 = 0; g8 < 8; ++g8) if (g8 < ngrp) {
#pragma unroll
            for (int k = 0; k < 8; ++k) { const int i = g8 * 8 + k; const bool keep = f[i] >= L; const unsigned long long mk = __ballot(keep); const int pos = ns + __popcll(mk & ltmask);
                if (keep && pos < 1024) { const unsigned bits = __float_as_uint(f[i]); cval[pos] = bits ^ ((bits >> 31) ? 0xffffffffu : 0x80000000u); ckey[pos] = (unsigned short)(64 * i + lane); }
                ns += __popcll(mk); }
        }
        if (ns <= 1024) {
            unsigned w[16];
#pragma unroll
            for (int j = 0; j < 16; ++j) w[j] = (64 * j + lane < ns) ? cval[64 * j + lane] : 0u;
            const bool two = ns > 512;
            float Mx = ta;
#pragma unroll
            for (int o_ = 1; o_ < 64; o_ <<= 1) Mx = fmaxf(Mx, __shfl_xor(Mx, o_));
            const unsigned Lb = __float_as_uint(L), Mb = __float_as_uint(Mx);
            const unsigned Lk = __builtin_amdgcn_readfirstlane(Lb ^ ((Lb >> 31) ? 0xffffffffu : 0x80000000u)), Mk = __builtin_amdgcn_readfirstlane(Mb ^ ((Mb >> 31) ? 0xffffffffu : 0x80000000u));
            const int hb = (Lk == Mk) ? -1 : 31 - __builtin_clz(Lk ^ Mk);
            unsigned tau = (hb >= 31) ? 0u : (hb < 0 ? Mk : (Mk & ~((2u << hb) - 1u)));
            for (int bit = hb; bit >= 0; --bit) {
                const unsigned cand = tau | (1u << bit);
                int c = count_ge8(w[0], w[1], w[2], w[3], w[4], w[5], w[6], w[7], cand);
                if (two) c += count_ge8(w[8], w[9], w[10], w[11], w[12], w[13], w[14], w[15], cand);
                if (c >= 256) { tau = cand; if (c == 256) break; }
            }
            int cgt = count_ge8(w[0], w[1], w[2], w[3], w[4], w[5], w[6], w[7], tau + 1u);
            if (two) cgt += count_ge8(w[8], w[9], w[10], w[11], w[12], w[13], w[14], w[15], tau + 1u);
            const int need = 256 - cgt; int base = 0, eqseen = 0;
#pragma unroll
            for (int j = 0; j < 16; ++j) if (64 * j < ns) {
                const bool gt = w[j] > tau, eq = w[j] == tau;
                const unsigned long long meq = __ballot(eq);
                const bool sel = gt || (eq && (eqseen + __popcll(meq & ltmask)) < need);
                const unsigned long long msel = __ballot(sel);
                if (sel) list[base + __popcll(msel & ltmask)] = ckey[64 * j + lane];
                base += __popcll(msel); eqseen += __popcll(meq);
            }
        } else {
#pragma unroll
            for (int i = 0; i < 64; ++i) { const unsigned bits = __float_as_uint(f[i]); f[i] = __uint_as_float((i < nreg) ? (bits ^ ((bits >> 31) ? 0xffffffffu : 0x80000000u)) : 0u); }
#define u_(i) __float_as_uint(f[i])
            unsigned tau = 0u;
            for (int bit = 31; bit >= 0; --bit) {
                const unsigned cand = tau | (1u << bit); int c = 0;
#pragma unroll
                for (int g8 = 0; g8 < 8; ++g8) if (g8 < ngrp)
                    c += count_ge8(u_(g8 * 8 + 0), u_(g8 * 8 + 1), u_(g8 * 8 + 2), u_(g8 * 8 + 3), u_(g8 * 8 + 4), u_(g8 * 8 + 5), u_(g8 * 8 + 6), u_(g8 * 8 + 7), cand);
                if (c >= 256) { tau = cand; if (c == 256) break; }
            }
            int cgt = 0;
#pragma unroll
            for (int g8 = 0; g8 < 8; ++g8) if (g8 < ngrp)
                cgt += count_ge8(u_(g8 * 8 + 0), u_(g8 * 8 + 1), u_(g8 * 8 + 2), u_(g8 * 8 + 3), u_(g8 * 8 + 4), u_(g8 * 8 + 5), u_(g8 * 8 + 6), u_(g8 * 8 + 7), tau + 1u);
            const int need = 256 - cgt; int base = 0, eqseen = 0;
#pragma unroll
            for (int g8 = 0; g8 < 8; ++g8) if (g8 < ngrp) {
#pragma unroll
                for (int k = 0; k < 8; ++k) { const int i = g8 * 8 + k;
                    const bool gt = u_(i) > tau, eq = u_(i) == tau;
                    const unsigned long long meq = __ballot(eq);
                    const bool sel = gt || (eq && (eqseen + __popcll(meq & ltmask)) < need);
                    const unsigned long long msel = __ballot(sel);
                    if (sel) list[base + __popcll(msel & ltmask)] = (unsigned short)(64 * i + lane);
                    base += __popcll(msel); eqseen += __popcll(meq); } }
        }
#undef u_
        cnt = 256;
    }
    __syncthreads();
    for (int repc = 0; repc < PROBE_DSA_C; ++repc)
    {
        const int head = lane & 15, g4 = lane >> 4, q4 = (lane & 15) >> 2, p4 = lane & 3;
        const bf16_t* qp = WSP(bf16_t, WS_Q1) + (tb + t) * 1024 + head * 64 + 8 * g4;
        const bf16x8 qf0 = *(const bf16x8*)qp, qf1 = *(const bf16x8*)(qp + 32);
        const bf16_t* K1 = WSP(bf16_t, WS_K1) + tb * 64; const bf16_t* V1 = WSP(bf16_t, WS_V1) + tb * 64;
        f32x4_t sA[8], sB[8];
        float mx = NEG_INF;
        const float cfar = lutd[113 * 16 + head];
        LAS unsigned char* kst = lds + wave * (96 * VROW);
        {
            u32x4 kr[8][4];
#pragma unroll
            for (int c = 0; c < 8; ++c) {
#pragma unroll
                for (int i = 0; i < 4; ++i) { const unsigned key = list[32 * c + 8 * i + (lane >> 3)]; kr[c][i] = *(const u32x4*)((const char*)K1 + (key * 128u + (unsigned)(lane & 7) * 16u)); }
            }
#pragma unroll
            for (int c = 0; c < 8; ++c) {
#pragma unroll
                for (int i = 0; i < 4; ++i) *(LAS u32x4*)(kst + (8 * i + (lane >> 3)) * VROW + (lane & 7) * 16) = kr[c][i];
                const LAS unsigned char* ka = kst + (lane & 15) * VROW + 16 * g4;
                const bf16x8 kA0 = *(const LAS bf16x8*)ka, kA1 = *(const LAS bf16x8*)(ka + 64), kB0 = *(const LAS bf16x8*)(ka + 16 * VROW), kB1 = *(const LAS bf16x8*)(ka + 16 * VROW + 64);
                const int kmax = __builtin_amdgcn_readfirstlane((int)list[32 * c + 31]);
                if (cnt == 256 && t - kmax >= 113) {
                    f32x4_t a = {cfar, cfar, cfar, cfar}, bb = {cfar, cfar, cfar, cfar};
                    a = __builtin_amdgcn_mfma_f32_16x16x32_bf16(kA0, qf0, a, 0, 0, 0); a = __builtin_amdgcn_mfma_f32_16x16x32_bf16(kA1, qf1, a, 0, 0, 0);
                    bb = __builtin_amdgcn_mfma_f32_16x16x32_bf16(kB0, qf0, bb, 0, 0, 0); bb = __builtin_amdgcn_mfma_f32_16x16x32_bf16(kB1, qf1, bb, 0, 0, 0);
                    sA[c] = a; sB[c] = bb;
                    mx = fmaxf(mx, fmaxf(fmaxf(fmaxf(a[0], a[1]), fmaxf(a[2], a[3])), fmaxf(fmaxf(bb[0], bb[1]), fmaxf(bb[2], bb[3]))));
                } else {
                    f32x4_t a = {0.f, 0.f, 0.f, 0.f}, bb = {0.f, 0.f, 0.f, 0.f};
                    a = __builtin_amdgcn_mfma_f32_16x16x32_bf16(kA0, qf0, a, 0, 0, 0); a = __builtin_amdgcn_mfma_f32_16x16x32_bf16(kA1, qf1, a, 0, 0, 0);
                    bb = __builtin_amdgcn_mfma_f32_16x16x32_bf16(kB0, qf0, bb, 0, 0, 0); bb = __builtin_amdgcn_mfma_f32_16x16x32_bf16(kB1, qf1, bb, 0, 0, 0);
                    const u32x2 ia = *(const LAS u32x2*)(list + 32 * c + 4 * g4), ib = *(const LAS u32x2*)(list + 32 * c + 16 + 4 * g4);
#pragma unroll
                    for (int i = 0; i < 4; ++i) {
                        const int keyA = (int)(((i < 2 ? ia.x : ia.y) >> (16 * (i & 1))) & 0xffffu), keyB = (int)(((i < 2 ? ib.x : ib.y) >> (16 * (i & 1))) & 0xffffu);
                        const int dA = t - keyA, dB = t - keyB;
                        const float bA = lutd[(dA > 113 ? 113 : (dA < 0 ? 0 : dA)) * 16 + head], bB = lutd[(dB > 113 ? 113 : (dB < 0 ? 0 : dB)) * 16 + head];
                        const int slotA = 32 * c + 4 * g4 + i, slotB = slotA + 16;
                        sA[c][i] = slotA < cnt ? a[i] + bA : NEG_INF; sB[c][i] = slotB < cnt ? bb[i] + bB : NEG_INF;
                        mx = fmaxf(mx, fmaxf(sA[c][i], sB[c][i]));
                    }
                }
            }
        }
        asm volatile("" ::: "memory");
        u32x4 vr[4][4];
#pragma unroll
        for (int c = 0; c < 4; ++c) {
#pragma unroll
            for (int i = 0; i < 4; ++i) { const unsigned key = list[32 * c + 8 * i + (lane >> 3)]; vr[c][i] = *(const u32x4*)((const char*)V1 + (key * 128u + (unsigned)(lane & 7) * 16u)); }
        }
        mx = fmaxf(mx, __shfl_xor(mx, 16)); mx = fmaxf(mx, __shfl_xor(mx, 32));
        float l = 0.f;
#pragma unroll
        for (int c = 0; c < 8; ++c)
#pragma unroll
            for (int i = 0; i < 4; ++i) { sA[c][i] = __builtin_amdgcn_exp2f(sA[c][i] - mx); sB[c][i] = __builtin_amdgcn_exp2f(sB[c][i] - mx); l += sA[c][i] + sB[c][i]; }
        l += __shfl_xor(l, 16); l += __shfl_xor(l, 32);
        f32x4_t o[4];
#pragma unroll
        for (int d = 0; d < 4; ++d) o[d] = (f32x4_t){0.f, 0.f, 0.f, 0.f};
#pragma unroll
        for (int c = 0; c < 8; ++c) {
            {
                LAS unsigned char* vst = kst + (32 + 32 * (c & 1)) * VROW;
#pragma unroll
                for (int i = 0; i < 4; ++i) *(LAS u32x4*)(vst + (8 * i + (lane >> 3)) * VROW + (lane & 7) * 16) = vr[c & 3][i];
                if (c + 4 < 8) {
#pragma unroll
                    for (int i = 0; i < 4; ++i) { const unsigned key = list[32 * (c + 4) + 8 * i + (lane >> 3)]; vr[c & 3][i] = *(const u32x4*)((const char*)V1 + (key * 128u + (unsigned)(lane & 7) * 16u)); }
                }
                u32x4 pw; pw.x = cvt_pk_bf16(sA[c][0], sA[c][1]); pw.y = cvt_pk_bf16(sA[c][2], sA[c][3]); pw.z = cvt_pk_bf16(sB[c][0], sB[c][1]); pw.w = cvt_pk_bf16(sB[c][2], sB[c][3]);
                const bf16x8 pb = __builtin_bit_cast(bf16x8, pw);
#pragma unroll
                for (int d = 0; d < 4; ++d) {
                    const LAS char* base = (const LAS char*)(vst + (4 * g4 + q4) * VROW + (16 * d + 4 * p4) * 2);
                    const s16x4 lo = att::vtr(base), hi = att::vtr(base + 16 * VROW);
                    const bf16x8 vf = {lo[0], lo[1], lo[2], lo[3], hi[0], hi[1], hi[2], hi[3]};
                    o[d] = __builtin_amdgcn_mfma_f32_16x16x32_bf16(vf, pb, o[d], 0, 0, 0);
                }
            }
        }
        const float inv = 1.f / l;
        bf16_t* orow = WSP(bf16_t, WS_MIX1) + (tb + t) * 1024 + head * 64 + 4 * g4;
#pragma unroll
        for (int d = 0; d < 4; ++d) { u32x2 w; w.x = cvt_pk_bf16(o[d][0] * inv, o[d][1] * inv); w.y = cvt_pk_bf16(o[d][2] * inv, o[d][3] * inv); *(u32x2*)(orow + 16 * d) = w; }
    }
    __syncthreads();
}

__device__ __forceinline__ void dsa_phase(Frame& F, const Args& A) {
    LAS float* lutd = (LAS float*)(F.lds + L_LUTD);
    for (int i = F.tid; i < 114 * 16; i += 512) lutd[i] = INP(I_RELB)[t5_bucket(i >> 4) * 16 + (i & 15)] * LOG2E;
    __syncthreads();
#ifndef PROBE_DSA_REP
#define PROBE_DSA_REP 1
#endif
    const bool xa = (F.G == 256);
    const int nround = xa ? 16 : (4096 + F.G - 1) / F.G;
    for (int ii = 0; ii < nround * PROBE_DSA_REP; ++ii) {
        const int i = ii % nround; int b, tb; bool ok = true;
        if (xa) { const int r = F.bid >> 3; b = F.bid & 7; tb = 511 - (i * 32 + ((i & 1) ? 31 - r : r)); }
        else { const int cc = (i & 1) ? (F.G - 1 - F.bid) : F.bid; const int I = i * F.G + cc; ok = I < 4096; b = I & 7; tb = 511 - (I >> 3); }
        if (ok) unit_dsa(F, A, b, 8 * tb);
    }
}
}
constexpr int NPHASE = 19;
__global__ void __launch_bounds__(512, 2) mk_fwd(Args args) {
    extern __shared__ __attribute__((aligned(16))) unsigned char lds_raw[];
    Frame F;
    F.lds = (LAS unsigned char*)lds_raw;
    F.tid = threadIdx.x; F.lane = F.tid & 63; F.wave = __builtin_amdgcn_readfirstlane(F.tid >> 6);
    F.G = gridDim.x; F.bid = blockIdx.x; F.ws = args.ws; F.out = args.out;
    volatile LAS unsigned* MISC = (volatile LAS unsigned*)(F.lds + LDS_MISC_OFF);
    if (F.tid < 64) MISC[F.tid] = 0u;
    __syncthreads();
    if (F.tid < 28) *(LAS unsigned long long*)(F.lds + LDS_PTR_OFF + 8 * F.tid) = (unsigned long long)args.in[F.tid];
    __syncthreads();
    const int lo = args.ph_lo, hi = args.ph_hi;
    const bool use_bar = (hi - lo) > 1;
    XcdBarrier bar; bar.bar = (unsigned*)(F.ws + WS_CTL) + CW_BAR; bar.x = 0; bar.st = nullptr;
    if (use_bar) bar = xcd_barrier_post((unsigned*)(F.ws + WS_CTL) + CW_BAR, MISC);
#ifdef PH_ONLY
#define IN(k) ((k) == PH_ONLY && lo <= (k) && (k) < hi)
#else
#define IN(k) (lo <= (k) && (k) < hi)
#endif
#ifndef PROBE_PH
#define PROBE_PH -1
#endif
#define REP(k) for (int rep_ = 0; rep_ < ((k) == PROBE_PH ? 2 : 1); ++rep_)
#define SEAM(k) do { if (IN(k) && IN((k) + 1)) xcd_barrier(bar); } while (0)
    LAS unsigned char* ring = F.lds;
    const Args& A = args;

    if (IN(0)) REP(0) { p0_prologue(F, A); } SEAM(0);
    if (IN(1)) REP(1) {
        pg8::Gemm g{WSP(bf16_t, WS_XB), WSP(bf16_t, WS_WIN0), DM}; pg8::Proj0OrderA S{F.G, F.bid};
        pg8::EpiProj0 E{F.ws};
        pg8::gemm_phase<pg8::EpiProj0, pg8::Proj0OrderA, true, true>(ring, g, S, E);
    } SEAM(1);
    if (IN(2)) REP(2) {
        pg8::Gemm g{WSP(bf16_t, WS_XB), WSP(bf16_t, WS_WIN0), DM}; pg8::Proj0OrderB S; S.so.init(T / 256, 7, F.G, F.bid); S.G = F.G; S.c = F.bid;
        pg8::EpiProj0 E{F.ws};
        pg8::gemm_phase<pg8::EpiProj0, pg8::Proj0OrderB, true, true>(ring, g, S, E);
    } SEAM(2);
    if (IN(3)) REP(3) { p2b_compress_tail(F, A); } SEAM(3);
    if (IN(4)) REP(4) { att::attn0_phase(F, A); } SEAM(4);
    if (IN(5)) REP(5) {
        pg8::Gemm g{WSP(bf16_t, WS_MIX0), WSP(bf16_t, WS_WOUT0), DM}; pg8::StaticOrder S; S.init(T / 256, DM / 256, F.G, F.bid);
        pg8::EpiRes E{INP(I_X), nullptr, (bf16_t*)F.out};
        pg8::gemm_phase<pg8::EpiRes, pg8::StaticOrder, true, true>(ring, g, S, E);
    } SEAM(5);
    if (IN(6)) REP(6) { p_layernorm(F, (const bf16_t*)F.out, INP(I_L0_LN1G), INP(I_L0_LN1B), WSP(bf16_t, WS_X1B)); } SEAM(6);
    if (IN(7)) REP(7) {
        pg8::Gemm g{WSP(bf16_t, WS_X1B), WSP(bf16_t, WS_WGU0), DM}; pg8::StaticOrder S; S.init(T / 256, 2 * DFF / 256, F.G, F.bid);
        pg8::EpiSwiglu E{WSP(bf16_t, WS_H0), 0};
        pg8::gemm_phase<pg8::EpiSwiglu, pg8::StaticOrder, true, true>(ring, g, S, E);
    } SEAM(7);
    if (IN(8)) REP(8) {
        pg8::Gemm g{WSP(bf16_t, WS_H0), WSP(bf16_t, WS_WDN0), DFF}; pg8::StaticOrder S; S.init(T / 256, DM / 256, F.G, F.bid);
        pg8::EpiRes E{nullptr, WSP(bf16_t, WS_X1B), (bf16_t*)F.out};
        pg8::gemm_phase<pg8::EpiRes, pg8::StaticOrder, true, true>(ring, g, S, E);
    } SEAM(8);
    if (IN(9)) REP(9) { p_layernorm(F, (const bf16_t*)F.out, INP(I_L0_LN2G), INP(I_L0_LN2B), WSP(bf16_t, WS_X2B)); } SEAM(9);
    if (IN(10)) REP(10) {
        pg8::Gemm g{WSP(bf16_t, WS_X2B), WSP(bf16_t, WS_WIN1), DM}; pg8::StaticOrder S; S.init(T / 256, N_IN1P / 256, F.G, F.bid);
        pg8::EpiProj1 E{F.ws};
        pg8::gemm_phase<pg8::EpiProj1, pg8::StaticOrder, true, true>(ring, g, S, E);
    } SEAM(10);
    if (IN(11)) REP(11) { dsa::dsa_phase(F, A); } SEAM(11);
    if (IN(12)) REP(12) {
        pg8::Gemm g{WSP(bf16_t, WS_MIX1), WSP(bf16_t, WS_WOUT1), DM}; pg8::StaticOrder S; S.init(T / 256, DM / 256, F.G, F.bid);
        pg8::EpiRes E{nullptr, WSP(bf16_t, WS_X2B), WSP(bf16_t, WS_Y3)};
        pg8::gemm_phase<pg8::EpiRes, pg8::StaticOrder, true, true>(ring, g, S, E);
    } SEAM(12);
    if (IN(13)) REP(13) { p12_ln_router(F, A); } SEAM(13);
    if (IN(14)) REP(14) { p13_moe_dispatch(F, A); } SEAM(14);
#define MOE_PASS(pidx, ph1, ph2) \
    if (IN(ph1)) REP(ph1) { LAS int* tile_e = (LAS int*)(F.lds + LDS_EXTRA_OFF); const int NT = moe_tile_table(F, tile_e); const int t0_ = (pidx) * MOE_PASS_TILES; int nM_ = NT - t0_; if ((pidx) == 0 && nM_ > MOE_PASS_TILES) nM_ = MOE_PASS_TILES; \
        if (nM_ > 0) { pg8::Gemm g{(const bf16_t*)F.out + 1024, WSP(bf16_t, WS_WGU1), DM}; pg8::MoeOrder S; S.gpitch = 2048;     S.so.init(nM_, 2 * DFF / 256, F.G, F.bid); S.tile0 = t0_; S.nN = 2 * DFF / 256; S.a_local = 0; S.tile_e = tile_e; S.rowlist = WSP(int, WS_ROWTOK); \
            pg8::EpiSwiglu E{WSP(bf16_t, WS_H1), t0_}; pg8::gemm_phase<pg8::EpiSwiglu, pg8::MoeOrder, true, true, true>(ring, g, S, E); } } SEAM(ph1); \
    if (IN(ph2)) REP(ph2) { LAS int* tile_e = (LAS int*)(F.lds + LDS_EXTRA_OFF); const int NT = moe_tile_table(F, tile_e); const int t0_ = (pidx) * MOE_PASS_TILES; int nM_ = NT - t0_; if ((pidx) == 0 && nM_ > MOE_PASS_TILES) nM_ = MOE_PASS_TILES; \
        if (nM_ > 0) { pg8::Gemm g{WSP(bf16_t, WS_H1), WSP(bf16_t, WS_WDN1), DFF}; pg8::MoeOrder S; S.so.init(nM_, DM / 256, F.G, F.bid); S.tile0 = t0_; S.nN = DM / 256; S.a_local = 1; S.tile_e = tile_e; S.rowlist = nullptr; S.gpitch = 0; \
            pg8::EpiBf16 E{WSP(bf16_t, WS_XG)}; pg8::gemm_phase<pg8::EpiBf16, pg8::MoeOrder, true, true>(ring, g, S, E); } } SEAM(ph2);
    MOE_PASS(0, 15, 16)
    MOE_PASS(1, 17, 18)
#undef MOE_PASS
    if (IN(19)) REP(19) { p_final(F, A); }
#undef IN
#undef SEAM
}

extern "C" void kernel_launch(void* const* d_in, const int* in_sizes, int n_in, void* d_out, int out_size, void* d_ws, size_t ws_size, hipStream_t stream) {
    static int grid = 0;
    if (grid == 0) {
        if (n_in != 28 || in_sizes[0] != T * DM || out_size != T * DM || ws_size < WS_END) {
            fprintf(stderr, "kernel_launch: unexpected problem (n_in %d, in0 %d, out %d, ws %zu); nothing launched\n", n_in, n_in > 0 ? in_sizes[0] : -1, out_size, ws_size); grid = -1; return; }
        int dev = 0, cus = 0, per_cu = 0;
        if (hipGetDevice(&dev) != hipSuccess || hipDeviceGetAttribute(&cus, hipDeviceAttributeMultiprocessorCount, dev) != hipSuccess) { grid = -1; return; }
        if (hipFuncSetAttribute((const void*)mk_fwd, hipFuncAttributeMaxDynamicSharedMemorySize, LDS_BYTES) != hipSuccess) { fprintf(stderr, "kernel_launch: hipFuncSetAttribute failed\n"); grid = -1; return; }
        if (hipOccupancyMaxActiveBlocksPerMultiprocessor(&per_cu, (const void*)mk_fwd, 512, LDS_BYTES) != hipSuccess || per_cu < 1) { fprintf(stderr, "kernel_launch: occupancy query says %d blocks per CU\n", per_cu); }
        (void)hipGetLastError();
        grid = cus;
    }
    if (grid < 0) return;
    (void)hipMemsetAsync((char*)d_ws + WS_CTL, 0, CTL_ZERO_BYTES, stream);
    Args a{};
    for (int i = 0; i < 28; ++i) a.in[i] = (const float*)d_in[i];
    a.out = (float*)d_out; a.ws = (unsigned char*)d_ws;
    constexpr int NPH = 20;
#if MK_N_LAUNCHES == 1
    a.ph_lo = 0; a.ph_hi = NPH;
    hipLaunchKernelGGL(mk_fwd, dim3(grid), dim3(512), LDS_BYTES, stream, a);
#else
    for (int p = 0; p < NPH; ++p) { a.ph_lo = p; a.ph_hi = p + 1; hipLaunchKernelGGL(mk_fwd, dim3(grid), dim3(512), LDS_BYTES, stream, a); }
#endif
}
```

```cpp
#include <hip/hip_runtime.h>
#include <cstdio>
#include <cstdint>

#ifndef MK_N_LAUNCHES
#define MK_N_LAUNCHES 1
#endif

#define LAS __attribute__((address_space(3)))
#define GAS __attribute__((address_space(1)))
typedef unsigned short bf16_t;
typedef short bf16x8 __attribute__((ext_vector_type(8)));
typedef short s16x4 __attribute__((ext_vector_type(4)));
typedef float f32x2 __attribute__((ext_vector_type(2)));
typedef float f32x4 __attribute__((ext_vector_type(4)));
typedef float f32x16 __attribute__((ext_vector_type(16)));
typedef unsigned u32x2 __attribute__((ext_vector_type(2)));
typedef unsigned u32x4 __attribute__((ext_vector_type(4)));

constexpr int NBATCH = 8, SEQ = 4096, T = NBATCH * SEQ, DM = 1024, DFF = 2816, NEXP = 8;
constexpr int N_IN0 = 2072, N_IN0P = 2304, N_IN1 = 1448, N_IN1P = 1536;
constexpr float ALPHA = 1.41421356237309515f;
constexpr float LN_EPS = 1e-5f;
constexpr float LOG2E = 1.4426950408889634f;
constexpr float QSCALE = 0.125f * LOG2E;

constexpr size_t MiB = 1u << 20;
constexpr size_t WS_CTL = 0, CTL_ZERO_BYTES = 1 * MiB;
constexpr size_t WS_KC = 1 * MiB;
constexpr size_t WS_POSW = 2 * MiB;
constexpr size_t WS_MOECNT = 2 * MiB + 64 * 1024;
constexpr size_t WS_MOEMETA = 2 * MiB + 128 * 1024;
constexpr size_t WS_TOKINFO = 2 * MiB + 256 * 1024;
constexpr size_t WS_WGU1 = 4 * MiB;
constexpr size_t WS_X3F8 = 48 * MiB;
constexpr size_t WS_X2F8 = 48 * MiB;
constexpr size_t WS_WDN1 = 92 * MiB;
constexpr size_t WS_WIN0 = 136 * MiB;
constexpr size_t WS_WC1 = 141 * MiB;
constexpr size_t WS_WOUT0 = 143 * MiB;
constexpr size_t WS_WGU0 = 145 * MiB;
constexpr size_t WS_WDN0 = 156 * MiB;
constexpr size_t WS_WIN1 = 162 * MiB;
constexpr size_t WS_WOUT1 = 165 * MiB;
constexpr size_t WS_XB = 168 * MiB;
constexpr size_t WS_QA = 232 * MiB;
constexpr size_t WS_QB = 264 * MiB;
constexpr size_t WS_KA = 296 * MiB;
constexpr size_t WS_VA = 304 * MiB;
constexpr size_t WS_KCMP = 312 * MiB;
constexpr size_t WS_VCMP = 320 * MiB;
constexpr size_t WS_KSLC = 328 * MiB;
constexpr size_t WS_VSLC = 336 * MiB;
constexpr size_t WS_KWIN = 344 * MiB;
constexpr size_t WS_VWIN = 352 * MiB;
constexpr size_t WS_GATES = 360 * MiB;
constexpr size_t WS_HCMP = 364 * MiB;
constexpr size_t WS_MIX0 = WS_XB;
constexpr size_t WS_X1B = 232 * MiB;
constexpr size_t WS_H0 = 296 * MiB;
constexpr size_t WS_X2B = WS_XB;
constexpr size_t WS_Q1 = 232 * MiB;
constexpr size_t WS_K1 = 296 * MiB;
constexpr size_t WS_V1 = 300 * MiB;
constexpr size_t WS_QI = 304 * MiB;
constexpr size_t WS_KI = 320 * MiB;
constexpr size_t WS_WI = 322 * MiB;
constexpr size_t WS_MIX1 = 328 * MiB;
constexpr size_t WS_Y3 = 392 * MiB;
constexpr size_t WS_X3B = 200 * MiB;
constexpr size_t WS_ROWTOK = 3 * MiB;
constexpr size_t WS_XG = 136 * MiB;
constexpr size_t WS_H1 = 268 * MiB;
constexpr size_t WS_PART = 456 * MiB;
constexpr size_t WS_END = 512 * MiB;
constexpr float FP8_SX = 8.f, FP8_SWGU = 1024.f, FP8_SH = 8.f, FP8_SWDN = 4096.f, FP8_SMIX = 32.f, FP8_SMIX0 = 16.f, FP8_SWOUT = 2048.f;
constexpr int MOE_PASS_TILES = 128;
constexpr int MOE_MAX_TILES = 264;

constexpr int CW_BAR = 4096;

constexpr int RING_BYTES = 131072;
constexpr int LDS_EXTRA_OFF = RING_BYTES;
constexpr int LDS_MISC_OFF = RING_BYTES + 16384;
constexpr int LDS_BYTES = RING_BYTES + 16384 + 512;


#ifndef PROBE_T
#define PROBE_T 0
#endif
#ifndef PROBE_TBASE
#define PROBE_TBASE 20.f
#endif
#define TPROBE_ACC(ws_) ((unsigned long long*)((ws_) + WS_CTL + 512))
#define T0W(id, ws_) do { if (PROBE_T == (id) && blockIdx.x == 0 && threadIdx.x == 0) TPROBE_ACC(ws_)[1] = __builtin_amdgcn_s_memrealtime(); } while (0)
#define T1(id, ws_) do { if (PROBE_T == (id) && blockIdx.x == 0 && threadIdx.x == 0) TPROBE_ACC(ws_)[0] += __builtin_amdgcn_s_memrealtime() - TPROBE_ACC(ws_)[1]; } while (0)

typedef __bf16 bf16x2_t __attribute__((ext_vector_type(2)));
__device__ __forceinline__ unsigned cvt_pk_bf16(float lo, float hi) { const f32x2 v = {lo, hi}; const bf16x2_t b = __builtin_convertvector(v, bf16x2_t); return __builtin_bit_cast(unsigned, b); }
__device__ __forceinline__ unsigned cvt4_fp8(float a, float b, float c, float d) {
    a = __builtin_amdgcn_fmed3f(a, 448.f, -448.f); b = __builtin_amdgcn_fmed3f(b, 448.f, -448.f); c = __builtin_amdgcn_fmed3f(c, 448.f, -448.f); d = __builtin_amdgcn_fmed3f(d, 448.f, -448.f);
    int r = __builtin_amdgcn_cvt_pk_fp8_f32(a, b, 0, false); r = __builtin_amdgcn_cvt_pk_fp8_f32(c, d, r, true); return (unsigned)r;
}
__device__ __forceinline__ float bf_lo(unsigned w) { return __uint_as_float(w << 16); }
__device__ __forceinline__ float bf_hi(unsigned w) { return __uint_as_float(w & 0xffff0000u); }
__device__ __forceinline__ float wave_sum(float v) {
#pragma unroll
    for (int o = 1; o < 64; o <<= 1) v += __shfl_xor(v, o);
    return v;
}
__device__ __forceinline__ float swap_max(float m) { auto rr = __builtin_amdgcn_permlane32_swap(__float_as_uint(m), __float_as_uint(m), false, false); return fmaxf(__uint_as_float(rr[0]), __uint_as_float(rr[1])); }
__device__ __forceinline__ float swap_sum(float m) { auto rr = __builtin_amdgcn_permlane32_swap(__float_as_uint(m), __float_as_uint(m), false, false); return __uint_as_float(rr[0]) + __uint_as_float(rr[1]); }
__device__ __forceinline__ int t5_bucket(int n) {
    if (n < 16) return n;
    int b = 16;
    b += (n >= 19); b += (n >= 21); b += (n >= 24); b += (n >= 27); b += (n >= 31); b += (n >= 35); b += (n >= 40); b += (n >= 46);
    b += (n >= 52); b += (n >= 59); b += (n >= 67); b += (n >= 77); b += (n >= 87); b += (n >= 99); b += (n >= 113);
    return b;
}
namespace pg8 {
#define PG8_LAS __attribute__((address_space(3)))
constexpr int BM = 256, BK = 64, HALF = 128, HTB = HALF * BK * 2  , STAGE_BYTES = 8 * HTB, NXCD = 8, WGM = 8;
__host__ __device__ __forceinline__ int lds_byte(int r, int c) { const int st = (r >> 4) * 2 + (c >> 5), rr = r & 15, cc = c & 31, ob = rr * 64 + cc * 2; return st * 1024 + (ob ^ (((ob >> 9) & 1) << 5)); }
__host__ __device__ __forceinline__ void stage_rc(int b, int& R, int& C) { const int st = b / 1024, sb = b % 1024, swz = sb ^ (((sb >> 9) & 1) << 5); R = (st >> 1) * 16 + swz / 64; C = (st & 1) * 32 + (swz % 64) / 2; }
__host__ __device__ __forceinline__ int perm32(int rho) { const int n = rho >> 4, i = rho & 15; return 8 * (i >> 2) + 4 * n + (i & 3); }

struct Unit { int pa, pb, pm, pn, kb, nt, aux; };
struct Gemm { const bf16_t* A; const bf16_t* Bt; int K; };

struct StaticOrder {
    int nM, nN, nwg, G, c; const int* rowlist; int gpitch;
    __host__ __device__ void init(int nM_, int nN_, int G_, int c_) { nM = nM_; nN = nN_; nwg = nM * nN; G = G_; c = c_; }
    __host__ __device__ bool next(int i, Unit& u) const {
        const long L = (long)i * G + c; if (L >= nwg) return false;
        int wgid = (int)L; { const int q = nwg / NXCD, r = nwg % NXCD, xcd = wgid % NXCD, off = wgid / NXCD; wgid = (xcd < r ? xcd * (q + 1) : r * (q + 1) + (xcd - r) * q) + off; }
        const int nig = WGM * nN, gid = wgid / nig, fm = gid * WGM, gsz = (nM - fm) < WGM ? (nM - fm) : WGM;
        u.pm = fm + ((wgid % nig) % gsz); u.pn = (wgid % nig) / gsz; u.pa = u.pm; u.pb = u.pn; return true;
    }
    __device__ __forceinline__ void a_ready(const Unit&) const {}
    __device__ __forceinline__ void done(const Unit&) const {}
};
typedef int pg8_i32x4 __attribute__((ext_vector_type(4)));
typedef int pg8_i32x8 __attribute__((ext_vector_type(8)));
template <class Epi, class Sched, bool ALIGN_EPI = false, bool SP2 = false, bool GATHER = false, bool KSPLIT = false, bool FP8 = false>
__device__ __forceinline__ void gemm_phase(PG8_LAS unsigned char* lds, const Gemm g, const Sched& S, const Epi& E) {
    const int tid = threadIdx.x, wid = __builtin_amdgcn_readfirstlane(tid >> 6), lane = tid & 63, wr = wid >> 2, wc = wid & 3, fr = lane & 15, fq = lane >> 4;
    const int K = g.K, nt = K / BK;
    unsigned voffA[2], voffB[2]; int rA[2], cA2[2];
#pragma unroll
    for (int i = 0; i < 2; ++i) { int R, C; stage_rc(tid * 16 + i * 8192, R, C); const int Rb = Epi::PERM ? ((R & ~31) + perm32(R & 31)) : R;
        voffA[i] = (unsigned)(R * K + C) * 2u; voffB[i] = (unsigned)(Rb * K + C) * 2u; rA[i] = R; cA2[i] = C; }
    unsigned vofC[2][2], vofN[2][2];
#define PG8_GOFF(dst, unit) do { if constexpr (GATHER) { _Pragma("unroll") for (int h_ = 0; h_ < 2; ++h_) _Pragma("unroll") for (int i_ = 0; i_ < 2; ++i_) \
        dst[h_][i_] = ((unsigned)S.rowlist[(unit).pm * BM + h_ * HALF + rA[i_]] * (unsigned)S.gpitch + (unsigned)cA2[i_]) * 2u; } } while (0)
    const size_t kstep = (size_t)(BK * 2);
    const size_t hstep = (size_t)HALF * K * 2;
    const size_t tstep = 2 * hstep;
    const unsigned ldsw = (unsigned)wid * 1024u;
    const int aoff = lds_byte(wr * 64 + fr, fq * 8), boff = lds_byte(wc * 32 + fr, fq * 8);
#define PG8_SA(b, h) (((b) * 2 + (h)) * HTB)
#define PG8_SB(b, h) ((4 + (b) * 2 + (h)) * HTB)
#define PG8_STAGE(bufoff, gbase, voff) do { _Pragma("unroll") for (int _i = 0; _i < 2; ++_i) \
        __builtin_amdgcn_global_load_lds((const unsigned*)((const char*)(gbase) + (voff)[_i]), (PG8_LAS unsigned*)(lds + (bufoff) + ldsw + _i * 8192), 16, 0, 0); } while (0)
#define PG8_STAGE_A(bufoff, gbase, h, VO) do { if constexpr (GATHER) PG8_STAGE(bufoff, gbase, VO[h]); else PG8_STAGE(bufoff, (gbase) + (h) * hstep, voffA); } while (0)
#define PG8_LD8(p_) __builtin_shufflevector(*(const PG8_LAS pg8_i32x4*)(p_), *(const PG8_LAS pg8_i32x4*)((p_) + 1024), 0, 1, 2, 3, 4, 5, 6, 7)
#define PG8_LDA(dst, b, h) do { if constexpr (FP8) { _Pragma("unroll") for (int m = 0; m < 4; ++m) dst##8[m] = PG8_LD8(lds + PG8_SA(b, h) + aoff + m * 2048); } else { \
        _Pragma("unroll") for (int m = 0; m < 4; ++m) _Pragma("unroll") for (int k = 0; k < 2; ++k) dst[m][k] = *(const PG8_LAS bf16x8*)(lds + PG8_SA(b, h) + aoff + m * 2048 + k * 1024); } } while (0)
#define PG8_LDB(dst, b, h) do { if constexpr (FP8) { _Pragma("unroll") for (int n = 0; n < 2; ++n) dst##8[n] = PG8_LD8(lds + PG8_SB(b, h) + boff + n * 2048); } else { \
        _Pragma("unroll") for (int n = 0; n < 2; ++n) _Pragma("unroll") for (int k = 0; k < 2; ++k) dst[n][k] = *(const PG8_LAS bf16x8*)(lds + PG8_SB(b, h) + boff + n * 2048 + k * 1024); } } while (0)
#define PG8_MMA(ai, bj, At, Bt) do { __builtin_amdgcn_s_setprio(1); if constexpr (FP8) { _Pragma("unroll") for (int m = 0; m < 4; ++m) _Pragma("unroll") for (int n = 0; n < 2; ++n) \
        asm volatile("v_mfma_f32_16x16x128_f8f6f4 %0, %1, %2, %0" : "+v"(acc[ai][bj][m][n]) : "v"(Bt##8[n]), "v"(At##8[m])); } else { \
        _Pragma("unroll") for (int m = 0; m < 4; ++m) _Pragma("unroll") for (int n = 0; n < 2; ++n) _Pragma("unroll") for (int k = 0; k < 2; ++k) \
        acc[ai][bj][m][n] = __builtin_amdgcn_mfma_f32_16x16x32_bf16(Bt[n][k], At[m][k], acc[ai][bj][m][n], 0, 0, 0); } __builtin_amdgcn_s_setprio(0); } while (0)
#define PG8_WAIT_V(n) asm volatile("s_waitcnt vmcnt(" #n ")" ::: "memory")
#define PG8_WAIT_L(n) asm volatile("s_waitcnt lgkmcnt(" #n ")" ::: "memory")
#define PG8_BAR __builtin_amdgcn_s_barrier()
#define PG8_SCHED __builtin_amdgcn_sched_barrier(0)
    Unit cur, nxt; int ui = 0;
    if (!S.next(0, cur)) return;
    f32x4 acc[2][2][4][2];
#pragma unroll
    for (int a = 0; a < 2; ++a)
#pragma unroll
        for (int b = 0; b < 2; ++b)
#pragma unroll
            for (int m = 0; m < 4; ++m)
#pragma unroll
                for (int n = 0; n < 2; ++n) acc[a][b][m][n] = (f32x4){0.f, 0.f, 0.f, 0.f};
    bf16x8 At[4][2], B0[2][2], B1[2][2]; pg8_i32x8 At8[4], B08[2], B18[2];
    const char* cA = (const char*)g.A + (size_t)cur.pa * tstep + (KSPLIT ? cur.kb : 0); const char* cB = (const char*)g.Bt + (size_t)cur.pb * tstep + (KSPLIT ? cur.kb : 0);
    S.a_ready(cur);
    PG8_GOFF(vofC, cur);
#pragma unroll
    for (int h_ = 0; h_ < 2; ++h_)
#pragma unroll
        for (int i_ = 0; i_ < 2; ++i_) { if constexpr (!GATHER) vofC[h_][i_] = 0u; vofN[h_][i_] = vofC[h_][i_]; }
    if constexpr (SP2) {
        PG8_STAGE(PG8_SB(0, 0), cB, voffB); PG8_STAGE(PG8_SB(0, 1), cB + hstep, voffB); PG8_STAGE_A(PG8_SA(0, 0), cA, 0, vofC); PG8_STAGE_A(PG8_SA(0, 1), cA, 1, vofC);
        if (wr == 1) PG8_BAR;
        PG8_WAIT_V(2); PG8_BAR;
        PG8_STAGE(PG8_SB(1, 0), cB + kstep, voffB); PG8_STAGE_A(PG8_SA(1, 0), cA + kstep, 0, vofC); PG8_STAGE(PG8_SB(1, 1), cB + hstep + kstep, voffB);
        PG8_WAIT_V(6); PG8_BAR;
    } else {
        PG8_STAGE(PG8_SB(0, 0), cB, voffB); PG8_STAGE_A(PG8_SA(0, 0), cA, 0, vofC); PG8_STAGE(PG8_SB(0, 1), cB + hstep, voffB); PG8_STAGE_A(PG8_SA(0, 1), cA, 1, vofC);
        if (wr == 1) PG8_BAR;
        PG8_WAIT_V(4); PG8_BAR;
        PG8_STAGE(PG8_SB(1, 0), cB + kstep, voffB); PG8_STAGE_A(PG8_SA(1, 0), cA + kstep, 0, vofC); PG8_STAGE(PG8_SB(1, 1), cB + hstep + kstep, voffB);
        PG8_WAIT_V(6); PG8_BAR;
    }
    for (;;) {
        const bool has_next = S.next(ui + 1, nxt);
        if constexpr (GATHER) { if (has_next) PG8_GOFF(vofN, nxt); }
        const char* nA = has_next ? (const char*)g.A + (size_t)nxt.pa * tstep + (KSPLIT ? nxt.kb : 0) : cA; const char* nB = has_next ? (const char*)g.Bt + (size_t)nxt.pb * tstep + (KSPLIT ? nxt.kb : 0) : cB;
        int ntu = KSPLIT ? cur.nt : nt; if constexpr (FP8) asm volatile("" : "+s"(ntu));
        for (int t = 0; t < ntu; t += 2) {
            const bool last = (t == ntu - 2);
            unsigned vsel[2][2];
#pragma unroll
            for (int h_ = 0; h_ < 2; ++h_)
#pragma unroll
                for (int i_ = 0; i_ < 2; ++i_) vsel[h_][i_] = last ? vofN[h_][i_] : vofC[h_][i_];
            const char* a1 = cA + (size_t)(t + 1) * kstep;
            const char* a2 = last ? nA : cA + (size_t)(t + 2) * kstep; const char* b2 = last ? nB : cB + (size_t)(t + 2) * kstep;
            const char* a3 = a2 + kstep; const char* b3 = b2 + kstep;
            if (last && has_next) S.a_ready(nxt);
            if constexpr (SP2) {
            PG8_LDB(B0, 0, 0); PG8_LDB(B1, 0, 1); PG8_SCHED; PG8_LDA(At, 0, 0); PG8_STAGE_A(PG8_SA(1, 1), a1, 1, vofC);
            PG8_WAIT_V(8); PG8_WAIT_L(0); PG8_BAR; PG8_MMA(0, 0, At, B0); PG8_MMA(0, 1, At, B1); PG8_BAR; PG8_SCHED;
            PG8_LDA(At, 0, 1); PG8_STAGE(PG8_SB(0, 0), b2, voffB); PG8_STAGE(PG8_SB(0, 1), b2 + hstep, voffB); PG8_STAGE_A(PG8_SA(0, 0), a2, 0, vsel);
            PG8_WAIT_V(8); PG8_WAIT_L(0); PG8_BAR; PG8_MMA(1, 0, At, B0); PG8_MMA(1, 1, At, B1); PG8_BAR; PG8_SCHED;
            PG8_LDB(B0, 1, 0); PG8_LDB(B1, 1, 1); PG8_SCHED; PG8_LDA(At, 1, 0); PG8_STAGE_A(PG8_SA(0, 1), a2, 1, vsel);
            PG8_WAIT_V(8); PG8_WAIT_L(0); PG8_BAR; PG8_MMA(0, 0, At, B0); PG8_MMA(0, 1, At, B1); PG8_BAR; PG8_SCHED;
            PG8_LDA(At, 1, 1); PG8_STAGE(PG8_SB(1, 0), b3, voffB); PG8_STAGE(PG8_SB(1, 1), b3 + hstep, voffB); PG8_STAGE_A(PG8_SA(1, 0), a3, 0, vsel);
            PG8_WAIT_V(8); PG8_WAIT_L(0); PG8_BAR; PG8_MMA(1, 0, At, B0); PG8_MMA(1, 1, At, B1); PG8_BAR; PG8_SCHED;
            } else {
            PG8_LDB(B0, 0, 0); PG8_SCHED; PG8_LDA(At, 0, 0); PG8_STAGE_A(PG8_SA(1, 1), a1, 1, vofC);
            PG8_WAIT_L(8); PG8_BAR; PG8_WAIT_L(0); PG8_MMA(0, 0, At, B0); PG8_BAR; PG8_SCHED;
            PG8_LDB(B1, 0, 1); PG8_STAGE(PG8_SB(0, 0), b2, voffB);
            PG8_BAR; PG8_WAIT_L(0); PG8_MMA(0, 1, At, B1); PG8_BAR;
            PG8_LDA(At, 0, 1); PG8_STAGE_A(PG8_SA(0, 0), a2, 0, vsel);
            PG8_BAR; PG8_WAIT_L(0); PG8_MMA(1, 0, At, B0); PG8_BAR; PG8_SCHED;
            PG8_STAGE(PG8_SB(0, 1), b2 + hstep, voffB);
            PG8_WAIT_V(6); PG8_BAR; PG8_MMA(1, 1, At, B1); PG8_BAR;
            PG8_LDB(B0, 1, 0); PG8_SCHED; PG8_LDA(At, 1, 0); PG8_STAGE_A(PG8_SA(0, 1), a2, 1, vsel);
            PG8_WAIT_L(8); PG8_BAR; PG8_WAIT_L(0); PG8_MMA(0, 0, At, B0); PG8_BAR; PG8_SCHED;
            PG8_LDB(B1, 1, 1); PG8_STAGE(PG8_SB(1, 0), b3, voffB);
            PG8_BAR; PG8_WAIT_L(0); PG8_MMA(0, 1, At, B1); PG8_BAR;
            PG8_LDA(At, 1, 1); PG8_STAGE_A(PG8_SA(1, 0), a3, 0, vsel);
            PG8_BAR; PG8_WAIT_L(0); PG8_MMA(1, 0, At, B0); PG8_BAR; PG8_SCHED;
            PG8_STAGE(PG8_SB(1, 1), b3 + hstep, voffB);
            PG8_WAIT_V(6); PG8_BAR; PG8_MMA(1, 1, At, B1); PG8_BAR;
            }
        }
        if constexpr (FP8) asm volatile("s_nop 15\n\ts_nop 7" ::: "memory");
        if constexpr (ALIGN_EPI) { if (wr == 0) PG8_BAR; }
        if constexpr (!Epi::AFTER_DRAIN) { E(acc, cur, wr, wc, fr, fq); S.done(cur); }
        if (!has_next) break;
#pragma unroll
        for (int a = 0; a < 2; ++a)
#pragma unroll
            for (int b = 0; b < 2; ++b)
#pragma unroll
                for (int m = 0; m < 4; ++m)
#pragma unroll
                    for (int n = 0; n < 2; ++n) acc[a][b][m][n] = (f32x4){0.f, 0.f, 0.f, 0.f};
        cur = nxt; cA = nA; cB = nB; ++ui;
#pragma unroll
        for (int h_ = 0; h_ < 2; ++h_)
#pragma unroll
            for (int i_ = 0; i_ < 2; ++i_) vofC[h_][i_] = vofN[h_][i_];
        if constexpr (ALIGN_EPI) { if (wr == 1) PG8_BAR; }
    }
    PG8_WAIT_V(0);
    if constexpr (!ALIGN_EPI) { if (wr == 0) PG8_BAR; }
    PG8_BAR;
    if constexpr (Epi::AFTER_DRAIN) { E.fused(acc, cur, wr, wc, fr, fq, lds, wid, lane); S.done(cur); }
#undef PG8_SA
#undef PG8_SB
#undef PG8_STAGE
#undef PG8_STAGE_A
#undef PG8_GOFF
#undef PG8_LDA
#undef PG8_LDB
#undef PG8_MMA
#undef PG8_LD8
#undef PG8_WAIT_V
#undef PG8_WAIT_L
#undef PG8_BAR
#undef PG8_SCHED
}
}
#define XB_TMO      128
#define XB_XCNT(j)  (256  + 64 * (j))
#define XB_XSUB(j)  (1280 + 64 * (j))
#define XB_XGEN(j)  (2304 + 64 * (j))
#define XB_TOP      3328
#define XB_TOPGEN   3392
#define XCD_BAR_WORDS 3456
#define XB_SPIN_CAP (1u << 18)

__device__ __forceinline__ unsigned xb_ld(unsigned* p)              { return __hip_atomic_load(p, __ATOMIC_RELAXED, __HIP_MEMORY_SCOPE_AGENT); }
__device__ __forceinline__ unsigned xb_add(unsigned* p, unsigned v) { return __hip_atomic_fetch_add(p, v, __ATOMIC_RELAXED, __HIP_MEMORY_SCOPE_AGENT); }
__device__ __forceinline__ unsigned xb_xcc_id() { return (unsigned)__builtin_amdgcn_s_getreg((3 << 11) | 20) & 0xFu; }
#define XB_SPIN(cond, bar) do { unsigned _sp = 0; while (cond) { __builtin_amdgcn_s_sleep(1); \
    if ((++_sp & 255u) == 0u) { if (xb_ld(&(bar)[XB_TMO])) break; if (_sp > XB_SPIN_CAP) { atomicAdd(&(bar)[XB_TMO], 1u); break; } } } } while (0)

struct XcdBarrier {
    unsigned* bar; unsigned x;
    volatile LAS unsigned* st;
};

__device__ __forceinline__ XcdBarrier xcd_barrier_post(unsigned* bar, volatile LAS unsigned* st) {
    XcdBarrier b; b.bar = bar; b.x = xb_xcc_id(); b.st = st;
    if (threadIdx.x == 0) (void)xb_add(&bar[XB_XCNT(b.x)], 1u);
    return b;
}
__device__ __forceinline__ void xcd_barrier_complete(unsigned* bar, unsigned x, unsigned& nloc, unsigned& nx) {
    const unsigned G = gridDim.x * gridDim.y * gridDim.z;
    unsigned sum, cnt, mine, sp = 0u;
    for (;;) {
        sum = 0u; cnt = 0u; mine = 0u;
#pragma unroll
        for (unsigned j = 0; j < 16; ++j) { const unsigned c = xb_ld(&bar[XB_XCNT(j)]); sum += c; cnt += (c > 0u) ? 1u : 0u; mine = (j == x) ? c : mine; }
        if (sum == G) break;
        __builtin_amdgcn_s_sleep(1);
        if ((++sp & 255u) == 0u) { if (xb_ld(&bar[XB_TMO])) break; if (sp > XB_SPIN_CAP) { atomicAdd(&bar[XB_TMO], 1u); break; } }
    }
    nloc = mine > 0u ? mine : 1u; nx = cnt > 0u ? cnt : 1u;
}

__device__ __forceinline__ void xcd_barrier(const XcdBarrier& b) {
    asm volatile("s_waitcnt vmcnt(0)" ::: "memory");
    __syncthreads();
    if (threadIdx.x == 0) {
        unsigned* bar = b.bar;
        __builtin_amdgcn_s_waitcnt(0);
        unsigned nloc = b.st[0], nx = b.st[1];
        if (nloc == 0u) { xcd_barrier_complete(bar, b.x, nloc, nx); b.st[0] = nloc; b.st[1] = nx; }
        const unsigned old = xb_add(&bar[XB_XSUB(b.x)], 1u);
        const unsigned gen = old / nloc;
        if (old + 1u == (gen + 1u) * nloc) {
            __builtin_amdgcn_fence(__ATOMIC_RELEASE, "agent");
            asm volatile("s_waitcnt vmcnt(0)" ::: "memory");
            const unsigned og = xb_add(&bar[XB_TOP], 1u);
            const unsigned tg = og / nx;
            if (og + 1u == (tg + 1u) * nx) xb_add(&bar[XB_TOPGEN], 1u);
            else XB_SPIN(xb_ld(&bar[XB_TOPGEN]) == tg, bar);
            __builtin_amdgcn_fence(__ATOMIC_ACQUIRE, "agent");
            xb_add(&bar[XB_XGEN(b.x)], 1u);
            asm volatile("s_waitcnt vmcnt(0)" ::: "memory");
        } else {
            XB_SPIN(xb_ld(&bar[XB_XGEN(b.x)]) == gen, bar);
            __builtin_amdgcn_fence(__ATOMIC_ACQUIRE, "agent");
            asm volatile("s_waitcnt vmcnt(0)" ::: "memory");
        }
    }
    __syncthreads();
}
struct Args {
    const float* in[28];
    float* out; unsigned char* ws;
    int ph_lo, ph_hi;
};
struct Frame {
    LAS unsigned char* lds;
    int tid, lane, wave, G, bid;
    unsigned char* ws; float* out;
};
#define WSP(type, off) ((type*)(F.ws + (off)))
constexpr int LDS_PTR_OFF = LDS_MISC_OFF + 16;
__device__ __forceinline__ const float* in_ptr(LAS unsigned char* lds, int k) {
    const unsigned long long v = *(volatile LAS unsigned long long*)(lds + LDS_PTR_OFF + 8 * k);
    const unsigned lo = __builtin_amdgcn_readfirstlane((unsigned)v), hi = __builtin_amdgcn_readfirstlane((unsigned)(v >> 32));
    return (const float*)(((unsigned long long)hi << 32) | lo);
}
#define INP(k) in_ptr(F.lds, (k))

namespace pg8 {
struct EpiProj0 {
    static constexpr bool PERM = true, AFTER_DRAIN = false;
    unsigned char* ws;
    __device__ __forceinline__ void operator()(const f32x4 (&acc)[2][2][4][2], const Unit& u, int wr, int wc, int fr, int fq) const {
        const int row0 = u.pm * BM + wr * 64 + fr, cl = wc * 32 + 8 * fq;
        if (u.pn >= 16) {
            float* H = (float*)(ws + WS_HCMP);
#pragma unroll
            for (int ai = 0; ai < 2; ++ai)
#pragma unroll
                for (int m = 0; m < 4; ++m) { float* rp = H + (size_t)(row0 + ai * HALF + m * 16) * 512 + (u.pn - 16) * BM + cl;
#pragma unroll
                    for (int bj = 0; bj < 2; ++bj) { *(f32x4*)(rp + bj * HALF) = acc[ai][bj][m][0]; *(f32x4*)(rp + bj * HALF + 4) = acc[ai][bj][m][1]; } }
            return;
        }
#pragma unroll
        for (int bj = 0; bj < 2; ++bj) {
            const int hb = 2 * u.pn + bj;
            bf16_t* dst = nullptr; int pitch = 128, cb = cl, mode = 0; float sc = 1.f;
            if (hb < 4) { dst = (bf16_t*)(ws + WS_QA); pitch = 512; cb = hb * 128 + cl; sc = QSCALE; }
            else if (hb == 4) dst = (bf16_t*)(ws + WS_KA);
            else if (hb == 5) dst = (bf16_t*)(ws + WS_VA);
            else if (hb < 10) { dst = (bf16_t*)(ws + WS_QB); pitch = 512; cb = (hb - 6) * 128 + cl; sc = QSCALE; }
            else if (hb == 10) { dst = (bf16_t*)(ws + WS_KCMP); mode = 1; }
            else if (hb == 11) { dst = (bf16_t*)(ws + WS_VCMP); mode = 1; }
            else if (hb == 12) dst = (bf16_t*)(ws + WS_KSLC);
            else if (hb == 13) dst = (bf16_t*)(ws + WS_VSLC);
            else if (hb == 14) dst = (bf16_t*)(ws + WS_KWIN);
            else if (hb == 15) dst = (bf16_t*)(ws + WS_VWIN);
            else if (hb == 16) mode = (cl < 24) ? 2 : 3;
            else mode = 3;
            if (mode == 3) continue;
#pragma unroll
            for (int ai = 0; ai < 2; ++ai)
#pragma unroll
                for (int m = 0; m < 4; ++m) {
                    const int row = row0 + ai * HALF + m * 16;
                    const f32x4 v0 = acc[ai][bj][m][0], v1 = acc[ai][bj][m][1];
                    if (mode == 2) {
                        float* gp = (float*)(ws + WS_GATES) + (size_t)row * 24 + cl;
                        f32x4 a, b;
#pragma unroll
                        for (int i = 0; i < 4; ++i) { a[i] = 1.f / (1.f + __expf(-v0[i])); b[i] = 1.f / (1.f + __expf(-v1[i])); }
                        *(f32x4*)gp = a; *(f32x4*)(gp + 4) = b;
                    } else {
                        u32x4 w; w.x = cvt_pk_bf16(v0[0] * sc, v0[1] * sc); w.y = cvt_pk_bf16(v0[2] * sc, v0[3] * sc); w.z = cvt_pk_bf16(v1[0] * sc, v1[1] * sc); w.w = cvt_pk_bf16(v1[2] * sc, v1[3] * sc);
                        size_t off;
                        if (mode == 1) { const int b = row >> 12, t = row & 4095, g = cb >> 6, d = cb & 63; off = ((size_t)((b * 2 + g) * 4096 + t)) * 64 + d; }
                        else off = (size_t)row * pitch + cb;
                        *(u32x4*)(dst + off) = w;
                    }
                }
        }
    }
};
struct EpiProj1 {
    static constexpr bool PERM = true, AFTER_DRAIN = false;
    unsigned char* ws; float qs;
    __device__ __forceinline__ void operator()(const f32x4 (&acc)[2][2][4][2], const Unit& u, int wr, int wc, int fr, int fq) const {
        const int row0 = u.pm * BM + wr * 64 + fr, cl = wc * 32 + 8 * fq;
#pragma unroll
        for (int bj = 0; bj < 2; ++bj) {
            const int hb = 2 * u.pn + bj;
            bf16_t* dst = nullptr; int pitch = 1024, cb = cl, mode = 0; float sc = 1.f;
            if (hb < 8) { dst = (bf16_t*)(ws + WS_Q1); cb = hb * 128 + cl; sc = qs; }
            else if (hb == 8) { if (cl < 64) { dst = (bf16_t*)(ws + WS_K1); pitch = 64; } else { dst = (bf16_t*)(ws + WS_V1); pitch = 64; cb = cl - 64; } }
            else if (hb < 11) { dst = (bf16_t*)(ws + WS_QI); pitch = 256; cb = (hb - 9) * 128 + cl; }
            else if (hb == 11) { if (cl < 32) { dst = (bf16_t*)(ws + WS_KI); pitch = 32; } else if (cl < 40) mode = 2; else mode = 3; }
            else mode = 3;
            if (mode == 3) continue;
#pragma unroll
            for (int ai = 0; ai < 2; ++ai)
#pragma unroll
                for (int m = 0; m < 4; ++m) {
                    const int row = row0 + ai * HALF + m * 16;
                    const f32x4 v0 = acc[ai][bj][m][0], v1 = acc[ai][bj][m][1];
                    if (mode == 2) { float* gp = (float*)(ws + WS_WI) + (size_t)row * 8; *(f32x4*)gp = v0; *(f32x4*)(gp + 4) = v1; }
                    else { u32x4 w; w.x = cvt_pk_bf16(v0[0] * sc, v0[1] * sc); w.y = cvt_pk_bf16(v0[2] * sc, v0[3] * sc); w.z = cvt_pk_bf16(v1[0] * sc, v1[1] * sc); w.w = cvt_pk_bf16(v1[2] * sc, v1[3] * sc);
                        *(u32x4*)(dst + (size_t)row * pitch + cb) = w; }
                }
        }
    }
};
struct EpiF32 {
    static constexpr bool PERM = false, AFTER_DRAIN = false;
    float* out; int ldc;
    __device__ __forceinline__ void operator()(const f32x4 (&acc)[2][2][4][2], const Unit& u, int wr, int wc, int fr, int fq) const {
#pragma unroll
        for (int ai = 0; ai < 2; ++ai)
#pragma unroll
            for (int m = 0; m < 4; ++m) { float* rp = out + (size_t)(u.pm * BM + ai * HALF + wr * 64 + m * 16 + fr) * ldc + u.pn * BM + wc * 32 + 4 * fq;
#pragma unroll
                for (int bj = 0; bj < 2; ++bj)
#pragma unroll
                    for (int n = 0; n < 2; ++n) *(f32x4*)(rp + bj * HALF + n * 16) = acc[ai][bj][m][n]; }
    }
};
struct EpiRes {
    static constexpr bool PERM = true, AFTER_DRAIN = false;
    const float* resf; const bf16_t* resb; bf16_t* out; float sc;
    __device__ __forceinline__ void operator()(const f32x4 (&acc)[2][2][4][2], const Unit& u, int wr, int wc, int fr, int fq) const {
#pragma unroll
        for (int ai = 0; ai < 2; ++ai)
#pragma unroll
            for (int m = 0; m < 4; ++m) { const size_t ro = (size_t)(u.pm * BM + ai * HALF + wr * 64 + m * 16 + fr) * DM + u.pn * BM + wc * 32 + 8 * fq;
#pragma unroll
                for (int bj = 0; bj < 2; ++bj) { const size_t o = ro + bj * HALF; f32x4 r0, r1;
                    if (resf) { r0 = *(const f32x4*)(resf + o); r1 = *(const f32x4*)(resf + o + 4); }
                    else { const u32x4 w = *(const u32x4*)(resb + o); r0 = (f32x4){bf_lo(w.x), bf_hi(w.x), bf_lo(w.y), bf_hi(w.y)}; r1 = (f32x4){bf_lo(w.z), bf_hi(w.z), bf_lo(w.w), bf_hi(w.w)}; }
                    const f32x4 v0 = r0 * ALPHA + acc[ai][bj][m][0] * sc, v1 = r1 * ALPHA + acc[ai][bj][m][1] * sc;
                    u32x4 q; q.x = cvt_pk_bf16(v0[0], v0[1]); q.y = cvt_pk_bf16(v0[2], v0[3]); q.z = cvt_pk_bf16(v1[0], v1[1]); q.w = cvt_pk_bf16(v1[2], v1[3]);
                    *(u32x4*)(out + o) = q; } }
    }
};
struct EpiSwiglu {
    static constexpr bool PERM = true, AFTER_DRAIN = false;
    bf16_t* H; int row_tile0;
    __device__ __forceinline__ void operator()(const f32x4 (&acc)[2][2][4][2], const Unit& u, int wr, int wc, int fr, int fq) const {
        const int row0 = (u.pm - row_tile0) * BM + wr * 64 + fr, col = u.pn * HALF + wc * 32 + 8 * fq;
#pragma unroll
        for (int ai = 0; ai < 2; ++ai)
#pragma unroll
            for (int m = 0; m < 4; ++m) {
                float h[8];
#pragma unroll
                for (int n = 0; n < 2; ++n)
#pragma unroll
                    for (int i = 0; i < 4; ++i) { const float g = acc[ai][0][m][n][i], up = acc[ai][1][m][n][i];
                        h[n * 4 + i] = g * __builtin_amdgcn_rcpf(1.f + __builtin_amdgcn_exp2f(-g * LOG2E)) * up; }
                u32x4 w; w.x = cvt_pk_bf16(h[0], h[1]); w.y = cvt_pk_bf16(h[2], h[3]); w.z = cvt_pk_bf16(h[4], h[5]); w.w = cvt_pk_bf16(h[6], h[7]);
                *(u32x4*)(H + (size_t)(row0 + ai * HALF + m * 16) * DFF + col) = w;
            }
    }
};
struct EpiSwiglu8 {
    static constexpr bool PERM = true, AFTER_DRAIN = false;
    unsigned char* H; int row_tile0; float SI;
    __device__ __forceinline__ void operator()(const f32x4 (&acc)[2][2][4][2], const Unit& u, int wr, int wc, int fr, int fq) const {
        const int row0 = (u.pm - row_tile0) * BM + wr * 64 + fr, col = u.pn * HALF + wc * 32 + 8 * fq;
#pragma unroll
        for (int ai = 0; ai < 2; ++ai)
#pragma unroll
            for (int m = 0; m < 4; ++m) {
                float h[8];
#pragma unroll
                for (int n = 0; n < 2; ++n)
#pragma unroll
                    for (int i = 0; i < 4; ++i) { const float g = acc[ai][0][m][n][i] * SI, up = acc[ai][1][m][n][i] * (SI * FP8_SH);
                        h[n * 4 + i] = g * __builtin_amdgcn_rcpf(1.f + __builtin_amdgcn_exp2f(-g * LOG2E)) * up; }
                u32x2 w; w.x = cvt4_fp8(h[0], h[1], h[2], h[3]); w.y = cvt4_fp8(h[4], h[5], h[6], h[7]);
                *(u32x2*)(H + (size_t)(row0 + ai * HALF + m * 16) * DFF + col) = w;
            }
    }
};
struct EpiBf16 {
    static constexpr bool PERM = true, AFTER_DRAIN = false;
    bf16_t* O; float sc;
    __device__ __forceinline__ void operator()(const f32x4 (&acc)[2][2][4][2], const Unit& u, int wr, int wc, int fr, int fq) const {
        const int row0 = u.pm * BM + wr * 64 + fr, col0 = u.pn * BM + wc * 32 + 8 * fq;
#pragma unroll
        for (int ai = 0; ai < 2; ++ai)
#pragma unroll
            for (int m = 0; m < 4; ++m) { bf16_t* rowp = O + (size_t)(row0 + ai * HALF + m * 16) * DM + col0;
#pragma unroll
                for (int bj = 0; bj < 2; ++bj) { const f32x4 v0 = acc[ai][bj][m][0] * sc, v1 = acc[ai][bj][m][1] * sc;
                    u32x4 w; w.x = cvt_pk_bf16(v0[0], v0[1]); w.y = cvt_pk_bf16(v0[2], v0[3]); w.z = cvt_pk_bf16(v1[0], v1[1]); w.w = cvt_pk_bf16(v1[2], v1[3]);
                    *(u32x4*)(rowp + bj * HALF) = w; } }
    }
};
struct Proj0OrderA {
    int G, c; const int* rowlist; int gpitch;
    __device__ bool next(int i, Unit& u) const { const int L = i * G + c; if (L >= 256) return false; u.pm = L >> 1; u.pa = u.pm; u.pn = (L & 1) ? 8 : 5; u.pb = u.pn; return true; }
    __device__ __forceinline__ void a_ready(const Unit&) const {}
    __device__ __forceinline__ void done(const Unit&) const {}
};
struct Proj0OrderB {
    StaticOrder so; int G, c; const int* rowlist; int gpitch;
    __device__ bool next(int i, Unit& u) const {
        if (so.next(i, u)) { u.pn = u.pn < 5 ? u.pn : u.pn + 1; u.pb = u.pn; return true; }
        const int L = i * G + c - 896; if (L < 0 || L >= 64) return false;
        const int ct = L >> 1; u.pm = ct; u.pa = (int)((WS_KCMP - WS_XB) / (512 * 1024)) + ct; u.pn = 16 + (L & 1); u.pb = (int)((WS_WC1 - WS_WIN0) / (512 * 1024)) + (ct >> 4) * 2 + (L & 1); return true;
    }
    __device__ __forceinline__ void a_ready(const Unit&) const {}
    __device__ __forceinline__ void done(const Unit&) const {}
};
struct OffOrder {
    StaticOrder so; int pn0; const int* rowlist; int gpitch;
    __device__ bool next(int i, Unit& u) const { if (!so.next(i, u)) return false; u.pn += pn0; u.pb = u.pn; return true; }
    __device__ __forceinline__ void a_ready(const Unit&) const {}
    __device__ __forceinline__ void done(const Unit&) const {}
};
struct MoeOrder {
    StaticOrder so; int tile0, nN, a_local, gpitch; const LAS int* tile_e; const int* rowlist;
    __device__ bool next(int i, Unit& u) const {
        if (!so.next(i, u)) return false;
        const int tile = tile0 + u.pm; u.pa = a_local ? u.pm : 0; u.pb = tile_e[tile] * nN + u.pn; u.pm = tile; return true;
    }
    __device__ __forceinline__ void a_ready(const Unit&) const {}
    __device__ __forceinline__ void done(const Unit&) const {}
};
struct EpiPart {
    static constexpr bool PERM = false, AFTER_DRAIN = false;
    float* part; float sc;
    __device__ __forceinline__ void operator()(const f32x4 (&acc)[2][2][4][2], const Unit& u, int wr, int wc, int fr, int fq) const {
        float* base = part + (size_t)u.aux * (8 * 256 * DM);
#pragma unroll
        for (int ai = 0; ai < 2; ++ai)
#pragma unroll
            for (int m = 0; m < 4; ++m) { float* rp = base + (size_t)(u.pm * BM + ai * HALF + wr * 64 + m * 16 + fr) * DM + u.pn * BM + wc * 32 + 4 * fq;
#pragma unroll
                for (int bj = 0; bj < 2; ++bj)
#pragma unroll
                    for (int n = 0; n < 2; ++n) *(f32x4*)(rp + bj * HALF + n * 16) = acc[ai][bj][m][n] * sc; }
    }
};
struct TailOrder {
    int G, c, ntail, tile_first, tile0; const LAS int* tile_e; const int* rowlist; int gpitch;
    __device__ bool next(int i, Unit& u) const {
        const int L = i * G + c; if (L >= ntail * 16) return false;
        const int sl = L & 3, pn = (L >> 2) & 3, tl = L >> 4, tile = tile_first + tl;
        u.pa = tile - tile0; u.pb = tile_e[tile] * 4 + pn; u.pm = tl; u.pn = pn; u.aux = sl;
        u.kb = sl * 768; u.nt = sl < 3 ? 6 : 4; return true;
    }
    __device__ __forceinline__ void a_ready(const Unit&) const {}
    __device__ __forceinline__ void done(const Unit&) const {}
};
}
enum { I_X = 0, I_RELB, I_L0_WIN, I_L0_SINKS, I_CK_POS, I_CK_W1, I_CK_W2, I_CV_POS, I_CV_W1, I_CV_W2, I_L0_WOUT, I_L0_LN1G, I_L0_LN1B, I_L0_GATE, I_L0_UP, I_L0_DOWN, I_L0_LN2G, I_L0_LN2B,
       I_L1_WIN, I_L1_WOUT, I_L1_LN1G, I_L1_LN1B, I_L1_ROUTER, I_L1_EGATE, I_L1_EUP, I_L1_EDOWN, I_L1_LN2G, I_L1_LN2B };

__device__ __forceinline__ void p0_transpose_item(const float* W, int ldw, int ncols, bf16_t* WT, int dk, int k0, int n0, int drow0, LAS float* scr, int lane, float f8scale) {
    const int cn = n0 + (lane & 31); const bool okc = cn < ncols;
    float tv[32];
#pragma unroll
    for (int i = 0; i < 32; ++i) { const int kk = 2 * i + (lane >> 5); tv[i] = okc ? W[(size_t)(k0 + kk) * ldw + cn] : 0.f; }
#pragma unroll
    for (int i = 0; i < 32; ++i) { const int kk = 2 * i + (lane >> 5); scr[kk * 33 + (lane & 31)] = tv[i]; }
    asm volatile("s_waitcnt lgkmcnt(0)" ::: "memory");
    const int c = lane & 7;
    if (f8scale > 0.f) {
#pragma unroll
        for (int j = 0; j < 4; ++j) { const int n = (lane >> 3) + 8 * j; const LAS float* s = scr + (8 * c) * 33 + n;
            u32x2 o; o.x = cvt4_fp8(s[0 * 33] * f8scale, s[1 * 33] * f8scale, s[2 * 33] * f8scale, s[3 * 33] * f8scale); o.y = cvt4_fp8(s[4 * 33] * f8scale, s[5 * 33] * f8scale, s[6 * 33] * f8scale, s[7 * 33] * f8scale);
            *(u32x2*)((unsigned char*)WT + (size_t)(drow0 + n) * dk + k0 + 8 * c) = o; }
    } else {
#pragma unroll
    for (int j = 0; j < 4; ++j) { const int n = (lane >> 3) + 8 * j; const LAS float* s = scr + (8 * c) * 33 + n;
        u32x4 o; o.x = cvt_pk_bf16(s[0 * 33], s[1 * 33]); o.y = cvt_pk_bf16(s[2 * 33], s[3 * 33]); o.z = cvt_pk_bf16(s[4 * 33], s[5 * 33]); o.w = cvt_pk_bf16(s[6 * 33], s[7 * 33]);
        *(u32x4*)(WT + (size_t)(drow0 + n) * dk + k0 + 8 * c) = o; }
    }
    asm volatile("s_waitcnt lgkmcnt(0)" ::: "memory");
}
struct TJob { const float* W; bf16_t* WT; int ldw, ncols, npad, ksrc, dk, map; float f8scale; };
__device__ __forceinline__ int tjob_items(const TJob& j) { return (j.ksrc / 64) * (j.npad / 32); }
__device__ __forceinline__ void tjob_run(const TJob& j, int item, LAS float* scr, int lane) {
    const int nblk = j.npad / 32, kb = item / nblk, nb = item % nblk, n0 = nb * 32;
    int drow0 = n0; if (j.map) drow0 = 256 * (n0 >> 7) + (n0 & 127) + (j.map == 2 ? 128 : 0);
    p0_transpose_item(j.W, j.ldw, j.ncols, j.WT, j.dk, kb * 64, n0, drow0, scr, lane, j.f8scale);
}
__device__ __forceinline__ void p0_prologue(Frame& F, const Args& A) {
    LAS float* scr = (LAS float*)(F.lds + F.wave * 16384);
    const int gw = F.bid * 8 + F.wave, NGW = F.G * 8;
    T0W(20, F.ws);
    int base = 0;
#define RUN_JOB(jb) do { const TJob j_ = (jb); const int n_ = tjob_items(j_); \
        int it_ = gw - (base % NGW); if (it_ < 0) it_ += NGW; for (; it_ < n_; it_ += NGW) tjob_run(j_, it_, scr, F.lane); base += n_; } while (0)
    RUN_JOB((TJob{INP(I_L0_WIN), WSP(bf16_t, WS_WIN0), N_IN0, N_IN0, N_IN0P, DM, DM, 0, 0.f}));
    RUN_JOB((TJob{INP(I_CK_W1), WSP(bf16_t, WS_WC1), 256, 256, 256, 1024, 1024, 0, 0.f}));
    RUN_JOB((TJob{INP(I_CK_W1) + 1024 * 256, WSP(bf16_t, WS_WC1) + 256 * 1024, 256, 256, 256, 1024, 1024, 0, 0.f}));
    RUN_JOB((TJob{INP(I_CV_W1), WSP(bf16_t, WS_WC1) + 512 * 1024, 256, 256, 256, 1024, 1024, 0, 0.f}));
    RUN_JOB((TJob{INP(I_CV_W1) + 1024 * 256, WSP(bf16_t, WS_WC1) + 768 * 1024, 256, 256, 256, 1024, 1024, 0, 0.f}));
    RUN_JOB((TJob{INP(I_L0_WOUT), WSP(bf16_t, WS_WOUT0), DM, DM, DM, DM, DM, 0, FP8_SWOUT}));
    RUN_JOB((TJob{INP(I_L0_GATE), WSP(bf16_t, WS_WGU0), DFF, DFF, DFF, DM, DM, 1, 0.f}));
    RUN_JOB((TJob{INP(I_L0_UP), WSP(bf16_t, WS_WGU0), DFF, DFF, DFF, DM, DM, 2, 0.f}));
    RUN_JOB((TJob{INP(I_L0_DOWN), WSP(bf16_t, WS_WDN0), DM, DM, DM, DFF, DFF, 0, FP8_SWDN}));
    RUN_JOB((TJob{INP(I_L1_WIN), WSP(bf16_t, WS_WIN1), N_IN1, 1024, 1024, DM, DM, 0, FP8_SWGU}));
    RUN_JOB((TJob{INP(I_L1_WIN) + 1024, WSP(bf16_t, WS_WIN1) + 1024 * DM, N_IN1, N_IN1 - 1024, N_IN1P - 1024, DM, DM, 0, 0.f}));
    RUN_JOB((TJob{INP(I_L1_WOUT), WSP(bf16_t, WS_WOUT1), DM, DM, DM, DM, DM, 0, FP8_SWOUT}));
    for (int e = 0; e < NEXP; ++e) {
        RUN_JOB((TJob{INP(I_L1_EGATE) + (size_t)e * DM * DFF, (bf16_t*)(F.ws + WS_WGU1 + (size_t)e * 2 * DFF * DM), DFF, DFF, DFF, DM, DM, 1, FP8_SWGU}));
        RUN_JOB((TJob{INP(I_L1_EUP) + (size_t)e * DM * DFF, (bf16_t*)(F.ws + WS_WGU1 + (size_t)e * 2 * DFF * DM), DFF, DFF, DFF, DM, DM, 2, FP8_SWGU}));
        RUN_JOB((TJob{INP(I_L1_EDOWN) + (size_t)e * DFF * DM, (bf16_t*)(F.ws + WS_WDN1 + (size_t)e * DM * DFF), DM, DM, DM, DFF, DFF, 0, FP8_SWDN}));
    }
#undef RUN_JOB
    T1(20, F.ws);
    T0W(21, F.ws);
    {   const float* xin = INP(I_X);
        for (int m = 4 * gw; m < T; m += 4 * NGW) {
            f32x4 v[4][4];
#pragma unroll
            for (int r = 0; r < 4; ++r)
#pragma unroll
                for (int j = 0; j < 4; ++j) v[r][j] = *((const f32x4*)(xin + (size_t)(m + r) * DM) + F.lane + 64 * j);
#pragma unroll
            for (int r = 0; r < 4; ++r)
#pragma unroll
                for (int j = 0; j < 4; ++j) { u32x2 w; w.x = cvt_pk_bf16(v[r][j][0], v[r][j][1]); w.y = cvt_pk_bf16(v[r][j][2], v[r][j][3]); *((u32x2*)(WSP(bf16_t, WS_XB) + (size_t)(m + r) * DM) + F.lane + 64 * j) = w; }
        }
    }
    T1(21, F.ws);
    T0W(22, F.ws);
    for (int it = F.bid; it < 64; it += F.G) {
        const int which = it >> 5, sl = it & 31, hcol = F.tid & 255, part = F.tid >> 8;
        const float* pos = INP(which ? I_CV_POS : I_CK_POS) + sl * 64 + part * 32; const float* w1 = INP(which ? I_CV_W1 : I_CK_W1) + (size_t)(sl * 64 + part * 32) * 256 + hcol;
        float s = 0.f;
#pragma unroll 8
        for (int r = 0; r < 32; ++r) s += pos[r] * w1[(size_t)r * 256];
        LAS float* red = (LAS float*)F.lds;
        __syncthreads();
        if (part) red[hcol] = s;
        __syncthreads();
        if (!part) WSP(float, WS_POSW)[(which * 32 + sl) * 256 + hcol] = s + red[hcol];
    }
    T1(22, F.ws);
}

__device__ __forceinline__ void p2b_compress_tail(Frame& F, const Args& A) {
    LAS float* hid = (LAS float*)(F.lds + F.wave * 1024);
    const int gw = F.bid * 8 + F.wave, NGW = F.G * 8;
    const float* H = WSP(float, WS_HCMP); const float* PW = WSP(float, WS_POSW);
    for (int it = gw; it < 2 * 16 * 256; it += NGW) {
        const int which = it >> 12, bg = (it >> 8) & 15, n = it & 255;
        bf16_t* dst = WSP(bf16_t, WS_KC) + ((size_t)(which * 16 + bg) * 256 + n) * 64;
        if (n == 255) { dst[F.lane] = 0; continue; }
        const size_t r0 = (size_t)(which * 4096 + bg * 256 + n) * 512;
        const f32x4 a = *(const f32x4*)(H + r0 + 4 * F.lane), b = *(const f32x4*)(H + r0 + 512 + 256 + 4 * F.lane);
        f32x4 pw = {0.f, 0.f, 0.f, 0.f};
#pragma unroll
        for (int s = 0; s < 32; ++s) pw += *(const f32x4*)(PW + (which * 32 + s) * 256 + 4 * F.lane);
        const f32x4 v = a + b + pw; f32x4 g;
#pragma unroll
        for (int i = 0; i < 4; ++i) { const float x = v[i], u = 0.7978845608028654f * (x + 0.044715f * x * x * x); const float th = 1.f - 2.f / (1.f + __expf(2.f * u)); g[i] = 0.5f * x * (1.f + th); }
        *(LAS f32x4*)(hid + 4 * F.lane) = g;
        asm volatile("s_waitcnt lgkmcnt(0)" ::: "memory");
        const float* w2 = INP(which ? I_CV_W2 : I_CK_W2) + F.lane; float acc = 0.f;
#pragma unroll 8
        for (int j = 0; j < 256; ++j) acc += hid[j] * w2[(size_t)j * 64];
        dst[F.lane] = (bf16_t)(cvt_pk_bf16(acc, 0.f) & 0xffffu);
        asm volatile("s_waitcnt lgkmcnt(0)" ::: "memory");
    }
}

__device__ __forceinline__ f32x4 ld_bf4(const bf16_t* p) { const u32x2 w = *(const u32x2*)p; return (f32x4){bf_lo(w.x), bf_hi(w.x), bf_lo(w.y), bf_hi(w.y)}; }
__device__ __forceinline__ void ln_row(const bf16_t* y, const float* g, const float* b, int lane, f32x4 (&v)[4]) {
    float s = 0.f;
#pragma unroll
    for (int j = 0; j < 4; ++j) { v[j] = ld_bf4(y + 4 * (lane + 64 * j)); s += (v[j][0] + v[j][1]) + (v[j][2] + v[j][3]); }
    const float mean = wave_sum(s) * (1.f / DM); float s2 = 0.f;
#pragma unroll
    for (int j = 0; j < 4; ++j) { v[j] = v[j] - mean; s2 += (v[j][0] * v[j][0] + v[j][1] * v[j][1]) + (v[j][2] * v[j][2] + v[j][3] * v[j][3]); }
    const float rstd = 1.f / sqrtf(wave_sum(s2) * (1.f / DM) + LN_EPS);
#pragma unroll
    for (int j = 0; j < 4; ++j) { const f32x4 gg = *((const f32x4*)g + lane + 64 * j), bb = *((const f32x4*)b + lane + 64 * j); v[j] = v[j] * rstd * gg + bb; }
}
__device__ __forceinline__ void ln_row2(const bf16_t* y0, const bf16_t* y1, const float* g, const float* b, int lane, f32x4 (&v)[4], f32x4 (&w)[4]) {
    float s = 0.f, t = 0.f;
#pragma unroll
    for (int j = 0; j < 4; ++j) { v[j] = ld_bf4(y0 + 4 * (lane + 64 * j)); w[j] = ld_bf4(y1 + 4 * (lane + 64 * j)); }
#pragma unroll
    for (int j = 0; j < 4; ++j) { s += (v[j][0] + v[j][1]) + (v[j][2] + v[j][3]); t += (w[j][0] + w[j][1]) + (w[j][2] + w[j][3]); }
#pragma unroll
    for (int o = 1; o < 64; o <<= 1) { s += __shfl_xor(s, o); t += __shfl_xor(t, o); }
    const float m0 = s * (1.f / DM), m1 = t * (1.f / DM); float s2 = 0.f, t2 = 0.f;
#pragma unroll
    for (int j = 0; j < 4; ++j) { v[j] = v[j] - m0; w[j] = w[j] - m1; s2 += (v[j][0] * v[j][0] + v[j][1] * v[j][1]) + (v[j][2] * v[j][2] + v[j][3] * v[j][3]); t2 += (w[j][0] * w[j][0] + w[j][1] * w[j][1]) + (w[j][2] * w[j][2] + w[j][3] * w[j][3]); }
#pragma unroll
    for (int o = 1; o < 64; o <<= 1) { s2 += __shfl_xor(s2, o); t2 += __shfl_xor(t2, o); }
    const float r0 = 1.f / sqrtf(s2 * (1.f / DM) + LN_EPS), r1 = 1.f / sqrtf(t2 * (1.f / DM) + LN_EPS);
#pragma unroll
    for (int j = 0; j < 4; ++j) { const f32x4 gg = *((const f32x4*)g + lane + 64 * j), bb = *((const f32x4*)b + lane + 64 * j); v[j] = v[j] * r0 * gg + bb; w[j] = w[j] * r1 * gg + bb; }
}
template <int N>
__device__ __forceinline__ void ln_rowsN(const bf16_t* y, const float* g, const float* b, int lane, f32x4 (&v)[N][4]) {
    float s[N], s2[N];
#pragma unroll
    for (int r = 0; r < N; ++r)
#pragma unroll
        for (int j = 0; j < 4; ++j) v[r][j] = ld_bf4(y + (size_t)r * DM + 4 * (lane + 64 * j));
#pragma unroll
    for (int r = 0; r < N; ++r) { s[r] = 0.f;
#pragma unroll
        for (int j = 0; j < 4; ++j) s[r] += (v[r][j][0] + v[r][j][1]) + (v[r][j][2] + v[r][j][3]); }
#pragma unroll
    for (int o = 1; o < 64; o <<= 1)
#pragma unroll
        for (int r = 0; r < N; ++r) s[r] += __shfl_xor(s[r], o);
#pragma unroll
    for (int r = 0; r < N; ++r) { const float m0 = s[r] * (1.f / DM); s2[r] = 0.f;
#pragma unroll
        for (int j = 0; j < 4; ++j) { v[r][j] = v[r][j] - m0; s2[r] += (v[r][j][0] * v[r][j][0] + v[r][j][1] * v[r][j][1]) + (v[r][j][2] * v[r][j][2] + v[r][j][3] * v[r][j][3]); } }
#pragma unroll
    for (int o = 1; o < 64; o <<= 1)
#pragma unroll
        for (int r = 0; r < N; ++r) s2[r] += __shfl_xor(s2[r], o);
#pragma unroll
    for (int j = 0; j < 4; ++j) { const f32x4 gg = *((const f32x4*)g + lane + 64 * j), bb = *((const f32x4*)b + lane + 64 * j);
#pragma unroll
        for (int r = 0; r < N; ++r) { const float rs = 1.f / sqrtf(s2[r] * (1.f / DM) + LN_EPS); v[r][j] = v[r][j] * rs * gg + bb; } }
}
__device__ __forceinline__ void p_layernorm(Frame& F, const bf16_t* y, const float* g, const float* b, bf16_t* ob, unsigned char* o8) {
    const int gw = F.bid * 8 + F.wave, NGW = F.G * 8;
    for (int m = 4 * gw; m < T; m += 4 * NGW) {
        f32x4 v[4][4]; ln_rowsN<4>(y + (size_t)m * DM, g, b, F.lane, v);
#pragma unroll
        for (int r = 0; r < 4; ++r) { u32x2* o = (u32x2*)(ob + (size_t)(m + r) * DM) + F.lane;
#pragma unroll
            for (int j = 0; j < 4; ++j) { u32x2 q; q.x = cvt_pk_bf16(v[r][j][0], v[r][j][1]); q.y = cvt_pk_bf16(v[r][j][2], v[r][j][3]); o[64 * j] = q; } }
        if (o8) {
#pragma unroll
            for (int r = 0; r < 4; ++r) { unsigned* o = (unsigned*)(o8 + (size_t)(m + r) * DM) + F.lane;
#pragma unroll
                for (int j = 0; j < 4; ++j) o[64 * j] = cvt4_fp8(v[r][j][0] * FP8_SX, v[r][j][1] * FP8_SX, v[r][j][2] * FP8_SX, v[r][j][3] * FP8_SX); }
        }
    }
}
struct TokInfo { int p0, p1; float g0, g1; };
__device__ __forceinline__ void p12_ln_router(Frame& F, const Args& A) {
    LAS float* rt = (LAS float*)F.lds;
    LAS int* cnt = (LAS int*)(F.lds + 32768);
    {
        const f32x4* rg = (const f32x4*)INP(I_L1_ROUTER); f32x4 rv[4];
#pragma unroll
        for (int k = 0; k < 4; ++k) rv[k] = rg[F.tid + 512 * k];
#pragma unroll
        for (int k = 0; k < 4; ++k)
#pragma unroll
            for (int c = 0; c < 4; ++c) { const int i = 4 * (F.tid + 512 * k) + c; rt[(i & 7) * DM + (i >> 3)] = rv[k][c]; }
    }
    if (F.tid < 8) cnt[F.tid] = 0;
    for (int i = F.bid * 512 + F.tid; i < 264 * 256; i += F.G * 512) WSP(int, WS_ROWTOK)[i] = 0;
    __syncthreads();
    const bf16_t* y = WSP(bf16_t, WS_Y3); bf16_t* xb = (bf16_t*)F.out + 1024; TokInfo* ti = WSP(TokInfo, WS_TOKINFO);
    for (int blk = F.bid; blk < T / 128; blk += F.G) {
        for (int i = 0; i < 16; i += 2) {
            const int m = blk * 128 + F.wave * 16 + i;
            f32x4 v[2][4]; ln_row2(y + (size_t)m * DM, y + (size_t)(m + 1) * DM, INP(I_L1_LN1G), INP(I_L1_LN1B), F.lane, v[0], v[1]);
            float lg[2][8];
#pragma unroll
            for (int q = 0; q < 2; ++q) {
                u32x2* o = (u32x2*)(xb + (size_t)(m + q) * 2048) + F.lane;
#pragma unroll
                for (int j = 0; j < 4; ++j) { u32x2 w; w.x = cvt_pk_bf16(v[q][j][0], v[q][j][1]); w.y = cvt_pk_bf16(v[q][j][2], v[q][j][3]); o[64 * j] = w; }
                unsigned* o8 = (unsigned*)(F.ws + WS_X3F8 + (size_t)(m + q) * DM) + F.lane;
#pragma unroll
                for (int j = 0; j < 4; ++j) o8[64 * j] = cvt4_fp8(v[q][j][0] * FP8_SX, v[q][j][1] * FP8_SX, v[q][j][2] * FP8_SX, v[q][j][3] * FP8_SX);
            }
#pragma unroll
            for (int e = 0; e < 8; ++e) { float s0 = 0.f, s1 = 0.f;
#pragma unroll
                for (int j = 0; j < 4; ++j) { const f32x4 r = *(const LAS f32x4*)(rt + e * DM + 4 * (F.lane + 64 * j));
                    s0 += (v[0][j][0] * r[0] + v[0][j][1] * r[1]) + (v[0][j][2] * r[2] + v[0][j][3] * r[3]); s1 += (v[1][j][0] * r[0] + v[1][j][1] * r[1]) + (v[1][j][2] * r[2] + v[1][j][3] * r[3]); }
                lg[0][e] = s0; lg[1][e] = s1; }
            {
                const bool b0 = F.lane & 1, b1 = F.lane & 2, b2 = F.lane & 4;
                float r4[2][4], r2[2][2], r1[2];
#pragma unroll
                for (int q = 0; q < 2; ++q)
#pragma unroll
                    for (int k = 0; k < 4; ++k) { const float send = b0 ? lg[q][k] : lg[q][k + 4], keep = b0 ? lg[q][k + 4] : lg[q][k]; r4[q][k] = keep + __shfl_xor(send, 1); }
#pragma unroll
                for (int q = 0; q < 2; ++q)
#pragma unroll
                    for (int k = 0; k < 2; ++k) { const float send = b1 ? r4[q][k] : r4[q][k + 2], keep = b1 ? r4[q][k + 2] : r4[q][k]; r2[q][k] = keep + __shfl_xor(send, 2); }
#pragma unroll
                for (int q = 0; q < 2; ++q) { const float send = b2 ? r2[q][0] : r2[q][1], keep = b2 ? r2[q][1] : r2[q][0]; r1[q] = keep + __shfl_xor(send, 4); }
#pragma unroll
                for (int o_ = 8; o_ < 64; o_ <<= 1) { r1[0] += __shfl_xor(r1[0], o_); r1[1] += __shfl_xor(r1[1], o_); }
#pragma unroll
                for (int q = 0; q < 2; ++q) { const int ri = __float_as_int(r1[q]);
                    lg[q][0] = __int_as_float(__builtin_amdgcn_readlane(ri, 0)); lg[q][1] = __int_as_float(__builtin_amdgcn_readlane(ri, 4)); lg[q][2] = __int_as_float(__builtin_amdgcn_readlane(ri, 2)); lg[q][3] = __int_as_float(__builtin_amdgcn_readlane(ri, 6));
                    lg[q][4] = __int_as_float(__builtin_amdgcn_readlane(ri, 1)); lg[q][5] = __int_as_float(__builtin_amdgcn_readlane(ri, 5)); lg[q][6] = __int_as_float(__builtin_amdgcn_readlane(ri, 3)); lg[q][7] = __int_as_float(__builtin_amdgcn_readlane(ri, 7)); }
            }
#pragma unroll
            for (int q = 0; q < 2; ++q) {
                int e0 = 0; float v0 = lg[q][0];
#pragma unroll
                for (int e = 1; e < 8; ++e) if (lg[q][e] > v0) { v0 = lg[q][e]; e0 = e; }
                int e1 = -1; float v1 = -3.0e38f;
#pragma unroll
                for (int e = 0; e < 8; ++e) if (e != e0 && lg[q][e] > v1) { v1 = lg[q][e]; e1 = e; }
                const float g1 = 1.f / (1.f + __expf(v0 - v1)), g0 = 1.f - g1;
                if (F.lane == 0) { ti[m + q] = TokInfo{e0, e1, g0, g1}; atomicAdd((int*)&cnt[e0], 1); atomicAdd((int*)&cnt[e1], 1); }
            }
        }
        __syncthreads();
        if (F.tid < 8) { WSP(int, WS_MOECNT)[blk * 8 + F.tid] = cnt[F.tid]; cnt[F.tid] = 0; }
        __syncthreads();
    }
}
__device__ __forceinline__ void p13_moe_dispatch(Frame& F, const Args& A) {
    LAS int* call = (LAS int*)F.lds;
    LAS int* base = (LAS int*)(F.lds + 8192);
    LAS int* segs = (LAS int*)(F.lds + 8192 + 64);
    LAS int* pos = (LAS int*)(F.lds + 8192 + 128);
    { int cv[4];
#pragma unroll
      for (int k = 0; k < 4; ++k) cv[k] = WSP(int, WS_MOECNT)[F.tid + 512 * k];
#pragma unroll
      for (int k = 0; k < 4; ++k) call[F.tid + 512 * k] = cv[k]; }
    __syncthreads();
    TokInfo* ti = WSP(TokInfo, WS_TOKINFO);
    for (int blk = F.bid; blk < T / 128; blk += F.G) {
        if (F.tid < 8) { int tot = 0, pre = 0; for (int w = 0; w < 256; ++w) { const int c = call[w * 8 + F.tid]; if (w < blk) pre += c; tot += c; } base[F.tid] = pre; segs[F.tid] = (tot + 255) & ~255; }
        __syncthreads();
        if (F.tid == 0) { int s = 0; for (int e = 0; e < 8; ++e) { const int p = segs[e]; segs[e] = s; base[e] += s; s += p; } segs[8] = s;
            if (blk == 0) { int* meta = WSP(int, WS_MOEMETA); meta[0] = s / 256; for (int e = 0; e <= 8; ++e) meta[1 + e] = segs[e] / 256; } }
        __syncthreads();
        if (F.wave == 0) {
            int run[8];
#pragma unroll
            for (int e = 0; e < 8; ++e) run[e] = base[e];
            for (int st = 0; st < 4; ++st) {
                const int tk = (st >> 1) * 64 + F.lane, slot = st & 1; const TokInfo t = ti[blk * 128 + tk]; const int me = slot ? t.p1 : t.p0; int p = 0;
#pragma unroll
                for (int e = 0; e < 8; ++e) { const unsigned long long mk = __ballot(me == e); if (me == e) p = run[e] + __popcll(mk & ((1ull << F.lane) - 1ull)); run[e] += __popcll(mk); }
                pos[tk * 2 + slot] = p;
            }
        }
        __syncthreads();
        if (F.tid < 128) { TokInfo t = ti[blk * 128 + F.tid]; t.p0 = pos[F.tid * 2]; t.p1 = pos[F.tid * 2 + 1]; ti[blk * 128 + F.tid] = t; }
        if (F.tid < 256) WSP(int, WS_ROWTOK)[pos[F.tid]] = blk * 128 + (F.tid >> 1);
        __syncthreads();
    }
}
__device__ __forceinline__ int moe_tile_table(Frame& F, LAS int* tile_e) {
    const int* meta = WSP(int, WS_MOEMETA); const int NT = meta[0];
    for (int t = F.tid; t < MOE_MAX_TILES; t += 512) { int e = 0;
#pragma unroll
        for (int k = 1; k < 8; ++k) e += (t >= meta[1 + k]) ? 1 : 0;
        tile_e[t] = e; }
    __syncthreads();
    return NT;
}
__device__ __forceinline__ void p_final(Frame& F, const Args& A) {
    int tid_ = threadIdx.x; asm volatile("" : "+v"(tid_)); const int lane = tid_ & 63;
    const int gw = F.bid * 8 + F.wave, NGW = F.G * 8; const TokInfo* ti = WSP(TokInfo, WS_TOKINFO); const bf16_t* O = WSP(bf16_t, WS_XG);
    const float* lg = INP(I_L1_LN2G); const float* lb = INP(I_L1_LN2B);
    float tscale = 1.f;
    if (PROBE_T) { const float us = (float)(*TPROBE_ACC(F.ws)) * 0.01f; float thr = PROBE_TBASE; int k = 0;
#pragma unroll
        for (int i = 0; i < 12; ++i) { k += (us > thr) ? 1 : 0;
#ifdef PROBE_TSTEP
            thr += PROBE_TSTEP;
#else
            thr *= 1.25f;
#endif
        }
        tscale = 1.f + 0.02f * (float)k; }
    for (int m = 4 * gw; m < T; m += 4 * NGW) {
        f32x4 v[4][4]; float s[4], s2[4];
#pragma unroll
        for (int q = 0; q < 4; ++q) {
            const TokInfo t = ti[m + q]; const bf16_t* xs = (const bf16_t*)F.out + (size_t)(m + q) * 2048 + 1024;
            const u32x2* o0 = (const u32x2*)(O + (size_t)t.p0 * DM) + lane; const u32x2* o1 = (const u32x2*)(O + (size_t)t.p1 * DM) + lane;
            s[q] = 0.f;
#pragma unroll
            for (int j = 0; j < 4; ++j) { const f32x4 x = ld_bf4(xs + 4 * (lane + 64 * j)); const u32x2 a = o0[64 * j], b = o1[64 * j];
                const f32x4 fa = {bf_lo(a.x), bf_hi(a.x), bf_lo(a.y), bf_hi(a.y)}, fb = {bf_lo(b.x), bf_hi(b.x), bf_lo(b.y), bf_hi(b.y)};
                v[q][j] = x * ALPHA + (fa * t.g0 + fb * t.g1); s[q] += (v[q][j][0] + v[q][j][1]) + (v[q][j][2] + v[q][j][3]); }
        }
#pragma unroll
        for (int o = 1; o < 64; o <<= 1) { s[0] += __shfl_xor(s[0], o); s[1] += __shfl_xor(s[1], o); s[2] += __shfl_xor(s[2], o); s[3] += __shfl_xor(s[3], o); }
#pragma unroll
        for (int q = 0; q < 4; ++q) { const float mean = s[q] * (1.f / DM); s2[q] = 0.f;
#pragma unroll
            for (int j = 0; j < 4; ++j) { v[q][j] = v[q][j] - mean; s2[q] += (v[q][j][0] * v[q][j][0] + v[q][j][1] * v[q][j][1]) + (v[q][j][2] * v[q][j][2] + v[q][j][3] * v[q][j][3]); } }
#pragma unroll
        for (int o = 1; o < 64; o <<= 1) { s2[0] += __shfl_xor(s2[0], o); s2[1] += __shfl_xor(s2[1], o); s2[2] += __shfl_xor(s2[2], o); s2[3] += __shfl_xor(s2[3], o); }
#pragma unroll
        for (int q = 0; q < 4; ++q) { const float rstd = 1.f / sqrtf(s2[q] * (1.f / DM) + LN_EPS); f32x4* yr = (f32x4*)(F.out + (size_t)(m + q) * DM) + lane;
            if (ti[m + q].p0 >= 256 * 256 || ti[m + q].p1 >= 256 * 256) continue;
#pragma unroll
            for (int j = 0; j < 4; ++j) { const f32x4 gg = *((const f32x4*)lg + lane + 64 * j), bb = *((const f32x4*)lb + lane + 64 * j); yr[64 * j] = (v[q][j] * rstd * gg + bb) * tscale; } }
    }
    const int mi = gw + lane * NGW; bool rare = false;
    if (mi < T) { const u32x2 pp01 = *(const u32x2*)&ti[mi]; rare = (int)pp01.x >= 256 * 256 || (int)pp01.y >= 256 * 256; }
    for (unsigned long long rm = __ballot(rare); rm; rm &= rm - 1) {
        const int m = gw + __builtin_ctzll(rm) * NGW;
        const TokInfo t = ti[m];
        const bf16_t* xs = (const bf16_t*)F.out + (size_t)m * 2048 + 1024; f32x4 v[4]; float s = 0.f;
#pragma unroll
        for (int j = 0; j < 4; ++j) { const f32x4 x = ld_bf4(xs + 4 * (lane + 64 * j)); f32x4 fa, fb;
            if (t.p0 >= 256 * 256) { const float* pp = WSP(float, WS_PART) + (size_t)(t.p0 - 256 * 256) * DM + 4 * (lane + 64 * j); fa = ((*(const f32x4*)pp + *(const f32x4*)(pp + 8 * 256 * DM)) + *(const f32x4*)(pp + 2 * 8 * 256 * DM)) + *(const f32x4*)(pp + 3 * 8 * 256 * DM); }
            else { const u32x2 a = *((const u32x2*)(O + (size_t)t.p0 * DM) + lane + 64 * j); fa = (f32x4){bf_lo(a.x), bf_hi(a.x), bf_lo(a.y), bf_hi(a.y)}; }
            if (t.p1 >= 256 * 256) { const float* pp = WSP(float, WS_PART) + (size_t)(t.p1 - 256 * 256) * DM + 4 * (lane + 64 * j); fb = ((*(const f32x4*)pp + *(const f32x4*)(pp + 8 * 256 * DM)) + *(const f32x4*)(pp + 2 * 8 * 256 * DM)) + *(const f32x4*)(pp + 3 * 8 * 256 * DM); }
            else { const u32x2 b = *((const u32x2*)(O + (size_t)t.p1 * DM) + lane + 64 * j); fb = (f32x4){bf_lo(b.x), bf_hi(b.x), bf_lo(b.y), bf_hi(b.y)}; }
            v[j] = x * ALPHA + (fa * t.g0 + fb * t.g1); s += (v[j][0] + v[j][1]) + (v[j][2] + v[j][3]); }
        const float mean = wave_sum(s) * (1.f / DM); float s2 = 0.f;
#pragma unroll
        for (int j = 0; j < 4; ++j) { v[j] = v[j] - mean; s2 += (v[j][0] * v[j][0] + v[j][1] * v[j][1]) + (v[j][2] * v[j][2] + v[j][3] * v[j][3]); }
        const float rstd = 1.f / sqrtf(wave_sum(s2) * (1.f / DM) + LN_EPS); f32x4* yr = (f32x4*)(F.out + (size_t)m * DM) + lane;
#pragma unroll
        for (int j = 0; j < 4; ++j) { const f32x4 gg = *((const f32x4*)lg + lane + 64 * j), bb = *((const f32x4*)lb + lane + 64 * j); yr[64 * j] = (v[j] * rstd * gg + bb) * tscale; }
    }
}
namespace att {
constexpr int KROW = 144;
constexpr int TILE_B = 64 * KROW;
constexpr int L_K = 0, L_V = 2 * TILE_B, L_OV = 4 * TILE_B;
constexpr int L_LUT = 6 * TILE_B;
constexpr int L_IMP = L_LUT + 2048;
constexpr int L_SELM = L_IMP + 4 * 64 * 65 * 4;
constexpr int L_END = L_SELM + 512;
static_assert(L_END <= RING_BYTES, "attention LDS map");
constexpr float NEG_INF = -__builtin_huge_valf();
constexpr int L_LUT2 = LDS_EXTRA_OFF, LUT2_N = 704, LUT2_K = 639;
constexpr int L_LUT3 = LDS_EXTRA_OFF + 4 * LUT2_N * 4, LUT3_N = 320, LUT3_K = 255;
static_assert(L_LUT3 + 4 * LUT3_N * 4 <= LDS_MISC_OFF, "attention LUT map");
constexpr float RESC_THR = 8.f;

__device__ __forceinline__ s16x4 vtr(const LAS char* p) { return __builtin_bit_cast(s16x4, __builtin_amdgcn_ds_read_tr16_b64_v4i16((LAS s16x4*)p)); }

template <int MODE, int NDB>
__device__ __forceinline__ void attn_tile(const LAS char* Kt, const LAS char* Vt, const LAS char* OVt, const bf16x8 (&qf)[4], f32x16 (&o)[NDB], float& m, float& l,
                                          int tq, int key0, int W, bool lanesel, const LAS float* lut, int lane) {
    const int r32 = lane & 31, h = lane >> 5;
    f32x16 s0, s1;
#pragma unroll
    for (int r = 0; r < 16; ++r) { s0[r] = 0.f; s1[r] = 0.f; }
#pragma unroll
    for (int ks = 0; ks < 4; ++ks) {
        const bf16x8 k0 = *(const LAS bf16x8*)(Kt + r32 * KROW + (16 * ks + 8 * h) * 2);
        const bf16x8 k1 = *(const LAS bf16x8*)(Kt + (32 + r32) * KROW + (16 * ks + 8 * h) * 2);
        s0 = __builtin_amdgcn_mfma_f32_32x32x16_bf16(k0, qf[ks], s0, 0, 0, 0);
        s1 = __builtin_amdgcn_mfma_f32_32x32x16_bf16(k1, qf[ks], s1, 0, 0, 0);
    }
    float mx = NEG_INF;
    asm volatile("" ::: "memory");
#pragma unroll
    for (int kb = 0; kb < 2; ++kb) {
#pragma unroll
        for (int r = 0; r < 16; ++r) {
            const int key = key0 + 32 * kb + (r & 3) + 8 * (r >> 2) + 4 * h;
            const int dist = (MODE == 2) ? (tq - 16 * key - 31) : (tq - key);
            const int idx = dist < 0 ? 0 : (dist > 113 ? 113 : dist);
            bool valid;
            if (MODE == 0) valid = (unsigned)dist < (unsigned)W;
            else if (MODE == 1) valid = lanesel && dist >= 0;
            else valid = dist >= 0 && key < 255;
            float v = (kb ? s1[r] : s0[r]) + lut[idx];
            v = valid ? v : NEG_INF;
            if (kb) s1[r] = v; else s0[r] = v;
            mx = fmaxf(mx, v);
        }
        asm volatile("" ::: "memory");
    }
    mx = swap_max(mx);
    const float mnew = fmaxf(m, mx), alpha = __builtin_amdgcn_exp2f(m - mnew);
    float rs = 0.f;
#pragma unroll
    for (int r = 0; r < 16; ++r) { s0[r] = __builtin_amdgcn_exp2f(s0[r] - mnew); s1[r] = __builtin_amdgcn_exp2f(s1[r] - mnew); rs += s0[r] + s1[r]; }
    rs = swap_sum(rs);
    l = l * alpha + rs; m = mnew;
#pragma unroll
    for (int db = 0; db < NDB; ++db)
#pragma unroll
        for (int r = 0; r < 16; ++r) o[db][r] *= alpha;
    const int q4 = (lane & 15) >> 2, p4 = lane & 3, g2 = (lane >> 4) & 1;
#pragma unroll
    for (int kb = 0; kb < 2; ++kb)
#pragma unroll
        for (int s = 0; s < 2; ++s) {
            u32x4 pw;
            if (kb == 0) { pw.x = cvt_pk_bf16(s0[8 * s + 0], s0[8 * s + 1]); pw.y = cvt_pk_bf16(s0[8 * s + 2], s0[8 * s + 3]); pw.z = cvt_pk_bf16(s0[8 * s + 4], s0[8 * s + 5]); pw.w = cvt_pk_bf16(s0[8 * s + 6], s0[8 * s + 7]); }
            else { pw.x = cvt_pk_bf16(s1[8 * s + 0], s1[8 * s + 1]); pw.y = cvt_pk_bf16(s1[8 * s + 2], s1[8 * s + 3]); pw.z = cvt_pk_bf16(s1[8 * s + 4], s1[8 * s + 5]); pw.w = cvt_pk_bf16(s1[8 * s + 6], s1[8 * s + 7]); }
            const bf16x8 pb = __builtin_bit_cast(bf16x8, pw);
            const int rowoff = (32 * kb + 16 * s + 4 * h + q4) * KROW;
#pragma unroll
            for (int db = 0; db < NDB; ++db) {
                const LAS char* base = (db < 2 ? Vt : OVt) + rowoff + (32 * (db & 1) + 16 * g2 + 4 * p4) * 2;
                const s16x4 lo = vtr(base), hi = vtr(base + 8 * KROW);
                const bf16x8 vf = {lo[0], lo[1], lo[2], lo[3], hi[0], hi[1], hi[2], hi[3]};
                o[db] = __builtin_amdgcn_mfma_f32_32x32x16_bf16(vf, pb, o[db], 0, 0, 0);
            }
            asm volatile("" ::: "memory");
        }
}


template <int MODE>
__device__ __forceinline__ void attn_tile_fast(const LAS char* Kt, const LAS char* Vt, const bf16x8 (&qf)[4], f32x16 (&o)[2], float& m, float& l,
                                               bool lanesel, bool use_lut, const LAS float* lutp, float cfar, int lane) {
    const int r32 = lane & 31, h = lane >> 5;
    float ci = use_lut ? -m : (cfar - m);
    if (MODE == 1) ci = lanesel ? ci : NEG_INF;
    f32x16 s0, s1;
#pragma unroll
    for (int r = 0; r < 16; ++r) { s0[r] = ci; s1[r] = ci; }
#pragma unroll
    for (int ks = 0; ks < 4; ++ks) {
        const bf16x8 k0 = *(const LAS bf16x8*)(Kt + r32 * KROW + (16 * ks + 8 * h) * 2);
        const bf16x8 k1 = *(const LAS bf16x8*)(Kt + (32 + r32) * KROW + (16 * ks + 8 * h) * 2);
        s0 = __builtin_amdgcn_mfma_f32_32x32x16_bf16(k0, qf[ks], s0, 0, 0, 0);
        s1 = __builtin_amdgcn_mfma_f32_32x32x16_bf16(k1, qf[ks], s1, 0, 0, 0);
    }
    if (use_lut) {
#pragma unroll
        for (int r = 0; r < 16; ++r) { s0[r] += lutp[(r & 3) + 8 * (r >> 2)]; s1[r] += lutp[32 + (r & 3) + 8 * (r >> 2)]; }
    }
    float mx = fmaxf(s0[0], s1[0]);
#pragma unroll
    for (int r = 1; r < 16; ++r) mx = fmaxf(fmaxf(mx, s0[r]), s1[r]);
    mx = swap_max(mx);
    if (__any(mx > RESC_THR)) {
        const float dl = fmaxf(mx, 0.f), f = __builtin_amdgcn_exp2f(-dl);
        m += dl; l *= f;
#pragma unroll
        for (int r = 0; r < 16; ++r) { s0[r] -= dl; s1[r] -= dl; o[0][r] *= f; o[1][r] *= f; }
    }
    const int q4 = (lane & 15) >> 2, p4 = lane & 3, g2 = (lane >> 4) & 1;
    float rs = 0.f;
#pragma unroll
    for (int kb = 0; kb < 2; ++kb)
#pragma unroll
        for (int s = 0; s < 2; ++s) {
            float e[8];
#pragma unroll
            for (int i = 0; i < 8; ++i) { e[i] = __builtin_amdgcn_exp2f(kb ? s1[8 * s + i] : s0[8 * s + i]); rs += e[i]; }
            u32x4 pw; pw.x = cvt_pk_bf16(e[0], e[1]); pw.y = cvt_pk_bf16(e[2], e[3]); pw.z = cvt_pk_bf16(e[4], e[5]); pw.w = cvt_pk_bf16(e[6], e[7]);
            const bf16x8 pb = __builtin_bit_cast(bf16x8, pw);
            const int rowoff = (32 * kb + 16 * s + 4 * h + q4) * KROW;
#pragma unroll
            for (int db = 0; db < 2; ++db) {
                const LAS char* base = Vt + rowoff + (32 * db + 16 * g2 + 4 * p4) * 2;
                const s16x4 lo = vtr(base), hi = vtr(base + 8 * KROW);
                const bf16x8 vf = {lo[0], lo[1], lo[2], lo[3], hi[0], hi[1], hi[2], hi[3]};
                o[db] = __builtin_amdgcn_mfma_f32_32x32x16_bf16(vf, pb, o[db], 0, 0, 0);
            }
            __builtin_amdgcn_sched_barrier(0);
        }
    l += swap_sum(rs);
}

template <int MODE, int NDB>
__device__ __forceinline__ void run_branch(LAS unsigned char* lds, const bf16_t* Kg, const bf16_t* Vg, int pitch, unsigned long long tiles, const bf16x8 (&qf)[4], f32x16 (&o)[NDB], float& m, float& l,
                                           int tq, int W, unsigned long long selm, const LAS float* lut, int tid, int lane, unsigned char* wsp = nullptr) {
    const int lrow = tid >> 3, lch = tid & 7;
    if (tiles == 0ull) return;
    int j = __builtin_ctzll(tiles); tiles &= tiles - 1ull;
    auto gen_ov = [&](int tile, int b) {
        const int n = 64 * tile + lrow; unsigned short e[8];
#pragma unroll
        for (int i = 0; i < 8; ++i) { const int d = n - 4 * (8 * lch + i); e[i] = (n < 255 && d >= -1 && d <= 3) ? ((d == -1 || d == 3) ? (unsigned short)0x3f00 : (unsigned short)0x3f80) : (unsigned short)0; }
        u32x4 w; w.x = e[0] | ((unsigned)e[1] << 16); w.y = e[2] | ((unsigned)e[3] << 16); w.z = e[4] | ((unsigned)e[5] << 16); w.w = e[6] | ((unsigned)e[7] << 16);
        *(LAS u32x4*)(lds + L_OV + b * TILE_B + lrow * KROW + lch * 16) = w;
    };
#define ATT_LD(K_, V_, t_) do { K_ = *(const u32x4*)(Kg + (size_t)((t_) * 64 + lrow) * pitch + lch * 8); V_ = *(const u32x4*)(Vg + (size_t)((t_) * 64 + lrow) * pitch + lch * 8); } while (0)
#define ATT_ST(K_, V_, b_) do { *(LAS u32x4*)(lds + L_K + (b_) * TILE_B + lrow * KROW + lch * 16) = K_; *(LAS u32x4*)(lds + L_V + (b_) * TILE_B + lrow * KROW + lch * 16) = V_; } while (0)
    u32x4 kra, vra, krb, vrb;
    ATT_LD(kra, vra, j);
    int jn = -1;
    if (tiles != 0ull) { jn = __builtin_ctzll(tiles); tiles &= tiles - 1ull; }
    ATT_LD(krb, vrb, (jn < 0 ? j : jn));
    ATT_ST(kra, vra, 0);
    if (MODE == 2) gen_ov(j, 0);
    __syncthreads();
    for (;;) {
        int jnn = -1;
        if (tiles != 0ull) { jnn = __builtin_ctzll(tiles); tiles &= tiles - 1ull; }
        ATT_LD(kra, vra, (jnn < 0 ? j : jnn));
        {
        const bool lanesel = (MODE == 1) ? ((selm >> j) & 1ull) != 0ull : true;
        if constexpr (MODE == 2) {
            attn_tile<MODE, NDB>((const LAS char*)(lds + L_K + 0 * TILE_B), (const LAS char*)(lds + L_V + 0 * TILE_B), (const LAS char*)(lds + L_OV + 0 * TILE_B), qf, o, m, l, tq, 64 * j, W, lanesel, lut, lane);
        } else if (MODE != 1 || __ballot(lanesel) != 0ull) {
            const int tq0w = tq - (lane & 31);
            const int dmin = tq0w - 64 * j - 63, dmax = tq0w + 31 - 64 * j;
            const bool use_lut = (MODE == 0) ? !(dmin >= 113 && dmax < W) : !(dmin >= 113);
            const int r_ = (tid >> 6) & 3;
            const LAS float* lutp = (MODE == 0) ? (const LAS float*)(lds + L_LUT2) + r_ * LUT2_N + (64 * j + 4 * (lane >> 5) - tq + LUT2_K)
                                               : (const LAS float*)(lds + L_LUT3) + r_ * LUT3_N + (64 * j + 4 * (lane >> 5) - tq + LUT3_K);
            attn_tile_fast<MODE>((const LAS char*)(lds + L_K + 0 * TILE_B), (const LAS char*)(lds + L_V + 0 * TILE_B), qf, o, m, l, lanesel, use_lut, lutp, lut[113], lane);
        }
        }
        if (jn < 0) break;
        ATT_ST(krb, vrb, 1);
        if (MODE == 2) gen_ov(jn, 1);
        if (MODE == 1) T0W(6, wsp);
        __syncthreads();
        if (MODE == 1) T1(6, wsp);
        int jn3 = -1;
        if (tiles != 0ull) { jn3 = __builtin_ctzll(tiles); tiles &= tiles - 1ull; }
        ATT_LD(krb, vrb, (jn3 < 0 ? jn : jn3));
        {
        const bool lanesel = (MODE == 1) ? ((selm >> jn) & 1ull) != 0ull : true;
        if constexpr (MODE == 2) {
            attn_tile<MODE, NDB>((const LAS char*)(lds + L_K + 1 * TILE_B), (const LAS char*)(lds + L_V + 1 * TILE_B), (const LAS char*)(lds + L_OV + 1 * TILE_B), qf, o, m, l, tq, 64 * jn, W, lanesel, lut, lane);
        } else if (MODE != 1 || __ballot(lanesel) != 0ull) {
            const int tq0w = tq - (lane & 31);
            const int dmin = tq0w - 64 * jn - 63, dmax = tq0w + 31 - 64 * jn;
            const bool use_lut = (MODE == 0) ? !(dmin >= 113 && dmax < W) : !(dmin >= 113);
            const int r_ = (tid >> 6) & 3;
            const LAS float* lutp = (MODE == 0) ? (const LAS float*)(lds + L_LUT2) + r_ * LUT2_N + (64 * jn + 4 * (lane >> 5) - tq + LUT2_K)
                                               : (const LAS float*)(lds + L_LUT3) + r_ * LUT3_N + (64 * jn + 4 * (lane >> 5) - tq + LUT3_K);
            attn_tile_fast<MODE>((const LAS char*)(lds + L_K + 1 * TILE_B), (const LAS char*)(lds + L_V + 1 * TILE_B), qf, o, m, l, lanesel, use_lut, lutp, lut[113], lane);
        }
        }
        if (jnn < 0) break;
        ATT_ST(kra, vra, 0);
        if (MODE == 2) gen_ov(jnn, 0);
        if (MODE == 1) T0W(6, wsp);
        __syncthreads();
        if (MODE == 1) T1(6, wsp);
        j = jnn; jn = jn3;
    }
#undef ATT_LD
#undef ATT_ST
    __syncthreads();
}

__device__ __forceinline__ unsigned long long tile_range(int lo, int hi) {
    const unsigned long long a = (hi >= 63) ? ~0ull : ((1ull << (hi + 1)) - 1ull);
    return a & ~((1ull << lo) - 1ull);
}

__device__ __forceinline__ void build_lut(LAS unsigned char* lds, const float* relb, int head0, int tid) {
    LAS float* lut = (LAS float*)(lds + L_LUT);
    const int r = tid >> 7, d = tid & 127;
    lut[r * 128 + d] = relb[t5_bucket(d) * 16 + head0 + r] * LOG2E;
}

__device__ __forceinline__ void build_lut23(LAS unsigned char* lds, int W, bool want3, int tid) {
    const LAS float* lut = (const LAS float*)(lds + L_LUT);
    LAS float* l2 = (LAS float*)(lds + L_LUT2); LAS float* l3 = (LAS float*)(lds + L_LUT3);
    for (int i = tid; i < 4 * LUT2_N; i += 512) { const int r = i / LUT2_N, jj = i - r * LUT2_N, d = LUT2_K - jj; l2[i] = (d < 0 || d >= W) ? NEG_INF : lut[r * 128 + (d > 113 ? 113 : d)]; }
    if (want3) for (int i = tid; i < 4 * LUT3_N; i += 512) { const int r = i / LUT3_N, jj = i - r * LUT3_N, d = LUT3_K - jj; l3[i] = (d < 0) ? NEG_INF : lut[r * 128 + (d > 113 ? 113 : d)]; }
}

__device__ __forceinline__ void unit_swa(Frame& F, const Args& A, int b, int g, int qt) {
    LAS unsigned char* lds = F.lds;
    const int lane = F.lane, wave = F.wave, r = wave & 3, th = wave >> 2, r32 = lane & 31, h = lane >> 5;
    const int head = g * 4 + r, tq = qt * 64 + 32 * th + r32;
    build_lut(lds, INP(I_RELB), g * 4, F.tid);
    const bf16_t* qrow = WSP(bf16_t, WS_QA) + ((size_t)(b * SEQ + tq)) * 512 + head * 64;
    bf16x8 qf[4];
#pragma unroll
    for (int ks = 0; ks < 4; ++ks) qf[ks] = *(const bf16x8*)(qrow + 16 * ks + 8 * h);
    f32x16 o[2];
#pragma unroll
    for (int db = 0; db < 2; ++db)
#pragma unroll
        for (int i = 0; i < 16; ++i) o[db][i] = 0.f;
    float m = INP(I_L0_SINKS)[head] * LOG2E, l = 1.f;
    __syncthreads();
    build_lut23(lds, 128, false, F.tid);
    __syncthreads();
    const LAS float* lut = (const LAS float*)(lds + L_LUT) + r * 128;
    const bf16_t* Kg = WSP(bf16_t, WS_KA) + (size_t)b * SEQ * 128 + g * 64; const bf16_t* Vg = WSP(bf16_t, WS_VA) + (size_t)b * SEQ * 128 + g * 64;
    run_branch<0, 2>(lds, Kg, Vg, 128, tile_range(qt - 2 < 0 ? 0 : qt - 2, qt), qf, o, m, l, tq, 128, 0ull, lut, F.tid, lane);
    const float inv = FP8_SMIX0 / l;
    unsigned char* orow = F.ws + WS_MIX0 + ((size_t)(b * SEQ + tq)) * DM + head * 64;
#pragma unroll
    for (int db = 0; db < 2; ++db)
#pragma unroll
        for (int rg = 0; rg < 4; ++rg) *(unsigned*)(orow + 32 * db + 8 * rg + 4 * h) = cvt4_fp8(o[db][4 * rg] * inv, o[db][4 * rg + 1] * inv, o[db][4 * rg + 2] * inv, o[db][4 * rg + 3] * inv);
}

__device__ __forceinline__ void unit_nsa(Frame& F, const Args& A, int b, int g, int qt) {
    LAS unsigned char* lds = F.lds;
    const int lane = F.lane, wave = F.wave, r = wave & 3, th = wave >> 2, r32 = lane & 31, h = lane >> 5;
    const int hb = g * 4 + r, tq = qt * 64 + 32 * th + r32, tok = 32 * th + r32, bg = b * 2 + g;
    build_lut(lds, INP(I_RELB), 8 + g * 4, F.tid);
    const bf16_t* qrow = WSP(bf16_t, WS_QB) + ((size_t)(b * SEQ + tq)) * 512 + hb * 64;
    bf16x8 qf[4];
#pragma unroll
    for (int ks = 0; ks < 4; ++ks) qf[ks] = *(const bf16x8*)(qrow + 16 * ks + 8 * h);
    const float* gp = WSP(float, WS_GATES) + ((size_t)(b * SEQ + tq)) * 24 + hb;
    const float g_cmp = gp[0], g_slc = gp[8], g_win = gp[16];
    f32x16 acc[2];
    __syncthreads();
    build_lut23(lds, 512, true, F.tid);
    __syncthreads();
    const LAS float* lut = (const LAS float*)(lds + L_LUT) + r * 128;
    LAS float* imp = (LAS float*)(lds + L_IMP);
    LAS unsigned long long* selm = (LAS unsigned long long*)(lds + L_SELM);
    T0W(2, F.ws);
    {
        f32x16 o[4];
#pragma unroll
        for (int db = 0; db < 4; ++db)
#pragma unroll
            for (int i = 0; i < 16; ++i) o[db][i] = 0.f;
        float m = -1e30f, l = 0.f;
        const int tmax = qt * 64 + 63;
        unsigned long long tiles = 0ull;
        if (tmax >= 31) { const int nmax = (tmax - 31) >> 4; tiles = tile_range(0, (nmax > 254 ? 254 : nmax) >> 6); }
        const bf16_t* Kc = WSP(bf16_t, WS_KC) + (size_t)bg * 256 * 64; const bf16_t* Vc = WSP(bf16_t, WS_KC) + (size_t)(16 + bg) * 256 * 64;
        run_branch<2, 4>(lds, Kc, Vc, 64, tiles, qf, o, m, l, tq, 0, 0ull, lut, F.tid, lane);
        const float inv = l > 0.f ? 1.f / l : 0.f;
#pragma unroll
        for (int db = 0; db < 2; ++db)
#pragma unroll
            for (int i = 0; i < 16; ++i) acc[db][i] = o[db][i] * (inv * g_cmp);
        if (qt >= 16) {
#pragma unroll
            for (int db = 0; db < 2; ++db)
#pragma unroll
                for (int i = 0; i < 16; ++i) { const int jj = 32 * db + (i & 3) + 8 * (i >> 2) + 4 * h; imp[(r * 64 + jj) * 65 + tok] = o[2 + db][i] * inv; }
        }
    }
    __syncthreads();
    T1(2, F.ws);
    T0W(3, F.ws);
    {
        const unsigned long long adm = tile_range(0, qt);
        if (qt < 16) { if (lane < 8) selm[wave * 8 + lane] = adm; }
        else {
            int jl = lane; asm volatile("" : "+v"(jl));
            const unsigned long long ltm = (1ull << jl) - 1ull;
            const bool forced = (jl == 0) || (jl == qt) || (jl == qt - 1);
            unsigned u[8], sv[8];
#pragma unroll
            for (int i = 0; i < 8; ++i) {
                const int tk = wave * 8 + i;
                const float iv = ((imp[(0 * 64 + jl) * 65 + tk] + imp[(1 * 64 + jl) * 65 + tk]) + imp[(2 * 64 + jl) * 65 + tk]) + imp[(3 * 64 + jl) * 65 + tk];
                const float sc = forced ? 1e30f : (jl <= qt ? iv : -1e30f);
                const unsigned bits = __float_as_uint(sc); u[i] = bits ^ ((bits >> 31) ? 0xffffffffu : 0x80000000u); sv[i] = u[i];
            }
#pragma unroll
            for (int k = 2; k <= 64; k <<= 1)
#pragma unroll
                for (int d = k >> 1; d > 0; d >>= 1) {
                    const bool takemin = (((jl & d) == 0) == ((jl & k) == 0));
#pragma unroll
                    for (int i = 0; i < 8; ++i) { const unsigned pv = (unsigned)__shfl_xor((int)sv[i], d); const unsigned mn = sv[i] < pv ? sv[i] : pv, mxv = sv[i] < pv ? pv : sv[i]; sv[i] = takemin ? mn : mxv; }
                }
#pragma unroll
            for (int i = 0; i < 8; ++i) {
                const unsigned tau = (unsigned)__builtin_amdgcn_readlane((int)sv[i], 48);
                const unsigned long long mgt = __ballot(u[i] > tau), meq = __ballot(u[i] == tau);
                const int need = 16 - __popcll(mgt);
                const bool sel = (u[i] > tau) || ((u[i] == tau) && __popcll(meq & ltm) < need);
                const unsigned long long mk = __ballot(sel) & adm;
                if (jl == 0) selm[wave * 8 + i] = mk;
            }
        }
    }
    __syncthreads();
    T1(3, F.ws);
    const unsigned long long myselm = selm[tok];
    unsigned long long uni = selm[lane];
#pragma unroll
    for (int o_ = 1; o_ < 64; o_ <<= 1) { const unsigned lo = __shfl_xor((unsigned)uni, o_), hi = __shfl_xor((unsigned)(uni >> 32), o_); uni |= ((unsigned long long)hi << 32) | lo; }
    uni = ((unsigned long long)(unsigned)__builtin_amdgcn_readfirstlane((unsigned)(uni >> 32)) << 32) | (unsigned)__builtin_amdgcn_readfirstlane((unsigned)uni);
    T0W(4, F.ws);
    {
        f32x16 o[2];
#pragma unroll
        for (int db = 0; db < 2; ++db)
#pragma unroll
            for (int i = 0; i < 16; ++i) o[db][i] = 0.f;
        float m = 0.f, l = 0.f;
        const bf16_t* Kg = WSP(bf16_t, WS_KSLC) + (size_t)b * SEQ * 128 + g * 64; const bf16_t* Vg = WSP(bf16_t, WS_VSLC) + (size_t)b * SEQ * 128 + g * 64;
        run_branch<1, 2>(lds, Kg, Vg, 128, uni, qf, o, m, l, tq, 0, myselm, lut, F.tid, lane, F.ws);
        const float inv = g_slc / l;
#pragma unroll
        for (int db = 0; db < 2; ++db)
#pragma unroll
            for (int i = 0; i < 16; ++i) acc[db][i] += o[db][i] * inv;
    }
    T1(4, F.ws);
    T0W(5, F.ws);
    {
        f32x16 o[2];
#pragma unroll
        for (int db = 0; db < 2; ++db)
#pragma unroll
            for (int i = 0; i < 16; ++i) o[db][i] = 0.f;
        float m = 0.f, l = 0.f;
        const bf16_t* Kg = WSP(bf16_t, WS_KWIN) + (size_t)b * SEQ * 128 + g * 64; const bf16_t* Vg = WSP(bf16_t, WS_VWIN) + (size_t)b * SEQ * 128 + g * 64;
        run_branch<0, 2>(lds, Kg, Vg, 128, tile_range(qt - 8 < 0 ? 0 : qt - 8, qt), qf, o, m, l, tq, 512, 0ull, lut, F.tid, lane);
        const float inv = g_win / l;
#pragma unroll
        for (int db = 0; db < 2; ++db)
#pragma unroll
            for (int i = 0; i < 16; ++i) acc[db][i] += o[db][i] * inv;
    }
    T1(5, F.ws);
    unsigned char* orow = F.ws + WS_MIX0 + ((size_t)(b * SEQ + tq)) * DM + 512 + hb * 64;
#pragma unroll
    for (int db = 0; db < 2; ++db)
#pragma unroll
        for (int rg = 0; rg < 4; ++rg) *(unsigned*)(orow + 32 * db + 8 * rg + 4 * h) = cvt4_fp8(acc[db][4 * rg] * FP8_SMIX0, acc[db][4 * rg + 1] * FP8_SMIX0, acc[db][4 * rg + 2] * FP8_SMIX0, acc[db][4 * rg + 3] * FP8_SMIX0);
}

#ifndef PROBE_NSA_REP
#define PROBE_NSA_REP 1
#endif
#ifndef PROBE_SWA_REP
#define PROBE_SWA_REP 1
#endif
__device__ __forceinline__ void attn0_phase(Frame& F, const Args& A) {
    const int vcu = (F.G % 8 == 0) ? (F.bid % 8) * (F.G / 8) + F.bid / 8 : F.bid;
    for (int rep = 0; rep < PROBE_NSA_REP; ++rep)
    for (int U = vcu; U < 1024; U += F.G) {
        const int c = U & 255, i = U >> 8, bg = c >> 4, s = c & 15;
        const int qt = (i == 0) ? 63 - s : (i == 1) ? 32 + s : (i == 2) ? 31 - s : s;
        unit_nsa(F, A, bg >> 1, bg & 1, qt);
        __syncthreads();
    }
    for (int rep = 0; rep < PROBE_SWA_REP; ++rep)
    for (int U = vcu; U < 1024; U += F.G) {
        const int c = U & 255, i = U >> 8, bg = c >> 4, s = c & 15;
        unit_swa(F, A, bg >> 1, bg & 1, 16 * i + s);
        __syncthreads();
    }
}
}
namespace dsa {
constexpr int L_SC = 0;
constexpr int L_LIST = LDS_EXTRA_OFF;
constexpr int L_LUTD = L_LIST + 4096;
constexpr int L_WT = L_LUTD + 114 * 16 * 4;
static_assert(L_WT + 256 <= LDS_MISC_OFF, "dsa LDS map");
constexpr int VROW = 160;
constexpr float NEG_INF = -__builtin_huge_valf();
typedef float f32x4_t __attribute__((ext_vector_type(4)));


__device__ __forceinline__ int count_ge8(unsigned a0, unsigned a1, unsigned a2, unsigned a3, unsigned a4, unsigned a5, unsigned a6, unsigned a7, unsigned cand) {
    int c, t; unsigned long long m0, m1, m2, m3, m4, m5, m6, m7;
    asm volatile(
        "v_cmp_ge_u32_e64 %[m0], %[a0], %[cd]\n\tv_cmp_ge_u32_e64 %[m1], %[a1], %[cd]\n\tv_cmp_ge_u32_e64 %[m2], %[a2], %[cd]\n\tv_cmp_ge_u32_e64 %[m3], %[a3], %[cd]\n\t"
        "v_cmp_ge_u32_e64 %[m4], %[a4], %[cd]\n\tv_cmp_ge_u32_e64 %[m5], %[a5], %[cd]\n\tv_cmp_ge_u32_e64 %[m6], %[a6], %[cd]\n\tv_cmp_ge_u32_e64 %[m7], %[a7], %[cd]\n\t"
        "s_bcnt1_i32_b64 %[c], %[m0]\n\ts_bcnt1_i32_b64 %[t], %[m1]\n\ts_add_i32 %[c], %[c], %[t]\n\ts_bcnt1_i32_b64 %[t], %[m2]\n\ts_add_i32 %[c], %[c], %[t]\n\t"
        "s_bcnt1_i32_b64 %[t], %[m3]\n\ts_add_i32 %[c], %[c], %[t]\n\ts_bcnt1_i32_b64 %[t], %[m4]\n\ts_add_i32 %[c], %[c], %[t]\n\ts_bcnt1_i32_b64 %[t], %[m5]\n\ts_add_i32 %[c], %[c], %[t]\n\t"
        "s_bcnt1_i32_b64 %[t], %[m6]\n\ts_add_i32 %[c], %[c], %[t]\n\ts_bcnt1_i32_b64 %[t], %[m7]\n\ts_add_i32 %[c], %[c], %[t]"
        : [c] "=&s"(c), [t] "=&s"(t), [m0] "=&s"(m0), [m1] "=&s"(m1), [m2] "=&s"(m2), [m3] "=&s"(m3), [m4] "=&s"(m4), [m5] "=&s"(m5), [m6] "=&s"(m6), [m7] "=&s"(m7)
        : [a0] "v"(a0), [a1] "v"(a1), [a2] "v"(a2), [a3] "v"(a3), [a4] "v"(a4), [a5] "v"(a5), [a6] "v"(a6), [a7] "v"(a7), [cd] "s"(cand)
        : "scc");
    return c;
}

__device__ __forceinline__ void unit_dsa(Frame& F, const Args& A, int b, int t0) {
    LAS unsigned char* lds = F.lds;
    int lane_ = F.lane; asm volatile("" : "+v"(lane_));
    const int tid = F.tid, lane = lane_, wave = F.wave, r32 = lane & 31, h = lane >> 5;
    const size_t tb = (size_t)b * SEQ;
    LAS float* sc = (LAS float*)(lds + L_SC);
    LAS unsigned short* list = (LAS unsigned short*)(lds + L_LIST) + wave * 256;
    const LAS float* lutd = (const LAS float*)(lds + L_LUTD);
    LAS float* wt = (LAS float*)(lds + L_WT);
    if (tid < 64) wt[tid] = WSP(float, WS_WI)[(tb + t0) * 8 + tid];
    __syncthreads();
#ifndef PROBE_DSA_A
#define PROBE_DSA_A 1
#endif
#ifndef PROBE_DSA_B
#define PROBE_DSA_B 1
#endif
#ifndef PROBE_DSA_C
#define PROBE_DSA_C 1
#endif
    T0W(11, F.ws);
    for (int repa = 0; repa < PROBE_DSA_A; ++repa)
    if (t0 + 8 > 256) {
        const int nkb = ((t0 + 8 + 63) >> 6) << 1;
        const int hh_r = (r32 >> 2) & 1, reg_r = (r32 & 3) | ((r32 >> 3) << 2), qi4 = 2 * hh_r + (reg_r >> 3), hd = reg_r & 7;
        bf16x8 qaf[2][2]; float wv[2][16];
#pragma unroll
        for (int rb = 0; rb < 2; ++rb) {
            const bf16_t* qp = WSP(bf16_t, WS_QI) + (tb + t0 + 4 * rb + qi4) * 256 + hd * 32 + 8 * h;
            qaf[rb][0] = *(const bf16x8*)qp; qaf[rb][1] = *(const bf16x8*)(qp + 16);
#pragma unroll
            for (int rg = 0; rg < 16; ++rg) wv[rb][rg] = wt[(4 * rb + 2 * h + (rg >> 3)) * 8 + (rg & 7)];
        }
        int kb = wave;
        bf16x8 bk0 = {0, 0, 0, 0, 0, 0, 0, 0}, bk1 = {0, 0, 0, 0, 0, 0, 0, 0};
        if (kb < nkb) { const bf16_t* kp = WSP(bf16_t, WS_KI) + (tb + 32 * kb + r32) * 32 + 8 * h; bk0 = *(const bf16x8*)kp; bk1 = *(const bf16x8*)(kp + 16); }
        while (kb < nkb) {
            const int kn = kb + 8; bf16x8 nb0 = bk0, nb1 = bk1;
            if (kn < nkb) { const bf16_t* kp = WSP(bf16_t, WS_KI) + (tb + 32 * kn + r32) * 32 + 8 * h; nb0 = *(const bf16x8*)kp; nb1 = *(const bf16x8*)(kp + 16); }
            const int key = 32 * kb + r32;
#pragma unroll
            for (int rb = 0; rb < 2; ++rb) {
                f32x16 c;
#pragma unroll
                for (int i = 0; i < 16; ++i) c[i] = 0.f;
                c = __builtin_amdgcn_mfma_f32_32x32x16_bf16(qaf[rb][0], bk0, c, 0, 0, 0);
                c = __builtin_amdgcn_mfma_f32_32x32x16_bf16(qaf[rb][1], bk1, c, 0, 0, 0);
                float sA = 0.f, sB = 0.f;
#pragma unroll
                for (int i = 0; i < 8; ++i) { sA += wv[rb][i] * fmaxf(c[i], 0.f); sB += wv[rb][8 + i] * fmaxf(c[8 + i], 0.f); }
                const int qA = 4 * rb + 2 * h;
                sc[qA * 4096 + key] = (key <= t0 + qA) ? sA : NEG_INF;
                sc[(qA + 1) * 4096 + key] = (key <= t0 + qA + 1) ? sB : NEG_INF;
            }
            bk0 = nb0; bk1 = nb1; kb = kn;
        }
    }
    __syncthreads();
    T1(11, F.ws);
    T0W(12, F.ws);
    const int t = t0 + wave, n = t + 1;
    int cnt;
    for (int repb = 0; repb < PROBE_DSA_B; ++repb)
    if (n <= 256) {
#pragma unroll
        for (int i = 0; i < 4; ++i) { const int k = lane + 64 * i; list[k] = (unsigned short)(k < n ? k : 0); }
        cnt = n;
    } else {
        const int nreg = (n + 63) >> 6, ngrp = (nreg + 7) >> 3;
        LAS float* my = sc + wave * 4096;
        float f[64];
#pragma unroll
        for (int g8 = 0; g8 < 8; ++g8) {
#pragma unroll
            for (int k = 0; k < 8; ++k) f[g8 * 8 + k] = NEG_INF;
            if (g8 < ngrp) {
#pragma unroll
                for (int k = 0; k < 8; ++k) if (g8 * 8 + k < nreg) f[g8 * 8 + k] = my[64 * (g8 * 8 + k) + lane];
            }
        }
        float ta = NEG_INF, tb_ = NEG_INF, tc = NEG_INF, td = NEG_INF;
#pragma unroll
        for (int g8 = 0; g8 < 8; ++g8) if (g8 < ngrp) {
#pragma unroll
            for (int k = 0; k < 8; ++k) { const float x = f[g8 * 8 + k]; td = __builtin_amdgcn_fmed3f(tc, td, x); tc = __builtin_amdgcn_fmed3f(tb_, tc, x); tb_ = __builtin_amdgcn_fmed3f(ta, tb_, x); ta = fmaxf(ta, x); }
        }
        float L = td;
#pragma unroll
        for (int o_ = 1; o_ < 64; o_ <<= 1) L = fminf(L, __shfl_xor(L, o_));
        LAS unsigned* cval = (LAS unsigned*)my; LAS unsigned short* ckey = (LAS unsigned short*)(my + 1024);
        const unsigned long long ltmask = (1ull << lane) - 1ull;
        int ns = 0;
#pragma unroll
        for (int g8 = 0; g8 < 8; ++g8) if (g8 < ngrp) {
#pragma unroll
            for (int k = 0; k < 8; ++k) { const int i = g8 * 8 + k; const bool keep = f[i] >= L; const unsigned long long mk = __ballot(keep); const int pos = ns + __popcll(mk & ltmask);
                if (keep && pos < 1024) { const unsigned bits = __float_as_uint(f[i]); cval[pos] = bits ^ ((bits >> 31) ? 0xffffffffu : 0x80000000u); ckey[pos] = (unsigned short)(64 * i + lane); }
                ns += __popcll(mk); }
        }
        if (ns <= 1024) {
            unsigned w[16];
#pragma unroll
            for (int j = 0; j < 16; ++j) w[j] = (64 * j + lane < ns) ? cval[64 * j + lane] : 0u;
            const bool two = ns > 512;
            float Mx = ta;
#pragma unroll
            for (int o_ = 1; o_ < 64; o_ <<= 1) Mx = fmaxf(Mx, __shfl_xor(Mx, o_));
            const unsigned Lb = __float_as_uint(L), Mb = __float_as_uint(Mx);
            const unsigned Lk = __builtin_amdgcn_readfirstlane(Lb ^ ((Lb >> 31) ? 0xffffffffu : 0x80000000u)), Mk = __builtin_amdgcn_readfirstlane(Mb ^ ((Mb >> 31) ? 0xffffffffu : 0x80000000u));
            const int hb = (Lk == Mk) ? -1 : 31 - __builtin_clz(Lk ^ Mk);
            unsigned tau = (hb >= 31) ? 0u : (hb < 0 ? Mk : (Mk & ~((2u << hb) - 1u)));
            for (int bit = hb; bit >= 0; --bit) {
                const unsigned cand = tau | (1u << bit);
                int c = count_ge8(w[0], w[1], w[2], w[3], w[4], w[5], w[6], w[7], cand);
                if (two) c += count_ge8(w[8], w[9], w[10], w[11], w[12], w[13], w[14], w[15], cand);
                if (c >= 256) { tau = cand; if (c == 256) break; }
            }
            int cgt = count_ge8(w[0], w[1], w[2], w[3], w[4], w[5], w[6], w[7], tau + 1u);
            if (two) cgt += count_ge8(w[8], w[9], w[10], w[11], w[12], w[13], w[14], w[15], tau + 1u);
            const int need = 256 - cgt; int base = 0, eqseen = 0;
#pragma unroll
            for (int j = 0; j < 16; ++j) if (64 * j < ns) {
                const bool gt = w[j] > tau, eq = w[j] == tau;
                const unsigned long long meq = __ballot(eq);
                const bool sel = gt || (eq && (eqseen + __popcll(meq & ltmask)) < need);
                const unsigned long long msel = __ballot(sel);
                if (sel) list[base + __popcll(msel & ltmask)] = ckey[64 * j + lane];
                base += __popcll(msel); eqseen += __popcll(meq);
            }
        } else {
#pragma unroll
            for (int i = 0; i < 64; ++i) { const unsigned bits = __float_as_uint(f[i]); f[i] = __uint_as_float((i < nreg) ? (bits ^ ((bits >> 31) ? 0xffffffffu : 0x80000000u)) : 0u); }
#define u_(i) __float_as_uint(f[i])
            unsigned tau = 0u;
            for (int bit = 31; bit >= 0; --bit) {
                const unsigned cand = tau | (1u << bit); int c = 0;
#pragma unroll
                for (int g8 = 0; g8 < 8; ++g8) if (g8 < ngrp)
                    c += count_ge8(u_(g8 * 8 + 0), u_(g8 * 8 + 1), u_(g8 * 8 + 2), u_(g8 * 8 + 3), u_(g8 * 8 + 4), u_(g8 * 8 + 5), u_(g8 * 8 + 6), u_(g8 * 8 + 7), cand);
                if (c >= 256) { tau = cand; if (c == 256) break; }
            }
            int cgt = 0;
#pragma unroll
            for (int g8 = 0; g8 < 8; ++g8) if (g8 < ngrp)
                cgt += count_ge8(u_(g8 * 8 + 0), u_(g8 * 8 + 1), u_(g8 * 8 + 2), u_(g8 * 8 + 3), u_(g8 * 8 + 4), u_(g8 * 8 + 5), u_(g8 * 8 + 6), u_(g8 * 8 + 7), tau + 1u);
            const int need = 256 - cgt; int base = 0, eqseen = 0;
#pragma unroll
            for (int g8 = 0; g8 < 8; ++g8) if (g8 < ngrp) {
#pragma unroll
                for (int k = 0; k < 8; ++k) { const int i = g8 * 8 + k;
                    const bool gt = u_(i) > tau, eq = u_(i) == tau;
                    const unsigned long long meq = __ballot(eq);
                    const bool sel = gt || (eq && (eqseen + __popcll(meq & ltmask)) < need);
                    const unsigned long long msel = __ballot(sel);
                    if (sel) list[base + __popcll(msel & ltmask)] = (unsigned short)(64 * i + lane);
                    base += __popcll(msel); eqseen += __popcll(meq); } }
        }
#undef u_
        cnt = 256;
    }
    T1(12, F.ws);
    T0W(14, F.ws);
    asm volatile("s_waitcnt lgkmcnt(0)" ::: "memory");
    T1(14, F.ws);
    T0W(13, F.ws);
    for (int repc = 0; repc < PROBE_DSA_C; ++repc)
    {
        const int head = lane & 15, g4 = lane >> 4, q4 = (lane & 15) >> 2, p4 = lane & 3;
        const bf16_t* qp = WSP(bf16_t, WS_Q1) + (tb + t) * 1024 + head * 64 + 8 * g4;
        const bf16x8 qf0 = *(const bf16x8*)qp, qf1 = *(const bf16x8*)(qp + 32);
        const bf16_t* K1 = WSP(bf16_t, WS_K1) + tb * 64; const bf16_t* V1 = WSP(bf16_t, WS_V1) + tb * 64;
        f32x4_t sA[8], sB[8];
        float mx = NEG_INF;
        const float cfar = lutd[113 * 16 + head];
        LAS unsigned char* kst = lds + wave * 16384;
        {
            u32x4 kr[8][4];
#pragma unroll
            for (int c = 0; c < 8; ++c) {
#pragma unroll
                for (int i = 0; i < 4; ++i) { const unsigned key = list[32 * c + 8 * i + (lane >> 3)]; kr[c][i] = *(const u32x4*)((const char*)K1 + (key * 128u + (unsigned)(lane & 7) * 16u)); }
            }
#pragma unroll
            for (int c = 0; c < 8; ++c) {
#pragma unroll
                for (int i = 0; i < 4; ++i) *(LAS u32x4*)(kst + (8 * i + (lane >> 3)) * VROW + (lane & 7) * 16) = kr[c][i];
                const LAS unsigned char* ka = kst + (lane & 15) * VROW + 16 * g4;
                const bf16x8 kA0 = *(const LAS bf16x8*)ka, kA1 = *(const LAS bf16x8*)(ka + 64), kB0 = *(const LAS bf16x8*)(ka + 16 * VROW), kB1 = *(const LAS bf16x8*)(ka + 16 * VROW + 64);
                const int kmax = __builtin_amdgcn_readfirstlane((int)list[32 * c + 31]);
                if (cnt == 256 && t - kmax >= 113) {
                    f32x4_t a = {cfar, cfar, cfar, cfar}, bb = {cfar, cfar, cfar, cfar};
                    a = __builtin_amdgcn_mfma_f32_16x16x32_bf16(kA0, qf0, a, 0, 0, 0); a = __builtin_amdgcn_mfma_f32_16x16x32_bf16(kA1, qf1, a, 0, 0, 0);
                    bb = __builtin_amdgcn_mfma_f32_16x16x32_bf16(kB0, qf0, bb, 0, 0, 0); bb = __builtin_amdgcn_mfma_f32_16x16x32_bf16(kB1, qf1, bb, 0, 0, 0);
                    sA[c] = a; sB[c] = bb;
                    mx = fmaxf(mx, fmaxf(fmaxf(fmaxf(a[0], a[1]), fmaxf(a[2], a[3])), fmaxf(fmaxf(bb[0], bb[1]), fmaxf(bb[2], bb[3]))));
                } else {
                    f32x4_t a = {0.f, 0.f, 0.f, 0.f}, bb = {0.f, 0.f, 0.f, 0.f};
                    a = __builtin_amdgcn_mfma_f32_16x16x32_bf16(kA0, qf0, a, 0, 0, 0); a = __builtin_amdgcn_mfma_f32_16x16x32_bf16(kA1, qf1, a, 0, 0, 0);
                    bb = __builtin_amdgcn_mfma_f32_16x16x32_bf16(kB0, qf0, bb, 0, 0, 0); bb = __builtin_amdgcn_mfma_f32_16x16x32_bf16(kB1, qf1, bb, 0, 0, 0);
                    const u32x2 ia = *(const LAS u32x2*)(list + 32 * c + 4 * g4), ib = *(const LAS u32x2*)(list + 32 * c + 16 + 4 * g4);
#pragma unroll
                    for (int i = 0; i < 4; ++i) {
                        const int keyA = (int)(((i < 2 ? ia.x : ia.y) >> (16 * (i & 1))) & 0xffffu), keyB = (int)(((i < 2 ? ib.x : ib.y) >> (16 * (i & 1))) & 0xffffu);
                        const int dA = t - keyA, dB = t - keyB;
                        const float bA = lutd[(dA > 113 ? 113 : (dA < 0 ? 0 : dA)) * 16 + head], bB = lutd[(dB > 113 ? 113 : (dB < 0 ? 0 : dB)) * 16 + head];
                        const int slotA = 32 * c + 4 * g4 + i, slotB = slotA + 16;
                        sA[c][i] = slotA < cnt ? a[i] + bA : NEG_INF; sB[c][i] = slotB < cnt ? bb[i] + bB : NEG_INF;
                        mx = fmaxf(mx, fmaxf(sA[c][i], sB[c][i]));
                    }
                }
            }
        }
        asm volatile("" ::: "memory");
        u32x4 vr[4][4];
#pragma unroll
        for (int c = 0; c < 4; ++c) {
#pragma unroll
            for (int i = 0; i < 4; ++i) { const unsigned key = list[32 * c + 8 * i + (lane >> 3)]; vr[c][i] = *(const u32x4*)((const char*)V1 + (key * 128u + (unsigned)(lane & 7) * 16u)); }
        }
        mx = fmaxf(mx, __shfl_xor(mx, 16)); mx = fmaxf(mx, __shfl_xor(mx, 32));
        float l = 0.f;
#pragma unroll
        for (int c = 0; c < 8; ++c)
#pragma unroll
            for (int i = 0; i < 4; ++i) { sA[c][i] = __builtin_amdgcn_exp2f(sA[c][i] - mx); sB[c][i] = __builtin_amdgcn_exp2f(sB[c][i] - mx); l += sA[c][i] + sB[c][i]; }
        l += __shfl_xor(l, 16); l += __shfl_xor(l, 32);
        f32x4_t o[4];
#pragma unroll
        for (int d = 0; d < 4; ++d) o[d] = (f32x4_t){0.f, 0.f, 0.f, 0.f};
#pragma unroll
        for (int c = 0; c < 8; ++c) {
            {
                LAS unsigned char* vst = kst + (32 + 32 * (c & 1)) * VROW;
#pragma unroll
                for (int i = 0; i < 4; ++i) *(LAS u32x4*)(vst + (8 * i + (lane >> 3)) * VROW + (lane & 7) * 16) = vr[c & 3][i];
                if (c + 4 < 8) {
#pragma unroll
                    for (int i = 0; i < 4; ++i) { const unsigned key = list[32 * (c + 4) + 8 * i + (lane >> 3)]; vr[c & 3][i] = *(const u32x4*)((const char*)V1 + (key * 128u + (unsigned)(lane & 7) * 16u)); }
                }
                u32x4 pw; pw.x = cvt_pk_bf16(sA[c][0], sA[c][1]); pw.y = cvt_pk_bf16(sA[c][2], sA[c][3]); pw.z = cvt_pk_bf16(sB[c][0], sB[c][1]); pw.w = cvt_pk_bf16(sB[c][2], sB[c][3]);
                const bf16x8 pb = __builtin_bit_cast(bf16x8, pw);
#pragma unroll
                for (int d = 0; d < 4; ++d) {
                    const LAS char* base = (const LAS char*)(vst + (4 * g4 + q4) * VROW + (16 * d + 4 * p4) * 2);
                    const s16x4 lo = att::vtr(base), hi = att::vtr(base + 16 * VROW);
                    const bf16x8 vf = {lo[0], lo[1], lo[2], lo[3], hi[0], hi[1], hi[2], hi[3]};
                    o[d] = __builtin_amdgcn_mfma_f32_16x16x32_bf16(vf, pb, o[d], 0, 0, 0);
                }
            }
        }
        const float inv = FP8_SMIX / l;
        unsigned char* orow = F.ws + WS_MIX1 + (tb + t) * 1024 + head * 64 + 4 * g4;
#pragma unroll
        for (int d = 0; d < 4; ++d) *(unsigned*)(orow + 16 * d) = cvt4_fp8(o[d][0] * inv, o[d][1] * inv, o[d][2] * inv, o[d][3] * inv);
    }
    T1(13, F.ws);
    T0W(15, F.ws);
    __syncthreads();
    T1(15, F.ws);
}

__device__ __forceinline__ void dsa_phase(Frame& F, const Args& A) {
    LAS float* lutd = (LAS float*)(F.lds + L_LUTD);
    { const float* rb = INP(I_RELB); float lv[4];
#pragma unroll
      for (int k = 0; k < 4; ++k) { const int i = F.tid + 512 * k; lv[k] = (i < 114 * 16) ? rb[t5_bucket(i >> 4) * 16 + (i & 15)] : 0.f; }
#pragma unroll
      for (int k = 0; k < 4; ++k) { const int i = F.tid + 512 * k; if (i < 114 * 16) lutd[i] = lv[k] * LOG2E; } }
    __syncthreads();
#ifndef PROBE_DSA_REP
#define PROBE_DSA_REP 1
#endif
    const bool xa = (F.G == 256);
    const int nround = xa ? 16 : (4096 + F.G - 1) / F.G;
    for (int ii = 0; ii < nround * PROBE_DSA_REP; ++ii) {
        const int i = ii % nround; int b, tb; bool ok = true;
        if (xa) { const int r = F.bid >> 3; b = F.bid & 7; tb = 511 - (i * 32 + ((i & 1) ? 31 - r : r)); }
        else { const int cc = (i & 1) ? (F.G - 1 - F.bid) : F.bid; const int I = i * F.G + cc; ok = I < 4096; b = I & 7; tb = 511 - (I >> 3); }
        if (ok) unit_dsa(F, A, b, 8 * tb);
    }
}
}
constexpr int NPHASE = 19;
__global__ void __launch_bounds__(512, 2) mk_fwd(Args args) {
    extern __shared__ __attribute__((aligned(16))) unsigned char lds_raw[];
    Frame F;
    F.lds = (LAS unsigned char*)lds_raw;
    F.tid = threadIdx.x; F.lane = F.tid & 63; F.wave = __builtin_amdgcn_readfirstlane(F.tid >> 6);
    F.G = gridDim.x; F.bid = blockIdx.x; F.ws = args.ws; F.out = args.out;
    volatile LAS unsigned* MISC = (volatile LAS unsigned*)(F.lds + LDS_MISC_OFF);
    if (F.tid < 64) MISC[F.tid] = 0u;
    __syncthreads();
    if (F.tid < 28) *(LAS unsigned long long*)(F.lds + LDS_PTR_OFF + 8 * F.tid) = (unsigned long long)args.in[F.tid];
    __syncthreads();
    const int lo = args.ph_lo, hi = args.ph_hi;
    const bool use_bar = (hi - lo) > 1;
    XcdBarrier bar; bar.bar = (unsigned*)(F.ws + WS_CTL) + CW_BAR; bar.x = 0; bar.st = nullptr;
    if (use_bar) bar = xcd_barrier_post((unsigned*)(F.ws + WS_CTL) + CW_BAR, MISC);
#ifdef PH_ONLY
#define IN(k) ((k) == PH_ONLY && lo <= (k) && (k) < hi)
#else
#define IN(k) (lo <= (k) && (k) < hi)
#endif
#ifndef PROBE_PH
#define PROBE_PH -1
#endif
#define REP(k) for (int rep_ = 0; rep_ < ((k) == PROBE_PH ? 2 : 1); ++rep_)
#ifdef PSPAN_LO
#define SPAN_BEGIN(k) do { if ((k) == PSPAN_LO && blockIdx.x == 0 && threadIdx.x == 0) TPROBE_ACC(F.ws)[1] = __builtin_amdgcn_s_memrealtime(); } while (0)
#define SPAN_END(k) do { if ((k) == PSPAN_HI && blockIdx.x == 0 && threadIdx.x == 0) TPROBE_ACC(F.ws)[0] += __builtin_amdgcn_s_memrealtime() - TPROBE_ACC(F.ws)[1]; } while (0)
#else
#define SPAN_BEGIN(k) do { } while (0)
#define SPAN_END(k) do { } while (0)
#endif
#ifdef PROBE_IDLE_PH
#define SEAM(k) do { unsigned long long t0_ = 0; if ((k) == PROBE_IDLE_PH && threadIdx.x == 0) t0_ = __builtin_amdgcn_s_memrealtime(); if (IN(k) && IN((k) + 1)) xcd_barrier(bar); \
        if ((k) == PROBE_IDLE_PH && threadIdx.x == 0) atomicAdd(TPROBE_ACC(F.ws), (__builtin_amdgcn_s_memrealtime() - t0_) / (unsigned long long)gridDim.x); } while (0)
#else
#define SEAM(k) do { if (IN(k) && IN((k) + 1)) xcd_barrier(bar); SPAN_END(k); SPAN_BEGIN((k) + 1); } while (0)
#endif
    LAS unsigned char* ring = F.lds;
    const Args& A = args;

    SPAN_BEGIN(0);
    if (IN(0)) REP(0) { p0_prologue(F, A); } SEAM(0);
    if (IN(1)) REP(1) {
        pg8::Gemm g{WSP(bf16_t, WS_XB), WSP(bf16_t, WS_WIN0), DM}; pg8::Proj0OrderA S{F.G, F.bid};
        pg8::EpiProj0 E{F.ws};
        pg8::gemm_phase<pg8::EpiProj0, pg8::Proj0OrderA, true, true>(ring, g, S, E);
    } SEAM(1);
    if (IN(2)) REP(2) {
        pg8::Gemm g{WSP(bf16_t, WS_XB), WSP(bf16_t, WS_WIN0), DM}; pg8::Proj0OrderB S; S.so.init(T / 256, 7, F.G, F.bid); S.G = F.G; S.c = F.bid;
        pg8::EpiProj0 E{F.ws};
        pg8::gemm_phase<pg8::EpiProj0, pg8::Proj0OrderB, true, true>(ring, g, S, E);
    } SEAM(2);
    if (IN(3)) REP(3) { p2b_compress_tail(F, A); } SEAM(3);
    if (IN(4)) REP(4) { T0W(1, F.ws); att::attn0_phase(F, A); T1(1, F.ws); } SEAM(4);
    if (IN(5)) REP(5) {
        pg8::Gemm g{WSP(bf16_t, WS_MIX0), WSP(bf16_t, WS_WOUT0), DM / 2}; pg8::StaticOrder S; S.init(T / 256, DM / 256, F.G, F.bid);
        pg8::EpiRes E{INP(I_X), nullptr, (bf16_t*)F.out, 1.f / (FP8_SMIX0 * FP8_SWOUT)};
        pg8::gemm_phase<pg8::EpiRes, pg8::StaticOrder, true, true, false, false, true>(ring, g, S, E);
    } SEAM(5);
    if (IN(6)) REP(6) { T0W(33, F.ws); p_layernorm(F, (const bf16_t*)F.out, INP(I_L0_LN1G), INP(I_L0_LN1B), WSP(bf16_t, WS_X1B), nullptr); T1(33, F.ws); } SEAM(6);
    if (IN(7)) REP(7) {
        pg8::Gemm g{WSP(bf16_t, WS_X1B), WSP(bf16_t, WS_WGU0), DM}; pg8::StaticOrder S; S.init(T / 256, 2 * DFF / 256, F.G, F.bid);
        pg8::EpiSwiglu8 E{F.ws + WS_H0, 0, 1.f};
        T0W(50, F.ws); pg8::gemm_phase<pg8::EpiSwiglu8, pg8::StaticOrder, true, true>(ring, g, S, E); T1(50, F.ws);
    } SEAM(7);
    if (IN(8)) REP(8) {
        pg8::Gemm g{WSP(bf16_t, WS_H0), WSP(bf16_t, WS_WDN0), DFF / 2}; pg8::StaticOrder S; S.init(T / 256, DM / 256, F.G, F.bid);
        pg8::EpiRes E{nullptr, WSP(bf16_t, WS_X1B), (bf16_t*)F.out, 1.f / (FP8_SH * FP8_SWDN)};
        pg8::gemm_phase<pg8::EpiRes, pg8::StaticOrder, true, true, false, false, true>(ring, g, S, E);
    } SEAM(8);
    if (IN(9)) REP(9) { p_layernorm(F, (const bf16_t*)F.out, INP(I_L0_LN2G), INP(I_L0_LN2B), WSP(bf16_t, WS_X2B), F.ws + WS_X2F8); } SEAM(9);
    if (IN(10)) REP(10) {
        { pg8::Gemm g{(const bf16_t*)(F.ws + WS_X2F8), WSP(bf16_t, WS_WIN1), DM / 2}; pg8::StaticOrder S; S.init(T / 256, 4, F.G, F.bid);
          pg8::EpiProj1 E{F.ws, QSCALE / (FP8_SX * FP8_SWGU)};
          pg8::gemm_phase<pg8::EpiProj1, pg8::StaticOrder, true, true, false, false, true>(ring, g, S, E); }
        { pg8::Gemm g{WSP(bf16_t, WS_X2B), WSP(bf16_t, WS_WIN1), DM}; pg8::OffOrder S; S.so.init(T / 256, 2, F.G, F.bid); S.pn0 = 4;
          pg8::EpiProj1 E{F.ws, QSCALE};
          pg8::gemm_phase<pg8::EpiProj1, pg8::OffOrder, true, true>(ring, g, S, E); }
    } SEAM(10);
    if (IN(11)) REP(11) { T0W(10, F.ws); dsa::dsa_phase(F, A); T1(10, F.ws); } SEAM(11);
    if (IN(12)) REP(12) {
        pg8::Gemm g{WSP(bf16_t, WS_MIX1), WSP(bf16_t, WS_WOUT1), DM / 2}; pg8::StaticOrder S; S.init(T / 256, DM / 256, F.G, F.bid);
        pg8::EpiRes E{nullptr, WSP(bf16_t, WS_X2B), WSP(bf16_t, WS_Y3), 1.f / (FP8_SMIX * FP8_SWOUT)};
        pg8::gemm_phase<pg8::EpiRes, pg8::StaticOrder, true, true, false, false, true>(ring, g, S, E);
    } SEAM(12);
    if (IN(13)) REP(13) { T0W(30, F.ws); p12_ln_router(F, A); T1(30, F.ws); } SEAM(13);
    if (IN(14)) REP(14) { T0W(31, F.ws); p13_moe_dispatch(F, A); T1(31, F.ws); } SEAM(14);
    if (IN(15)) REP(15) { LAS int* tile_e = (LAS int*)(F.lds + LDS_EXTRA_OFF); const int NT = moe_tile_table(F, tile_e);
        if (NT > 0) { pg8::Gemm g{(const bf16_t*)(F.ws + WS_X3F8), (const bf16_t*)(F.ws + WS_WGU1), DM / 2}; pg8::MoeOrder S; S.gpitch = DM / 2;
            S.so.init(NT, 2 * DFF / 256, F.G, F.bid); S.tile0 = 0; S.nN = 2 * DFF / 256; S.a_local = 0; S.tile_e = tile_e; S.rowlist = WSP(int, WS_ROWTOK);
            pg8::EpiSwiglu8 E{F.ws + WS_H1, 0, 1.f / (FP8_SX * FP8_SWGU)}; T0W(65, F.ws); pg8::gemm_phase<pg8::EpiSwiglu8, pg8::MoeOrder, true, true, true, false, true>(ring, g, S, E); T1(65, F.ws); } } SEAM(15);
    if (IN(16)) REP(16) { LAS int* tile_e = (LAS int*)(F.lds + LDS_EXTRA_OFF); const int NT = moe_tile_table(F, tile_e); const int nM_ = NT > 256 ? 256 : NT, ntail = NT - nM_;
        constexpr float SO = 1.f / (FP8_SH * FP8_SWDN);
        if (nM_ > 0) { pg8::Gemm g{(const bf16_t*)(F.ws + WS_H1), (const bf16_t*)(F.ws + WS_WDN1), DFF / 2}; pg8::MoeOrder S; S.so.init(nM_, DM / 256, F.G, F.bid); S.tile0 = 0; S.nN = DM / 256; S.a_local = 1; S.tile_e = tile_e; S.rowlist = nullptr; S.gpitch = 0;
            pg8::EpiBf16 E{WSP(bf16_t, WS_XG), SO}; T0W(66, F.ws); pg8::gemm_phase<pg8::EpiBf16, pg8::MoeOrder, true, true, false, false, true>(ring, g, S, E); T1(66, F.ws); }
        if (ntail > 0) { pg8::Gemm g{(const bf16_t*)(F.ws + WS_H1), (const bf16_t*)(F.ws + WS_WDN1), DFF / 2}; pg8::TailOrder S{F.G, F.bid, ntail, 256, 0, tile_e, nullptr, 0};
            pg8::EpiPart E{WSP(float, WS_PART), SO}; T0W(69, F.ws); pg8::gemm_phase<pg8::EpiPart, pg8::TailOrder, true, true, false, true, true>(ring, g, S, E); T1(69, F.ws); } } SEAM(16);
    if (IN(17)) REP(17) { T0W(32, F.ws); p_final(F, A); T1(32, F.ws); }
#undef IN
#undef SEAM
}

extern "C" void kernel_launch(void* const* d_in, const int* in_sizes, int n_in, void* d_out, int out_size, void* d_ws, size_t ws_size, hipStream_t stream) {
    static int grid = 0;
    if (grid == 0) {
        if (n_in != 28 || in_sizes[0] != T * DM || out_size != T * DM || ws_size < WS_END) {
            fprintf(stderr, "kernel_launch: unexpected problem (n_in %d, in0 %d, out %d, ws %zu); nothing launched\n", n_in, n_in > 0 ? in_sizes[0] : -1, out_size, ws_size); grid = -1; return; }
        int dev = 0, cus = 0, per_cu = 0;
        if (hipGetDevice(&dev) != hipSuccess || hipDeviceGetAttribute(&cus, hipDeviceAttributeMultiprocessorCount, dev) != hipSuccess) { grid = -1; return; }
        if (hipFuncSetAttribute((const void*)mk_fwd, hipFuncAttributeMaxDynamicSharedMemorySize, LDS_BYTES) != hipSuccess) { fprintf(stderr, "kernel_launch: hipFuncSetAttribute failed\n"); grid = -1; return; }
        if (hipOccupancyMaxActiveBlocksPerMultiprocessor(&per_cu, (const void*)mk_fwd, 512, LDS_BYTES) != hipSuccess || per_cu < 1) { fprintf(stderr, "kernel_launch: occupancy query says %d blocks per CU\n", per_cu); }
        (void)hipGetLastError();
        grid = cus;
    }
    if (grid < 0) return;
    (void)hipMemsetAsync((char*)d_ws + WS_CTL, 0, CTL_ZERO_BYTES, stream);
    Args a{};
    for (int i = 0; i < 28; ++i) a.in[i] = (const float*)d_in[i];
    a.out = (float*)d_out; a.ws = (unsigned char*)d_ws;
    constexpr int NPH = 18;
#if MK_N_LAUNCHES == 1
    a.ph_lo = 0; a.ph_hi = NPH;
    hipLaunchKernelGGL(mk_fwd, dim3(grid), dim3(512), LDS_BYTES, stream, a);
#else
    for (int p = 0; p < NPH; ++p) { a.ph_lo = p; a.ph_hi = p + 1; hipLaunchKernelGGL(mk_fwd, dim3(grid), dim3(512), LDS_BYTES, stream, a); }
#endif
}
```

```cpp
#include <hip/hip_runtime.h>
#include <cstdio>
#include <cstdint>

#ifndef MK_N_LAUNCHES
#define MK_N_LAUNCHES 1
#endif

#define LAS __attribute__((address_space(3)))
#define GAS __attribute__((address_space(1)))
typedef unsigned short bf16_t;
typedef short bf16x8 __attribute__((ext_vector_type(8)));
typedef short s16x4 __attribute__((ext_vector_type(4)));
typedef float f32x2 __attribute__((ext_vector_type(2)));
typedef float f32x4 __attribute__((ext_vector_type(4)));
typedef float f32x16 __attribute__((ext_vector_type(16)));
typedef unsigned u32x2 __attribute__((ext_vector_type(2)));
typedef unsigned u32x4 __attribute__((ext_vector_type(4)));

constexpr int NBATCH = 8, SEQ = 4096, T = NBATCH * SEQ, DM = 1024, DFF = 2816, NEXP = 8;
constexpr int N_IN0 = 2072, N_IN0P = 2304, N_IN1 = 1448, N_IN1P = 1536;
constexpr float ALPHA = 1.41421356237309515f;
constexpr float LN_EPS = 1e-5f;
constexpr float LOG2E = 1.4426950408889634f;
constexpr float QSCALE = 0.125f * LOG2E;

constexpr size_t MiB = 1u << 20;
constexpr size_t WS_CTL = 0, CTL_ZERO_BYTES = 1 * MiB;
constexpr size_t WS_KC = 1 * MiB;
constexpr size_t WS_POSW = 2 * MiB;
constexpr size_t WS_MOECNT = 2 * MiB + 64 * 1024;
constexpr size_t WS_MOEMETA = 2 * MiB + 128 * 1024;
constexpr size_t WS_TOKINFO = 2 * MiB + 256 * 1024;
constexpr size_t WS_WGU1 = 4 * MiB;
constexpr size_t WS_X3F8 = 48 * MiB;
constexpr size_t WS_WDN1 = 92 * MiB;
constexpr size_t WS_WIN0 = 136 * MiB;
constexpr size_t WS_WC1 = 141 * MiB;
constexpr size_t WS_WOUT0 = 143 * MiB;
constexpr size_t WS_WGU0 = 145 * MiB;
constexpr size_t WS_WDN0 = 156 * MiB;
constexpr size_t WS_WIN1 = 162 * MiB;
constexpr size_t WS_WOUT1 = 165 * MiB;
constexpr size_t WS_XB = 168 * MiB;
constexpr size_t WS_QA = 232 * MiB;
constexpr size_t WS_QB = 264 * MiB;
constexpr size_t WS_KA = 296 * MiB;
constexpr size_t WS_VA = 304 * MiB;
constexpr size_t WS_KCMP = 312 * MiB;
constexpr size_t WS_VCMP = 320 * MiB;
constexpr size_t WS_KSLC = 328 * MiB;
constexpr size_t WS_VSLC = 336 * MiB;
constexpr size_t WS_KWIN = 344 * MiB;
constexpr size_t WS_VWIN = 352 * MiB;
constexpr size_t WS_GATES = 360 * MiB;
constexpr size_t WS_HCMP = 364 * MiB;
constexpr size_t WS_MIX0 = WS_XB;
constexpr size_t WS_X1B = 232 * MiB;
constexpr size_t WS_H0 = 296 * MiB;
constexpr size_t WS_X2B = WS_XB;
constexpr size_t WS_Q1 = 232 * MiB;
constexpr size_t WS_K1 = 296 * MiB;
constexpr size_t WS_V1 = 300 * MiB;
constexpr size_t WS_QI = 304 * MiB;
constexpr size_t WS_KI = 320 * MiB;
constexpr size_t WS_WI = 322 * MiB;
constexpr size_t WS_MIX1 = 328 * MiB;
constexpr size_t WS_Y3 = 392 * MiB;
constexpr size_t WS_X3B = 200 * MiB;
constexpr size_t WS_ROWTOK = 3 * MiB;
constexpr size_t WS_XG = 136 * MiB;
constexpr size_t WS_H1 = 268 * MiB;
constexpr size_t WS_PART = 456 * MiB;
constexpr size_t WS_END = 512 * MiB;
constexpr float FP8_SX = 8.f, FP8_SWGU = 1024.f, FP8_SH = 8.f, FP8_SWDN = 4096.f, FP8_SMIX = 32.f, FP8_SMIX0 = 16.f, FP8_SWOUT = 2048.f;
constexpr int MOE_PASS_TILES = 128;
constexpr int MOE_MAX_TILES = 264;

constexpr int CW_BAR = 4096;

constexpr int RING_BYTES = 131072;
constexpr int LDS_EXTRA_OFF = RING_BYTES;
constexpr int LDS_MISC_OFF = RING_BYTES + 16384;
constexpr int LDS_BYTES = RING_BYTES + 16384 + 512;


#ifndef PROBE_T
#define PROBE_T 0
#endif
#ifndef PROBE_TBASE
#define PROBE_TBASE 20.f
#endif
#define TPROBE_ACC(ws_) ((unsigned long long*)((ws_) + WS_CTL + 512))
#define T0W(id, ws_) do { if (PROBE_T == (id) && blockIdx.x == 0 && threadIdx.x == 0) TPROBE_ACC(ws_)[1] = __builtin_amdgcn_s_memrealtime(); } while (0)
#define T1(id, ws_) do { if (PROBE_T == (id) && blockIdx.x == 0 && threadIdx.x == 0) TPROBE_ACC(ws_)[0] += __builtin_amdgcn_s_memrealtime() - TPROBE_ACC(ws_)[1]; } while (0)

typedef __bf16 bf16x2_t __attribute__((ext_vector_type(2)));
__device__ __forceinline__ unsigned cvt_pk_bf16(float lo, float hi) { const f32x2 v = {lo, hi}; const bf16x2_t b = __builtin_convertvector(v, bf16x2_t); return __builtin_bit_cast(unsigned, b); }
__device__ __forceinline__ unsigned cvt4_fp8(float a, float b, float c, float d) {
    a = __builtin_amdgcn_fmed3f(a, 448.f, -448.f); b = __builtin_amdgcn_fmed3f(b, 448.f, -448.f); c = __builtin_amdgcn_fmed3f(c, 448.f, -448.f); d = __builtin_amdgcn_fmed3f(d, 448.f, -448.f);
    int r = __builtin_amdgcn_cvt_pk_fp8_f32(a, b, 0, false); r = __builtin_amdgcn_cvt_pk_fp8_f32(c, d, r, true); return (unsigned)r;
}
__device__ __forceinline__ float bf_lo(unsigned w) { return __uint_as_float(w << 16); }
__device__ __forceinline__ float bf_hi(unsigned w) { return __uint_as_float(w & 0xffff0000u); }
__device__ __forceinline__ float wave_sum(float v) {
#pragma unroll
    for (int o = 1; o < 64; o <<= 1) v += __shfl_xor(v, o);
    return v;
}
__device__ __forceinline__ float swap_max(float m) { auto rr = __builtin_amdgcn_permlane32_swap(__float_as_uint(m), __float_as_uint(m), false, false); return fmaxf(__uint_as_float(rr[0]), __uint_as_float(rr[1])); }
__device__ __forceinline__ float swap_sum(float m) { auto rr = __builtin_amdgcn_permlane32_swap(__float_as_uint(m), __float_as_uint(m), false, false); return __uint_as_float(rr[0]) + __uint_as_float(rr[1]); }
__device__ __forceinline__ int t5_bucket(int n) {
    if (n < 16) return n;
    int b = 16;
    b += (n >= 19); b += (n >= 21); b += (n >= 24); b += (n >= 27); b += (n >= 31); b += (n >= 35); b += (n >= 40); b += (n >= 46);
    b += (n >= 52); b += (n >= 59); b += (n >= 67); b += (n >= 77); b += (n >= 87); b += (n >= 99); b += (n >= 113);
    return b;
}
namespace pg8 {
#define PG8_LAS __attribute__((address_space(3)))
constexpr int BM = 256, BK = 64, HALF = 128, HTB = HALF * BK * 2  , STAGE_BYTES = 8 * HTB, NXCD = 8, WGM = 8;
__host__ __device__ __forceinline__ int lds_byte(int r, int c) { const int st = (r >> 4) * 2 + (c >> 5), rr = r & 15, cc = c & 31, ob = rr * 64 + cc * 2; return st * 1024 + (ob ^ (((ob >> 9) & 1) << 5)); }
__host__ __device__ __forceinline__ void stage_rc(int b, int& R, int& C) { const int st = b / 1024, sb = b % 1024, swz = sb ^ (((sb >> 9) & 1) << 5); R = (st >> 1) * 16 + swz / 64; C = (st & 1) * 32 + (swz % 64) / 2; }
__host__ __device__ __forceinline__ int perm32(int rho) { const int n = rho >> 4, i = rho & 15; return 8 * (i >> 2) + 4 * n + (i & 3); }

struct Unit { int pa, pb, pm, pn, kb, nt, aux; };
struct Gemm { const bf16_t* A; const bf16_t* Bt; int K; };

struct StaticOrder {
    int nM, nN, nwg, G, c; const int* rowlist; int gpitch;
    __host__ __device__ void init(int nM_, int nN_, int G_, int c_) { nM = nM_; nN = nN_; nwg = nM * nN; G = G_; c = c_; }
    __host__ __device__ bool next(int i, Unit& u) const {
        const long L = (long)i * G + c; if (L >= nwg) return false;
        int wgid = (int)L; { const int q = nwg / NXCD, r = nwg % NXCD, xcd = wgid % NXCD, off = wgid / NXCD; wgid = (xcd < r ? xcd * (q + 1) : r * (q + 1) + (xcd - r) * q) + off; }
        const int nig = WGM * nN, gid = wgid / nig, fm = gid * WGM, gsz = (nM - fm) < WGM ? (nM - fm) : WGM;
        u.pm = fm + ((wgid % nig) % gsz); u.pn = (wgid % nig) / gsz; u.pa = u.pm; u.pb = u.pn; return true;
    }
    __device__ __forceinline__ void a_ready(const Unit&) const {}
    __device__ __forceinline__ void done(const Unit&) const {}
};
typedef int pg8_i32x4 __attribute__((ext_vector_type(4)));
typedef int pg8_i32x8 __attribute__((ext_vector_type(8)));
template <class Epi, class Sched, bool ALIGN_EPI = false, bool SP2 = false, bool GATHER = false, bool KSPLIT = false, bool FP8 = false>
__device__ __forceinline__ void gemm_phase(PG8_LAS unsigned char* lds, const Gemm g, const Sched& S, const Epi& E) {
    const int tid = threadIdx.x, wid = __builtin_amdgcn_readfirstlane(tid >> 6), lane = tid & 63, wr = wid >> 2, wc = wid & 3, fr = lane & 15, fq = lane >> 4;
    const int K = g.K, nt = K / BK;
    unsigned voffA[2], voffB[2]; int rA[2], cA2[2];
#pragma unroll
    for (int i = 0; i < 2; ++i) { int R, C; stage_rc(tid * 16 + i * 8192, R, C); const int Rb = Epi::PERM ? ((R & ~31) + perm32(R & 31)) : R;
        voffA[i] = (unsigned)(R * K + C) * 2u; voffB[i] = (unsigned)(Rb * K + C) * 2u; rA[i] = R; cA2[i] = C; }
    unsigned vofC[2][2], vofN[2][2];
#define PG8_GOFF(dst, unit) do { if constexpr (GATHER) { _Pragma("unroll") for (int h_ = 0; h_ < 2; ++h_) _Pragma("unroll") for (int i_ = 0; i_ < 2; ++i_) \
        dst[h_][i_] = ((unsigned)S.rowlist[(unit).pm * BM + h_ * HALF + rA[i_]] * (unsigned)S.gpitch + (unsigned)cA2[i_]) * 2u; } } while (0)
    const size_t kstep = (size_t)(BK * 2);
    const size_t hstep = (size_t)HALF * K * 2;
    const size_t tstep = 2 * hstep;
    const unsigned ldsw = (unsigned)wid * 1024u;
    const int aoff = lds_byte(wr * 64 + fr, fq * 8), boff = lds_byte(wc * 32 + fr, fq * 8);
#define PG8_SA(b, h) (((b) * 2 + (h)) * HTB)
#define PG8_SB(b, h) ((4 + (b) * 2 + (h)) * HTB)
#define PG8_STAGE(bufoff, gbase, voff) do { _Pragma("unroll") for (int _i = 0; _i < 2; ++_i) \
        __builtin_amdgcn_global_load_lds((const unsigned*)((const char*)(gbase) + (voff)[_i]), (PG8_LAS unsigned*)(lds + (bufoff) + ldsw + _i * 8192), 16, 0, 0); } while (0)
#define PG8_STAGE_A(bufoff, gbase, h, VO) do { if constexpr (GATHER) PG8_STAGE(bufoff, gbase, VO[h]); else PG8_STAGE(bufoff, (gbase) + (h) * hstep, voffA); } while (0)
#define PG8_LD8(p_) __builtin_shufflevector(*(const PG8_LAS pg8_i32x4*)(p_), *(const PG8_LAS pg8_i32x4*)((p_) + 1024), 0, 1, 2, 3, 4, 5, 6, 7)
#define PG8_LDA(dst, b, h) do { if constexpr (FP8) { _Pragma("unroll") for (int m = 0; m < 4; ++m) dst##8[m] = PG8_LD8(lds + PG8_SA(b, h) + aoff + m * 2048); } else { \
        _Pragma("unroll") for (int m = 0; m < 4; ++m) _Pragma("unroll") for (int k = 0; k < 2; ++k) dst[m][k] = *(const PG8_LAS bf16x8*)(lds + PG8_SA(b, h) + aoff + m * 2048 + k * 1024); } } while (0)
#define PG8_LDB(dst, b, h) do { if constexpr (FP8) { _Pragma("unroll") for (int n = 0; n < 2; ++n) dst##8[n] = PG8_LD8(lds + PG8_SB(b, h) + boff + n * 2048); } else { \
        _Pragma("unroll") for (int n = 0; n < 2; ++n) _Pragma("unroll") for (int k = 0; k < 2; ++k) dst[n][k] = *(const PG8_LAS bf16x8*)(lds + PG8_SB(b, h) + boff + n * 2048 + k * 1024); } } while (0)
#define PG8_MMA(ai, bj, At, Bt) do { __builtin_amdgcn_s_setprio(1); if constexpr (FP8) { _Pragma("unroll") for (int m = 0; m < 4; ++m) _Pragma("unroll") for (int n = 0; n < 2; ++n) \
        asm volatile("v_mfma_f32_16x16x128_f8f6f4 %0, %1, %2, %0" : "+v"(acc[ai][bj][m][n]) : "v"(Bt##8[n]), "v"(At##8[m])); } else { \
        _Pragma("unroll") for (int m = 0; m < 4; ++m) _Pragma("unroll") for (int n = 0; n < 2; ++n) _Pragma("unroll") for (int k = 0; k < 2; ++k) \
        acc[ai][bj][m][n] = __builtin_amdgcn_mfma_f32_16x16x32_bf16(Bt[n][k], At[m][k], acc[ai][bj][m][n], 0, 0, 0); } __builtin_amdgcn_s_setprio(0); } while (0)
#define PG8_WAIT_V(n) asm volatile("s_waitcnt vmcnt(" #n ")" ::: "memory")
#define PG8_WAIT_L(n) asm volatile("s_waitcnt lgkmcnt(" #n ")" ::: "memory")
#define PG8_BAR __builtin_amdgcn_s_barrier()
#define PG8_SCHED __builtin_amdgcn_sched_barrier(0)
    Unit cur, nxt; int ui = 0;
    if (!S.next(0, cur)) return;
    f32x4 acc[2][2][4][2];
#pragma unroll
    for (int a = 0; a < 2; ++a)
#pragma unroll
        for (int b = 0; b < 2; ++b)
#pragma unroll
            for (int m = 0; m < 4; ++m)
#pragma unroll
                for (int n = 0; n < 2; ++n) acc[a][b][m][n] = (f32x4){0.f, 0.f, 0.f, 0.f};
    bf16x8 At[4][2], B0[2][2], B1[2][2]; pg8_i32x8 At8[4], B08[2], B18[2];
    const char* cA = (const char*)g.A + (size_t)cur.pa * tstep + (KSPLIT ? cur.kb : 0); const char* cB = (const char*)g.Bt + (size_t)cur.pb * tstep + (KSPLIT ? cur.kb : 0);
    S.a_ready(cur);
    PG8_GOFF(vofC, cur);
#pragma unroll
    for (int h_ = 0; h_ < 2; ++h_)
#pragma unroll
        for (int i_ = 0; i_ < 2; ++i_) { if constexpr (!GATHER) vofC[h_][i_] = 0u; vofN[h_][i_] = vofC[h_][i_]; }
    if constexpr (SP2) {
        PG8_STAGE(PG8_SB(0, 0), cB, voffB); PG8_STAGE(PG8_SB(0, 1), cB + hstep, voffB); PG8_STAGE_A(PG8_SA(0, 0), cA, 0, vofC); PG8_STAGE_A(PG8_SA(0, 1), cA, 1, vofC);
        if (wr == 1) PG8_BAR;
        PG8_WAIT_V(2); PG8_BAR;
        PG8_STAGE(PG8_SB(1, 0), cB + kstep, voffB); PG8_STAGE_A(PG8_SA(1, 0), cA + kstep, 0, vofC); PG8_STAGE(PG8_SB(1, 1), cB + hstep + kstep, voffB);
        PG8_WAIT_V(6); PG8_BAR;
    } else {
        PG8_STAGE(PG8_SB(0, 0), cB, voffB); PG8_STAGE_A(PG8_SA(0, 0), cA, 0, vofC); PG8_STAGE(PG8_SB(0, 1), cB + hstep, voffB); PG8_STAGE_A(PG8_SA(0, 1), cA, 1, vofC);
        if (wr == 1) PG8_BAR;
        PG8_WAIT_V(4); PG8_BAR;
        PG8_STAGE(PG8_SB(1, 0), cB + kstep, voffB); PG8_STAGE_A(PG8_SA(1, 0), cA + kstep, 0, vofC); PG8_STAGE(PG8_SB(1, 1), cB + hstep + kstep, voffB);
        PG8_WAIT_V(6); PG8_BAR;
    }
    for (;;) {
        const bool has_next = S.next(ui + 1, nxt);
        if constexpr (GATHER) { if (has_next) PG8_GOFF(vofN, nxt); }
        const char* nA = has_next ? (const char*)g.A + (size_t)nxt.pa * tstep + (KSPLIT ? nxt.kb : 0) : cA; const char* nB = has_next ? (const char*)g.Bt + (size_t)nxt.pb * tstep + (KSPLIT ? nxt.kb : 0) : cB;
        int ntu = KSPLIT ? cur.nt : nt; if constexpr (FP8) asm volatile("" : "+s"(ntu));
        for (int t = 0; t < ntu; t += 2) {
            const bool last = (t == ntu - 2);
            unsigned vsel[2][2];
#pragma unroll
            for (int h_ = 0; h_ < 2; ++h_)
#pragma unroll
                for (int i_ = 0; i_ < 2; ++i_) vsel[h_][i_] = last ? vofN[h_][i_] : vofC[h_][i_];
            const char* a1 = cA + (size_t)(t + 1) * kstep;
            const char* a2 = last ? nA : cA + (size_t)(t + 2) * kstep; const char* b2 = last ? nB : cB + (size_t)(t + 2) * kstep;
            const char* a3 = a2 + kstep; const char* b3 = b2 + kstep;
            if (last && has_next) S.a_ready(nxt);
            if constexpr (SP2) {
            PG8_LDB(B0, 0, 0); PG8_LDB(B1, 0, 1); PG8_SCHED; PG8_LDA(At, 0, 0); PG8_STAGE_A(PG8_SA(1, 1), a1, 1, vofC);
            PG8_WAIT_V(8); PG8_WAIT_L(0); PG8_BAR; PG8_MMA(0, 0, At, B0); PG8_MMA(0, 1, At, B1); PG8_BAR; PG8_SCHED;
            PG8_LDA(At, 0, 1); PG8_STAGE(PG8_SB(0, 0), b2, voffB); PG8_STAGE(PG8_SB(0, 1), b2 + hstep, voffB); PG8_STAGE_A(PG8_SA(0, 0), a2, 0, vsel);
            PG8_WAIT_V(8); PG8_WAIT_L(0); PG8_BAR; PG8_MMA(1, 0, At, B0); PG8_MMA(1, 1, At, B1); PG8_BAR; PG8_SCHED;
            PG8_LDB(B0, 1, 0); PG8_LDB(B1, 1, 1); PG8_SCHED; PG8_LDA(At, 1, 0); PG8_STAGE_A(PG8_SA(0, 1), a2, 1, vsel);
            PG8_WAIT_V(8); PG8_WAIT_L(0); PG8_BAR; PG8_MMA(0, 0, At, B0); PG8_MMA(0, 1, At, B1); PG8_BAR; PG8_SCHED;
            PG8_LDA(At, 1, 1); PG8_STAGE(PG8_SB(1, 0), b3, voffB); PG8_STAGE(PG8_SB(1, 1), b3 + hstep, voffB); PG8_STAGE_A(PG8_SA(1, 0), a3, 0, vsel);
            PG8_WAIT_V(8); PG8_WAIT_L(0); PG8_BAR; PG8_MMA(1, 0, At, B0); PG8_MMA(1, 1, At, B1); PG8_BAR; PG8_SCHED;
            } else {
            PG8_LDB(B0, 0, 0); PG8_SCHED; PG8_LDA(At, 0, 0); PG8_STAGE_A(PG8_SA(1, 1), a1, 1, vofC);
            PG8_WAIT_L(8); PG8_BAR; PG8_WAIT_L(0); PG8_MMA(0, 0, At, B0); PG8_BAR; PG8_SCHED;
            PG8_LDB(B1, 0, 1); PG8_STAGE(PG8_SB(0, 0), b2, voffB);
            PG8_BAR; PG8_WAIT_L(0); PG8_MMA(0, 1, At, B1); PG8_BAR;
            PG8_LDA(At, 0, 1); PG8_STAGE_A(PG8_SA(0, 0), a2, 0, vsel);
            PG8_BAR; PG8_WAIT_L(0); PG8_MMA(1, 0, At, B0); PG8_BAR; PG8_SCHED;
            PG8_STAGE(PG8_SB(0, 1), b2 + hstep, voffB);
            PG8_WAIT_V(6); PG8_BAR; PG8_MMA(1, 1, At, B1); PG8_BAR;
            PG8_LDB(B0, 1, 0); PG8_SCHED; PG8_LDA(At, 1, 0); PG8_STAGE_A(PG8_SA(0, 1), a2, 1, vsel);
            PG8_WAIT_L(8); PG8_BAR; PG8_WAIT_L(0); PG8_MMA(0, 0, At, B0); PG8_BAR; PG8_SCHED;
            PG8_LDB(B1, 1, 1); PG8_STAGE(PG8_SB(1, 0), b3, voffB);
            PG8_BAR; PG8_WAIT_L(0); PG8_MMA(0, 1, At, B1); PG8_BAR;
            PG8_LDA(At, 1, 1); PG8_STAGE_A(PG8_SA(1, 0), a3, 0, vsel);
            PG8_BAR; PG8_WAIT_L(0); PG8_MMA(1, 0, At, B0); PG8_BAR; PG8_SCHED;
            PG8_STAGE(PG8_SB(1, 1), b3 + hstep, voffB);
            PG8_WAIT_V(6); PG8_BAR; PG8_MMA(1, 1, At, B1); PG8_BAR;
            }
        }
        if constexpr (FP8) asm volatile("s_nop 15\n\ts_nop 7" ::: "memory");
        if constexpr (ALIGN_EPI) { if (wr == 0) PG8_BAR; }
        if constexpr (!Epi::AFTER_DRAIN) { E(acc, cur, wr, wc, fr, fq); S.done(cur); }
        if (!has_next) break;
#pragma unroll
        for (int a = 0; a < 2; ++a)
#pragma unroll
            for (int b = 0; b < 2; ++b)
#pragma unroll
                for (int m = 0; m < 4; ++m)
#pragma unroll
                    for (int n = 0; n < 2; ++n) acc[a][b][m][n] = (f32x4){0.f, 0.f, 0.f, 0.f};
        cur = nxt; cA = nA; cB = nB; ++ui;
#pragma unroll
        for (int h_ = 0; h_ < 2; ++h_)
#pragma unroll
            for (int i_ = 0; i_ < 2; ++i_) vofC[h_][i_] = vofN[h_][i_];
        if constexpr (ALIGN_EPI) { if (wr == 1) PG8_BAR; }
    }
    PG8_WAIT_V(0);
    if constexpr (!ALIGN_EPI) { if (wr == 0) PG8_BAR; }
    PG8_BAR;
    if constexpr (Epi::AFTER_DRAIN) { E.fused(acc, cur, wr, wc, fr, fq, lds, wid, lane); S.done(cur); }
#undef PG8_SA
#undef PG8_SB
#undef PG8_STAGE
#undef PG8_STAGE_A
#undef PG8_GOFF
#undef PG8_LDA
#undef PG8_LDB
#undef PG8_MMA
#undef PG8_LD8
#undef PG8_WAIT_V
#undef PG8_WAIT_L
#undef PG8_BAR
#undef PG8_SCHED
}
}
#define XB_TMO      128
#define XB_XCNT(j)  (256  + 64 * (j))
#define XB_XSUB(j)  (1280 + 64 * (j))
#define XB_XGEN(j)  (2304 + 64 * (j))
#define XB_TOP      3328
#define XB_TOPGEN   3392
#define XCD_BAR_WORDS 3456
#define XB_SPIN_CAP (1u << 18)

__device__ __forceinline__ unsigned xb_ld(unsigned* p)              { return __hip_atomic_load(p, __ATOMIC_RELAXED, __HIP_MEMORY_SCOPE_AGENT); }
__device__ __forceinline__ unsigned xb_add(unsigned* p, unsigned v) { return __hip_atomic_fetch_add(p, v, __ATOMIC_RELAXED, __HIP_MEMORY_SCOPE_AGENT); }
__device__ __forceinline__ unsigned xb_xcc_id() { return (unsigned)__builtin_amdgcn_s_getreg((3 << 11) | 20) & 0xFu; }
#define XB_SPIN(cond, bar) do { unsigned _sp = 0; while (cond) { __builtin_amdgcn_s_sleep(1); \
    if ((++_sp & 255u) == 0u) { if (xb_ld(&(bar)[XB_TMO])) break; if (_sp > XB_SPIN_CAP) { atomicAdd(&(bar)[XB_TMO], 1u); break; } } } } while (0)

struct XcdBarrier {
    unsigned* bar; unsigned x;
    volatile LAS unsigned* st;
};

__device__ __forceinline__ XcdBarrier xcd_barrier_post(unsigned* bar, volatile LAS unsigned* st) {
    XcdBarrier b; b.bar = bar; b.x = xb_xcc_id(); b.st = st;
    if (threadIdx.x == 0) (void)xb_add(&bar[XB_XCNT(b.x)], 1u);
    return b;
}
__device__ __forceinline__ void xcd_barrier_complete(unsigned* bar, unsigned x, unsigned& nloc, unsigned& nx) {
    const unsigned G = gridDim.x * gridDim.y * gridDim.z;
    unsigned sum, cnt, mine, sp = 0u;
    for (;;) {
        sum = 0u; cnt = 0u; mine = 0u;
#pragma unroll
        for (unsigned j = 0; j < 16; ++j) { const unsigned c = xb_ld(&bar[XB_XCNT(j)]); sum += c; cnt += (c > 0u) ? 1u : 0u; mine = (j == x) ? c : mine; }
        if (sum == G) break;
        __builtin_amdgcn_s_sleep(1);
        if ((++sp & 255u) == 0u) { if (xb_ld(&bar[XB_TMO])) break; if (sp > XB_SPIN_CAP) { atomicAdd(&bar[XB_TMO], 1u); break; } }
    }
    nloc = mine > 0u ? mine : 1u; nx = cnt > 0u ? cnt : 1u;
}

__device__ __forceinline__ void xcd_barrier(const XcdBarrier& b) {
    asm volatile("s_waitcnt vmcnt(0)" ::: "memory");
    __syncthreads();
    if (threadIdx.x == 0) {
        unsigned* bar = b.bar;
        __builtin_amdgcn_s_waitcnt(0);
        unsigned nloc = b.st[0], nx = b.st[1];
        if (nloc == 0u) { xcd_barrier_complete(bar, b.x, nloc, nx); b.st[0] = nloc; b.st[1] = nx; }
        const unsigned old = xb_add(&bar[XB_XSUB(b.x)], 1u);
        const unsigned gen = old / nloc;
        if (old + 1u == (gen + 1u) * nloc) {
            __builtin_amdgcn_fence(__ATOMIC_RELEASE, "agent");
            asm volatile("s_waitcnt vmcnt(0)" ::: "memory");
            const unsigned og = xb_add(&bar[XB_TOP], 1u);
            const unsigned tg = og / nx;
            if (og + 1u == (tg + 1u) * nx) xb_add(&bar[XB_TOPGEN], 1u);
            else XB_SPIN(xb_ld(&bar[XB_TOPGEN]) == tg, bar);
            __builtin_amdgcn_fence(__ATOMIC_ACQUIRE, "agent");
            xb_add(&bar[XB_XGEN(b.x)], 1u);
            asm volatile("s_waitcnt vmcnt(0)" ::: "memory");
        } else {
            XB_SPIN(xb_ld(&bar[XB_XGEN(b.x)]) == gen, bar);
            __builtin_amdgcn_fence(__ATOMIC_ACQUIRE, "agent");
            asm volatile("s_waitcnt vmcnt(0)" ::: "memory");
        }
    }
    __syncthreads();
}
struct Args {
    const float* in[28];
    float* out; unsigned char* ws;
    int ph_lo, ph_hi;
};
struct Frame {
    LAS unsigned char* lds;
    int tid, lane, wave, G, bid;
    unsigned char* ws; float* out;
};
#define WSP(type, off) ((type*)(F.ws + (off)))
constexpr int LDS_PTR_OFF = LDS_MISC_OFF + 16;
__device__ __forceinline__ const float* in_ptr(LAS unsigned char* lds, int k) {
    const unsigned long long v = *(volatile LAS unsigned long long*)(lds + LDS_PTR_OFF + 8 * k);
    const unsigned lo = __builtin_amdgcn_readfirstlane((unsigned)v), hi = __builtin_amdgcn_readfirstlane((unsigned)(v >> 32));
    return (const float*)(((unsigned long long)hi << 32) | lo);
}
#define INP(k) in_ptr(F.lds, (k))

namespace pg8 {
struct EpiProj0 {
    static constexpr bool PERM = true, AFTER_DRAIN = false;
    unsigned char* ws;
    __device__ __forceinline__ void operator()(const f32x4 (&acc)[2][2][4][2], const Unit& u, int wr, int wc, int fr, int fq) const {
        const int row0 = u.pm * BM + wr * 64 + fr, cl = wc * 32 + 8 * fq;
        if (u.pn >= 16) {
            float* H = (float*)(ws + WS_HCMP);
#pragma unroll
            for (int ai = 0; ai < 2; ++ai)
#pragma unroll
                for (int m = 0; m < 4; ++m) { float* rp = H + (size_t)(row0 + ai * HALF + m * 16) * 512 + (u.pn - 16) * BM + cl;
#pragma unroll
                    for (int bj = 0; bj < 2; ++bj) { *(f32x4*)(rp + bj * HALF) = acc[ai][bj][m][0]; *(f32x4*)(rp + bj * HALF + 4) = acc[ai][bj][m][1]; } }
            return;
        }
#pragma unroll
        for (int bj = 0; bj < 2; ++bj) {
            const int hb = 2 * u.pn + bj;
            bf16_t* dst = nullptr; int pitch = 128, cb = cl, mode = 0; float sc = 1.f;
            if (hb < 4) { dst = (bf16_t*)(ws + WS_QA); pitch = 512; cb = hb * 128 + cl; sc = QSCALE; }
            else if (hb == 4) dst = (bf16_t*)(ws + WS_KA);
            else if (hb == 5) dst = (bf16_t*)(ws + WS_VA);
            else if (hb < 10) { dst = (bf16_t*)(ws + WS_QB); pitch = 512; cb = (hb - 6) * 128 + cl; sc = QSCALE; }
            else if (hb == 10) { dst = (bf16_t*)(ws + WS_KCMP); mode = 1; }
            else if (hb == 11) { dst = (bf16_t*)(ws + WS_VCMP); mode = 1; }
            else if (hb == 12) dst = (bf16_t*)(ws + WS_KSLC);
            else if (hb == 13) dst = (bf16_t*)(ws + WS_VSLC);
            else if (hb == 14) dst = (bf16_t*)(ws + WS_KWIN);
            else if (hb == 15) dst = (bf16_t*)(ws + WS_VWIN);
            else if (hb == 16) mode = (cl < 24) ? 2 : 3;
            else mode = 3;
            if (mode == 3) continue;
#pragma unroll
            for (int ai = 0; ai < 2; ++ai)
#pragma unroll
                for (int m = 0; m < 4; ++m) {
                    const int row = row0 + ai * HALF + m * 16;
                    const f32x4 v0 = acc[ai][bj][m][0], v1 = acc[ai][bj][m][1];
                    if (mode == 2) {
                        float* gp = (float*)(ws + WS_GATES) + (size_t)row * 24 + cl;
                        f32x4 a, b;
#pragma unroll
                        for (int i = 0; i < 4; ++i) { a[i] = 1.f / (1.f + __expf(-v0[i])); b[i] = 1.f / (1.f + __expf(-v1[i])); }
                        *(f32x4*)gp = a; *(f32x4*)(gp + 4) = b;
                    } else {
                        u32x4 w; w.x = cvt_pk_bf16(v0[0] * sc, v0[1] * sc); w.y = cvt_pk_bf16(v0[2] * sc, v0[3] * sc); w.z = cvt_pk_bf16(v1[0] * sc, v1[1] * sc); w.w = cvt_pk_bf16(v1[2] * sc, v1[3] * sc);
                        size_t off;
                        if (mode == 1) { const int b = row >> 12, t = row & 4095, g = cb >> 6, d = cb & 63; off = ((size_t)((b * 2 + g) * 4096 + t)) * 64 + d; }
                        else off = (size_t)row * pitch + cb;
                        *(u32x4*)(dst + off) = w;
                    }
                }
        }
    }
};
struct EpiProj1 {
    static constexpr bool PERM = true, AFTER_DRAIN = false;
    unsigned char* ws;
    __device__ __forceinline__ void operator()(const f32x4 (&acc)[2][2][4][2], const Unit& u, int wr, int wc, int fr, int fq) const {
        const int row0 = u.pm * BM + wr * 64 + fr, cl = wc * 32 + 8 * fq;
#pragma unroll
        for (int bj = 0; bj < 2; ++bj) {
            const int hb = 2 * u.pn + bj;
            bf16_t* dst = nullptr; int pitch = 1024, cb = cl, mode = 0; float sc = 1.f;
            if (hb < 8) { dst = (bf16_t*)(ws + WS_Q1); cb = hb * 128 + cl; sc = QSCALE; }
            else if (hb == 8) { if (cl < 64) { dst = (bf16_t*)(ws + WS_K1); pitch = 64; } else { dst = (bf16_t*)(ws + WS_V1); pitch = 64; cb = cl - 64; } }
            else if (hb < 11) { dst = (bf16_t*)(ws + WS_QI); pitch = 256; cb = (hb - 9) * 128 + cl; }
            else if (hb == 11) { if (cl < 32) { dst = (bf16_t*)(ws + WS_KI); pitch = 32; } else if (cl < 40) mode = 2; else mode = 3; }
            else mode = 3;
            if (mode == 3) continue;
#pragma unroll
            for (int ai = 0; ai < 2; ++ai)
#pragma unroll
                for (int m = 0; m < 4; ++m) {
                    const int row = row0 + ai * HALF + m * 16;
                    const f32x4 v0 = acc[ai][bj][m][0], v1 = acc[ai][bj][m][1];
                    if (mode == 2) { float* gp = (float*)(ws + WS_WI) + (size_t)row * 8; *(f32x4*)gp = v0; *(f32x4*)(gp + 4) = v1; }
                    else { u32x4 w; w.x = cvt_pk_bf16(v0[0] * sc, v0[1] * sc); w.y = cvt_pk_bf16(v0[2] * sc, v0[3] * sc); w.z = cvt_pk_bf16(v1[0] * sc, v1[1] * sc); w.w = cvt_pk_bf16(v1[2] * sc, v1[3] * sc);
                        *(u32x4*)(dst + (size_t)row * pitch + cb) = w; }
                }
        }
    }
};
struct EpiF32 {
    static constexpr bool PERM = false, AFTER_DRAIN = false;
    float* out; int ldc;
    __device__ __forceinline__ void operator()(const f32x4 (&acc)[2][2][4][2], const Unit& u, int wr, int wc, int fr, int fq) const {
#pragma unroll
        for (int ai = 0; ai < 2; ++ai)
#pragma unroll
            for (int m = 0; m < 4; ++m) { float* rp = out + (size_t)(u.pm * BM + ai * HALF + wr * 64 + m * 16 + fr) * ldc + u.pn * BM + wc * 32 + 4 * fq;
#pragma unroll
                for (int bj = 0; bj < 2; ++bj)
#pragma unroll
                    for (int n = 0; n < 2; ++n) *(f32x4*)(rp + bj * HALF + n * 16) = acc[ai][bj][m][n]; }
    }
};
struct EpiRes {
    static constexpr bool PERM = true, AFTER_DRAIN = false;
    const float* resf; const bf16_t* resb; bf16_t* out; float sc;
    __device__ __forceinline__ void operator()(const f32x4 (&acc)[2][2][4][2], const Unit& u, int wr, int wc, int fr, int fq) const {
#pragma unroll
        for (int ai = 0; ai < 2; ++ai)
#pragma unroll
            for (int m = 0; m < 4; ++m) { const size_t ro = (size_t)(u.pm * BM + ai * HALF + wr * 64 + m * 16 + fr) * DM + u.pn * BM + wc * 32 + 8 * fq;
#pragma unroll
                for (int bj = 0; bj < 2; ++bj) { const size_t o = ro + bj * HALF; f32x4 r0, r1;
                    if (resf) { r0 = *(const f32x4*)(resf + o); r1 = *(const f32x4*)(resf + o + 4); }
                    else { const u32x4 w = *(const u32x4*)(resb + o); r0 = (f32x4){bf_lo(w.x), bf_hi(w.x), bf_lo(w.y), bf_hi(w.y)}; r1 = (f32x4){bf_lo(w.z), bf_hi(w.z), bf_lo(w.w), bf_hi(w.w)}; }
                    const f32x4 v0 = r0 * ALPHA + acc[ai][bj][m][0] * sc, v1 = r1 * ALPHA + acc[ai][bj][m][1] * sc;
                    u32x4 q; q.x = cvt_pk_bf16(v0[0], v0[1]); q.y = cvt_pk_bf16(v0[2], v0[3]); q.z = cvt_pk_bf16(v1[0], v1[1]); q.w = cvt_pk_bf16(v1[2], v1[3]);
                    *(u32x4*)(out + o) = q; } }
    }
};
struct EpiSwiglu {
    static constexpr bool PERM = true, AFTER_DRAIN = false;
    bf16_t* H; int row_tile0;
    __device__ __forceinline__ void operator()(const f32x4 (&acc)[2][2][4][2], const Unit& u, int wr, int wc, int fr, int fq) const {
        const int row0 = (u.pm - row_tile0) * BM + wr * 64 + fr, col = u.pn * HALF + wc * 32 + 8 * fq;
#pragma unroll
        for (int ai = 0; ai < 2; ++ai)
#pragma unroll
            for (int m = 0; m < 4; ++m) {
                float h[8];
#pragma unroll
                for (int n = 0; n < 2; ++n)
#pragma unroll
                    for (int i = 0; i < 4; ++i) { const float g = acc[ai][0][m][n][i], up = acc[ai][1][m][n][i];
                        h[n * 4 + i] = g * __builtin_amdgcn_rcpf(1.f + __builtin_amdgcn_exp2f(-g * LOG2E)) * up; }
                u32x4 w; w.x = cvt_pk_bf16(h[0], h[1]); w.y = cvt_pk_bf16(h[2], h[3]); w.z = cvt_pk_bf16(h[4], h[5]); w.w = cvt_pk_bf16(h[6], h[7]);
                *(u32x4*)(H + (size_t)(row0 + ai * HALF + m * 16) * DFF + col) = w;
            }
    }
};
struct EpiSwiglu8 {
    static constexpr bool PERM = true, AFTER_DRAIN = false;
    unsigned char* H; int row_tile0; float SI;
    __device__ __forceinline__ void operator()(const f32x4 (&acc)[2][2][4][2], const Unit& u, int wr, int wc, int fr, int fq) const {
        const int row0 = (u.pm - row_tile0) * BM + wr * 64 + fr, col = u.pn * HALF + wc * 32 + 8 * fq;
        const float c1 = -SI * LOG2E, ic2 = 1.f / (SI * SI * FP8_SH);
#pragma unroll
        for (int ai = 0; ai < 2; ++ai)
#pragma unroll
            for (int m = 0; m < 4; ++m) {
                float h[8];
#pragma unroll
                for (int n = 0; n < 2; ++n)
#pragma unroll
                    for (int i = 0; i < 4; ++i) { const float a = acc[ai][0][m][n][i], b = acc[ai][1][m][n][i];
                        h[n * 4 + i] = (a * b) * __builtin_amdgcn_rcpf(__builtin_fmaf(__builtin_amdgcn_exp2f(a * c1), ic2, ic2)); }
                u32x2 w; w.x = cvt4_fp8(h[0], h[1], h[2], h[3]); w.y = cvt4_fp8(h[4], h[5], h[6], h[7]);
                *(u32x2*)(H + (size_t)(row0 + ai * HALF + m * 16) * DFF + col) = w;
            }
    }
};
struct EpiBf16 {
    static constexpr bool PERM = true, AFTER_DRAIN = false;
    bf16_t* O; float sc;
    __device__ __forceinline__ void operator()(const f32x4 (&acc)[2][2][4][2], const Unit& u, int wr, int wc, int fr, int fq) const {
        const int row0 = u.pm * BM + wr * 64 + fr, col0 = u.pn * BM + wc * 32 + 8 * fq;
#pragma unroll
        for (int ai = 0; ai < 2; ++ai)
#pragma unroll
            for (int m = 0; m < 4; ++m) { bf16_t* rowp = O + (size_t)(row0 + ai * HALF + m * 16) * DM + col0;
#pragma unroll
                for (int bj = 0; bj < 2; ++bj) { const f32x4 v0 = acc[ai][bj][m][0] * sc, v1 = acc[ai][bj][m][1] * sc;
                    u32x4 w; w.x = cvt_pk_bf16(v0[0], v0[1]); w.y = cvt_pk_bf16(v0[2], v0[3]); w.z = cvt_pk_bf16(v1[0], v1[1]); w.w = cvt_pk_bf16(v1[2], v1[3]);
                    *(u32x4*)(rowp + bj * HALF) = w; } }
    }
};
struct Proj0OrderA {
    int G, c; const int* rowlist; int gpitch;
    __device__ bool next(int i, Unit& u) const { const int L = i * G + c; if (L >= 256) return false; u.pm = L >> 1; u.pa = u.pm; u.pn = (L & 1) ? 8 : 5; u.pb = u.pn; return true; }
    __device__ __forceinline__ void a_ready(const Unit&) const {}
    __device__ __forceinline__ void done(const Unit&) const {}
};
struct Proj0OrderB {
    StaticOrder so; int G, c; const int* rowlist; int gpitch;
    __device__ bool next(int i, Unit& u) const {
        if (so.next(i, u)) { u.pn = u.pn < 5 ? u.pn : u.pn + 1; u.pb = u.pn; return true; }
        const int L = i * G + c - 896; if (L < 0 || L >= 64) return false;
        const int ct = L >> 1; u.pm = ct; u.pa = (int)((WS_KCMP - WS_XB) / (512 * 1024)) + ct; u.pn = 16 + (L & 1); u.pb = (int)((WS_WC1 - WS_WIN0) / (512 * 1024)) + (ct >> 4) * 2 + (L & 1); return true;
    }
    __device__ __forceinline__ void a_ready(const Unit&) const {}
    __device__ __forceinline__ void done(const Unit&) const {}
};
struct MoeOrder {
    StaticOrder so; int tile0, nN, a_local, gpitch; const LAS int* tile_e; const int* rowlist;
    __device__ bool next(int i, Unit& u) const {
        if (!so.next(i, u)) return false;
        const int tile = tile0 + u.pm; u.pa = a_local ? u.pm : 0; u.pb = tile_e[tile] * nN + u.pn; u.pm = tile; return true;
    }
    __device__ __forceinline__ void a_ready(const Unit&) const {}
    __device__ __forceinline__ void done(const Unit&) const {}
};
struct EpiPart {
    static constexpr bool PERM = false, AFTER_DRAIN = false;
    float* part; float sc;
    __device__ __forceinline__ void operator()(const f32x4 (&acc)[2][2][4][2], const Unit& u, int wr, int wc, int fr, int fq) const {
        float* base = part + (size_t)u.aux * (8 * 256 * DM);
#pragma unroll
        for (int ai = 0; ai < 2; ++ai)
#pragma unroll
            for (int m = 0; m < 4; ++m) { float* rp = base + (size_t)(u.pm * BM + ai * HALF + wr * 64 + m * 16 + fr) * DM + u.pn * BM + wc * 32 + 4 * fq;
#pragma unroll
                for (int bj = 0; bj < 2; ++bj)
#pragma unroll
                    for (int n = 0; n < 2; ++n) *(f32x4*)(rp + bj * HALF + n * 16) = acc[ai][bj][m][n] * sc; }
    }
};
struct TailOrder {
    int G, c, ntail, tile_first, tile0; const LAS int* tile_e; const int* rowlist; int gpitch;
    __device__ bool next(int i, Unit& u) const {
        const int L = i * G + c; if (L >= ntail * 16) return false;
        const int sl = L & 3, pn = (L >> 2) & 3, tl = L >> 4, tile = tile_first + tl;
        u.pa = tile - tile0; u.pb = tile_e[tile] * 4 + pn; u.pm = tl; u.pn = pn; u.aux = sl;
        u.kb = sl * 768; u.nt = sl < 3 ? 6 : 4; return true;
    }
    __device__ __forceinline__ void a_ready(const Unit&) const {}
    __device__ __forceinline__ void done(const Unit&) const {}
};
}
enum { I_X = 0, I_RELB, I_L0_WIN, I_L0_SINKS, I_CK_POS, I_CK_W1, I_CK_W2, I_CV_POS, I_CV_W1, I_CV_W2, I_L0_WOUT, I_L0_LN1G, I_L0_LN1B, I_L0_GATE, I_L0_UP, I_L0_DOWN, I_L0_LN2G, I_L0_LN2B,
       I_L1_WIN, I_L1_WOUT, I_L1_LN1G, I_L1_LN1B, I_L1_ROUTER, I_L1_EGATE, I_L1_EUP, I_L1_EDOWN, I_L1_LN2G, I_L1_LN2B };

__device__ __forceinline__ void p0_transpose_item(const float* W, int ldw, int ncols, bf16_t* WT, int dk, int k0, int n0, int drow0, LAS float* scr, int lane, float f8scale) {
    const int cn = n0 + (lane & 31); const bool okc = cn < ncols;
    float tv[32];
#pragma unroll
    for (int i = 0; i < 32; ++i) { const int kk = 2 * i + (lane >> 5); tv[i] = okc ? W[(size_t)(k0 + kk) * ldw + cn] : 0.f; }
#pragma unroll
    for (int i = 0; i < 32; ++i) { const int kk = 2 * i + (lane >> 5); scr[kk * 33 + (lane & 31)] = tv[i]; }
    asm volatile("s_waitcnt lgkmcnt(0)" ::: "memory");
    const int c = lane & 7;
    if (f8scale > 0.f) {
#pragma unroll
        for (int j = 0; j < 4; ++j) { const int n = (lane >> 3) + 8 * j; const LAS float* s = scr + (8 * c) * 33 + n;
            u32x2 o; o.x = cvt4_fp8(s[0 * 33] * f8scale, s[1 * 33] * f8scale, s[2 * 33] * f8scale, s[3 * 33] * f8scale); o.y = cvt4_fp8(s[4 * 33] * f8scale, s[5 * 33] * f8scale, s[6 * 33] * f8scale, s[7 * 33] * f8scale);
            *(u32x2*)((unsigned char*)WT + (size_t)(drow0 + n) * dk + k0 + 8 * c) = o; }
    } else {
#pragma unroll
    for (int j = 0; j < 4; ++j) { const int n = (lane >> 3) + 8 * j; const LAS float* s = scr + (8 * c) * 33 + n;
        u32x4 o; o.x = cvt_pk_bf16(s[0 * 33], s[1 * 33]); o.y = cvt_pk_bf16(s[2 * 33], s[3 * 33]); o.z = cvt_pk_bf16(s[4 * 33], s[5 * 33]); o.w = cvt_pk_bf16(s[6 * 33], s[7 * 33]);
        *(u32x4*)(WT + (size_t)(drow0 + n) * dk + k0 + 8 * c) = o; }
    }
    asm volatile("s_waitcnt lgkmcnt(0)" ::: "memory");
}
struct TJob { const float* W; bf16_t* WT; int ldw, ncols, npad, ksrc, dk, map; float f8scale; };
__device__ __forceinline__ int tjob_items(const TJob& j) { return (j.ksrc / 64) * (j.npad / 32); }
__device__ __forceinline__ void tjob_run(const TJob& j, int item, LAS float* scr, int lane) {
    const int nblk = j.npad / 32, kb = item / nblk, nb = item % nblk, n0 = nb * 32;
    int drow0 = n0; if (j.map) drow0 = 256 * (n0 >> 7) + (n0 & 127) + (j.map == 2 ? 128 : 0);
    p0_transpose_item(j.W, j.ldw, j.ncols, j.WT, j.dk, kb * 64, n0, drow0, scr, lane, j.f8scale);
}
__device__ __forceinline__ void p0_prologue(Frame& F, const Args& A) {
    LAS float* scr = (LAS float*)(F.lds + F.wave * 16384);
    const int gw = F.bid * 8 + F.wave, NGW = F.G * 8;
    T0W(20, F.ws);
    int base = 0;
#define RUN_JOB(jb) do { const TJob j_ = (jb); const int n_ = tjob_items(j_); \
        int it_ = gw - (base % NGW); if (it_ < 0) it_ += NGW; for (; it_ < n_; it_ += NGW) tjob_run(j_, it_, scr, F.lane); base += n_; } while (0)
    RUN_JOB((TJob{INP(I_L0_WIN), WSP(bf16_t, WS_WIN0), N_IN0, N_IN0, N_IN0P, DM, DM, 0, 0.f}));
    RUN_JOB((TJob{INP(I_CK_W1), WSP(bf16_t, WS_WC1), 256, 256, 256, 1024, 1024, 0, 0.f}));
    RUN_JOB((TJob{INP(I_CK_W1) + 1024 * 256, WSP(bf16_t, WS_WC1) + 256 * 1024, 256, 256, 256, 1024, 1024, 0, 0.f}));
    RUN_JOB((TJob{INP(I_CV_W1), WSP(bf16_t, WS_WC1) + 512 * 1024, 256, 256, 256, 1024, 1024, 0, 0.f}));
    RUN_JOB((TJob{INP(I_CV_W1) + 1024 * 256, WSP(bf16_t, WS_WC1) + 768 * 1024, 256, 256, 256, 1024, 1024, 0, 0.f}));
    RUN_JOB((TJob{INP(I_L0_WOUT), WSP(bf16_t, WS_WOUT0), DM, DM, DM, DM, DM, 0, FP8_SWOUT}));
    RUN_JOB((TJob{INP(I_L0_GATE), WSP(bf16_t, WS_WGU0), DFF, DFF, DFF, DM, DM, 1, 0.f}));
    RUN_JOB((TJob{INP(I_L0_UP), WSP(bf16_t, WS_WGU0), DFF, DFF, DFF, DM, DM, 2, 0.f}));
    RUN_JOB((TJob{INP(I_L0_DOWN), WSP(bf16_t, WS_WDN0), DM, DM, DM, DFF, DFF, 0, FP8_SWDN}));
    RUN_JOB((TJob{INP(I_L1_WIN), WSP(bf16_t, WS_WIN1), N_IN1, N_IN1, N_IN1P, DM, DM, 0, 0.f}));
    RUN_JOB((TJob{INP(I_L1_WOUT), WSP(bf16_t, WS_WOUT1), DM, DM, DM, DM, DM, 0, FP8_SWOUT}));
    for (int e = 0; e < NEXP; ++e) {
        RUN_JOB((TJob{INP(I_L1_EGATE) + (size_t)e * DM * DFF, (bf16_t*)(F.ws + WS_WGU1 + (size_t)e * 2 * DFF * DM), DFF, DFF, DFF, DM, DM, 1, FP8_SWGU}));
        RUN_JOB((TJob{INP(I_L1_EUP) + (size_t)e * DM * DFF, (bf16_t*)(F.ws + WS_WGU1 + (size_t)e * 2 * DFF * DM), DFF, DFF, DFF, DM, DM, 2, FP8_SWGU}));
        RUN_JOB((TJob{INP(I_L1_EDOWN) + (size_t)e * DFF * DM, (bf16_t*)(F.ws + WS_WDN1 + (size_t)e * DM * DFF), DM, DM, DM, DFF, DFF, 0, FP8_SWDN}));
    }
#undef RUN_JOB
    T1(20, F.ws);
    T0W(21, F.ws);
    {   const float* xin = INP(I_X);
        for (int m = 4 * gw; m < T; m += 4 * NGW) {
            f32x4 v[4][4];
#pragma unroll
            for (int r = 0; r < 4; ++r)
#pragma unroll
                for (int j = 0; j < 4; ++j) v[r][j] = *((const f32x4*)(xin + (size_t)(m + r) * DM) + F.lane + 64 * j);
#pragma unroll
            for (int r = 0; r < 4; ++r)
#pragma unroll
                for (int j = 0; j < 4; ++j) { u32x2 w; w.x = cvt_pk_bf16(v[r][j][0], v[r][j][1]); w.y = cvt_pk_bf16(v[r][j][2], v[r][j][3]); *((u32x2*)(WSP(bf16_t, WS_XB) + (size_t)(m + r) * DM) + F.lane + 64 * j) = w; }
        }
    }
    T1(21, F.ws);
    T0W(22, F.ws);
    for (int it = F.bid; it < 64; it += F.G) {
        const int which = it >> 5, sl = it & 31, hcol = F.tid & 255, part = F.tid >> 8;
        const float* pos = INP(which ? I_CV_POS : I_CK_POS) + sl * 64 + part * 32; const float* w1 = INP(which ? I_CV_W1 : I_CK_W1) + (size_t)(sl * 64 + part * 32) * 256 + hcol;
        float s = 0.f;
#pragma unroll 8
        for (int r = 0; r < 32; ++r) s += pos[r] * w1[(size_t)r * 256];
        LAS float* red = (LAS float*)F.lds;
        __syncthreads();
        if (part) red[hcol] = s;
        __syncthreads();
        if (!part) WSP(float, WS_POSW)[(which * 32 + sl) * 256 + hcol] = s + red[hcol];
    }
    T1(22, F.ws);
}

__device__ __forceinline__ void p2b_compress_tail(Frame& F, const Args& A) {
    LAS float* hid = (LAS float*)(F.lds + F.wave * 1024);
    const int gw = F.bid * 8 + F.wave, NGW = F.G * 8;
    const float* H = WSP(float, WS_HCMP); const float* PW = WSP(float, WS_POSW);
    for (int it = gw; it < 2 * 16 * 256; it += NGW) {
        const int which = it >> 12, bg = (it >> 8) & 15, n = it & 255;
        bf16_t* dst = WSP(bf16_t, WS_KC) + ((size_t)(which * 16 + bg) * 256 + n) * 64;
        if (n == 255) { dst[F.lane] = 0; continue; }
        const size_t r0 = (size_t)(which * 4096 + bg * 256 + n) * 512;
        const f32x4 a = *(const f32x4*)(H + r0 + 4 * F.lane), b = *(const f32x4*)(H + r0 + 512 + 256 + 4 * F.lane);
        f32x4 pw = {0.f, 0.f, 0.f, 0.f};
#pragma unroll
        for (int s = 0; s < 32; ++s) pw += *(const f32x4*)(PW + (which * 32 + s) * 256 + 4 * F.lane);
        const f32x4 v = a + b + pw; f32x4 g;
#pragma unroll
        for (int i = 0; i < 4; ++i) { const float x = v[i], u = 0.7978845608028654f * (x + 0.044715f * x * x * x); const float th = 1.f - 2.f / (1.f + __expf(2.f * u)); g[i] = 0.5f * x * (1.f + th); }
        *(LAS f32x4*)(hid + 4 * F.lane) = g;
        asm volatile("s_waitcnt lgkmcnt(0)" ::: "memory");
        const float* w2 = INP(which ? I_CV_W2 : I_CK_W2) + F.lane; float acc = 0.f;
#pragma unroll 8
        for (int j = 0; j < 256; ++j) acc += hid[j] * w2[(size_t)j * 64];
        dst[F.lane] = (bf16_t)(cvt_pk_bf16(acc, 0.f) & 0xffffu);
        asm volatile("s_waitcnt lgkmcnt(0)" ::: "memory");
    }
}

__device__ __forceinline__ f32x4 ld_bf4(const bf16_t* p) { const u32x2 w = *(const u32x2*)p; return (f32x4){bf_lo(w.x), bf_hi(w.x), bf_lo(w.y), bf_hi(w.y)}; }
__device__ __forceinline__ void ln_row(const bf16_t* y, const float* g, const float* b, int lane, f32x4 (&v)[4]) {
    float s = 0.f;
#pragma unroll
    for (int j = 0; j < 4; ++j) { v[j] = ld_bf4(y + 4 * (lane + 64 * j)); s += (v[j][0] + v[j][1]) + (v[j][2] + v[j][3]); }
    const float mean = wave_sum(s) * (1.f / DM); float s2 = 0.f;
#pragma unroll
    for (int j = 0; j < 4; ++j) { v[j] = v[j] - mean; s2 += (v[j][0] * v[j][0] + v[j][1] * v[j][1]) + (v[j][2] * v[j][2] + v[j][3] * v[j][3]); }
    const float rstd = 1.f / sqrtf(wave_sum(s2) * (1.f / DM) + LN_EPS);
#pragma unroll
    for (int j = 0; j < 4; ++j) { const f32x4 gg = *((const f32x4*)g + lane + 64 * j), bb = *((const f32x4*)b + lane + 64 * j); v[j] = v[j] * rstd * gg + bb; }
}
__device__ __forceinline__ void ln_row2(const bf16_t* y0, const bf16_t* y1, const float* g, const float* b, int lane, f32x4 (&v)[4], f32x4 (&w)[4]) {
    float s = 0.f, t = 0.f;
#pragma unroll
    for (int j = 0; j < 4; ++j) { v[j] = ld_bf4(y0 + 4 * (lane + 64 * j)); w[j] = ld_bf4(y1 + 4 * (lane + 64 * j)); }
#pragma unroll
    for (int j = 0; j < 4; ++j) { s += (v[j][0] + v[j][1]) + (v[j][2] + v[j][3]); t += (w[j][0] + w[j][1]) + (w[j][2] + w[j][3]); }
#pragma unroll
    for (int o = 1; o < 64; o <<= 1) { s += __shfl_xor(s, o); t += __shfl_xor(t, o); }
    const float m0 = s * (1.f / DM), m1 = t * (1.f / DM); float s2 = 0.f, t2 = 0.f;
#pragma unroll
    for (int j = 0; j < 4; ++j) { v[j] = v[j] - m0; w[j] = w[j] - m1; s2 += (v[j][0] * v[j][0] + v[j][1] * v[j][1]) + (v[j][2] * v[j][2] + v[j][3] * v[j][3]); t2 += (w[j][0] * w[j][0] + w[j][1] * w[j][1]) + (w[j][2] * w[j][2] + w[j][3] * w[j][3]); }
#pragma unroll
    for (int o = 1; o < 64; o <<= 1) { s2 += __shfl_xor(s2, o); t2 += __shfl_xor(t2, o); }
    const float r0 = 1.f / sqrtf(s2 * (1.f / DM) + LN_EPS), r1 = 1.f / sqrtf(t2 * (1.f / DM) + LN_EPS);
#pragma unroll
    for (int j = 0; j < 4; ++j) { const f32x4 gg = *((const f32x4*)g + lane + 64 * j), bb = *((const f32x4*)b + lane + 64 * j); v[j] = v[j] * r0 * gg + bb; w[j] = w[j] * r1 * gg + bb; }
}
template <int N>
__device__ __forceinline__ void ln_rowsN(const bf16_t* y, const float* g, const float* b, int lane, f32x4 (&v)[N][4]) {
    float s[N], s2[N];
#pragma unroll
    for (int r = 0; r < N; ++r)
#pragma unroll
        for (int j = 0; j < 4; ++j) v[r][j] = ld_bf4(y + (size_t)r * DM + 4 * (lane + 64 * j));
#pragma unroll
    for (int r = 0; r < N; ++r) { s[r] = 0.f;
#pragma unroll
        for (int j = 0; j < 4; ++j) s[r] += (v[r][j][0] + v[r][j][1]) + (v[r][j][2] + v[r][j][3]); }
#pragma unroll
    for (int o = 1; o < 64; o <<= 1)
#pragma unroll
        for (int r = 0; r < N; ++r) s[r] += __shfl_xor(s[r], o);
#pragma unroll
    for (int r = 0; r < N; ++r) { const float m0 = s[r] * (1.f / DM); s2[r] = 0.f;
#pragma unroll
        for (int j = 0; j < 4; ++j) { v[r][j] = v[r][j] - m0; s2[r] += (v[r][j][0] * v[r][j][0] + v[r][j][1] * v[r][j][1]) + (v[r][j][2] * v[r][j][2] + v[r][j][3] * v[r][j][3]); } }
#pragma unroll
    for (int o = 1; o < 64; o <<= 1)
#pragma unroll
        for (int r = 0; r < N; ++r) s2[r] += __shfl_xor(s2[r], o);
#pragma unroll
    for (int j = 0; j < 4; ++j) { const f32x4 gg = *((const f32x4*)g + lane + 64 * j), bb = *((const f32x4*)b + lane + 64 * j);
#pragma unroll
        for (int r = 0; r < N; ++r) { const float rs = 1.f / sqrtf(s2[r] * (1.f / DM) + LN_EPS); v[r][j] = v[r][j] * rs * gg + bb; } }
}
__device__ __forceinline__ void p_layernorm(Frame& F, const bf16_t* y, const float* g, const float* b, bf16_t* ob) {
    const int gw = F.bid * 8 + F.wave, NGW = F.G * 8;
    for (int m = 4 * gw; m < T; m += 4 * NGW) {
        f32x4 v[4][4]; ln_rowsN<4>(y + (size_t)m * DM, g, b, F.lane, v);
#pragma unroll
        for (int r = 0; r < 4; ++r) { u32x2* o = (u32x2*)(ob + (size_t)(m + r) * DM) + F.lane;
#pragma unroll
            for (int j = 0; j < 4; ++j) { u32x2 q; q.x = cvt_pk_bf16(v[r][j][0], v[r][j][1]); q.y = cvt_pk_bf16(v[r][j][2], v[r][j][3]); o[64 * j] = q; } }
    }
}
struct TokInfo { int p0, p1; float g0, g1; };
__device__ __forceinline__ void p12_ln_router(Frame& F, const Args& A) {
    LAS float* rt = (LAS float*)F.lds;
    LAS int* cnt = (LAS int*)(F.lds + 32768);
    {
        const f32x4* rg = (const f32x4*)INP(I_L1_ROUTER); f32x4 rv[4];
#pragma unroll
        for (int k = 0; k < 4; ++k) rv[k] = rg[F.tid + 512 * k];
#pragma unroll
        for (int k = 0; k < 4; ++k)
#pragma unroll
            for (int c = 0; c < 4; ++c) { const int i = 4 * (F.tid + 512 * k) + c; rt[(i & 7) * DM + (i >> 3)] = rv[k][c]; }
    }
    if (F.tid < 8) cnt[F.tid] = 0;
    for (int i = F.bid * 512 + F.tid; i < 264 * 256; i += F.G * 512) WSP(int, WS_ROWTOK)[i] = 0;
    __syncthreads();
    const bf16_t* y = WSP(bf16_t, WS_Y3); bf16_t* xb = (bf16_t*)F.out + 1024; TokInfo* ti = WSP(TokInfo, WS_TOKINFO);
    for (int blk = F.bid; blk < T / 128; blk += F.G) {
        for (int i = 0; i < 16; i += 2) {
            const int m = blk * 128 + F.wave * 16 + i;
            f32x4 v[2][4]; ln_row2(y + (size_t)m * DM, y + (size_t)(m + 1) * DM, INP(I_L1_LN1G), INP(I_L1_LN1B), F.lane, v[0], v[1]);
            float lg[2][8];
#pragma unroll
            for (int q = 0; q < 2; ++q) {
                u32x2* o = (u32x2*)(xb + (size_t)(m + q) * 2048) + F.lane;
#pragma unroll
                for (int j = 0; j < 4; ++j) { u32x2 w; w.x = cvt_pk_bf16(v[q][j][0], v[q][j][1]); w.y = cvt_pk_bf16(v[q][j][2], v[q][j][3]); o[64 * j] = w; }
                unsigned* o8 = (unsigned*)(F.ws + WS_X3F8 + (size_t)(m + q) * DM) + F.lane;
#pragma unroll
                for (int j = 0; j < 4; ++j) o8[64 * j] = cvt4_fp8(v[q][j][0] * FP8_SX, v[q][j][1] * FP8_SX, v[q][j][2] * FP8_SX, v[q][j][3] * FP8_SX);
            }
#pragma unroll
            for (int e = 0; e < 8; ++e) { float s0 = 0.f, s1 = 0.f;
#pragma unroll
                for (int j = 0; j < 4; ++j) { const f32x4 r = *(const LAS f32x4*)(rt + e * DM + 4 * (F.lane + 64 * j));
                    s0 += (v[0][j][0] * r[0] + v[0][j][1] * r[1]) + (v[0][j][2] * r[2] + v[0][j][3] * r[3]); s1 += (v[1][j][0] * r[0] + v[1][j][1] * r[1]) + (v[1][j][2] * r[2] + v[1][j][3] * r[3]); }
                lg[0][e] = s0; lg[1][e] = s1; }
            {
                const bool b0 = F.lane & 1, b1 = F.lane & 2, b2 = F.lane & 4;
                float r4[2][4], r2[2][2], r1[2];
#pragma unroll
                for (int q = 0; q < 2; ++q)
#pragma unroll
                    for (int k = 0; k < 4; ++k) { const float send = b0 ? lg[q][k] : lg[q][k + 4], keep = b0 ? lg[q][k + 4] : lg[q][k]; r4[q][k] = keep + __shfl_xor(send, 1); }
#pragma unroll
                for (int q = 0; q < 2; ++q)
#pragma unroll
                    for (int k = 0; k < 2; ++k) { const float send = b1 ? r4[q][k] : r4[q][k + 2], keep = b1 ? r4[q][k + 2] : r4[q][k]; r2[q][k] = keep + __shfl_xor(send, 2); }
#pragma unroll
                for (int q = 0; q < 2; ++q) { const float send = b2 ? r2[q][0] : r2[q][1], keep = b2 ? r2[q][1] : r2[q][0]; r1[q] = keep + __shfl_xor(send, 4); }
#pragma unroll
                for (int o_ = 8; o_ < 64; o_ <<= 1) { r1[0] += __shfl_xor(r1[0], o_); r1[1] += __shfl_xor(r1[1], o_); }
#pragma unroll
                for (int q = 0; q < 2; ++q) { const int ri = __float_as_int(r1[q]);
                    lg[q][0] = __int_as_float(__builtin_amdgcn_readlane(ri, 0)); lg[q][1] = __int_as_float(__builtin_amdgcn_readlane(ri, 4)); lg[q][2] = __int_as_float(__builtin_amdgcn_readlane(ri, 2)); lg[q][3] = __int_as_float(__builtin_amdgcn_readlane(ri, 6));
                    lg[q][4] = __int_as_float(__builtin_amdgcn_readlane(ri, 1)); lg[q][5] = __int_as_float(__builtin_amdgcn_readlane(ri, 5)); lg[q][6] = __int_as_float(__builtin_amdgcn_readlane(ri, 3)); lg[q][7] = __int_as_float(__builtin_amdgcn_readlane(ri, 7)); }
            }
#pragma unroll
            for (int q = 0; q < 2; ++q) {
                int e0 = 0; float v0 = lg[q][0];
#pragma unroll
                for (int e = 1; e < 8; ++e) if (lg[q][e] > v0) { v0 = lg[q][e]; e0 = e; }
                int e1 = -1; float v1 = -3.0e38f;
#pragma unroll
                for (int e = 0; e < 8; ++e) if (e != e0 && lg[q][e] > v1) { v1 = lg[q][e]; e1 = e; }
                const float g1 = 1.f / (1.f + __expf(v0 - v1)), g0 = 1.f - g1;
                if (F.lane == 0) { ti[m + q] = TokInfo{e0, e1, g0, g1}; atomicAdd((int*)&cnt[e0], 1); atomicAdd((int*)&cnt[e1], 1); }
            }
        }
        __syncthreads();
        if (F.tid < 8) { WSP(int, WS_MOECNT)[blk * 8 + F.tid] = cnt[F.tid]; cnt[F.tid] = 0; }
        __syncthreads();
    }
}
__device__ __forceinline__ void p13_moe_dispatch(Frame& F, const Args& A) {
    LAS int* call = (LAS int*)F.lds;
    LAS int* base = (LAS int*)(F.lds + 8192);
    LAS int* segs = (LAS int*)(F.lds + 8192 + 64);
    LAS int* pos = (LAS int*)(F.lds + 8192 + 128);
    { int cv[4];
#pragma unroll
      for (int k = 0; k < 4; ++k) cv[k] = WSP(int, WS_MOECNT)[F.tid + 512 * k];
#pragma unroll
      for (int k = 0; k < 4; ++k) call[F.tid + 512 * k] = cv[k]; }
    __syncthreads();
    TokInfo* ti = WSP(TokInfo, WS_TOKINFO);
    for (int blk = F.bid; blk < T / 128; blk += F.G) {
        if (F.tid < 8) { int tot = 0, pre = 0; for (int w = 0; w < 256; ++w) { const int c = call[w * 8 + F.tid]; if (w < blk) pre += c; tot += c; } base[F.tid] = pre; segs[F.tid] = (tot + 255) & ~255; }
        __syncthreads();
        if (F.tid == 0) { int s = 0; for (int e = 0; e < 8; ++e) { const int p = segs[e]; segs[e] = s; base[e] += s; s += p; } segs[8] = s;
            if (blk == 0) { int* meta = WSP(int, WS_MOEMETA); meta[0] = s / 256; for (int e = 0; e <= 8; ++e) meta[1 + e] = segs[e] / 256; } }
        __syncthreads();
        if (F.wave == 0) {
            int run[8];
#pragma unroll
            for (int e = 0; e < 8; ++e) run[e] = base[e];
            for (int st = 0; st < 4; ++st) {
                const int tk = (st >> 1) * 64 + F.lane, slot = st & 1; const TokInfo t = ti[blk * 128 + tk]; const int me = slot ? t.p1 : t.p0; int p = 0;
#pragma unroll
                for (int e = 0; e < 8; ++e) { const unsigned long long mk = __ballot(me == e); if (me == e) p = run[e] + __popcll(mk & ((1ull << F.lane) - 1ull)); run[e] += __popcll(mk); }
                pos[tk * 2 + slot] = p;
            }
        }
        __syncthreads();
        if (F.tid < 128) { TokInfo t = ti[blk * 128 + F.tid]; t.p0 = pos[F.tid * 2]; t.p1 = pos[F.tid * 2 + 1]; ti[blk * 128 + F.tid] = t; }
        if (F.tid < 256) WSP(int, WS_ROWTOK)[pos[F.tid]] = blk * 128 + (F.tid >> 1);
        __syncthreads();
    }
}
__device__ __forceinline__ int moe_tile_table(Frame& F, LAS int* tile_e) {
    const int* meta = WSP(int, WS_MOEMETA); const int NT = meta[0];
    for (int t = F.tid; t < MOE_MAX_TILES; t += 512) { int e = 0;
#pragma unroll
        for (int k = 1; k < 8; ++k) e += (t >= meta[1 + k]) ? 1 : 0;
        tile_e[t] = e; }
    __syncthreads();
    return NT;
}
__device__ __forceinline__ void p_final(Frame& F, const Args& A) {
    int tid_ = threadIdx.x; asm volatile("" : "+v"(tid_)); const int lane = tid_ & 63;
    const int gw = F.bid * 8 + F.wave, NGW = F.G * 8; const TokInfo* ti = WSP(TokInfo, WS_TOKINFO); const bf16_t* O = WSP(bf16_t, WS_XG);
    const float* lg = INP(I_L1_LN2G); const float* lb = INP(I_L1_LN2B);
    float tscale = 1.f;
    if (PROBE_T) { const float us = (float)(*TPROBE_ACC(F.ws)) * 0.01f; float thr = PROBE_TBASE; int k = 0;
#pragma unroll
        for (int i = 0; i < 12; ++i) { k += (us > thr) ? 1 : 0;
#ifdef PROBE_TSTEP
            thr += PROBE_TSTEP;
#else
            thr *= 1.25f;
#endif
        }
        tscale = 1.f + 0.02f * (float)k; }
    for (int m = 4 * gw; m < T; m += 4 * NGW) {
        f32x4 v[4][4]; float s[4], s2[4];
#pragma unroll
        for (int q = 0; q < 4; ++q) {
            const TokInfo t = ti[m + q]; const bf16_t* xs = (const bf16_t*)F.out + (size_t)(m + q) * 2048 + 1024;
            const u32x2* o0 = (const u32x2*)(O + (size_t)t.p0 * DM) + lane; const u32x2* o1 = (const u32x2*)(O + (size_t)t.p1 * DM) + lane;
            s[q] = 0.f;
#pragma unroll
            for (int j = 0; j < 4; ++j) { const f32x4 x = ld_bf4(xs + 4 * (lane + 64 * j)); const u32x2 a = o0[64 * j], b = o1[64 * j];
                const f32x4 fa = {bf_lo(a.x), bf_hi(a.x), bf_lo(a.y), bf_hi(a.y)}, fb = {bf_lo(b.x), bf_hi(b.x), bf_lo(b.y), bf_hi(b.y)};
                v[q][j] = x * ALPHA + (fa * t.g0 + fb * t.g1); s[q] += (v[q][j][0] + v[q][j][1]) + (v[q][j][2] + v[q][j][3]); }
        }
#pragma unroll
        for (int o = 1; o < 64; o <<= 1) { s[0] += __shfl_xor(s[0], o); s[1] += __shfl_xor(s[1], o); s[2] += __shfl_xor(s[2], o); s[3] += __shfl_xor(s[3], o); }
#pragma unroll
        for (int q = 0; q < 4; ++q) { const float mean = s[q] * (1.f / DM); s2[q] = 0.f;
#pragma unroll
            for (int j = 0; j < 4; ++j) { v[q][j] = v[q][j] - mean; s2[q] += (v[q][j][0] * v[q][j][0] + v[q][j][1] * v[q][j][1]) + (v[q][j][2] * v[q][j][2] + v[q][j][3] * v[q][j][3]); } }
#pragma unroll
        for (int o = 1; o < 64; o <<= 1) { s2[0] += __shfl_xor(s2[0], o); s2[1] += __shfl_xor(s2[1], o); s2[2] += __shfl_xor(s2[2], o); s2[3] += __shfl_xor(s2[3], o); }
#pragma unroll
        for (int q = 0; q < 4; ++q) { const float rstd = 1.f / sqrtf(s2[q] * (1.f / DM) + LN_EPS); f32x4* yr = (f32x4*)(F.out + (size_t)(m + q) * DM) + lane;
            if (ti[m + q].p0 >= 256 * 256 || ti[m + q].p1 >= 256 * 256) continue;
#pragma unroll
            for (int j = 0; j < 4; ++j) { const f32x4 gg = *((const f32x4*)lg + lane + 64 * j), bb = *((const f32x4*)lb + lane + 64 * j); yr[64 * j] = (v[q][j] * rstd * gg + bb) * tscale; } }
    }
    const int mi = gw + lane * NGW; bool rare = false;
    if (mi < T) { const u32x2 pp01 = *(const u32x2*)&ti[mi]; rare = (int)pp01.x >= 256 * 256 || (int)pp01.y >= 256 * 256; }
    for (unsigned long long rm = __ballot(rare); rm; rm &= rm - 1) {
        const int m = gw + __builtin_ctzll(rm) * NGW;
        const TokInfo t = ti[m];
        const bf16_t* xs = (const bf16_t*)F.out + (size_t)m * 2048 + 1024; f32x4 v[4]; float s = 0.f;
#pragma unroll
        for (int j = 0; j < 4; ++j) { const f32x4 x = ld_bf4(xs + 4 * (lane + 64 * j)); f32x4 fa, fb;
            if (t.p0 >= 256 * 256) { const float* pp = WSP(float, WS_PART) + (size_t)(t.p0 - 256 * 256) * DM + 4 * (lane + 64 * j); fa = ((*(const f32x4*)pp + *(const f32x4*)(pp + 8 * 256 * DM)) + *(const f32x4*)(pp + 2 * 8 * 256 * DM)) + *(const f32x4*)(pp + 3 * 8 * 256 * DM); }
            else { const u32x2 a = *((const u32x2*)(O + (size_t)t.p0 * DM) + lane + 64 * j); fa = (f32x4){bf_lo(a.x), bf_hi(a.x), bf_lo(a.y), bf_hi(a.y)}; }
            if (t.p1 >= 256 * 256) { const float* pp = WSP(float, WS_PART) + (size_t)(t.p1 - 256 * 256) * DM + 4 * (lane + 64 * j); fb = ((*(const f32x4*)pp + *(const f32x4*)(pp + 8 * 256 * DM)) + *(const f32x4*)(pp + 2 * 8 * 256 * DM)) + *(const f32x4*)(pp + 3 * 8 * 256 * DM); }
            else { const u32x2 b = *((const u32x2*)(O + (size_t)t.p1 * DM) + lane + 64 * j); fb = (f32x4){bf_lo(b.x), bf_hi(b.x), bf_lo(b.y), bf_hi(b.y)}; }
            v[j] = x * ALPHA + (fa * t.g0 + fb * t.g1); s += (v[j][0] + v[j][1]) + (v[j][2] + v[j][3]); }
        const float mean = wave_sum(s) * (1.f / DM); float s2 = 0.f;
#pragma unroll
        for (int j = 0; j < 4; ++j) { v[j] = v[j] - mean; s2 += (v[j][0] * v[j][0] + v[j][1] * v[j][1]) + (v[j][2] * v[j][2] + v[j][3] * v[j][3]); }
        const float rstd = 1.f / sqrtf(wave_sum(s2) * (1.f / DM) + LN_EPS); f32x4* yr = (f32x4*)(F.out + (size_t)m * DM) + lane;
#pragma unroll
        for (int j = 0; j < 4; ++j) { const f32x4 gg = *((const f32x4*)lg + lane + 64 * j), bb = *((const f32x4*)lb + lane + 64 * j); yr[64 * j] = (v[j] * rstd * gg + bb) * tscale; }
    }
}
namespace att {
constexpr int KROW = 144;
constexpr int TILE_B = 64 * KROW;
constexpr int L_K = 0, L_V = 2 * TILE_B, L_OV = 4 * TILE_B;
constexpr int L_LUT = 6 * TILE_B;
constexpr int L_IMP = L_LUT + 2048;
constexpr int L_SELM = L_IMP + 4 * 64 * 65 * 4;
constexpr int L_END = L_SELM + 512;
static_assert(L_END <= RING_BYTES, "attention LDS map");
constexpr float NEG_INF = -__builtin_huge_valf();
constexpr int L_LUT2 = LDS_EXTRA_OFF, LUT2_N = 704, LUT2_K = 639;
constexpr int L_LUT3 = LDS_EXTRA_OFF + 4 * LUT2_N * 4, LUT3_N = 320, LUT3_K = 255;
static_assert(L_LUT3 + 4 * LUT3_N * 4 <= LDS_MISC_OFF, "attention LUT map");
constexpr float RESC_THR = 8.f;

__device__ __forceinline__ s16x4 vtr(const LAS char* p) { return __builtin_bit_cast(s16x4, __builtin_amdgcn_ds_read_tr16_b64_v4i16((LAS s16x4*)p)); }

template <int MODE, int NDB>
__device__ __forceinline__ void attn_tile(const LAS char* Kt, const LAS char* Vt, const LAS char* OVt, const bf16x8 (&qf)[4], f32x16 (&o)[NDB], float& m, float& l,
                                          int tq, int key0, int W, bool lanesel, const LAS float* lut, int lane) {
    const int r32 = lane & 31, h = lane >> 5;
    f32x16 s0, s1;
#pragma unroll
    for (int r = 0; r < 16; ++r) { s0[r] = 0.f; s1[r] = 0.f; }
#pragma unroll
    for (int ks = 0; ks < 4; ++ks) {
        const bf16x8 k0 = *(const LAS bf16x8*)(Kt + r32 * KROW + (16 * ks + 8 * h) * 2);
        const bf16x8 k1 = *(const LAS bf16x8*)(Kt + (32 + r32) * KROW + (16 * ks + 8 * h) * 2);
        s0 = __builtin_amdgcn_mfma_f32_32x32x16_bf16(k0, qf[ks], s0, 0, 0, 0);
        s1 = __builtin_amdgcn_mfma_f32_32x32x16_bf16(k1, qf[ks], s1, 0, 0, 0);
    }
    float mx = NEG_INF;
    asm volatile("" ::: "memory");
#pragma unroll
    for (int kb = 0; kb < 2; ++kb) {
#pragma unroll
        for (int r = 0; r < 16; ++r) {
            const int key = key0 + 32 * kb + (r & 3) + 8 * (r >> 2) + 4 * h;
            const int dist = (MODE == 2) ? (tq - 16 * key - 31) : (tq - key);
            const int idx = dist < 0 ? 0 : (dist > 113 ? 113 : dist);
            bool valid;
            if (MODE == 0) valid = (unsigned)dist < (unsigned)W;
            else if (MODE == 1) valid = lanesel && dist >= 0;
            else valid = dist >= 0 && key < 255;
            float v = (kb ? s1[r] : s0[r]) + lut[idx];
            v = valid ? v : NEG_INF;
            if (kb) s1[r] = v; else s0[r] = v;
            mx = fmaxf(mx, v);
        }
        asm volatile("" ::: "memory");
    }
    mx = swap_max(mx);
    const float mnew = fmaxf(m, mx), alpha = __builtin_amdgcn_exp2f(m - mnew);
    float rs = 0.f;
#pragma unroll
    for (int r = 0; r < 16; ++r) { s0[r] = __builtin_amdgcn_exp2f(s0[r] - mnew); s1[r] = __builtin_amdgcn_exp2f(s1[r] - mnew); rs += s0[r] + s1[r]; }
    rs = swap_sum(rs);
    l = l * alpha + rs; m = mnew;
#pragma unroll
    for (int db = 0; db < NDB; ++db)
#pragma unroll
        for (int r = 0; r < 16; ++r) o[db][r] *= alpha;
    const int q4 = (lane & 15) >> 2, p4 = lane & 3, g2 = (lane >> 4) & 1;
#pragma unroll
    for (int kb = 0; kb < 2; ++kb)
#pragma unroll
        for (int s = 0; s < 2; ++s) {
            u32x4 pw;
            if (kb == 0) { pw.x = cvt_pk_bf16(s0[8 * s + 0], s0[8 * s + 1]); pw.y = cvt_pk_bf16(s0[8 * s + 2], s0[8 * s + 3]); pw.z = cvt_pk_bf16(s0[8 * s + 4], s0[8 * s + 5]); pw.w = cvt_pk_bf16(s0[8 * s + 6], s0[8 * s + 7]); }
            else { pw.x = cvt_pk_bf16(s1[8 * s + 0], s1[8 * s + 1]); pw.y = cvt_pk_bf16(s1[8 * s + 2], s1[8 * s + 3]); pw.z = cvt_pk_bf16(s1[8 * s + 4], s1[8 * s + 5]); pw.w = cvt_pk_bf16(s1[8 * s + 6], s1[8 * s + 7]); }
            const bf16x8 pb = __builtin_bit_cast(bf16x8, pw);
            const int rowoff = (32 * kb + 16 * s + 4 * h + q4) * KROW;
#pragma unroll
            for (int db = 0; db < NDB; ++db) {
                const LAS char* base = (db < 2 ? Vt : OVt) + rowoff + (32 * (db & 1) + 16 * g2 + 4 * p4) * 2;
                const s16x4 lo = vtr(base), hi = vtr(base + 8 * KROW);
                const bf16x8 vf = {lo[0], lo[1], lo[2], lo[3], hi[0], hi[1], hi[2], hi[3]};
                o[db] = __builtin_amdgcn_mfma_f32_32x32x16_bf16(vf, pb, o[db], 0, 0, 0);
            }
            asm volatile("" ::: "memory");
        }
}


template <int MODE>
__device__ __forceinline__ void attn_tile_fast(const LAS char* Kt, const LAS char* Vt, const bf16x8 (&qf)[4], f32x16 (&o)[2], float& m, float& l,
                                               bool lanesel, bool use_lut, const LAS float* lutp, float cfar, int lane) {
    const int r32 = lane & 31, h = lane >> 5;
    float ci = use_lut ? -m : (cfar - m);
    if (MODE == 1) ci = lanesel ? ci : NEG_INF;
    f32x16 s0, s1;
#pragma unroll
    for (int r = 0; r < 16; ++r) { s0[r] = ci; s1[r] = ci; }
#pragma unroll
    for (int ks = 0; ks < 4; ++ks) {
        const bf16x8 k0 = *(const LAS bf16x8*)(Kt + r32 * KROW + (16 * ks + 8 * h) * 2);
        const bf16x8 k1 = *(const LAS bf16x8*)(Kt + (32 + r32) * KROW + (16 * ks + 8 * h) * 2);
        s0 = __builtin_amdgcn_mfma_f32_32x32x16_bf16(k0, qf[ks], s0, 0, 0, 0);
        s1 = __builtin_amdgcn_mfma_f32_32x32x16_bf16(k1, qf[ks], s1, 0, 0, 0);
    }
    if (use_lut) {
#pragma unroll
        for (int r = 0; r < 16; ++r) { s0[r] += lutp[(r & 3) + 8 * (r >> 2)]; s1[r] += lutp[32 + (r & 3) + 8 * (r >> 2)]; }
    }
    float mx = fmaxf(s0[0], s1[0]);
#pragma unroll
    for (int r = 1; r < 16; ++r) mx = fmaxf(fmaxf(mx, s0[r]), s1[r]);
    mx = swap_max(mx);
    if (__any(mx > RESC_THR)) {
        const float dl = fmaxf(mx, 0.f), f = __builtin_amdgcn_exp2f(-dl);
        m += dl; l *= f;
#pragma unroll
        for (int r = 0; r < 16; ++r) { s0[r] -= dl; s1[r] -= dl; o[0][r] *= f; o[1][r] *= f; }
    }
    const int q4 = (lane & 15) >> 2, p4 = lane & 3, g2 = (lane >> 4) & 1;
    float rs = 0.f;
#pragma unroll
    for (int kb = 0; kb < 2; ++kb)
#pragma unroll
        for (int s = 0; s < 2; ++s) {
            float e[8];
#pragma unroll
            for (int i = 0; i < 8; ++i) { e[i] = __builtin_amdgcn_exp2f(kb ? s1[8 * s + i] : s0[8 * s + i]); rs += e[i]; }
            u32x4 pw; pw.x = cvt_pk_bf16(e[0], e[1]); pw.y = cvt_pk_bf16(e[2], e[3]); pw.z = cvt_pk_bf16(e[4], e[5]); pw.w = cvt_pk_bf16(e[6], e[7]);
            const bf16x8 pb = __builtin_bit_cast(bf16x8, pw);
            const int rowoff = (32 * kb + 16 * s + 4 * h + q4) * KROW;
#pragma unroll
            for (int db = 0; db < 2; ++db) {
                const LAS char* base = Vt + rowoff + (32 * db + 16 * g2 + 4 * p4) * 2;
                const s16x4 lo = vtr(base), hi = vtr(base + 8 * KROW);
                const bf16x8 vf = {lo[0], lo[1], lo[2], lo[3], hi[0], hi[1], hi[2], hi[3]};
                o[db] = __builtin_amdgcn_mfma_f32_32x32x16_bf16(vf, pb, o[db], 0, 0, 0);
            }
            __builtin_amdgcn_sched_barrier(0);
        }
    l += swap_sum(rs);
}

template <int MODE, int NDB>
__device__ __forceinline__ void run_branch(LAS unsigned char* lds, const bf16_t* Kg, const bf16_t* Vg, int pitch, unsigned long long tiles, const bf16x8 (&qf)[4], f32x16 (&o)[NDB], float& m, float& l,
                                           int tq, int W, unsigned long long selm, const LAS float* lut, int tid, int lane, unsigned char* wsp = nullptr) {
    const int lrow = tid >> 3, lch = tid & 7;
    if (tiles == 0ull) return;
    int j = __builtin_ctzll(tiles); tiles &= tiles - 1ull;
    auto gen_ov = [&](int tile, int b) {
        const int n = 64 * tile + lrow; unsigned short e[8];
#pragma unroll
        for (int i = 0; i < 8; ++i) { const int d = n - 4 * (8 * lch + i); e[i] = (n < 255 && d >= -1 && d <= 3) ? ((d == -1 || d == 3) ? (unsigned short)0x3f00 : (unsigned short)0x3f80) : (unsigned short)0; }
        u32x4 w; w.x = e[0] | ((unsigned)e[1] << 16); w.y = e[2] | ((unsigned)e[3] << 16); w.z = e[4] | ((unsigned)e[5] << 16); w.w = e[6] | ((unsigned)e[7] << 16);
        *(LAS u32x4*)(lds + L_OV + b * TILE_B + lrow * KROW + lch * 16) = w;
    };
#define ATT_LD(K_, V_, t_) do { K_ = *(const u32x4*)(Kg + (size_t)((t_) * 64 + lrow) * pitch + lch * 8); V_ = *(const u32x4*)(Vg + (size_t)((t_) * 64 + lrow) * pitch + lch * 8); } while (0)
#define ATT_ST(K_, V_, b_) do { *(LAS u32x4*)(lds + L_K + (b_) * TILE_B + lrow * KROW + lch * 16) = K_; *(LAS u32x4*)(lds + L_V + (b_) * TILE_B + lrow * KROW + lch * 16) = V_; } while (0)
    u32x4 kra, vra, krb, vrb;
    ATT_LD(kra, vra, j);
    int jn = -1;
    if (tiles != 0ull) { jn = __builtin_ctzll(tiles); tiles &= tiles - 1ull; }
    ATT_LD(krb, vrb, (jn < 0 ? j : jn));
    ATT_ST(kra, vra, 0);
    if (MODE == 2) gen_ov(j, 0);
    __syncthreads();
    for (;;) {
        int jnn = -1;
        if (tiles != 0ull) { jnn = __builtin_ctzll(tiles); tiles &= tiles - 1ull; }
        ATT_LD(kra, vra, (jnn < 0 ? j : jnn));
        {
        const bool lanesel = (MODE == 1) ? ((selm >> j) & 1ull) != 0ull : true;
        if constexpr (MODE == 2) {
            attn_tile<MODE, NDB>((const LAS char*)(lds + L_K + 0 * TILE_B), (const LAS char*)(lds + L_V + 0 * TILE_B), (const LAS char*)(lds + L_OV + 0 * TILE_B), qf, o, m, l, tq, 64 * j, W, lanesel, lut, lane);
        } else if (MODE != 1 || __ballot(lanesel) != 0ull) {
            const int tq0w = tq - (lane & 31);
            const int dmin = tq0w - 64 * j - 63, dmax = tq0w + 31 - 64 * j;
            const bool use_lut = (MODE == 0) ? !(dmin >= 113 && dmax < W) : !(dmin >= 113);
            const int r_ = (tid >> 6) & 3;
            const LAS float* lutp = (MODE == 0) ? (const LAS float*)(lds + L_LUT2) + r_ * LUT2_N + (64 * j + 4 * (lane >> 5) - tq + LUT2_K)
                                               : (const LAS float*)(lds + L_LUT3) + r_ * LUT3_N + (64 * j + 4 * (lane >> 5) - tq + LUT3_K);
            attn_tile_fast<MODE>((const LAS char*)(lds + L_K + 0 * TILE_B), (const LAS char*)(lds + L_V + 0 * TILE_B), qf, o, m, l, lanesel, use_lut, lutp, lut[113], lane);
        }
        }
        if (jn < 0) break;
        ATT_ST(krb, vrb, 1);
        if (MODE == 2) gen_ov(jn, 1);
        if (MODE == 1) T0W(6, wsp);
        __syncthreads();
        if (MODE == 1) T1(6, wsp);
        int jn3 = -1;
        if (tiles != 0ull) { jn3 = __builtin_ctzll(tiles); tiles &= tiles - 1ull; }
        ATT_LD(krb, vrb, (jn3 < 0 ? jn : jn3));
        {
        const bool lanesel = (MODE == 1) ? ((selm >> jn) & 1ull) != 0ull : true;
        if constexpr (MODE == 2) {
            attn_tile<MODE, NDB>((const LAS char*)(lds + L_K + 1 * TILE_B), (const LAS char*)(lds + L_V + 1 * TILE_B), (const LAS char*)(lds + L_OV + 1 * TILE_B), qf, o, m, l, tq, 64 * jn, W, lanesel, lut, lane);
        } else if (MODE != 1 || __ballot(lanesel) != 0ull) {
            const int tq0w = tq - (lane & 31);
            const int dmin = tq0w - 64 * jn - 63, dmax = tq0w + 31 - 64 * jn;
            const bool use_lut = (MODE == 0) ? !(dmin >= 113 && dmax < W) : !(dmin >= 113);
            const int r_ = (tid >> 6) & 3;
            const LAS float* lutp = (MODE == 0) ? (const LAS float*)(lds + L_LUT2) + r_ * LUT2_N + (64 * jn + 4 * (lane >> 5) - tq + LUT2_K)
                                               : (const LAS float*)(lds + L_LUT3) + r_ * LUT3_N + (64 * jn + 4 * (lane >> 5) - tq + LUT3_K);
            attn_tile_fast<MODE>((const LAS char*)(lds + L_K + 1 * TILE_B), (const LAS char*)(lds + L_V + 1 * TILE_B), qf, o, m, l, lanesel, use_lut, lutp, lut[113], lane);
        }
        }
        if (jnn < 0) break;
        ATT_ST(kra, vra, 0);
        if (MODE == 2) gen_ov(jnn, 0);
        if (MODE == 1) T0W(6, wsp);
        __syncthreads();
        if (MODE == 1) T1(6, wsp);
        j = jnn; jn = jn3;
    }
#undef ATT_LD
#undef ATT_ST
    __syncthreads();
}

__device__ __forceinline__ unsigned long long tile_range(int lo, int hi) {
    const unsigned long long a = (hi >= 63) ? ~0ull : ((1ull << (hi + 1)) - 1ull);
    return a & ~((1ull << lo) - 1ull);
}

__device__ __forceinline__ void build_lut(LAS unsigned char* lds, const float* relb, int head0, int tid) {
    LAS float* lut = (LAS float*)(lds + L_LUT);
    const int r = tid >> 7, d = tid & 127;
    lut[r * 128 + d] = relb[t5_bucket(d) * 16 + head0 + r] * LOG2E;
}

__device__ __forceinline__ void build_lut23(LAS unsigned char* lds, int W, bool want3, int tid) {
    const LAS float* lut = (const LAS float*)(lds + L_LUT);
    LAS float* l2 = (LAS float*)(lds + L_LUT2); LAS float* l3 = (LAS float*)(lds + L_LUT3);
    for (int i = tid; i < 4 * LUT2_N; i += 512) { const int r = i / LUT2_N, jj = i - r * LUT2_N, d = LUT2_K - jj; l2[i] = (d < 0 || d >= W) ? NEG_INF : lut[r * 128 + (d > 113 ? 113 : d)]; }
    if (want3) for (int i = tid; i < 4 * LUT3_N; i += 512) { const int r = i / LUT3_N, jj = i - r * LUT3_N, d = LUT3_K - jj; l3[i] = (d < 0) ? NEG_INF : lut[r * 128 + (d > 113 ? 113 : d)]; }
}

__device__ __forceinline__ void unit_swa(Frame& F, const Args& A, int b, int g, int qt) {
    LAS unsigned char* lds = F.lds;
    const int lane = F.lane, wave = F.wave, r = wave & 3, th = wave >> 2, r32 = lane & 31, h = lane >> 5;
    const int head = g * 4 + r, tq = qt * 64 + 32 * th + r32;
    build_lut(lds, INP(I_RELB), g * 4, F.tid);
    const bf16_t* qrow = WSP(bf16_t, WS_QA) + ((size_t)(b * SEQ + tq)) * 512 + head * 64;
    bf16x8 qf[4];
#pragma unroll
    for (int ks = 0; ks < 4; ++ks) qf[ks] = *(const bf16x8*)(qrow + 16 * ks + 8 * h);
    f32x16 o[2];
#pragma unroll
    for (int db = 0; db < 2; ++db)
#pragma unroll
        for (int i = 0; i < 16; ++i) o[db][i] = 0.f;
    float m = INP(I_L0_SINKS)[head] * LOG2E, l = 1.f;
    __syncthreads();
    build_lut23(lds, 128, false, F.tid);
    __syncthreads();
    const LAS float* lut = (const LAS float*)(lds + L_LUT) + r * 128;
    const bf16_t* Kg = WSP(bf16_t, WS_KA) + (size_t)b * SEQ * 128 + g * 64; const bf16_t* Vg = WSP(bf16_t, WS_VA) + (size_t)b * SEQ * 128 + g * 64;
    run_branch<0, 2>(lds, Kg, Vg, 128, tile_range(qt - 2 < 0 ? 0 : qt - 2, qt), qf, o, m, l, tq, 128, 0ull, lut, F.tid, lane);
    const float inv = FP8_SMIX0 / l;
    unsigned char* orow = F.ws + WS_MIX0 + ((size_t)(b * SEQ + tq)) * DM + head * 64;
#pragma unroll
    for (int db = 0; db < 2; ++db)
#pragma unroll
        for (int rg = 0; rg < 4; ++rg) *(unsigned*)(orow + 32 * db + 8 * rg + 4 * h) = cvt4_fp8(o[db][4 * rg] * inv, o[db][4 * rg + 1] * inv, o[db][4 * rg + 2] * inv, o[db][4 * rg + 3] * inv);
}

__device__ __forceinline__ void unit_nsa(Frame& F, const Args& A, int b, int g, int qt) {
    LAS unsigned char* lds = F.lds;
    const int lane = F.lane, wave = F.wave, r = wave & 3, th = wave >> 2, r32 = lane & 31, h = lane >> 5;
    const int hb = g * 4 + r, tq = qt * 64 + 32 * th + r32, tok = 32 * th + r32, bg = b * 2 + g;
    build_lut(lds, INP(I_RELB), 8 + g * 4, F.tid);
    const bf16_t* qrow = WSP(bf16_t, WS_QB) + ((size_t)(b * SEQ + tq)) * 512 + hb * 64;
    bf16x8 qf[4];
#pragma unroll
    for (int ks = 0; ks < 4; ++ks) qf[ks] = *(const bf16x8*)(qrow + 16 * ks + 8 * h);
    const float* gp = WSP(float, WS_GATES) + ((size_t)(b * SEQ + tq)) * 24 + hb;
    const float g_cmp = gp[0], g_slc = gp[8], g_win = gp[16];
    f32x16 acc[2];
    __syncthreads();
    build_lut23(lds, 512, true, F.tid);
    __syncthreads();
    const LAS float* lut = (const LAS float*)(lds + L_LUT) + r * 128;
    LAS float* imp = (LAS float*)(lds + L_IMP);
    LAS unsigned long long* selm = (LAS unsigned long long*)(lds + L_SELM);
    T0W(2, F.ws);
    {
        f32x16 o[4];
#pragma unroll
        for (int db = 0; db < 4; ++db)
#pragma unroll
            for (int i = 0; i < 16; ++i) o[db][i] = 0.f;
        float m = -1e30f, l = 0.f;
        const int tmax = qt * 64 + 63;
        unsigned long long tiles = 0ull;
        if (tmax >= 31) { const int nmax = (tmax - 31) >> 4; tiles = tile_range(0, (nmax > 254 ? 254 : nmax) >> 6); }
        const bf16_t* Kc = WSP(bf16_t, WS_KC) + (size_t)bg * 256 * 64; const bf16_t* Vc = WSP(bf16_t, WS_KC) + (size_t)(16 + bg) * 256 * 64;
        run_branch<2, 4>(lds, Kc, Vc, 64, tiles, qf, o, m, l, tq, 0, 0ull, lut, F.tid, lane);
        const float inv = l > 0.f ? 1.f / l : 0.f;
#pragma unroll
        for (int db = 0; db < 2; ++db)
#pragma unroll
            for (int i = 0; i < 16; ++i) acc[db][i] = o[db][i] * (inv * g_cmp);
        if (qt >= 16) {
#pragma unroll
            for (int db = 0; db < 2; ++db)
#pragma unroll
                for (int i = 0; i < 16; ++i) { const int jj = 32 * db + (i & 3) + 8 * (i >> 2) + 4 * h; imp[(r * 64 + jj) * 65 + tok] = o[2 + db][i] * inv; }
        }
    }
    __syncthreads();
    T1(2, F.ws);
    T0W(3, F.ws);
    {
        const unsigned long long adm = tile_range(0, qt);
        if (qt < 16) { if (lane < 8) selm[wave * 8 + lane] = adm; }
        else {
            int jl = lane; asm volatile("" : "+v"(jl));
            const unsigned long long ltm = (1ull << jl) - 1ull;
            const bool forced = (jl == 0) || (jl == qt) || (jl == qt - 1);
            unsigned u[8], sv[8];
#pragma unroll
            for (int i = 0; i < 8; ++i) {
                const int tk = wave * 8 + i;
                const float iv = ((imp[(0 * 64 + jl) * 65 + tk] + imp[(1 * 64 + jl) * 65 + tk]) + imp[(2 * 64 + jl) * 65 + tk]) + imp[(3 * 64 + jl) * 65 + tk];
                const float sc = forced ? 1e30f : (jl <= qt ? iv : -1e30f);
                const unsigned bits = __float_as_uint(sc); u[i] = bits ^ ((bits >> 31) ? 0xffffffffu : 0x80000000u); sv[i] = u[i];
            }
#pragma unroll
            for (int k = 2; k <= 64; k <<= 1)
#pragma unroll
                for (int d = k >> 1; d > 0; d >>= 1) {
                    const bool takemin = (((jl & d) == 0) == ((jl & k) == 0));
#pragma unroll
                    for (int i = 0; i < 8; ++i) { const unsigned pv = (unsigned)__shfl_xor((int)sv[i], d); const unsigned mn = sv[i] < pv ? sv[i] : pv, mxv = sv[i] < pv ? pv : sv[i]; sv[i] = takemin ? mn : mxv; }
                }
#pragma unroll
            for (int i = 0; i < 8; ++i) {
                const unsigned tau = (unsigned)__builtin_amdgcn_readlane((int)sv[i], 48);
                const unsigned long long mgt = __ballot(u[i] > tau), meq = __ballot(u[i] == tau);
                const int need = 16 - __popcll(mgt);
                const bool sel = (u[i] > tau) || ((u[i] == tau) && __popcll(meq & ltm) < need);
                const unsigned long long mk = __ballot(sel) & adm;
                if (jl == 0) selm[wave * 8 + i] = mk;
            }
        }
    }
    __syncthreads();
    T1(3, F.ws);
    const unsigned long long myselm = selm[tok];
    unsigned long long uni = selm[lane];
#pragma unroll
    for (int o_ = 1; o_ < 64; o_ <<= 1) { const unsigned lo = __shfl_xor((unsigned)uni, o_), hi = __shfl_xor((unsigned)(uni >> 32), o_); uni |= ((unsigned long long)hi << 32) | lo; }
    uni = ((unsigned long long)(unsigned)__builtin_amdgcn_readfirstlane((unsigned)(uni >> 32)) << 32) | (unsigned)__builtin_amdgcn_readfirstlane((unsigned)uni);
    T0W(4, F.ws);
    {
        f32x16 o[2];
#pragma unroll
        for (int db = 0; db < 2; ++db)
#pragma unroll
            for (int i = 0; i < 16; ++i) o[db][i] = 0.f;
        float m = 0.f, l = 0.f;
        const bf16_t* Kg = WSP(bf16_t, WS_KSLC) + (size_t)b * SEQ * 128 + g * 64; const bf16_t* Vg = WSP(bf16_t, WS_VSLC) + (size_t)b * SEQ * 128 + g * 64;
        run_branch<1, 2>(lds, Kg, Vg, 128, uni, qf, o, m, l, tq, 0, myselm, lut, F.tid, lane, F.ws);
        const float inv = g_slc / l;
#pragma unroll
        for (int db = 0; db < 2; ++db)
#pragma unroll
            for (int i = 0; i < 16; ++i) acc[db][i] += o[db][i] * inv;
    }
    T1(4, F.ws);
    T0W(5, F.ws);
    {
        f32x16 o[2];
#pragma unroll
        for (int db = 0; db < 2; ++db)
#pragma unroll
            for (int i = 0; i < 16; ++i) o[db][i] = 0.f;
        float m = 0.f, l = 0.f;
        const bf16_t* Kg = WSP(bf16_t, WS_KWIN) + (size_t)b * SEQ * 128 + g * 64; const bf16_t* Vg = WSP(bf16_t, WS_VWIN) + (size_t)b * SEQ * 128 + g * 64;
        run_branch<0, 2>(lds, Kg, Vg, 128, tile_range(qt - 8 < 0 ? 0 : qt - 8, qt), qf, o, m, l, tq, 512, 0ull, lut, F.tid, lane);
        const float inv = g_win / l;
#pragma unroll
        for (int db = 0; db < 2; ++db)
#pragma unroll
            for (int i = 0; i < 16; ++i) acc[db][i] += o[db][i] * inv;
    }
    T1(5, F.ws);
    unsigned char* orow = F.ws + WS_MIX0 + ((size_t)(b * SEQ + tq)) * DM + 512 + hb * 64;
#pragma unroll
    for (int db = 0; db < 2; ++db)
#pragma unroll
        for (int rg = 0; rg < 4; ++rg) *(unsigned*)(orow + 32 * db + 8 * rg + 4 * h) = cvt4_fp8(acc[db][4 * rg] * FP8_SMIX0, acc[db][4 * rg + 1] * FP8_SMIX0, acc[db][4 * rg + 2] * FP8_SMIX0, acc[db][4 * rg + 3] * FP8_SMIX0);
}

#ifndef PROBE_NSA_REP
#define PROBE_NSA_REP 1
#endif
#ifndef PROBE_SWA_REP
#define PROBE_SWA_REP 1
#endif
__device__ __forceinline__ void attn0_phase(Frame& F, const Args& A) {
    const int vcu = (F.G % 8 == 0) ? (F.bid % 8) * (F.G / 8) + F.bid / 8 : F.bid;
    for (int rep = 0; rep < PROBE_NSA_REP; ++rep)
    for (int U = vcu; U < 1024; U += F.G) {
        const int c = U & 255, i = U >> 8, bg = c >> 4, s = c & 15;
        const int qt = (i == 0) ? 63 - s : (i == 1) ? 32 + s : (i == 2) ? 31 - s : s;
        unit_nsa(F, A, bg >> 1, bg & 1, qt);
        __syncthreads();
    }
    for (int rep = 0; rep < PROBE_SWA_REP; ++rep)
    for (int U = vcu; U < 1024; U += F.G) {
        const int c = U & 255, i = U >> 8, bg = c >> 4, s = c & 15;
        unit_swa(F, A, bg >> 1, bg & 1, 16 * i + s);
        __syncthreads();
    }
}
}
namespace dsa {
constexpr int L_SC = 0;
constexpr int L_LIST = LDS_EXTRA_OFF;
constexpr int L_LUTD = L_LIST + 4096;
constexpr int L_WT = L_LUTD + 114 * 16 * 4;
static_assert(L_WT + 256 <= LDS_MISC_OFF, "dsa LDS map");
constexpr int VROW = 160;
constexpr float NEG_INF = -__builtin_huge_valf();
typedef float f32x4_t __attribute__((ext_vector_type(4)));


__device__ __forceinline__ int count_ge8(unsigned a0, unsigned a1, unsigned a2, unsigned a3, unsigned a4, unsigned a5, unsigned a6, unsigned a7, unsigned cand) {
    int c, t; unsigned long long m0, m1, m2, m3, m4, m5, m6, m7;
    asm volatile(
        "v_cmp_ge_u32_e64 %[m0], %[a0], %[cd]\n\tv_cmp_ge_u32_e64 %[m1], %[a1], %[cd]\n\tv_cmp_ge_u32_e64 %[m2], %[a2], %[cd]\n\tv_cmp_ge_u32_e64 %[m3], %[a3], %[cd]\n\t"
        "v_cmp_ge_u32_e64 %[m4], %[a4], %[cd]\n\tv_cmp_ge_u32_e64 %[m5], %[a5], %[cd]\n\tv_cmp_ge_u32_e64 %[m6], %[a6], %[cd]\n\tv_cmp_ge_u32_e64 %[m7], %[a7], %[cd]\n\t"
        "s_bcnt1_i32_b64 %[c], %[m0]\n\ts_bcnt1_i32_b64 %[t], %[m1]\n\ts_add_i32 %[c], %[c], %[t]\n\ts_bcnt1_i32_b64 %[t], %[m2]\n\ts_add_i32 %[c], %[c], %[t]\n\t"
        "s_bcnt1_i32_b64 %[t], %[m3]\n\ts_add_i32 %[c], %[c], %[t]\n\ts_bcnt1_i32_b64 %[t], %[m4]\n\ts_add_i32 %[c], %[c], %[t]\n\ts_bcnt1_i32_b64 %[t], %[m5]\n\ts_add_i32 %[c], %[c], %[t]\n\t"
        "s_bcnt1_i32_b64 %[t], %[m6]\n\ts_add_i32 %[c], %[c], %[t]\n\ts_bcnt1_i32_b64 %[t], %[m7]\n\ts_add_i32 %[c], %[c], %[t]"
        : [c] "=&s"(c), [t] "=&s"(t), [m0] "=&s"(m0), [m1] "=&s"(m1), [m2] "=&s"(m2), [m3] "=&s"(m3), [m4] "=&s"(m4), [m5] "=&s"(m5), [m6] "=&s"(m6), [m7] "=&s"(m7)
        : [a0] "v"(a0), [a1] "v"(a1), [a2] "v"(a2), [a3] "v"(a3), [a4] "v"(a4), [a5] "v"(a5), [a6] "v"(a6), [a7] "v"(a7), [cd] "s"(cand)
        : "scc");
    return c;
}

__device__ __forceinline__ void unit_dsa(Frame& F, const Args& A, int b, int t0) {
    LAS unsigned char* lds = F.lds;
    int lane_ = F.lane; asm volatile("" : "+v"(lane_));
    const int tid = F.tid, lane = lane_, wave = F.wave, r32 = lane & 31, h = lane >> 5;
    const size_t tb = (size_t)b * SEQ;
    LAS float* sc = (LAS float*)(lds + L_SC);
    LAS unsigned short* list = (LAS unsigned short*)(lds + L_LIST) + wave * 256;
    const LAS float* lutd = (const LAS float*)(lds + L_LUTD);
    LAS float* wt = (LAS float*)(lds + L_WT);
    if (tid < 64) wt[tid] = WSP(float, WS_WI)[(tb + t0) * 8 + tid];
    __syncthreads();
#ifndef PROBE_DSA_A
#define PROBE_DSA_A 1
#endif
#ifndef PROBE_DSA_B
#define PROBE_DSA_B 1
#endif
#ifndef PROBE_DSA_C
#define PROBE_DSA_C 1
#endif
    T0W(11, F.ws);
    for (int repa = 0; repa < PROBE_DSA_A; ++repa)
    if (t0 + 8 > 256) {
        const int nkb = ((t0 + 8 + 63) >> 6) << 1;
        const int hh_r = (r32 >> 2) & 1, reg_r = (r32 & 3) | ((r32 >> 3) << 2), qi4 = 2 * hh_r + (reg_r >> 3), hd = reg_r & 7;
        bf16x8 qaf[2][2]; float wv[2][16];
#pragma unroll
        for (int rb = 0; rb < 2; ++rb) {
            const bf16_t* qp = WSP(bf16_t, WS_QI) + (tb + t0 + 4 * rb + qi4) * 256 + hd * 32 + 8 * h;
            qaf[rb][0] = *(const bf16x8*)qp; qaf[rb][1] = *(const bf16x8*)(qp + 16);
#pragma unroll
            for (int rg = 0; rg < 16; ++rg) wv[rb][rg] = wt[(4 * rb + 2 * h + (rg >> 3)) * 8 + (rg & 7)];
        }
        int kb = wave;
        bf16x8 bk0 = {0, 0, 0, 0, 0, 0, 0, 0}, bk1 = {0, 0, 0, 0, 0, 0, 0, 0};
        if (kb < nkb) { const bf16_t* kp = WSP(bf16_t, WS_KI) + (tb + 32 * kb + r32) * 32 + 8 * h; bk0 = *(const bf16x8*)kp; bk1 = *(const bf16x8*)(kp + 16); }
        while (kb < nkb) {
            const int kn = kb + 8; bf16x8 nb0 = bk0, nb1 = bk1;
            if (kn < nkb) { const bf16_t* kp = WSP(bf16_t, WS_KI) + (tb + 32 * kn + r32) * 32 + 8 * h; nb0 = *(const bf16x8*)kp; nb1 = *(const bf16x8*)(kp + 16); }
            const int key = 32 * kb + r32;
#pragma unroll
            for (int rb = 0; rb < 2; ++rb) {
                f32x16 c;
#pragma unroll
                for (int i = 0; i < 16; ++i) c[i] = 0.f;
                c = __builtin_amdgcn_mfma_f32_32x32x16_bf16(qaf[rb][0], bk0, c, 0, 0, 0);
                c = __builtin_amdgcn_mfma_f32_32x32x16_bf16(qaf[rb][1], bk1, c, 0, 0, 0);
                float sA = 0.f, sB = 0.f;
#pragma unroll
                for (int i = 0; i < 8; ++i) { sA += wv[rb][i] * fmaxf(c[i], 0.f); sB += wv[rb][8 + i] * fmaxf(c[8 + i], 0.f); }
                const int qA = 4 * rb + 2 * h;
                sc[qA * 4096 + key] = (key <= t0 + qA) ? sA : NEG_INF;
                sc[(qA + 1) * 4096 + key] = (key <= t0 + qA + 1) ? sB : NEG_INF;
            }
            bk0 = nb0; bk1 = nb1; kb = kn;
        }
    }
    __syncthreads();
    T1(11, F.ws);
    T0W(12, F.ws);
    const int t = t0 + wave, n = t + 1;
    int cnt;
    for (int repb = 0; repb < PROBE_DSA_B; ++repb)
    if (n <= 256) {
#pragma unroll
        for (int i = 0; i < 4; ++i) { const int k = lane + 64 * i; list[k] = (unsigned short)(k < n ? k : 0); }
        cnt = n;
    } else {
        const int nreg = (n + 63) >> 6, ngrp = (nreg + 7) >> 3;
        LAS float* my = sc + wave * 4096;
        float f[64];
#pragma unroll
        for (int g8 = 0; g8 < 8; ++g8) {
#pragma unroll
            for (int k = 0; k < 8; ++k) f[g8 * 8 + k] = NEG_INF;
            if (g8 < ngrp) {
#pragma unroll
                for (int k = 0; k < 8; ++k) if (g8 * 8 + k < nreg) f[g8 * 8 + k] = my[64 * (g8 * 8 + k) + lane];
            }
        }
        float ta = NEG_INF, tb_ = NEG_INF, tc = NEG_INF, td = NEG_INF;
#pragma unroll
        for (int g8 = 0; g8 < 8; ++g8) if (g8 < ngrp) {
#pragma unroll
            for (int k = 0; k < 8; ++k) { const float x = f[g8 * 8 + k]; td = __builtin_amdgcn_fmed3f(tc, td, x); tc = __builtin_amdgcn_fmed3f(tb_, tc, x); tb_ = __builtin_amdgcn_fmed3f(ta, tb_, x); ta = fmaxf(ta, x); }
        }
        float L = td;
#pragma unroll
        for (int o_ = 1; o_ < 64; o_ <<= 1) L = fminf(L, __shfl_xor(L, o_));
        LAS unsigned* cval = (LAS unsigned*)my; LAS unsigned short* ckey = (LAS unsigned short*)(my + 1024);
        const unsigned long long ltmask = (1ull << lane) - 1ull;
        int ns = 0;
#pragma unroll
        for (int g8 = 0; g8 < 8; ++g8) if (g8 < ngrp) {
#pragma unroll
            for (int k = 0; k < 8; ++k) { const int i = g8 * 8 + k; const bool keep = f[i] >= L; const unsigned long long mk = __ballot(keep); const int pos = ns + __popcll(mk & ltmask);
                if (keep && pos < 1024) { const unsigned bits = __float_as_uint(f[i]); cval[pos] = bits ^ ((bits >> 31) ? 0xffffffffu : 0x80000000u); ckey[pos] = (unsigned short)(64 * i + lane); }
                ns += __popcll(mk); }
        }
        if (ns <= 1024) {
            unsigned w[16];
#pragma unroll
            for (int j = 0; j < 16; ++j) w[j] = (64 * j + lane < ns) ? cval[64 * j + lane] : 0u;
            const bool two = ns > 512;
            float Mx = ta;
#pragma unroll
            for (int o_ = 1; o_ < 64; o_ <<= 1) Mx = fmaxf(Mx, __shfl_xor(Mx, o_));
            const unsigned Lb = __float_as_uint(L), Mb = __float_as_uint(Mx);
            const unsigned Lk = __builtin_amdgcn_readfirstlane(Lb ^ ((Lb >> 31) ? 0xffffffffu : 0x80000000u)), Mk = __builtin_amdgcn_readfirstlane(Mb ^ ((Mb >> 31) ? 0xffffffffu : 0x80000000u));
            const int hb = (Lk == Mk) ? -1 : 31 - __builtin_clz(Lk ^ Mk);
            unsigned tau = (hb >= 31) ? 0u : (hb < 0 ? Mk : (Mk & ~((2u << hb) - 1u)));
            for (int bit = hb; bit >= 0; --bit) {
                const unsigned cand = tau | (1u << bit);
                int c = count_ge8(w[0], w[1], w[2], w[3], w[4], w[5], w[6], w[7], cand);
                if (two) c += count_ge8(w[8], w[9], w[10], w[11], w[12], w[13], w[14], w[15], cand);
                if (c >= 256) { tau = cand; if (c == 256) break; }
            }
            int cgt = count_ge8(w[0], w[1], w[2], w[3], w[4], w[5], w[6], w[7], tau + 1u);
            if (two) cgt += count_ge8(w[8], w[9], w[10], w[11], w[12], w[13], w[14], w[15], tau + 1u);
            const int need = 256 - cgt; int base = 0, eqseen = 0;
#pragma unroll
            for (int j = 0; j < 16; ++j) if (64 * j < ns) {
                const bool gt = w[j] > tau, eq = w[j] == tau;
                const unsigned long long meq = __ballot(eq);
                const bool sel = gt || (eq && (eqseen + __popcll(meq & ltmask)) < need);
                const unsigned long long msel = __ballot(sel);
                if (sel) list[base + __popcll(msel & ltmask)] = ckey[64 * j + lane];
                base += __popcll(msel); eqseen += __popcll(meq);
            }
        } else {
#pragma unroll
            for (int i = 0; i < 64; ++i) { const unsigned bits = __float_as_uint(f[i]); f[i] = __uint_as_float((i < nreg) ? (bits ^ ((bits >> 31) ? 0xffffffffu : 0x80000000u)) : 0u); }
#define u_(i) __float_as_uint(f[i])
            unsigned tau = 0u;
            for (int bit = 31; bit >= 0; --bit) {
                const unsigned cand = tau | (1u << bit); int c = 0;
#pragma unroll
                for (int g8 = 0; g8 < 8; ++g8) if (g8 < ngrp)
                    c += count_ge8(u_(g8 * 8 + 0), u_(g8 * 8 + 1), u_(g8 * 8 + 2), u_(g8 * 8 + 3), u_(g8 * 8 + 4), u_(g8 * 8 + 5), u_(g8 * 8 + 6), u_(g8 * 8 + 7), cand);
                if (c >= 256) { tau = cand; if (c == 256) break; }
            }
            int cgt = 0;
#pragma unroll
            for (int g8 = 0; g8 < 8; ++g8) if (g8 < ngrp)
                cgt += count_ge8(u_(g8 * 8 + 0), u_(g8 * 8 + 1), u_(g8 * 8 + 2), u_(g8 * 8 + 3), u_(g8 * 8 + 4), u_(g8 * 8 + 5), u_(g8 * 8 + 6), u_(g8 * 8 + 7), tau + 1u);
            const int need = 256 - cgt; int base = 0, eqseen = 0;
#pragma unroll
            for (int g8 = 0; g8 < 8; ++g8) if (g8 < ngrp) {
#pragma unroll
                for (int k = 0; k < 8; ++k) { const int i = g8 * 8 + k;
                    const bool gt = u_(i) > tau, eq = u_(i) == tau;
                    const unsigned long long meq = __ballot(eq);
                    const bool sel = gt || (eq && (eqseen + __popcll(meq & ltmask)) < need);
                    const unsigned long long msel = __ballot(sel);
                    if (sel) list[base + __popcll(msel & ltmask)] = (unsigned short)(64 * i + lane);
                    base += __popcll(msel); eqseen += __popcll(meq); } }
        }
#undef u_
        cnt = 256;
    }
    T1(12, F.ws);
    T0W(14, F.ws);
    asm volatile("s_waitcnt lgkmcnt(0)" ::: "memory");
    T1(14, F.ws);
    T0W(13, F.ws);
    for (int repc = 0; repc < PROBE_DSA_C; ++repc)
    {
        const int head = lane & 15, g4 = lane >> 4, q4 = (lane & 15) >> 2, p4 = lane & 3;
        const bf16_t* qp = WSP(bf16_t, WS_Q1) + (tb + t) * 1024 + head * 64 + 8 * g4;
        const bf16x8 qf0 = *(const bf16x8*)qp, qf1 = *(const bf16x8*)(qp + 32);
        const bf16_t* K1 = WSP(bf16_t, WS_K1) + tb * 64; const bf16_t* V1 = WSP(bf16_t, WS_V1) + tb * 64;
        f32x4_t sA[8], sB[8];
        float mx = NEG_INF;
        const float cfar = lutd[113 * 16 + head];
        LAS unsigned char* kst = lds + wave * 16384;
        {
            u32x4 kr[8][4];
#pragma unroll
            for (int c = 0; c < 8; ++c) {
#pragma unroll
                for (int i = 0; i < 4; ++i) { const unsigned key = list[32 * c + 8 * i + (lane >> 3)]; kr[c][i] = *(const u32x4*)((const char*)K1 + (key * 128u + (unsigned)(lane & 7) * 16u)); }
            }
#pragma unroll
            for (int c = 0; c < 8; ++c) {
#pragma unroll
                for (int i = 0; i < 4; ++i) *(LAS u32x4*)(kst + (8 * i + (lane >> 3)) * VROW + (lane & 7) * 16) = kr[c][i];
                const LAS unsigned char* ka = kst + (lane & 15) * VROW + 16 * g4;
                const bf16x8 kA0 = *(const LAS bf16x8*)ka, kA1 = *(const LAS bf16x8*)(ka + 64), kB0 = *(const LAS bf16x8*)(ka + 16 * VROW), kB1 = *(const LAS bf16x8*)(ka + 16 * VROW + 64);
                const int kmax = __builtin_amdgcn_readfirstlane((int)list[32 * c + 31]);
                if (cnt == 256 && t - kmax >= 113) {
                    f32x4_t a = {cfar, cfar, cfar, cfar}, bb = {cfar, cfar, cfar, cfar};
                    a = __builtin_amdgcn_mfma_f32_16x16x32_bf16(kA0, qf0, a, 0, 0, 0); a = __builtin_amdgcn_mfma_f32_16x16x32_bf16(kA1, qf1, a, 0, 0, 0);
                    bb = __builtin_amdgcn_mfma_f32_16x16x32_bf16(kB0, qf0, bb, 0, 0, 0); bb = __builtin_amdgcn_mfma_f32_16x16x32_bf16(kB1, qf1, bb, 0, 0, 0);
                    sA[c] = a; sB[c] = bb;
                    mx = fmaxf(mx, fmaxf(fmaxf(fmaxf(a[0], a[1]), fmaxf(a[2], a[3])), fmaxf(fmaxf(bb[0], bb[1]), fmaxf(bb[2], bb[3]))));
                } else {
                    f32x4_t a = {0.f, 0.f, 0.f, 0.f}, bb = {0.f, 0.f, 0.f, 0.f};
                    a = __builtin_amdgcn_mfma_f32_16x16x32_bf16(kA0, qf0, a, 0, 0, 0); a = __builtin_amdgcn_mfma_f32_16x16x32_bf16(kA1, qf1, a, 0, 0, 0);
                    bb = __builtin_amdgcn_mfma_f32_16x16x32_bf16(kB0, qf0, bb, 0, 0, 0); bb = __builtin_amdgcn_mfma_f32_16x16x32_bf16(kB1, qf1, bb, 0, 0, 0);
                    const u32x2 ia = *(const LAS u32x2*)(list + 32 * c + 4 * g4), ib = *(const LAS u32x2*)(list + 32 * c + 16 + 4 * g4);
#pragma unroll
                    for (int i = 0; i < 4; ++i) {
                        const int keyA = (int)(((i < 2 ? ia.x : ia.y) >> (16 * (i & 1))) & 0xffffu), keyB = (int)(((i < 2 ? ib.x : ib.y) >> (16 * (i & 1))) & 0xffffu);
                        const int dA = t - keyA, dB = t - keyB;
                        const float bA = lutd[(dA > 113 ? 113 : (dA < 0 ? 0 : dA)) * 16 + head], bB = lutd[(dB > 113 ? 113 : (dB < 0 ? 0 : dB)) * 16 + head];
                        const int slotA = 32 * c + 4 * g4 + i, slotB = slotA + 16;
                        sA[c][i] = slotA < cnt ? a[i] + bA : NEG_INF; sB[c][i] = slotB < cnt ? bb[i] + bB : NEG_INF;
                        mx = fmaxf(mx, fmaxf(sA[c][i], sB[c][i]));
                    }
                }
            }
        }
        asm volatile("" ::: "memory");
        u32x4 vr[4][4];
#pragma unroll
        for (int c = 0; c < 4; ++c) {
#pragma unroll
            for (int i = 0; i < 4; ++i) { const unsigned key = list[32 * c + 8 * i + (lane >> 3)]; vr[c][i] = *(const u32x4*)((const char*)V1 + (key * 128u + (unsigned)(lane & 7) * 16u)); }
        }
        mx = fmaxf(mx, __shfl_xor(mx, 16)); mx = fmaxf(mx, __shfl_xor(mx, 32));
        float l = 0.f;
#pragma unroll
        for (int c = 0; c < 8; ++c)
#pragma unroll
            for (int i = 0; i < 4; ++i) { sA[c][i] = __builtin_amdgcn_exp2f(sA[c][i] - mx); sB[c][i] = __builtin_amdgcn_exp2f(sB[c][i] - mx); l += sA[c][i] + sB[c][i]; }
        l += __shfl_xor(l, 16); l += __shfl_xor(l, 32);
        f32x4_t o[4];
#pragma unroll
        for (int d = 0; d < 4; ++d) o[d] = (f32x4_t){0.f, 0.f, 0.f, 0.f};
#pragma unroll
        for (int c = 0; c < 8; ++c) {
            {
                LAS unsigned char* vst = kst + (32 + 32 * (c & 1)) * VROW;
#pragma unroll
                for (int i = 0; i < 4; ++i) *(LAS u32x4*)(vst + (8 * i + (lane >> 3)) * VROW + (lane & 7) * 16) = vr[c & 3][i];
                if (c + 4 < 8) {
#pragma unroll
                    for (int i = 0; i < 4; ++i) { const unsigned key = list[32 * (c + 4) + 8 * i + (lane >> 3)]; vr[c & 3][i] = *(const u32x4*)((const char*)V1 + (key * 128u + (unsigned)(lane & 7) * 16u)); }
                }
                u32x4 pw; pw.x = cvt_pk_bf16(sA[c][0], sA[c][1]); pw.y = cvt_pk_bf16(sA[c][2], sA[c][3]); pw.z = cvt_pk_bf16(sB[c][0], sB[c][1]); pw.w = cvt_pk_bf16(sB[c][2], sB[c][3]);
                const bf16x8 pb = __builtin_bit_cast(bf16x8, pw);
#pragma unroll
                for (int d = 0; d < 4; ++d) {
                    const LAS char* base = (const LAS char*)(vst + (4 * g4 + q4) * VROW + (16 * d + 4 * p4) * 2);
                    const s16x4 lo = att::vtr(base), hi = att::vtr(base + 16 * VROW);
                    const bf16x8 vf = {lo[0], lo[1], lo[2], lo[3], hi[0], hi[1], hi[2], hi[3]};
                    o[d] = __builtin_amdgcn_mfma_f32_16x16x32_bf16(vf, pb, o[d], 0, 0, 0);
                }
            }
        }
        const float inv = FP8_SMIX / l;
        unsigned char* orow = F.ws + WS_MIX1 + (tb + t) * 1024 + head * 64 + 4 * g4;
#pragma unroll
        for (int d = 0; d < 4; ++d) *(unsigned*)(orow + 16 * d) = cvt4_fp8(o[d][0] * inv, o[d][1] * inv, o[d][2] * inv, o[d][3] * inv);
    }
    T1(13, F.ws);
    T0W(15, F.ws);
    __syncthreads();
    T1(15, F.ws);
}

__device__ __forceinline__ void dsa_phase(Frame& F, const Args& A) {
    LAS float* lutd = (LAS float*)(F.lds + L_LUTD);
    { const float* rb = INP(I_RELB); float lv[4];
#pragma unroll
      for (int k = 0; k < 4; ++k) { const int i = F.tid + 512 * k; lv[k] = (i < 114 * 16) ? rb[t5_bucket(i >> 4) * 16 + (i & 15)] : 0.f; }
#pragma unroll
      for (int k = 0; k < 4; ++k) { const int i = F.tid + 512 * k; if (i < 114 * 16) lutd[i] = lv[k] * LOG2E; } }
    __syncthreads();
#ifndef PROBE_DSA_REP
#define PROBE_DSA_REP 1
#endif
    const bool xa = (F.G == 256);
    const int nround = xa ? 16 : (4096 + F.G - 1) / F.G;
    for (int ii = 0; ii < nround * PROBE_DSA_REP; ++ii) {
        const int i = ii % nround; int b, tb; bool ok = true;
        if (xa) { const int r = F.bid >> 3; b = F.bid & 7; tb = 511 - (i * 32 + ((i & 1) ? 31 - r : r)); }
        else { const int cc = (i & 1) ? (F.G - 1 - F.bid) : F.bid; const int I = i * F.G + cc; ok = I < 4096; b = I & 7; tb = 511 - (I >> 3); }
        if (ok) unit_dsa(F, A, b, 8 * tb);
    }
}
}
constexpr int NPHASE = 19;
__global__ void __launch_bounds__(512, 2) mk_fwd(Args args) {
    extern __shared__ __attribute__((aligned(16))) unsigned char lds_raw[];
    Frame F;
    F.lds = (LAS unsigned char*)lds_raw;
    F.tid = threadIdx.x; F.lane = F.tid & 63; F.wave = __builtin_amdgcn_readfirstlane(F.tid >> 6);
    F.G = gridDim.x; F.bid = blockIdx.x; F.ws = args.ws; F.out = args.out;
    volatile LAS unsigned* MISC = (volatile LAS unsigned*)(F.lds + LDS_MISC_OFF);
    if (F.tid < 64) MISC[F.tid] = 0u;
    __syncthreads();
    if (F.tid < 28) *(LAS unsigned long long*)(F.lds + LDS_PTR_OFF + 8 * F.tid) = (unsigned long long)args.in[F.tid];
    __syncthreads();
    const int lo = args.ph_lo, hi = args.ph_hi;
    const bool use_bar = (hi - lo) > 1;
    XcdBarrier bar; bar.bar = (unsigned*)(F.ws + WS_CTL) + CW_BAR; bar.x = 0; bar.st = nullptr;
    if (use_bar) bar = xcd_barrier_post((unsigned*)(F.ws + WS_CTL) + CW_BAR, MISC);
#ifdef PH_ONLY
#define IN(k) ((k) == PH_ONLY && lo <= (k) && (k) < hi)
#else
#define IN(k) (lo <= (k) && (k) < hi)
#endif
#ifndef PROBE_PH
#define PROBE_PH -1
#endif
#define REP(k) for (int rep_ = 0; rep_ < ((k) == PROBE_PH ? 2 : 1); ++rep_)
#ifdef PSPAN_LO
#define SPAN_BEGIN(k) do { if ((k) == PSPAN_LO && blockIdx.x == 0 && threadIdx.x == 0) TPROBE_ACC(F.ws)[1] = __builtin_amdgcn_s_memrealtime(); } while (0)
#define SPAN_END(k) do { if ((k) == PSPAN_HI && blockIdx.x == 0 && threadIdx.x == 0) TPROBE_ACC(F.ws)[0] += __builtin_amdgcn_s_memrealtime() - TPROBE_ACC(F.ws)[1]; } while (0)
#else
#define SPAN_BEGIN(k) do { } while (0)
#define SPAN_END(k) do { } while (0)
#endif
#ifdef PROBE_IDLE_PH
#define SEAM(k) do { unsigned long long t0_ = 0; if ((k) == PROBE_IDLE_PH && threadIdx.x == 0) t0_ = __builtin_amdgcn_s_memrealtime(); if (IN(k) && IN((k) + 1)) xcd_barrier(bar); \
        if ((k) == PROBE_IDLE_PH && threadIdx.x == 0) atomicAdd(TPROBE_ACC(F.ws), (__builtin_amdgcn_s_memrealtime() - t0_) / (unsigned long long)gridDim.x); } while (0)
#else
#define SEAM(k) do { if (IN(k) && IN((k) + 1)) xcd_barrier(bar); SPAN_END(k); SPAN_BEGIN((k) + 1); } while (0)
#endif
    LAS unsigned char* ring = F.lds;
    const Args& A = args;

    SPAN_BEGIN(0);
    if (IN(0)) REP(0) { p0_prologue(F, A); } SEAM(0);
    if (IN(1)) REP(1) {
        pg8::Gemm g{WSP(bf16_t, WS_XB), WSP(bf16_t, WS_WIN0), DM}; pg8::Proj0OrderA S{F.G, F.bid};
        pg8::EpiProj0 E{F.ws};
        pg8::gemm_phase<pg8::EpiProj0, pg8::Proj0OrderA, true, true>(ring, g, S, E);
    } SEAM(1);
    if (IN(2)) REP(2) {
        pg8::Gemm g{WSP(bf16_t, WS_XB), WSP(bf16_t, WS_WIN0), DM}; pg8::Proj0OrderB S; S.so.init(T / 256, 7, F.G, F.bid); S.G = F.G; S.c = F.bid;
        pg8::EpiProj0 E{F.ws};
        pg8::gemm_phase<pg8::EpiProj0, pg8::Proj0OrderB, true, true>(ring, g, S, E);
    } SEAM(2);
    if (IN(3)) REP(3) { p2b_compress_tail(F, A); } SEAM(3);
    if (IN(4)) REP(4) { T0W(1, F.ws); att::attn0_phase(F, A); T1(1, F.ws); } SEAM(4);
    if (IN(5)) REP(5) {
        pg8::Gemm g{WSP(bf16_t, WS_MIX0), WSP(bf16_t, WS_WOUT0), DM / 2}; pg8::StaticOrder S; S.init(T / 256, DM / 256, F.G, F.bid);
        pg8::EpiRes E{INP(I_X), nullptr, (bf16_t*)F.out, 1.f / (FP8_SMIX0 * FP8_SWOUT)};
        pg8::gemm_phase<pg8::EpiRes, pg8::StaticOrder, true, true, false, false, true>(ring, g, S, E);
    } SEAM(5);
    if (IN(6)) REP(6) { T0W(33, F.ws); p_layernorm(F, (const bf16_t*)F.out, INP(I_L0_LN1G), INP(I_L0_LN1B), WSP(bf16_t, WS_X1B)); T1(33, F.ws); } SEAM(6);
    if (IN(7)) REP(7) {
        pg8::Gemm g{WSP(bf16_t, WS_X1B), WSP(bf16_t, WS_WGU0), DM}; pg8::StaticOrder S; S.init(T / 256, 2 * DFF / 256, F.G, F.bid);
        pg8::EpiSwiglu8 E{F.ws + WS_H0, 0, 1.f};
        T0W(50, F.ws); pg8::gemm_phase<pg8::EpiSwiglu8, pg8::StaticOrder, true, true>(ring, g, S, E); T1(50, F.ws);
    } SEAM(7);
    if (IN(8)) REP(8) {
        pg8::Gemm g{WSP(bf16_t, WS_H0), WSP(bf16_t, WS_WDN0), DFF / 2}; pg8::StaticOrder S; S.init(T / 256, DM / 256, F.G, F.bid);
        pg8::EpiRes E{nullptr, WSP(bf16_t, WS_X1B), (bf16_t*)F.out, 1.f / (FP8_SH * FP8_SWDN)};
        pg8::gemm_phase<pg8::EpiRes, pg8::StaticOrder, true, true, false, false, true>(ring, g, S, E);
    } SEAM(8);
    if (IN(9)) REP(9) { p_layernorm(F, (const bf16_t*)F.out, INP(I_L0_LN2G), INP(I_L0_LN2B), WSP(bf16_t, WS_X2B)); } SEAM(9);
    if (IN(10)) REP(10) {
        pg8::Gemm g{WSP(bf16_t, WS_X2B), WSP(bf16_t, WS_WIN1), DM}; pg8::StaticOrder S; S.init(T / 256, N_IN1P / 256, F.G, F.bid);
        pg8::EpiProj1 E{F.ws};
        pg8::gemm_phase<pg8::EpiProj1, pg8::StaticOrder, true, true>(ring, g, S, E);
    } SEAM(10);
    if (IN(11)) REP(11) { T0W(10, F.ws); dsa::dsa_phase(F, A); T1(10, F.ws); } SEAM(11);
    if (IN(12)) REP(12) {
        pg8::Gemm g{WSP(bf16_t, WS_MIX1), WSP(bf16_t, WS_WOUT1), DM / 2}; pg8::StaticOrder S; S.init(T / 256, DM / 256, F.G, F.bid);
        pg8::EpiRes E{nullptr, WSP(bf16_t, WS_X2B), WSP(bf16_t, WS_Y3), 1.f / (FP8_SMIX * FP8_SWOUT)};
        pg8::gemm_phase<pg8::EpiRes, pg8::StaticOrder, true, true, false, false, true>(ring, g, S, E);
    } SEAM(12);
    if (IN(13)) REP(13) { T0W(30, F.ws); p12_ln_router(F, A); T1(30, F.ws); } SEAM(13);
    if (IN(14)) REP(14) { T0W(31, F.ws); p13_moe_dispatch(F, A); T1(31, F.ws); } SEAM(14);
    if (IN(15)) REP(15) { LAS int* tile_e = (LAS int*)(F.lds + LDS_EXTRA_OFF); const int NT = moe_tile_table(F, tile_e);
        if (NT > 0) { pg8::Gemm g{(const bf16_t*)(F.ws + WS_X3F8), (const bf16_t*)(F.ws + WS_WGU1), DM / 2}; pg8::MoeOrder S; S.gpitch = DM / 2;
            S.so.init(NT, 2 * DFF / 256, F.G, F.bid); S.tile0 = 0; S.nN = 2 * DFF / 256; S.a_local = 0; S.tile_e = tile_e; S.rowlist = WSP(int, WS_ROWTOK);
            pg8::EpiSwiglu8 E{F.ws + WS_H1, 0, 1.f / (FP8_SX * FP8_SWGU)}; T0W(65, F.ws); pg8::gemm_phase<pg8::EpiSwiglu8, pg8::MoeOrder, true, true, true, false, true>(ring, g, S, E); T1(65, F.ws); } } SEAM(15);
    if (IN(16)) REP(16) { LAS int* tile_e = (LAS int*)(F.lds + LDS_EXTRA_OFF); const int NT = moe_tile_table(F, tile_e); const int nM_ = NT > 256 ? 256 : NT, ntail = NT - nM_;
        constexpr float SO = 1.f / (FP8_SH * FP8_SWDN);
        if (nM_ > 0) { pg8::Gemm g{(const bf16_t*)(F.ws + WS_H1), (const bf16_t*)(F.ws + WS_WDN1), DFF / 2}; pg8::MoeOrder S; S.so.init(nM_, DM / 256, F.G, F.bid); S.tile0 = 0; S.nN = DM / 256; S.a_local = 1; S.tile_e = tile_e; S.rowlist = nullptr; S.gpitch = 0;
            pg8::EpiBf16 E{WSP(bf16_t, WS_XG), SO}; T0W(66, F.ws); pg8::gemm_phase<pg8::EpiBf16, pg8::MoeOrder, true, true, false, false, true>(ring, g, S, E); T1(66, F.ws); }
        if (ntail > 0) { pg8::Gemm g{(const bf16_t*)(F.ws + WS_H1), (const bf16_t*)(F.ws + WS_WDN1), DFF / 2}; pg8::TailOrder S{F.G, F.bid, ntail, 256, 0, tile_e, nullptr, 0};
            pg8::EpiPart E{WSP(float, WS_PART), SO}; T0W(69, F.ws); pg8::gemm_phase<pg8::EpiPart, pg8::TailOrder, true, true, false, true, true>(ring, g, S, E); T1(69, F.ws); } } SEAM(16);
    if (IN(17)) REP(17) { T0W(32, F.ws); p_final(F, A); T1(32, F.ws); }
#undef IN
#undef SEAM
}

extern "C" void kernel_launch(void* const* d_in, const int* in_sizes, int n_in, void* d_out, int out_size, void* d_ws, size_t ws_size, hipStream_t stream) {
    static int grid = 0;
    if (grid == 0) {
        if (n_in != 28 || in_sizes[0] != T * DM || out_size != T * DM || ws_size < WS_END) {
            fprintf(stderr, "kernel_launch: unexpected problem (n_in %d, in0 %d, out %d, ws %zu); nothing launched\n", n_in, n_in > 0 ? in_sizes[0] : -1, out_size, ws_size); grid = -1; return; }
        int dev = 0, cus = 0, per_cu = 0;
        if (hipGetDevice(&dev) != hipSuccess || hipDeviceGetAttribute(&cus, hipDeviceAttributeMultiprocessorCount, dev) != hipSuccess) { grid = -1; return; }
        if (hipFuncSetAttribute((const void*)mk_fwd, hipFuncAttributeMaxDynamicSharedMemorySize, LDS_BYTES) != hipSuccess) { fprintf(stderr, "kernel_launch: hipFuncSetAttribute failed\n"); grid = -1; return; }
        if (hipOccupancyMaxActiveBlocksPerMultiprocessor(&per_cu, (const void*)mk_fwd, 512, LDS_BYTES) != hipSuccess || per_cu < 1) { fprintf(stderr, "kernel_launch: occupancy query says %d blocks per CU\n", per_cu); }
        (void)hipGetLastError();
        grid = cus;
    }
    if (grid < 0) return;
    (void)hipMemsetAsync((char*)d_ws + WS_CTL, 0, CTL_ZERO_BYTES, stream);
    Args a{};
    for (int i = 0; i < 28; ++i) a.in[i] = (const float*)d_in[i];
    a.out = (float*)d_out; a.ws = (unsigned char*)d_ws;
    constexpr int NPH = 18;
#if MK_N_LAUNCHES == 1
    a.ph_lo = 0; a.ph_hi = NPH;
    hipLaunchKernelGGL(mk_fwd, dim3(grid), dim3(512), LDS_BYTES, stream, a);
#else
    for (int p = 0; p < NPH; ++p) { a.ph_lo = p; a.ph_hi = p + 1; hipLaunchKernelGGL(mk_fwd, dim3(grid), dim3(512), LDS_BYTES, stream, a); }
#endif
}
```

```cpp
#include <hip/hip_runtime.h>
#include <cstdio>
#include <cstdint>

#ifndef MK_N_LAUNCHES
#define MK_N_LAUNCHES 1
#endif

#define LAS __attribute__((address_space(3)))
#define GAS __attribute__((address_space(1)))
typedef unsigned short bf16_t;
typedef short bf16x8 __attribute__((ext_vector_type(8)));
typedef short s16x4 __attribute__((ext_vector_type(4)));
typedef float f32x2 __attribute__((ext_vector_type(2)));
typedef float f32x4 __attribute__((ext_vector_type(4)));
typedef float f32x16 __attribute__((ext_vector_type(16)));
typedef unsigned u32x2 __attribute__((ext_vector_type(2)));
typedef unsigned u32x4 __attribute__((ext_vector_type(4)));

constexpr int NBATCH = 8, SEQ = 4096, T = NBATCH * SEQ, DM = 1024, DFF = 2816, NEXP = 8;
constexpr int N_IN0 = 2072, N_IN0P = 2304, N_IN1 = 1448, N_IN1P = 1536;
constexpr float ALPHA = 1.41421356237309515f;
constexpr float LN_EPS = 1e-5f;
constexpr float LOG2E = 1.4426950408889634f;
constexpr float QSCALE = 0.125f * LOG2E;

constexpr size_t MiB = 1u << 20;
constexpr size_t WS_CTL = 0, CTL_ZERO_BYTES = 1 * MiB;
constexpr size_t WS_KC = 1 * MiB;
constexpr size_t WS_POSW = 2 * MiB;
constexpr size_t WS_MOECNT = 2 * MiB + 64 * 1024;
constexpr size_t WS_MOEMETA = 2 * MiB + 128 * 1024;
constexpr size_t WS_TOKINFO = 2 * MiB + 256 * 1024;
constexpr size_t WS_WGU1 = 4 * MiB;
constexpr size_t WS_X3F8 = 48 * MiB;
constexpr size_t WS_WDN1 = 92 * MiB;
constexpr size_t WS_WIN0 = 136 * MiB;
constexpr size_t WS_WC1 = 141 * MiB;
constexpr size_t WS_WOUT0 = 143 * MiB;
constexpr size_t WS_WGU0 = 145 * MiB;
constexpr size_t WS_WDN0 = 156 * MiB;
constexpr size_t WS_WIN1 = 162 * MiB;
constexpr size_t WS_WOUT1 = 165 * MiB;
constexpr size_t WS_XB = 168 * MiB;
constexpr size_t WS_QA = 232 * MiB;
constexpr size_t WS_QB = 264 * MiB;
constexpr size_t WS_KA = 296 * MiB;
constexpr size_t WS_VA = 304 * MiB;
constexpr size_t WS_KCMP = 312 * MiB;
constexpr size_t WS_VCMP = 320 * MiB;
constexpr size_t WS_KSLC = 328 * MiB;
constexpr size_t WS_VSLC = 336 * MiB;
constexpr size_t WS_KWIN = 344 * MiB;
constexpr size_t WS_VWIN = 352 * MiB;
constexpr size_t WS_GATES = 360 * MiB;
constexpr size_t WS_HCMP = 364 * MiB;
constexpr size_t WS_MIX0 = WS_XB;
constexpr size_t WS_X1B = 232 * MiB;
constexpr size_t WS_H0 = 296 * MiB;
constexpr size_t WS_X2B = WS_XB;
constexpr size_t WS_Q1 = 232 * MiB;
constexpr size_t WS_K1 = 296 * MiB;
constexpr size_t WS_V1 = 300 * MiB;
constexpr size_t WS_QI = 304 * MiB;
constexpr size_t WS_KI = 320 * MiB;
constexpr size_t WS_WI = 322 * MiB;
constexpr size_t WS_MIX1 = 328 * MiB;
constexpr size_t WS_Y3 = 392 * MiB;
constexpr size_t WS_X3B = 200 * MiB;
constexpr size_t WS_ROWTOK = 3 * MiB;
constexpr size_t WS_XG = 136 * MiB;
constexpr size_t WS_H1 = 268 * MiB;
constexpr size_t WS_PART = 456 * MiB;
constexpr size_t WS_END = 512 * MiB;
constexpr float FP8_SX = 8.f, FP8_SWGU = 1024.f, FP8_SH = 8.f, FP8_SWDN = 4096.f, FP8_SMIX = 32.f, FP8_SMIX0 = 16.f, FP8_SWOUT = 2048.f;
constexpr int MOE_PASS_TILES = 128;
constexpr int MOE_MAX_TILES = 264;

constexpr int CW_BAR = 4096;

constexpr int RING_BYTES = 131072;
constexpr int LDS_EXTRA_OFF = RING_BYTES;
constexpr int LDS_MISC_OFF = RING_BYTES + 16384;
constexpr int LDS_BYTES = RING_BYTES + 16384 + 512;


#ifndef PROBE_T
#define PROBE_T 0
#endif
#ifndef PROBE_TBASE
#define PROBE_TBASE 20.f
#endif
#define TPROBE_ACC(ws_) ((unsigned long long*)((ws_) + WS_CTL + 512))
#define T0W(id, ws_) do { if (PROBE_T == (id) && blockIdx.x == 0 && threadIdx.x == 0) TPROBE_ACC(ws_)[1] = __builtin_amdgcn_s_memrealtime(); } while (0)
#define T1(id, ws_) do { if (PROBE_T == (id) && blockIdx.x == 0 && threadIdx.x == 0) TPROBE_ACC(ws_)[0] += __builtin_amdgcn_s_memrealtime() - TPROBE_ACC(ws_)[1]; } while (0)

typedef __bf16 bf16x2_t __attribute__((ext_vector_type(2)));
__device__ __forceinline__ unsigned cvt_pk_bf16(float lo, float hi) { const f32x2 v = {lo, hi}; const bf16x2_t b = __builtin_convertvector(v, bf16x2_t); return __builtin_bit_cast(unsigned, b); }
__device__ __forceinline__ unsigned cvt4_fp8(float a, float b, float c, float d) {
    a = __builtin_amdgcn_fmed3f(a, 448.f, -448.f); b = __builtin_amdgcn_fmed3f(b, 448.f, -448.f); c = __builtin_amdgcn_fmed3f(c, 448.f, -448.f); d = __builtin_amdgcn_fmed3f(d, 448.f, -448.f);
    int r = __builtin_amdgcn_cvt_pk_fp8_f32(a, b, 0, false); r = __builtin_amdgcn_cvt_pk_fp8_f32(c, d, r, true); return (unsigned)r;
}
__device__ __forceinline__ float bf_lo(unsigned w) { return __uint_as_float(w << 16); }
__device__ __forceinline__ float bf_hi(unsigned w) { return __uint_as_float(w & 0xffff0000u); }
__device__ __forceinline__ float wave_sum(float v) {
#pragma unroll
    for (int o = 1; o < 64; o <<= 1) v += __shfl_xor(v, o);
    return v;
}
__device__ __forceinline__ float swap_max(float m) { auto rr = __builtin_amdgcn_permlane32_swap(__float_as_uint(m), __float_as_uint(m), false, false); return fmaxf(__uint_as_float(rr[0]), __uint_as_float(rr[1])); }
__device__ __forceinline__ float swap_sum(float m) { auto rr = __builtin_amdgcn_permlane32_swap(__float_as_uint(m), __float_as_uint(m), false, false); return __uint_as_float(rr[0]) + __uint_as_float(rr[1]); }
__device__ __forceinline__ int t5_bucket(int n) {
    if (n < 16) return n;
    int b = 16;
    b += (n >= 19); b += (n >= 21); b += (n >= 24); b += (n >= 27); b += (n >= 31); b += (n >= 35); b += (n >= 40); b += (n >= 46);
    b += (n >= 52); b += (n >= 59); b += (n >= 67); b += (n >= 77); b += (n >= 87); b += (n >= 99); b += (n >= 113);
    return b;
}
namespace pg8 {
#define PG8_LAS __attribute__((address_space(3)))
constexpr int BM = 256, BK = 64, HALF = 128, HTB = HALF * BK * 2  , STAGE_BYTES = 8 * HTB, NXCD = 8, WGM = 8;
__host__ __device__ __forceinline__ int lds_byte(int r, int c) { const int st = (r >> 4) * 2 + (c >> 5), rr = r & 15, cc = c & 31, ob = rr * 64 + cc * 2; return st * 1024 + (ob ^ (((ob >> 9) & 1) << 5)); }
__host__ __device__ __forceinline__ void stage_rc(int b, int& R, int& C) { const int st = b / 1024, sb = b % 1024, swz = sb ^ (((sb >> 9) & 1) << 5); R = (st >> 1) * 16 + swz / 64; C = (st & 1) * 32 + (swz % 64) / 2; }
__host__ __device__ __forceinline__ int perm32(int rho) { const int n = rho >> 4, i = rho & 15; return 8 * (i >> 2) + 4 * n + (i & 3); }

struct Unit { int pa, pb, pm, pn, kb, nt, aux; };
struct Gemm { const bf16_t* A; const bf16_t* Bt; int K; };

struct StaticOrder {
    int nM, nN, nwg, G, c; const int* rowlist; int gpitch;
    __host__ __device__ void init(int nM_, int nN_, int G_, int c_) { nM = nM_; nN = nN_; nwg = nM * nN; G = G_; c = c_; }
    __host__ __device__ bool next(int i, Unit& u) const {
        const long L = (long)i * G + c; if (L >= nwg) return false;
        int wgid = (int)L; { const int q = nwg / NXCD, r = nwg % NXCD, xcd = wgid % NXCD, off = wgid / NXCD; wgid = (xcd < r ? xcd * (q + 1) : r * (q + 1) + (xcd - r) * q) + off; }
        const int nig = WGM * nN, gid = wgid / nig, fm = gid * WGM, gsz = (nM - fm) < WGM ? (nM - fm) : WGM;
        u.pm = fm + ((wgid % nig) % gsz); u.pn = (wgid % nig) / gsz; u.pa = u.pm; u.pb = u.pn; return true;
    }
    __device__ __forceinline__ void a_ready(const Unit&) const {}
    __device__ __forceinline__ void done(const Unit&) const {}
};
typedef int pg8_i32x4 __attribute__((ext_vector_type(4)));
typedef int pg8_i32x8 __attribute__((ext_vector_type(8)));
template <class Epi, class Sched, bool ALIGN_EPI = false, bool SP2 = false, bool GATHER = false, bool KSPLIT = false, bool FP8 = false>
__device__ __forceinline__ void gemm_phase(PG8_LAS unsigned char* lds, const Gemm g, const Sched& S, const Epi& E) {
    const int tid = threadIdx.x, wid = __builtin_amdgcn_readfirstlane(tid >> 6), lane = tid & 63, wr = wid >> 2, wc = wid & 3, fr = lane & 15, fq = lane >> 4;
    const int K = g.K, nt = K / BK;
    unsigned voffA[2], voffB[2]; int rA[2], cA2[2];
#pragma unroll
    for (int i = 0; i < 2; ++i) { int R, C; stage_rc(tid * 16 + i * 8192, R, C); const int Rb = Epi::PERM ? ((R & ~31) + perm32(R & 31)) : R;
        voffA[i] = (unsigned)(R * K + C) * 2u; voffB[i] = (unsigned)(Rb * K + C) * 2u; rA[i] = R; cA2[i] = C; }
    unsigned vofC[2][2], vofN[2][2];
#define PG8_GOFF(dst, unit) do { if constexpr (GATHER) { _Pragma("unroll") for (int h_ = 0; h_ < 2; ++h_) _Pragma("unroll") for (int i_ = 0; i_ < 2; ++i_) \
        dst[h_][i_] = ((unsigned)S.rowlist[(unit).pm * BM + h_ * HALF + rA[i_]] * (unsigned)S.gpitch + (unsigned)cA2[i_]) * 2u; } } while (0)
    const size_t kstep = (size_t)(BK * 2);
    const size_t hstep = (size_t)HALF * K * 2;
    const size_t tstep = 2 * hstep;
    const unsigned ldsw = (unsigned)wid * 1024u;
    const int aoff = lds_byte(wr * 64 + fr, fq * 8), boff = lds_byte(wc * 32 + fr, fq * 8);
#define PG8_SA(b, h) (((b) * 2 + (h)) * HTB)
#define PG8_SB(b, h) ((4 + (b) * 2 + (h)) * HTB)
#define PG8_STAGE(bufoff, gbase, voff) do { _Pragma("unroll") for (int _i = 0; _i < 2; ++_i) \
        __builtin_amdgcn_global_load_lds((const unsigned*)((const char*)(gbase) + (voff)[_i]), (PG8_LAS unsigned*)(lds + (bufoff) + ldsw + _i * 8192), 16, 0, 0); } while (0)
#define PG8_STAGE_A(bufoff, gbase, h, VO) do { if constexpr (GATHER) PG8_STAGE(bufoff, gbase, VO[h]); else PG8_STAGE(bufoff, (gbase) + (h) * hstep, voffA); } while (0)
#define PG8_LD8(p_) __builtin_shufflevector(*(const PG8_LAS pg8_i32x4*)(p_), *(const PG8_LAS pg8_i32x4*)((p_) + 1024), 0, 1, 2, 3, 4, 5, 6, 7)
#define PG8_LDA(dst, b, h) do { if constexpr (FP8) { _Pragma("unroll") for (int m = 0; m < 4; ++m) dst##8[m] = PG8_LD8(lds + PG8_SA(b, h) + aoff + m * 2048); } else { \
        _Pragma("unroll") for (int m = 0; m < 4; ++m) _Pragma("unroll") for (int k = 0; k < 2; ++k) dst[m][k] = *(const PG8_LAS bf16x8*)(lds + PG8_SA(b, h) + aoff + m * 2048 + k * 1024); } } while (0)
#define PG8_LDB(dst, b, h) do { if constexpr (FP8) { _Pragma("unroll") for (int n = 0; n < 2; ++n) dst##8[n] = PG8_LD8(lds + PG8_SB(b, h) + boff + n * 2048); } else { \
        _Pragma("unroll") for (int n = 0; n < 2; ++n) _Pragma("unroll") for (int k = 0; k < 2; ++k) dst[n][k] = *(const PG8_LAS bf16x8*)(lds + PG8_SB(b, h) + boff + n * 2048 + k * 1024); } } while (0)
#define PG8_MMA(ai, bj, At, Bt) do { __builtin_amdgcn_s_setprio(1); if constexpr (FP8) { _Pragma("unroll") for (int m = 0; m < 4; ++m) _Pragma("unroll") for (int n = 0; n < 2; ++n) \
        asm volatile("v_mfma_f32_16x16x128_f8f6f4 %0, %1, %2, %0" : "+v"(acc[ai][bj][m][n]) : "v"(Bt##8[n]), "v"(At##8[m])); } else { \
        _Pragma("unroll") for (int m = 0; m < 4; ++m) _Pragma("unroll") for (int n = 0; n < 2; ++n) _Pragma("unroll") for (int k = 0; k < 2; ++k) \
        acc[ai][bj][m][n] = __builtin_amdgcn_mfma_f32_16x16x32_bf16(Bt[n][k], At[m][k], acc[ai][bj][m][n], 0, 0, 0); } __builtin_amdgcn_s_setprio(0); } while (0)
#define PG8_WAIT_V(n) asm volatile("s_waitcnt vmcnt(" #n ")" ::: "memory")
#define PG8_WAIT_L(n) asm volatile("s_waitcnt lgkmcnt(" #n ")" ::: "memory")
#define PG8_BAR __builtin_amdgcn_s_barrier()
#define PG8_SCHED __builtin_amdgcn_sched_barrier(0)
    Unit cur, nxt; int ui = 0;
    if (!S.next(0, cur)) return;
    f32x4 acc[2][2][4][2];
#pragma unroll
    for (int a = 0; a < 2; ++a)
#pragma unroll
        for (int b = 0; b < 2; ++b)
#pragma unroll
            for (int m = 0; m < 4; ++m)
#pragma unroll
                for (int n = 0; n < 2; ++n) acc[a][b][m][n] = (f32x4){0.f, 0.f, 0.f, 0.f};
    bf16x8 At[4][2], B0[2][2], B1[2][2]; pg8_i32x8 At8[4], B08[2], B18[2];
    const char* cA = (const char*)g.A + (size_t)cur.pa * tstep + (KSPLIT ? cur.kb : 0); const char* cB = (const char*)g.Bt + (size_t)cur.pb * tstep + (KSPLIT ? cur.kb : 0);
    S.a_ready(cur);
    PG8_GOFF(vofC, cur);
#pragma unroll
    for (int h_ = 0; h_ < 2; ++h_)
#pragma unroll
        for (int i_ = 0; i_ < 2; ++i_) { if constexpr (!GATHER) vofC[h_][i_] = 0u; vofN[h_][i_] = vofC[h_][i_]; }
    if constexpr (SP2) {
        PG8_STAGE(PG8_SB(0, 0), cB, voffB); PG8_STAGE(PG8_SB(0, 1), cB + hstep, voffB); PG8_STAGE_A(PG8_SA(0, 0), cA, 0, vofC); PG8_STAGE_A(PG8_SA(0, 1), cA, 1, vofC);
        if (wr == 1) PG8_BAR;
        PG8_WAIT_V(2); PG8_BAR;
        PG8_STAGE(PG8_SB(1, 0), cB + kstep, voffB); PG8_STAGE_A(PG8_SA(1, 0), cA + kstep, 0, vofC); PG8_STAGE(PG8_SB(1, 1), cB + hstep + kstep, voffB);
        PG8_WAIT_V(6); PG8_BAR;
    } else {
        PG8_STAGE(PG8_SB(0, 0), cB, voffB); PG8_STAGE_A(PG8_SA(0, 0), cA, 0, vofC); PG8_STAGE(PG8_SB(0, 1), cB + hstep, voffB); PG8_STAGE_A(PG8_SA(0, 1), cA, 1, vofC);
        if (wr == 1) PG8_BAR;
        PG8_WAIT_V(4); PG8_BAR;
        PG8_STAGE(PG8_SB(1, 0), cB + kstep, voffB); PG8_STAGE_A(PG8_SA(1, 0), cA + kstep, 0, vofC); PG8_STAGE(PG8_SB(1, 1), cB + hstep + kstep, voffB);
        PG8_WAIT_V(6); PG8_BAR;
    }
    for (;;) {
        const bool has_next = S.next(ui + 1, nxt);
        if constexpr (GATHER) { if (has_next) PG8_GOFF(vofN, nxt); }
        const char* nA = has_next ? (const char*)g.A + (size_t)nxt.pa * tstep + (KSPLIT ? nxt.kb : 0) : cA; const char* nB = has_next ? (const char*)g.Bt + (size_t)nxt.pb * tstep + (KSPLIT ? nxt.kb : 0) : cB;
        int ntu = KSPLIT ? cur.nt : nt; if constexpr (FP8) asm volatile("" : "+s"(ntu));
        for (int t = 0; t < ntu; t += 2) {
            const bool last = (t == ntu - 2);
            unsigned vsel[2][2];
#pragma unroll
            for (int h_ = 0; h_ < 2; ++h_)
#pragma unroll
                for (int i_ = 0; i_ < 2; ++i_) vsel[h_][i_] = last ? vofN[h_][i_] : vofC[h_][i_];
            const char* a1 = cA + (size_t)(t + 1) * kstep;
            const char* a2 = last ? nA : cA + (size_t)(t + 2) * kstep; const char* b2 = last ? nB : cB + (size_t)(t + 2) * kstep;
            const char* a3 = a2 + kstep; const char* b3 = b2 + kstep;
            if (last && has_next) S.a_ready(nxt);
            if constexpr (SP2) {
            PG8_LDB(B0, 0, 0); PG8_LDB(B1, 0, 1); PG8_SCHED; PG8_LDA(At, 0, 0); PG8_STAGE_A(PG8_SA(1, 1), a1, 1, vofC);
            PG8_WAIT_V(8); PG8_WAIT_L(0); PG8_BAR; PG8_MMA(0, 0, At, B0); PG8_MMA(0, 1, At, B1); PG8_BAR; PG8_SCHED;
            PG8_LDA(At, 0, 1); PG8_STAGE(PG8_SB(0, 0), b2, voffB); PG8_STAGE(PG8_SB(0, 1), b2 + hstep, voffB); PG8_STAGE_A(PG8_SA(0, 0), a2, 0, vsel);
            PG8_WAIT_V(8); PG8_WAIT_L(0); PG8_BAR; PG8_MMA(1, 0, At, B0); PG8_MMA(1, 1, At, B1); PG8_BAR; PG8_SCHED;
            PG8_LDB(B0, 1, 0); PG8_LDB(B1, 1, 1); PG8_SCHED; PG8_LDA(At, 1, 0); PG8_STAGE_A(PG8_SA(0, 1), a2, 1, vsel);
            PG8_WAIT_V(8); PG8_WAIT_L(0); PG8_BAR; PG8_MMA(0, 0, At, B0); PG8_MMA(0, 1, At, B1); PG8_BAR; PG8_SCHED;
            PG8_LDA(At, 1, 1); PG8_STAGE(PG8_SB(1, 0), b3, voffB); PG8_STAGE(PG8_SB(1, 1), b3 + hstep, voffB); PG8_STAGE_A(PG8_SA(1, 0), a3, 0, vsel);
            PG8_WAIT_V(8); PG8_WAIT_L(0); PG8_BAR; PG8_MMA(1, 0, At, B0); PG8_MMA(1, 1, At, B1); PG8_BAR; PG8_SCHED;
            } else {
            PG8_LDB(B0, 0, 0); PG8_SCHED; PG8_LDA(At, 0, 0); PG8_STAGE_A(PG8_SA(1, 1), a1, 1, vofC);
            PG8_WAIT_L(8); PG8_BAR; PG8_WAIT_L(0); PG8_MMA(0, 0, At, B0); PG8_BAR; PG8_SCHED;
            PG8_LDB(B1, 0, 1); PG8_STAGE(PG8_SB(0, 0), b2, voffB);
            PG8_BAR; PG8_WAIT_L(0); PG8_MMA(0, 1, At, B1); PG8_BAR;
            PG8_LDA(At, 0, 1); PG8_STAGE_A(PG8_SA(0, 0), a2, 0, vsel);
            PG8_BAR; PG8_WAIT_L(0); PG8_MMA(1, 0, At, B0); PG8_BAR; PG8_SCHED;
            PG8_STAGE(PG8_SB(0, 1), b2 + hstep, voffB);
            PG8_WAIT_V(6); PG8_BAR; PG8_MMA(1, 1, At, B1); PG8_BAR;
            PG8_LDB(B0, 1, 0); PG8_SCHED; PG8_LDA(At, 1, 0); PG8_STAGE_A(PG8_SA(0, 1), a2, 1, vsel);
            PG8_WAIT_L(8); PG8_BAR; PG8_WAIT_L(0); PG8_MMA(0, 0, At, B0); PG8_BAR; PG8_SCHED;
            PG8_LDB(B1, 1, 1); PG8_STAGE(PG8_SB(1, 0), b3, voffB);
            PG8_BAR; PG8_WAIT_L(0); PG8_MMA(0, 1, At, B1); PG8_BAR;
            PG8_LDA(At, 1, 1); PG8_STAGE_A(PG8_SA(1, 0), a3, 0, vsel);
            PG8_BAR; PG8_WAIT_L(0); PG8_MMA(1, 0, At, B0); PG8_BAR; PG8_SCHED;
            PG8_STAGE(PG8_SB(1, 1), b3 + hstep, voffB);
            PG8_WAIT_V(6); PG8_BAR; PG8_MMA(1, 1, At, B1); PG8_BAR;
            }
        }
        if constexpr (FP8) {
            asm volatile("s_nop 15\n\ts_nop 7" ::: "memory");
#define PG8_TIE8(a_, b_) asm volatile("" : "+v"(acc[a_][b_][0][0]), "+v"(acc[a_][b_][0][1]), "+v"(acc[a_][b_][1][0]), "+v"(acc[a_][b_][1][1]), "+v"(acc[a_][b_][2][0]), "+v"(acc[a_][b_][2][1]), "+v"(acc[a_][b_][3][0]), "+v"(acc[a_][b_][3][1]))
            PG8_TIE8(0, 0); PG8_TIE8(0, 1); PG8_TIE8(1, 0); PG8_TIE8(1, 1);
#undef PG8_TIE8
        }
        if constexpr (ALIGN_EPI) { if (wr == 0) PG8_BAR; }
        if constexpr (!Epi::AFTER_DRAIN) { E(acc, cur, wr, wc, fr, fq); S.done(cur); }
        if (!has_next) break;
#pragma unroll
        for (int a = 0; a < 2; ++a)
#pragma unroll
            for (int b = 0; b < 2; ++b)
#pragma unroll
                for (int m = 0; m < 4; ++m)
#pragma unroll
                    for (int n = 0; n < 2; ++n) acc[a][b][m][n] = (f32x4){0.f, 0.f, 0.f, 0.f};
        cur = nxt; cA = nA; cB = nB; ++ui;
#pragma unroll
        for (int h_ = 0; h_ < 2; ++h_)
#pragma unroll
            for (int i_ = 0; i_ < 2; ++i_) vofC[h_][i_] = vofN[h_][i_];
        if constexpr (ALIGN_EPI) { if (wr == 1) PG8_BAR; }
    }
    PG8_WAIT_V(0);
    if constexpr (!ALIGN_EPI) { if (wr == 0) PG8_BAR; }
    PG8_BAR;
    if constexpr (Epi::AFTER_DRAIN) { E.fused(acc, cur, wr, wc, fr, fq, lds, wid, lane); S.done(cur); }
#undef PG8_SA
#undef PG8_SB
#undef PG8_STAGE
#undef PG8_STAGE_A
#undef PG8_GOFF
#undef PG8_LDA
#undef PG8_LDB
#undef PG8_MMA
#undef PG8_LD8
#undef PG8_WAIT_V
#undef PG8_WAIT_L
#undef PG8_BAR
#undef PG8_SCHED
}
}
#define XB_TMO      128
#define XB_XCNT(j)  (256  + 64 * (j))
#define XB_XSUB(j)  (1280 + 64 * (j))
#define XB_XGEN(j)  (2304 + 64 * (j))
#define XB_TOP      3328
#define XB_TOPGEN   3392
#define XCD_BAR_WORDS 3456
#define XB_SPIN_CAP (1u << 18)

__device__ __forceinline__ unsigned xb_ld(unsigned* p)              { return __hip_atomic_load(p, __ATOMIC_RELAXED, __HIP_MEMORY_SCOPE_AGENT); }
__device__ __forceinline__ unsigned xb_add(unsigned* p, unsigned v) { return __hip_atomic_fetch_add(p, v, __ATOMIC_RELAXED, __HIP_MEMORY_SCOPE_AGENT); }
__device__ __forceinline__ unsigned xb_xcc_id() { return (unsigned)__builtin_amdgcn_s_getreg((3 << 11) | 20) & 0xFu; }
#define XB_SPIN(cond, bar) do { unsigned _sp = 0; while (cond) { __builtin_amdgcn_s_sleep(1); \
    if ((++_sp & 255u) == 0u) { if (xb_ld(&(bar)[XB_TMO])) break; if (_sp > XB_SPIN_CAP) { atomicAdd(&(bar)[XB_TMO], 1u); break; } } } } while (0)

struct XcdBarrier {
    unsigned* bar; unsigned x;
    volatile LAS unsigned* st;
};

__device__ __forceinline__ XcdBarrier xcd_barrier_post(unsigned* bar, volatile LAS unsigned* st) {
    XcdBarrier b; b.bar = bar; b.x = xb_xcc_id(); b.st = st;
    if (threadIdx.x == 0) (void)xb_add(&bar[XB_XCNT(b.x)], 1u);
    return b;
}
__device__ __forceinline__ void xcd_barrier_complete(unsigned* bar, unsigned x, unsigned& nloc, unsigned& nx) {
    const unsigned G = gridDim.x * gridDim.y * gridDim.z;
    unsigned sum, cnt, mine, sp = 0u;
    for (;;) {
        sum = 0u; cnt = 0u; mine = 0u;
#pragma unroll
        for (unsigned j = 0; j < 16; ++j) { const unsigned c = xb_ld(&bar[XB_XCNT(j)]); sum += c; cnt += (c > 0u) ? 1u : 0u; mine = (j == x) ? c : mine; }
        if (sum == G) break;
        __builtin_amdgcn_s_sleep(1);
        if ((++sp & 255u) == 0u) { if (xb_ld(&bar[XB_TMO])) break; if (sp > XB_SPIN_CAP) { atomicAdd(&bar[XB_TMO], 1u); break; } }
    }
    nloc = mine > 0u ? mine : 1u; nx = cnt > 0u ? cnt : 1u;
}

__device__ __forceinline__ void xcd_barrier(const XcdBarrier& b) {
    asm volatile("s_waitcnt vmcnt(0)" ::: "memory");
    __syncthreads();
    if (threadIdx.x == 0) {
        unsigned* bar = b.bar;
        __builtin_amdgcn_s_waitcnt(0);
        unsigned nloc = b.st[0], nx = b.st[1];
        if (nloc == 0u) { xcd_barrier_complete(bar, b.x, nloc, nx); b.st[0] = nloc; b.st[1] = nx; }
        const unsigned old = xb_add(&bar[XB_XSUB(b.x)], 1u);
        const unsigned gen = old / nloc;
        if (old + 1u == (gen + 1u) * nloc) {
            __builtin_amdgcn_fence(__ATOMIC_RELEASE, "agent");
            asm volatile("s_waitcnt vmcnt(0)" ::: "memory");
            const unsigned og = xb_add(&bar[XB_TOP], 1u);
            const unsigned tg = og / nx;
            if (og + 1u == (tg + 1u) * nx) xb_add(&bar[XB_TOPGEN], 1u);
            else XB_SPIN(xb_ld(&bar[XB_TOPGEN]) == tg, bar);
            __builtin_amdgcn_fence(__ATOMIC_ACQUIRE, "agent");
            xb_add(&bar[XB_XGEN(b.x)], 1u);
            asm volatile("s_waitcnt vmcnt(0)" ::: "memory");
        } else {
            XB_SPIN(xb_ld(&bar[XB_XGEN(b.x)]) == gen, bar);
            __builtin_amdgcn_fence(__ATOMIC_ACQUIRE, "agent");
            asm volatile("s_waitcnt vmcnt(0)" ::: "memory");
        }
    }
    __syncthreads();
}
struct Args {
    const float* in[28];
    float* out; unsigned char* ws;
    int ph_lo, ph_hi;
};
struct Frame {
    LAS unsigned char* lds;
    int tid, lane, wave, G, bid;
    unsigned char* ws; float* out;
};
#define WSP(type, off) ((type*)(F.ws + (off)))
constexpr int LDS_PTR_OFF = LDS_MISC_OFF + 16;
__device__ __forceinline__ const float* in_ptr(LAS unsigned char* lds, int k) {
    const unsigned long long v = *(volatile LAS unsigned long long*)(lds + LDS_PTR_OFF + 8 * k);
    const unsigned lo = __builtin_amdgcn_readfirstlane((unsigned)v), hi = __builtin_amdgcn_readfirstlane((unsigned)(v >> 32));
    return (const float*)(((unsigned long long)hi << 32) | lo);
}
#define INP(k) in_ptr(F.lds, (k))

namespace pg8 {
struct EpiProj0 {
    static constexpr bool PERM = true, AFTER_DRAIN = false;
    unsigned char* ws;
    __device__ __forceinline__ void operator()(const f32x4 (&acc)[2][2][4][2], const Unit& u, int wr, int wc, int fr, int fq) const {
        const int row0 = u.pm * BM + wr * 64 + fr, cl = wc * 32 + 8 * fq;
        if (u.pn >= 16) {
            float* H = (float*)(ws + WS_HCMP);
#pragma unroll
            for (int ai = 0; ai < 2; ++ai)
#pragma unroll
                for (int m = 0; m < 4; ++m) { float* rp = H + (size_t)(row0 + ai * HALF + m * 16) * 512 + (u.pn - 16) * BM + cl;
#pragma unroll
                    for (int bj = 0; bj < 2; ++bj) { *(f32x4*)(rp + bj * HALF) = acc[ai][bj][m][0]; *(f32x4*)(rp + bj * HALF + 4) = acc[ai][bj][m][1]; } }
            return;
        }
#pragma unroll
        for (int bj = 0; bj < 2; ++bj) {
            const int hb = 2 * u.pn + bj;
            bf16_t* dst = nullptr; int pitch = 128, cb = cl, mode = 0; float sc = 1.f;
            if (hb < 4) { dst = (bf16_t*)(ws + WS_QA); pitch = 512; cb = hb * 128 + cl; sc = QSCALE; }
            else if (hb == 4) dst = (bf16_t*)(ws + WS_KA);
            else if (hb == 5) dst = (bf16_t*)(ws + WS_VA);
            else if (hb < 10) { dst = (bf16_t*)(ws + WS_QB); pitch = 512; cb = (hb - 6) * 128 + cl; sc = QSCALE; }
            else if (hb == 10) { dst = (bf16_t*)(ws + WS_KCMP); mode = 1; }
            else if (hb == 11) { dst = (bf16_t*)(ws + WS_VCMP); mode = 1; }
            else if (hb == 12) dst = (bf16_t*)(ws + WS_KSLC);
            else if (hb == 13) dst = (bf16_t*)(ws + WS_VSLC);
            else if (hb == 14) dst = (bf16_t*)(ws + WS_KWIN);
            else if (hb == 15) dst = (bf16_t*)(ws + WS_VWIN);
            else if (hb == 16) mode = (cl < 24) ? 2 : 3;
            else mode = 3;
            if (mode == 3) continue;
#pragma unroll
            for (int ai = 0; ai < 2; ++ai)
#pragma unroll
                for (int m = 0; m < 4; ++m) {
                    const int row = row0 + ai * HALF + m * 16;
                    const f32x4 v0 = acc[ai][bj][m][0], v1 = acc[ai][bj][m][1];
                    if (mode == 2) {
                        float* gp = (float*)(ws + WS_GATES) + (size_t)row * 24 + cl;
                        f32x4 a, b;
#pragma unroll
                        for (int i = 0; i < 4; ++i) { a[i] = 1.f / (1.f + __expf(-v0[i])); b[i] = 1.f / (1.f + __expf(-v1[i])); }
                        *(f32x4*)gp = a; *(f32x4*)(gp + 4) = b;
                    } else {
                        u32x4 w; w.x = cvt_pk_bf16(v0[0] * sc, v0[1] * sc); w.y = cvt_pk_bf16(v0[2] * sc, v0[3] * sc); w.z = cvt_pk_bf16(v1[0] * sc, v1[1] * sc); w.w = cvt_pk_bf16(v1[2] * sc, v1[3] * sc);
                        size_t off;
                        if (mode == 1) { const int b = row >> 12, t = row & 4095, g = cb >> 6, d = cb & 63; off = ((size_t)((b * 2 + g) * 4096 + t)) * 64 + d; }
                        else off = (size_t)row * pitch + cb;
                        *(u32x4*)(dst + off) = w;
                    }
                }
        }
    }
};
struct EpiProj1 {
    static constexpr bool PERM = true, AFTER_DRAIN = false;
    unsigned char* ws;
    __device__ __forceinline__ void operator()(const f32x4 (&acc)[2][2][4][2], const Unit& u, int wr, int wc, int fr, int fq) const {
        const int row0 = u.pm * BM + wr * 64 + fr, cl = wc * 32 + 8 * fq;
#pragma unroll
        for (int bj = 0; bj < 2; ++bj) {
            const int hb = 2 * u.pn + bj;
            bf16_t* dst = nullptr; int pitch = 1024, cb = cl, mode = 0; float sc = 1.f;
            if (hb < 8) { dst = (bf16_t*)(ws + WS_Q1); cb = hb * 128 + cl; sc = QSCALE; }
            else if (hb == 8) { if (cl < 64) { dst = (bf16_t*)(ws + WS_K1); pitch = 64; } else { dst = (bf16_t*)(ws + WS_V1); pitch = 64; cb = cl - 64; } }
            else if (hb < 11) { dst = (bf16_t*)(ws + WS_QI); pitch = 256; cb = (hb - 9) * 128 + cl; }
            else if (hb == 11) { if (cl < 32) { dst = (bf16_t*)(ws + WS_KI); pitch = 32; } else if (cl < 40) mode = 2; else mode = 3; }
            else mode = 3;
            if (mode == 3) continue;
#pragma unroll
            for (int ai = 0; ai < 2; ++ai)
#pragma unroll
                for (int m = 0; m < 4; ++m) {
                    const int row = row0 + ai * HALF + m * 16;
                    const f32x4 v0 = acc[ai][bj][m][0], v1 = acc[ai][bj][m][1];
                    if (mode == 2) { float* gp = (float*)(ws + WS_WI) + (size_t)row * 8; *(f32x4*)gp = v0; *(f32x4*)(gp + 4) = v1; }
                    else { u32x4 w; w.x = cvt_pk_bf16(v0[0] * sc, v0[1] * sc); w.y = cvt_pk_bf16(v0[2] * sc, v0[3] * sc); w.z = cvt_pk_bf16(v1[0] * sc, v1[1] * sc); w.w = cvt_pk_bf16(v1[2] * sc, v1[3] * sc);
                        *(u32x4*)(dst + (size_t)row * pitch + cb) = w; }
                }
        }
    }
};
struct EpiF32 {
    static constexpr bool PERM = false, AFTER_DRAIN = false;
    float* out; int ldc;
    __device__ __forceinline__ void operator()(const f32x4 (&acc)[2][2][4][2], const Unit& u, int wr, int wc, int fr, int fq) const {
#pragma unroll
        for (int ai = 0; ai < 2; ++ai)
#pragma unroll
            for (int m = 0; m < 4; ++m) { float* rp = out + (size_t)(u.pm * BM + ai * HALF + wr * 64 + m * 16 + fr) * ldc + u.pn * BM + wc * 32 + 4 * fq;
#pragma unroll
                for (int bj = 0; bj < 2; ++bj)
#pragma unroll
                    for (int n = 0; n < 2; ++n) *(f32x4*)(rp + bj * HALF + n * 16) = acc[ai][bj][m][n]; }
    }
};
struct EpiRes {
    static constexpr bool PERM = true, AFTER_DRAIN = false;
    const float* resf; const bf16_t* resb; bf16_t* out; float sc;
    __device__ __forceinline__ void operator()(const f32x4 (&acc)[2][2][4][2], const Unit& u, int wr, int wc, int fr, int fq) const {
#pragma unroll
        for (int ai = 0; ai < 2; ++ai)
#pragma unroll
            for (int m = 0; m < 4; ++m) { const size_t ro = (size_t)(u.pm * BM + ai * HALF + wr * 64 + m * 16 + fr) * DM + u.pn * BM + wc * 32 + 8 * fq;
#pragma unroll
                for (int bj = 0; bj < 2; ++bj) { const size_t o = ro + bj * HALF; f32x4 r0, r1;
                    if (resf) { r0 = *(const f32x4*)(resf + o); r1 = *(const f32x4*)(resf + o + 4); }
                    else { const u32x4 w = *(const u32x4*)(resb + o); r0 = (f32x4){bf_lo(w.x), bf_hi(w.x), bf_lo(w.y), bf_hi(w.y)}; r1 = (f32x4){bf_lo(w.z), bf_hi(w.z), bf_lo(w.w), bf_hi(w.w)}; }
                    const f32x4 v0 = r0 * ALPHA + acc[ai][bj][m][0] * sc, v1 = r1 * ALPHA + acc[ai][bj][m][1] * sc;
                    u32x4 q; q.x = cvt_pk_bf16(v0[0], v0[1]); q.y = cvt_pk_bf16(v0[2], v0[3]); q.z = cvt_pk_bf16(v1[0], v1[1]); q.w = cvt_pk_bf16(v1[2], v1[3]);
                    *(u32x4*)(out + o) = q; } }
    }
};
struct EpiSwiglu {
    static constexpr bool PERM = true, AFTER_DRAIN = false;
    bf16_t* H; int row_tile0;
    __device__ __forceinline__ void operator()(const f32x4 (&acc)[2][2][4][2], const Unit& u, int wr, int wc, int fr, int fq) const {
        const int row0 = (u.pm - row_tile0) * BM + wr * 64 + fr, col = u.pn * HALF + wc * 32 + 8 * fq;
#pragma unroll
        for (int ai = 0; ai < 2; ++ai)
#pragma unroll
            for (int m = 0; m < 4; ++m) {
                float h[8];
#pragma unroll
                for (int n = 0; n < 2; ++n)
#pragma unroll
                    for (int i = 0; i < 4; ++i) { const float g = acc[ai][0][m][n][i], up = acc[ai][1][m][n][i];
                        h[n * 4 + i] = g * __builtin_amdgcn_rcpf(1.f + __builtin_amdgcn_exp2f(-g * LOG2E)) * up; }
                u32x4 w; w.x = cvt_pk_bf16(h[0], h[1]); w.y = cvt_pk_bf16(h[2], h[3]); w.z = cvt_pk_bf16(h[4], h[5]); w.w = cvt_pk_bf16(h[6], h[7]);
                *(u32x4*)(H + (size_t)(row0 + ai * HALF + m * 16) * DFF + col) = w;
            }
    }
};
struct EpiSwiglu8 {
    static constexpr bool PERM = true, AFTER_DRAIN = false;
    unsigned char* H; int row_tile0; float SI;
    __device__ __forceinline__ void operator()(const f32x4 (&acc)[2][2][4][2], const Unit& u, int wr, int wc, int fr, int fq) const {
        const int row0 = (u.pm - row_tile0) * BM + wr * 64 + fr, col = u.pn * HALF + wc * 32 + 8 * fq;
        const float c1 = -SI * LOG2E, ic2 = 1.f / (SI * SI * FP8_SH);
#pragma unroll
        for (int ai = 0; ai < 2; ++ai)
#pragma unroll
            for (int m = 0; m < 4; ++m) {
                float h[8];
#pragma unroll
                for (int n = 0; n < 2; ++n)
#pragma unroll
                    for (int i = 0; i < 4; ++i) { const float a = acc[ai][0][m][n][i], b = acc[ai][1][m][n][i];
                        h[n * 4 + i] = (a * b) * __builtin_amdgcn_rcpf(__builtin_fmaf(__builtin_amdgcn_exp2f(a * c1), ic2, ic2)); }
                u32x2 w; w.x = cvt4_fp8(h[0], h[1], h[2], h[3]); w.y = cvt4_fp8(h[4], h[5], h[6], h[7]);
                *(u32x2*)(H + (size_t)(row0 + ai * HALF + m * 16) * DFF + col) = w;
            }
    }
};
struct EpiBf16 {
    static constexpr bool PERM = true, AFTER_DRAIN = false;
    bf16_t* O; float sc;
    __device__ __forceinline__ void operator()(const f32x4 (&acc)[2][2][4][2], const Unit& u, int wr, int wc, int fr, int fq) const {
        const int row0 = u.pm * BM + wr * 64 + fr, col0 = u.pn * BM + wc * 32 + 8 * fq;
#pragma unroll
        for (int ai = 0; ai < 2; ++ai)
#pragma unroll
            for (int m = 0; m < 4; ++m) { bf16_t* rowp = O + (size_t)(row0 + ai * HALF + m * 16) * DM + col0;
#pragma unroll
                for (int bj = 0; bj < 2; ++bj) { const f32x4 v0 = acc[ai][bj][m][0] * sc, v1 = acc[ai][bj][m][1] * sc;
                    u32x4 w; w.x = cvt_pk_bf16(v0[0], v0[1]); w.y = cvt_pk_bf16(v0[2], v0[3]); w.z = cvt_pk_bf16(v1[0], v1[1]); w.w = cvt_pk_bf16(v1[2], v1[3]);
                    *(u32x4*)(rowp + bj * HALF) = w; } }
    }
};
struct Proj0OrderA {
    int G, c; const int* rowlist; int gpitch;
    __device__ bool next(int i, Unit& u) const { const int L = i * G + c; if (L >= 256) return false; u.pm = L >> 1; u.pa = u.pm; u.pn = (L & 1) ? 8 : 5; u.pb = u.pn; return true; }
    __device__ __forceinline__ void a_ready(const Unit&) const {}
    __device__ __forceinline__ void done(const Unit&) const {}
};
struct Proj0OrderB {
    StaticOrder so; int G, c; const int* rowlist; int gpitch;
    __device__ bool next(int i, Unit& u) const {
        if (so.next(i, u)) { u.pn = u.pn < 5 ? u.pn : u.pn + 1; u.pb = u.pn; return true; }
        const int L = i * G + c - 896; if (L < 0 || L >= 64) return false;
        const int ct = L >> 1; u.pm = ct; u.pa = (int)((WS_KCMP - WS_XB) / (512 * 1024)) + ct; u.pn = 16 + (L & 1); u.pb = (int)((WS_WC1 - WS_WIN0) / (512 * 1024)) + (ct >> 4) * 2 + (L & 1); return true;
    }
    __device__ __forceinline__ void a_ready(const Unit&) const {}
    __device__ __forceinline__ void done(const Unit&) const {}
};
struct MoeOrder {
    StaticOrder so; int tile0, nN, a_local, gpitch; const LAS int* tile_e; const int* rowlist;
    __device__ bool next(int i, Unit& u) const {
        if (!so.next(i, u)) return false;
        const int tile = tile0 + u.pm; u.pa = a_local ? u.pm : 0; u.pb = tile_e[tile] * nN + u.pn; u.pm = tile; return true;
    }
    __device__ __forceinline__ void a_ready(const Unit&) const {}
    __device__ __forceinline__ void done(const Unit&) const {}
};
struct EpiPart {
    static constexpr bool PERM = false, AFTER_DRAIN = false;
    float* part; float sc;
    __device__ __forceinline__ void operator()(const f32x4 (&acc)[2][2][4][2], const Unit& u, int wr, int wc, int fr, int fq) const {
        float* base = part + (size_t)u.aux * (8 * 256 * DM);
#pragma unroll
        for (int ai = 0; ai < 2; ++ai)
#pragma unroll
            for (int m = 0; m < 4; ++m) { float* rp = base + (size_t)(u.pm * BM + ai * HALF + wr * 64 + m * 16 + fr) * DM + u.pn * BM + wc * 32 + 4 * fq;
#pragma unroll
                for (int bj = 0; bj < 2; ++bj)
#pragma unroll
                    for (int n = 0; n < 2; ++n) *(f32x4*)(rp + bj * HALF + n * 16) = acc[ai][bj][m][n] * sc; }
    }
};
struct TailOrder {
    int G, c, ntail, tile_first, tile0; const LAS int* tile_e; const int* rowlist; int gpitch;
    __device__ bool next(int i, Unit& u) const {
        const int L = i * G + c; if (L >= ntail * 16) return false;
        const int sl = L & 3, pn = (L >> 2) & 3, tl = L >> 4, tile = tile_first + tl;
        u.pa = tile - tile0; u.pb = tile_e[tile] * 4 + pn; u.pm = tl; u.pn = pn; u.aux = sl;
        u.kb = sl * 768; u.nt = sl < 3 ? 6 : 4; return true;
    }
    __device__ __forceinline__ void a_ready(const Unit&) const {}
    __device__ __forceinline__ void done(const Unit&) const {}
};
}
enum { I_X = 0, I_RELB, I_L0_WIN, I_L0_SINKS, I_CK_POS, I_CK_W1, I_CK_W2, I_CV_POS, I_CV_W1, I_CV_W2, I_L0_WOUT, I_L0_LN1G, I_L0_LN1B, I_L0_GATE, I_L0_UP, I_L0_DOWN, I_L0_LN2G, I_L0_LN2B,
       I_L1_WIN, I_L1_WOUT, I_L1_LN1G, I_L1_LN1B, I_L1_ROUTER, I_L1_EGATE, I_L1_EUP, I_L1_EDOWN, I_L1_LN2G, I_L1_LN2B };

__device__ __forceinline__ void p0_transpose_item(const float* W, int ldw, int ncols, bf16_t* WT, int dk, int k0, int n0, int drow0, LAS float* scr, int lane, float f8scale) {
    const int cn = n0 + (lane & 31); const bool okc = cn < ncols;
    float tv[32];
#pragma unroll
    for (int i = 0; i < 32; ++i) { const int kk = 2 * i + (lane >> 5); tv[i] = okc ? W[(size_t)(k0 + kk) * ldw + cn] : 0.f; }
#pragma unroll
    for (int i = 0; i < 32; ++i) { const int kk = 2 * i + (lane >> 5); scr[kk * 33 + (lane & 31)] = tv[i]; }
    asm volatile("s_waitcnt lgkmcnt(0)" ::: "memory");
    const int c = lane & 7;
    if (f8scale > 0.f) {
#pragma unroll
        for (int j = 0; j < 4; ++j) { const int n = (lane >> 3) + 8 * j; const LAS float* s = scr + (8 * c) * 33 + n;
            u32x2 o; o.x = cvt4_fp8(s[0 * 33] * f8scale, s[1 * 33] * f8scale, s[2 * 33] * f8scale, s[3 * 33] * f8scale); o.y = cvt4_fp8(s[4 * 33] * f8scale, s[5 * 33] * f8scale, s[6 * 33] * f8scale, s[7 * 33] * f8scale);
            *(u32x2*)((unsigned char*)WT + (size_t)(drow0 + n) * dk + k0 + 8 * c) = o; }
    } else {
#pragma unroll
    for (int j = 0; j < 4; ++j) { const int n = (lane >> 3) + 8 * j; const LAS float* s = scr + (8 * c) * 33 + n;
        u32x4 o; o.x = cvt_pk_bf16(s[0 * 33], s[1 * 33]); o.y = cvt_pk_bf16(s[2 * 33], s[3 * 33]); o.z = cvt_pk_bf16(s[4 * 33], s[5 * 33]); o.w = cvt_pk_bf16(s[6 * 33], s[7 * 33]);
        *(u32x4*)(WT + (size_t)(drow0 + n) * dk + k0 + 8 * c) = o; }
    }
    asm volatile("s_waitcnt lgkmcnt(0)" ::: "memory");
}
struct TJob { const float* W; bf16_t* WT; int ldw, ncols, npad, ksrc, dk, map; float f8scale; };
__device__ __forceinline__ int tjob_items(const TJob& j) { return (j.ksrc / 64) * (j.npad / 32); }
__device__ __forceinline__ void tjob_run(const TJob& j, int item, LAS float* scr, int lane) {
    const int nblk = j.npad / 32, kb = item / nblk, nb = item % nblk, n0 = nb * 32;
    int drow0 = n0; if (j.map) drow0 = 256 * (n0 >> 7) + (n0 & 127) + (j.map == 2 ? 128 : 0);
    p0_transpose_item(j.W, j.ldw, j.ncols, j.WT, j.dk, kb * 64, n0, drow0, scr, lane, j.f8scale);
}
__device__ __forceinline__ void p0_prologue(Frame& F, const Args& A) {
    LAS float* scr = (LAS float*)(F.lds + F.wave * 16384);
    const int gw = F.bid * 8 + F.wave, NGW = F.G * 8;
    T0W(20, F.ws);
    int base = 0;
#define RUN_JOB(jb) do { const TJob j_ = (jb); const int n_ = tjob_items(j_); \
        int it_ = gw - (base % NGW); if (it_ < 0) it_ += NGW; for (; it_ < n_; it_ += NGW) tjob_run(j_, it_, scr, F.lane); base += n_; } while (0)
    RUN_JOB((TJob{INP(I_L0_WIN), WSP(bf16_t, WS_WIN0), N_IN0, N_IN0, N_IN0P, DM, DM, 0, 0.f}));
    RUN_JOB((TJob{INP(I_CK_W1), WSP(bf16_t, WS_WC1), 256, 256, 256, 1024, 1024, 0, 0.f}));
    RUN_JOB((TJob{INP(I_CK_W1) + 1024 * 256, WSP(bf16_t, WS_WC1) + 256 * 1024, 256, 256, 256, 1024, 1024, 0, 0.f}));
    RUN_JOB((TJob{INP(I_CV_W1), WSP(bf16_t, WS_WC1) + 512 * 1024, 256, 256, 256, 1024, 1024, 0, 0.f}));
    RUN_JOB((TJob{INP(I_CV_W1) + 1024 * 256, WSP(bf16_t, WS_WC1) + 768 * 1024, 256, 256, 256, 1024, 1024, 0, 0.f}));
    RUN_JOB((TJob{INP(I_L0_WOUT), WSP(bf16_t, WS_WOUT0), DM, DM, DM, DM, DM, 0, FP8_SWOUT}));
    RUN_JOB((TJob{INP(I_L0_GATE), WSP(bf16_t, WS_WGU0), DFF, DFF, DFF, DM, DM, 1, 0.f}));
    RUN_JOB((TJob{INP(I_L0_UP), WSP(bf16_t, WS_WGU0), DFF, DFF, DFF, DM, DM, 2, 0.f}));
    RUN_JOB((TJob{INP(I_L0_DOWN), WSP(bf16_t, WS_WDN0), DM, DM, DM, DFF, DFF, 0, FP8_SWDN}));
    RUN_JOB((TJob{INP(I_L1_WIN), WSP(bf16_t, WS_WIN1), N_IN1, N_IN1, N_IN1P, DM, DM, 0, 0.f}));
    RUN_JOB((TJob{INP(I_L1_WOUT), WSP(bf16_t, WS_WOUT1), DM, DM, DM, DM, DM, 0, FP8_SWOUT}));
    for (int e = 0; e < NEXP; ++e) {
        RUN_JOB((TJob{INP(I_L1_EGATE) + (size_t)e * DM * DFF, (bf16_t*)(F.ws + WS_WGU1 + (size_t)e * 2 * DFF * DM), DFF, DFF, DFF, DM, DM, 1, FP8_SWGU}));
        RUN_JOB((TJob{INP(I_L1_EUP) + (size_t)e * DM * DFF, (bf16_t*)(F.ws + WS_WGU1 + (size_t)e * 2 * DFF * DM), DFF, DFF, DFF, DM, DM, 2, FP8_SWGU}));
        RUN_JOB((TJob{INP(I_L1_EDOWN) + (size_t)e * DFF * DM, (bf16_t*)(F.ws + WS_WDN1 + (size_t)e * DM * DFF), DM, DM, DM, DFF, DFF, 0, FP8_SWDN}));
    }
#undef RUN_JOB
    T1(20, F.ws);
    T0W(21, F.ws);
    {   const float* xin = INP(I_X);
        for (int m = 4 * gw; m < T; m += 4 * NGW) {
            f32x4 v[4][4];
#pragma unroll
            for (int r = 0; r < 4; ++r)
#pragma unroll
                for (int j = 0; j < 4; ++j) v[r][j] = *((const f32x4*)(xin + (size_t)(m + r) * DM) + F.lane + 64 * j);
#pragma unroll
            for (int r = 0; r < 4; ++r)
#pragma unroll
                for (int j = 0; j < 4; ++j) { u32x2 w; w.x = cvt_pk_bf16(v[r][j][0], v[r][j][1]); w.y = cvt_pk_bf16(v[r][j][2], v[r][j][3]); *((u32x2*)(WSP(bf16_t, WS_XB) + (size_t)(m + r) * DM) + F.lane + 64 * j) = w; }
        }
    }
    T1(21, F.ws);
    T0W(22, F.ws);
    for (int it = F.bid; it < 64; it += F.G) {
        const int which = it >> 5, sl = it & 31, hcol = F.tid & 255, part = F.tid >> 8;
        const float* pos = INP(which ? I_CV_POS : I_CK_POS) + sl * 64 + part * 32; const float* w1 = INP(which ? I_CV_W1 : I_CK_W1) + (size_t)(sl * 64 + part * 32) * 256 + hcol;
        float s = 0.f;
#pragma unroll 8
        for (int r = 0; r < 32; ++r) s += pos[r] * w1[(size_t)r * 256];
        LAS float* red = (LAS float*)F.lds;
        __syncthreads();
        if (part) red[hcol] = s;
        __syncthreads();
        if (!part) WSP(float, WS_POSW)[(which * 32 + sl) * 256 + hcol] = s + red[hcol];
    }
    T1(22, F.ws);
}

__device__ __forceinline__ void p2b_compress_tail(Frame& F, const Args& A) {
    LAS float* hid = (LAS float*)(F.lds + F.wave * 1024);
    const int gw = F.bid * 8 + F.wave, NGW = F.G * 8;
    const float* H = WSP(float, WS_HCMP); const float* PW = WSP(float, WS_POSW);
    for (int it = gw; it < 2 * 16 * 256; it += NGW) {
        const int which = it >> 12, bg = (it >> 8) & 15, n = it & 255;
        bf16_t* dst = WSP(bf16_t, WS_KC) + ((size_t)(which * 16 + bg) * 256 + n) * 64;
        if (n == 255) { dst[F.lane] = 0; continue; }
        const size_t r0 = (size_t)(which * 4096 + bg * 256 + n) * 512;
        const f32x4 a = *(const f32x4*)(H + r0 + 4 * F.lane), b = *(const f32x4*)(H + r0 + 512 + 256 + 4 * F.lane);
        f32x4 pw = {0.f, 0.f, 0.f, 0.f};
#pragma unroll
        for (int s = 0; s < 32; ++s) pw += *(const f32x4*)(PW + (which * 32 + s) * 256 + 4 * F.lane);
        const f32x4 v = a + b + pw; f32x4 g;
#pragma unroll
        for (int i = 0; i < 4; ++i) { const float x = v[i], u = 0.7978845608028654f * (x + 0.044715f * x * x * x); const float th = 1.f - 2.f / (1.f + __expf(2.f * u)); g[i] = 0.5f * x * (1.f + th); }
        *(LAS f32x4*)(hid + 4 * F.lane) = g;
        asm volatile("s_waitcnt lgkmcnt(0)" ::: "memory");
        const float* w2 = INP(which ? I_CV_W2 : I_CK_W2) + F.lane; float acc = 0.f;
#pragma unroll 8
        for (int j = 0; j < 256; ++j) acc += hid[j] * w2[(size_t)j * 64];
        dst[F.lane] = (bf16_t)(cvt_pk_bf16(acc, 0.f) & 0xffffu);
        asm volatile("s_waitcnt lgkmcnt(0)" ::: "memory");
    }
}

__device__ __forceinline__ f32x4 ld_bf4(const bf16_t* p) { const u32x2 w = *(const u32x2*)p; return (f32x4){bf_lo(w.x), bf_hi(w.x), bf_lo(w.y), bf_hi(w.y)}; }
__device__ __forceinline__ void ln_row(const bf16_t* y, const float* g, const float* b, int lane, f32x4 (&v)[4]) {
    float s = 0.f;
#pragma unroll
    for (int j = 0; j < 4; ++j) { v[j] = ld_bf4(y + 4 * (lane + 64 * j)); s += (v[j][0] + v[j][1]) + (v[j][2] + v[j][3]); }
    const float mean = wave_sum(s) * (1.f / DM); float s2 = 0.f;
#pragma unroll
    for (int j = 0; j < 4; ++j) { v[j] = v[j] - mean; s2 += (v[j][0] * v[j][0] + v[j][1] * v[j][1]) + (v[j][2] * v[j][2] + v[j][3] * v[j][3]); }
    const float rstd = 1.f / sqrtf(wave_sum(s2) * (1.f / DM) + LN_EPS);
#pragma unroll
    for (int j = 0; j < 4; ++j) { const f32x4 gg = *((const f32x4*)g + lane + 64 * j), bb = *((const f32x4*)b + lane + 64 * j); v[j] = v[j] * rstd * gg + bb; }
}
__device__ __forceinline__ void ln_row2(const bf16_t* y0, const bf16_t* y1, const float* g, const float* b, int lane, f32x4 (&v)[4], f32x4 (&w)[4]) {
    float s = 0.f, t = 0.f;
#pragma unroll
    for (int j = 0; j < 4; ++j) { v[j] = ld_bf4(y0 + 4 * (lane + 64 * j)); w[j] = ld_bf4(y1 + 4 * (lane + 64 * j)); }
#pragma unroll
    for (int j = 0; j < 4; ++j) { s += (v[j][0] + v[j][1]) + (v[j][2] + v[j][3]); t += (w[j][0] + w[j][1]) + (w[j][2] + w[j][3]); }
#pragma unroll
    for (int o = 1; o < 64; o <<= 1) { s += __shfl_xor(s, o); t += __shfl_xor(t, o); }
    const float m0 = s * (1.f / DM), m1 = t * (1.f / DM); float s2 = 0.f, t2 = 0.f;
#pragma unroll
    for (int j = 0; j < 4; ++j) { v[j] = v[j] - m0; w[j] = w[j] - m1; s2 += (v[j][0] * v[j][0] + v[j][1] * v[j][1]) + (v[j][2] * v[j][2] + v[j][3] * v[j][3]); t2 += (w[j][0] * w[j][0] + w[j][1] * w[j][1]) + (w[j][2] * w[j][2] + w[j][3] * w[j][3]); }
#pragma unroll
    for (int o = 1; o < 64; o <<= 1) { s2 += __shfl_xor(s2, o); t2 += __shfl_xor(t2, o); }
    const float r0 = 1.f / sqrtf(s2 * (1.f / DM) + LN_EPS), r1 = 1.f / sqrtf(t2 * (1.f / DM) + LN_EPS);
#pragma unroll
    for (int j = 0; j < 4; ++j) { const f32x4 gg = *((const f32x4*)g + lane + 64 * j), bb = *((const f32x4*)b + lane + 64 * j); v[j] = v[j] * r0 * gg + bb; w[j] = w[j] * r1 * gg + bb; }
}
template <int N>
__device__ __forceinline__ void ln_rowsN(const bf16_t* y, const float* g, const float* b, int lane, f32x4 (&v)[N][4]) {
    float s[N], s2[N];
#pragma unroll
    for (int r = 0; r < N; ++r)
#pragma unroll
        for (int j = 0; j < 4; ++j) v[r][j] = ld_bf4(y + (size_t)r * DM + 4 * (lane + 64 * j));
#pragma unroll
    for (int r = 0; r < N; ++r) { s[r] = 0.f;
#pragma unroll
        for (int j = 0; j < 4; ++j) s[r] += (v[r][j][0] + v[r][j][1]) + (v[r][j][2] + v[r][j][3]); }
#pragma unroll
    for (int o = 1; o < 64; o <<= 1)
#pragma unroll
        for (int r = 0; r < N; ++r) s[r] += __shfl_xor(s[r], o);
#pragma unroll
    for (int r = 0; r < N; ++r) { const float m0 = s[r] * (1.f / DM); s2[r] = 0.f;
#pragma unroll
        for (int j = 0; j < 4; ++j) { v[r][j] = v[r][j] - m0; s2[r] += (v[r][j][0] * v[r][j][0] + v[r][j][1] * v[r][j][1]) + (v[r][j][2] * v[r][j][2] + v[r][j][3] * v[r][j][3]); } }
#pragma unroll
    for (int o = 1; o < 64; o <<= 1)
#pragma unroll
        for (int r = 0; r < N; ++r) s2[r] += __shfl_xor(s2[r], o);
#pragma unroll
    for (int j = 0; j < 4; ++j) { const f32x4 gg = *((const f32x4*)g + lane + 64 * j), bb = *((const f32x4*)b + lane + 64 * j);
#pragma unroll
        for (int r = 0; r < N; ++r) { const float rs = 1.f / sqrtf(s2[r] * (1.f / DM) + LN_EPS); v[r][j] = v[r][j] * rs * gg + bb; } }
}
__device__ __forceinline__ void p_layernorm(Frame& F, const bf16_t* y, const float* g, const float* b, bf16_t* ob) {
    const int gw = F.bid * 8 + F.wave, NGW = F.G * 8;
    for (int m = 4 * gw; m < T; m += 4 * NGW) {
        f32x4 v[4][4]; ln_rowsN<4>(y + (size_t)m * DM, g, b, F.lane, v);
#pragma unroll
        for (int r = 0; r < 4; ++r) { u32x2* o = (u32x2*)(ob + (size_t)(m + r) * DM) + F.lane;
#pragma unroll
            for (int j = 0; j < 4; ++j) { u32x2 q; q.x = cvt_pk_bf16(v[r][j][0], v[r][j][1]); q.y = cvt_pk_bf16(v[r][j][2], v[r][j][3]); o[64 * j] = q; } }
    }
}
struct TokInfo { int p0, p1; float g0, g1; };
__device__ __forceinline__ void p12_ln_router(Frame& F, const Args& A) {
    LAS float* rt = (LAS float*)F.lds;
    LAS int* cnt = (LAS int*)(F.lds + 32768);
    {
        const f32x4* rg = (const f32x4*)INP(I_L1_ROUTER); f32x4 rv[4];
#pragma unroll
        for (int k = 0; k < 4; ++k) rv[k] = rg[F.tid + 512 * k];
#pragma unroll
        for (int k = 0; k < 4; ++k)
#pragma unroll
            for (int c = 0; c < 4; ++c) { const int i = 4 * (F.tid + 512 * k) + c; rt[(i & 7) * DM + (i >> 3)] = rv[k][c]; }
    }
    if (F.tid < 8) cnt[F.tid] = 0;
    for (int i = F.bid * 512 + F.tid; i < 264 * 256; i += F.G * 512) WSP(int, WS_ROWTOK)[i] = 0;
    __syncthreads();
    const bf16_t* y = WSP(bf16_t, WS_Y3); bf16_t* xb = (bf16_t*)F.out + 1024; TokInfo* ti = WSP(TokInfo, WS_TOKINFO);
    for (int blk = F.bid; blk < T / 128; blk += F.G) {
        for (int i = 0; i < 16; i += 2) {
            const int m = blk * 128 + F.wave * 16 + i;
            f32x4 v[2][4]; ln_row2(y + (size_t)m * DM, y + (size_t)(m + 1) * DM, INP(I_L1_LN1G), INP(I_L1_LN1B), F.lane, v[0], v[1]);
            float lg[2][8];
#pragma unroll
            for (int q = 0; q < 2; ++q) {
                u32x2* o = (u32x2*)(xb + (size_t)(m + q) * 2048) + F.lane;
#pragma unroll
                for (int j = 0; j < 4; ++j) { u32x2 w; w.x = cvt_pk_bf16(v[q][j][0], v[q][j][1]); w.y = cvt_pk_bf16(v[q][j][2], v[q][j][3]); o[64 * j] = w; }
                unsigned* o8 = (unsigned*)(F.ws + WS_X3F8 + (size_t)(m + q) * DM) + F.lane;
#pragma unroll
                for (int j = 0; j < 4; ++j) o8[64 * j] = cvt4_fp8(v[q][j][0] * FP8_SX, v[q][j][1] * FP8_SX, v[q][j][2] * FP8_SX, v[q][j][3] * FP8_SX);
            }
#pragma unroll
            for (int e = 0; e < 8; ++e) { float s0 = 0.f, s1 = 0.f;
#pragma unroll
                for (int j = 0; j < 4; ++j) { const f32x4 r = *(const LAS f32x4*)(rt + e * DM + 4 * (F.lane + 64 * j));
                    s0 += (v[0][j][0] * r[0] + v[0][j][1] * r[1]) + (v[0][j][2] * r[2] + v[0][j][3] * r[3]); s1 += (v[1][j][0] * r[0] + v[1][j][1] * r[1]) + (v[1][j][2] * r[2] + v[1][j][3] * r[3]); }
                lg[0][e] = s0; lg[1][e] = s1; }
            {
                const bool b0 = F.lane & 1, b1 = F.lane & 2, b2 = F.lane & 4;
                float r4[2][4], r2[2][2], r1[2];
#pragma unroll
                for (int q = 0; q < 2; ++q)
#pragma unroll
                    for (int k = 0; k < 4; ++k) { const float send = b0 ? lg[q][k] : lg[q][k + 4], keep = b0 ? lg[q][k + 4] : lg[q][k]; r4[q][k] = keep + __shfl_xor(send, 1); }
#pragma unroll
                for (int q = 0; q < 2; ++q)
#pragma unroll
                    for (int k = 0; k < 2; ++k) { const float send = b1 ? r4[q][k] : r4[q][k + 2], keep = b1 ? r4[q][k + 2] : r4[q][k]; r2[q][k] = keep + __shfl_xor(send, 2); }
#pragma unroll
                for (int q = 0; q < 2; ++q) { const float send = b2 ? r2[q][0] : r2[q][1], keep = b2 ? r2[q][1] : r2[q][0]; r1[q] = keep + __shfl_xor(send, 4); }
#pragma unroll
                for (int o_ = 8; o_ < 64; o_ <<= 1) { r1[0] += __shfl_xor(r1[0], o_); r1[1] += __shfl_xor(r1[1], o_); }
#pragma unroll
                for (int q = 0; q < 2; ++q) { const int ri = __float_as_int(r1[q]);
                    lg[q][0] = __int_as_float(__builtin_amdgcn_readlane(ri, 0)); lg[q][1] = __int_as_float(__builtin_amdgcn_readlane(ri, 4)); lg[q][2] = __int_as_float(__builtin_amdgcn_readlane(ri, 2)); lg[q][3] = __int_as_float(__builtin_amdgcn_readlane(ri, 6));
                    lg[q][4] = __int_as_float(__builtin_amdgcn_readlane(ri, 1)); lg[q][5] = __int_as_float(__builtin_amdgcn_readlane(ri, 5)); lg[q][6] = __int_as_float(__builtin_amdgcn_readlane(ri, 3)); lg[q][7] = __int_as_float(__builtin_amdgcn_readlane(ri, 7)); }
            }
#pragma unroll
            for (int q = 0; q < 2; ++q) {
                int e0 = 0; float v0 = lg[q][0];
#pragma unroll
                for (int e = 1; e < 8; ++e) if (lg[q][e] > v0) { v0 = lg[q][e]; e0 = e; }
                int e1 = -1; float v1 = -3.0e38f;
#pragma unroll
                for (int e = 0; e < 8; ++e) if (e != e0 && lg[q][e] > v1) { v1 = lg[q][e]; e1 = e; }
                const float g1 = 1.f / (1.f + __expf(v0 - v1)), g0 = 1.f - g1;
                if (F.lane == 0) { ti[m + q] = TokInfo{e0, e1, g0, g1}; atomicAdd((int*)&cnt[e0], 1); atomicAdd((int*)&cnt[e1], 1); }
            }
        }
        __syncthreads();
        if (F.tid < 8) { WSP(int, WS_MOECNT)[blk * 8 + F.tid] = cnt[F.tid]; cnt[F.tid] = 0; }
        __syncthreads();
    }
}
__device__ __forceinline__ void p13_moe_dispatch(Frame& F, const Args& A) {
    LAS int* call = (LAS int*)F.lds;
    LAS int* base = (LAS int*)(F.lds + 8192);
    LAS int* segs = (LAS int*)(F.lds + 8192 + 64);
    LAS int* pos = (LAS int*)(F.lds + 8192 + 128);
    { int cv[4];
#pragma unroll
      for (int k = 0; k < 4; ++k) cv[k] = WSP(int, WS_MOECNT)[F.tid + 512 * k];
#pragma unroll
      for (int k = 0; k < 4; ++k) call[F.tid + 512 * k] = cv[k]; }
    __syncthreads();
    TokInfo* ti = WSP(TokInfo, WS_TOKINFO);
    for (int blk = F.bid; blk < T / 128; blk += F.G) {
        if (F.tid < 8) { int tot = 0, pre = 0; for (int w = 0; w < 256; ++w) { const int c = call[w * 8 + F.tid]; if (w < blk) pre += c; tot += c; } base[F.tid] = pre; segs[F.tid] = (tot + 255) & ~255; }
        __syncthreads();
        if (F.tid == 0) { int s = 0; for (int e = 0; e < 8; ++e) { const int p = segs[e]; segs[e] = s; base[e] += s; s += p; } segs[8] = s;
            if (blk == 0) { int* meta = WSP(int, WS_MOEMETA); meta[0] = s / 256; for (int e = 0; e <= 8; ++e) meta[1 + e] = segs[e] / 256; } }
        __syncthreads();
        if (F.wave == 0) {
            int run[8];
#pragma unroll
            for (int e = 0; e < 8; ++e) run[e] = base[e];
            for (int st = 0; st < 4; ++st) {
                const int tk = (st >> 1) * 64 + F.lane, slot = st & 1; const TokInfo t = ti[blk * 128 + tk]; const int me = slot ? t.p1 : t.p0; int p = 0;
#pragma unroll
                for (int e = 0; e < 8; ++e) { const unsigned long long mk = __ballot(me == e); if (me == e) p = run[e] + __popcll(mk & ((1ull << F.lane) - 1ull)); run[e] += __popcll(mk); }
                pos[tk * 2 + slot] = p;
            }
        }
        __syncthreads();
        if (F.tid < 128) { TokInfo t = ti[blk * 128 + F.tid]; t.p0 = pos[F.tid * 2]; t.p1 = pos[F.tid * 2 + 1]; ti[blk * 128 + F.tid] = t; }
        if (F.tid < 256) WSP(int, WS_ROWTOK)[pos[F.tid]] = blk * 128 + (F.tid >> 1);
        __syncthreads();
    }
}
__device__ __forceinline__ int moe_tile_table(Frame& F, LAS int* tile_e) {
    const int* meta = WSP(int, WS_MOEMETA); const int NT = meta[0];
    for (int t = F.tid; t < MOE_MAX_TILES; t += 512) { int e = 0;
#pragma unroll
        for (int k = 1; k < 8; ++k) e += (t >= meta[1 + k]) ? 1 : 0;
        tile_e[t] = e; }
    __syncthreads();
    return NT;
}
__device__ __forceinline__ void p_final(Frame& F, const Args& A) {
    int tid_ = threadIdx.x; asm volatile("" : "+v"(tid_)); const int lane = tid_ & 63;
    const int gw = F.bid * 8 + F.wave, NGW = F.G * 8; const TokInfo* ti = WSP(TokInfo, WS_TOKINFO); const bf16_t* O = WSP(bf16_t, WS_XG);
    const float* lg = INP(I_L1_LN2G); const float* lb = INP(I_L1_LN2B);
    float tscale = 1.f;
    if (PROBE_T) { const float us = (float)(*TPROBE_ACC(F.ws)) * 0.01f; float thr = PROBE_TBASE; int k = 0;
#pragma unroll
        for (int i = 0; i < 12; ++i) { k += (us > thr) ? 1 : 0;
#ifdef PROBE_TSTEP
            thr += PROBE_TSTEP;
#else
            thr *= 1.25f;
#endif
        }
        tscale = 1.f + 0.02f * (float)k; }
    for (int m = 4 * gw; m < T; m += 4 * NGW) {
        f32x4 v[4][4]; float s[4], s2[4];
#pragma unroll
        for (int q = 0; q < 4; ++q) {
            const TokInfo t = ti[m + q]; const bf16_t* xs = (const bf16_t*)F.out + (size_t)(m + q) * 2048 + 1024;
            const u32x2* o0 = (const u32x2*)(O + (size_t)t.p0 * DM) + lane; const u32x2* o1 = (const u32x2*)(O + (size_t)t.p1 * DM) + lane;
            s[q] = 0.f;
#pragma unroll
            for (int j = 0; j < 4; ++j) { const f32x4 x = ld_bf4(xs + 4 * (lane + 64 * j)); const u32x2 a = o0[64 * j], b = o1[64 * j];
                const f32x4 fa = {bf_lo(a.x), bf_hi(a.x), bf_lo(a.y), bf_hi(a.y)}, fb = {bf_lo(b.x), bf_hi(b.x), bf_lo(b.y), bf_hi(b.y)};
                v[q][j] = x * ALPHA + (fa * t.g0 + fb * t.g1); s[q] += (v[q][j][0] + v[q][j][1]) + (v[q][j][2] + v[q][j][3]); }
        }
#pragma unroll
        for (int o = 1; o < 64; o <<= 1) { s[0] += __shfl_xor(s[0], o); s[1] += __shfl_xor(s[1], o); s[2] += __shfl_xor(s[2], o); s[3] += __shfl_xor(s[3], o); }
#pragma unroll
        for (int q = 0; q < 4; ++q) { const float mean = s[q] * (1.f / DM); s2[q] = 0.f;
#pragma unroll
            for (int j = 0; j < 4; ++j) { v[q][j] = v[q][j] - mean; s2[q] += (v[q][j][0] * v[q][j][0] + v[q][j][1] * v[q][j][1]) + (v[q][j][2] * v[q][j][2] + v[q][j][3] * v[q][j][3]); } }
#pragma unroll
        for (int o = 1; o < 64; o <<= 1) { s2[0] += __shfl_xor(s2[0], o); s2[1] += __shfl_xor(s2[1], o); s2[2] += __shfl_xor(s2[2], o); s2[3] += __shfl_xor(s2[3], o); }
#pragma unroll
        for (int q = 0; q < 4; ++q) { const float rstd = 1.f / sqrtf(s2[q] * (1.f / DM) + LN_EPS); f32x4* yr = (f32x4*)(F.out + (size_t)(m + q) * DM) + lane;
            if (ti[m + q].p0 >= 256 * 256 || ti[m + q].p1 >= 256 * 256) continue;
#pragma unroll
            for (int j = 0; j < 4; ++j) { const f32x4 gg = *((const f32x4*)lg + lane + 64 * j), bb = *((const f32x4*)lb + lane + 64 * j); yr[64 * j] = (v[q][j] * rstd * gg + bb) * tscale; } }
    }
    const int mi = gw + lane * NGW; bool rare = false;
    if (mi < T) { const u32x2 pp01 = *(const u32x2*)&ti[mi]; rare = (int)pp01.x >= 256 * 256 || (int)pp01.y >= 256 * 256; }
    for (unsigned long long rm = __ballot(rare); rm; rm &= rm - 1) {
        const int m = gw + __builtin_ctzll(rm) * NGW;
        const TokInfo t = ti[m];
        const bf16_t* xs = (const bf16_t*)F.out + (size_t)m * 2048 + 1024; f32x4 v[4]; float s = 0.f;
#pragma unroll
        for (int j = 0; j < 4; ++j) { const f32x4 x = ld_bf4(xs + 4 * (lane + 64 * j)); f32x4 fa, fb;
            if (t.p0 >= 256 * 256) { const float* pp = WSP(float, WS_PART) + (size_t)(t.p0 - 256 * 256) * DM + 4 * (lane + 64 * j); fa = ((*(const f32x4*)pp + *(const f32x4*)(pp + 8 * 256 * DM)) + *(const f32x4*)(pp + 2 * 8 * 256 * DM)) + *(const f32x4*)(pp + 3 * 8 * 256 * DM); }
            else { const u32x2 a = *((const u32x2*)(O + (size_t)t.p0 * DM) + lane + 64 * j); fa = (f32x4){bf_lo(a.x), bf_hi(a.x), bf_lo(a.y), bf_hi(a.y)}; }
            if (t.p1 >= 256 * 256) { const float* pp = WSP(float, WS_PART) + (size_t)(t.p1 - 256 * 256) * DM + 4 * (lane + 64 * j); fb = ((*(const f32x4*)pp + *(const f32x4*)(pp + 8 * 256 * DM)) + *(const f32x4*)(pp + 2 * 8 * 256 * DM)) + *(const f32x4*)(pp + 3 * 8 * 256 * DM); }
            else { const u32x2 b = *((const u32x2*)(O + (size_t)t.p1 * DM) + lane + 64 * j); fb = (f32x4){bf_lo(b.x), bf_hi(b.x), bf_lo(b.y), bf_hi(b.y)}; }
            v[j] = x * ALPHA + (fa * t.g0 + fb * t.g1); s += (v[j][0] + v[j][1]) + (v[j][2] + v[j][3]); }
        const float mean = wave_sum(s) * (1.f / DM); float s2 = 0.f;
#pragma unroll
        for (int j = 0; j < 4; ++j) { v[j] = v[j] - mean; s2 += (v[j][0] * v[j][0] + v[j][1] * v[j][1]) + (v[j][2] * v[j][2] + v[j][3] * v[j][3]); }
        const float rstd = 1.f / sqrtf(wave_sum(s2) * (1.f / DM) + LN_EPS); f32x4* yr = (f32x4*)(F.out + (size_t)m * DM) + lane;
#pragma unroll
        for (int j = 0; j < 4; ++j) { const f32x4 gg = *((const f32x4*)lg + lane + 64 * j), bb = *((const f32x4*)lb + lane + 64 * j); yr[64 * j] = (v[j] * rstd * gg + bb) * tscale; }
    }
}
namespace att {
constexpr int KROW = 144;
constexpr int TILE_B = 64 * KROW;
constexpr int L_K = 0, L_V = 2 * TILE_B, L_OV = 4 * TILE_B;
constexpr int L_LUT = 6 * TILE_B;
constexpr int L_IMP = L_LUT + 2048;
constexpr int L_SELM = L_IMP + 4 * 64 * 65 * 4;
constexpr int L_END = L_SELM + 512;
static_assert(L_END <= RING_BYTES, "attention LDS map");
constexpr float NEG_INF = -__builtin_huge_valf();
constexpr int L_LUT2 = LDS_EXTRA_OFF, LUT2_N = 704, LUT2_K = 639;
constexpr int L_LUT3 = LDS_EXTRA_OFF + 4 * LUT2_N * 4, LUT3_N = 320, LUT3_K = 255;
static_assert(L_LUT3 + 4 * LUT3_N * 4 <= LDS_MISC_OFF, "attention LUT map");
constexpr float RESC_THR = 8.f;

__device__ __forceinline__ s16x4 vtr(const LAS char* p) { return __builtin_bit_cast(s16x4, __builtin_amdgcn_ds_read_tr16_b64_v4i16((LAS s16x4*)p)); }

template <int MODE, int NDB>
__device__ __forceinline__ void attn_tile(const LAS char* Kt, const LAS char* Vt, const LAS char* OVt, const bf16x8 (&qf)[4], f32x16 (&o)[NDB], float& m, float& l,
                                          int tq, int key0, int W, bool lanesel, const LAS float* lut, int lane) {
    const int r32 = lane & 31, h = lane >> 5;
    f32x16 s0, s1;
#pragma unroll
    for (int r = 0; r < 16; ++r) { s0[r] = 0.f; s1[r] = 0.f; }
#pragma unroll
    for (int ks = 0; ks < 4; ++ks) {
        const bf16x8 k0 = *(const LAS bf16x8*)(Kt + r32 * KROW + (16 * ks + 8 * h) * 2);
        const bf16x8 k1 = *(const LAS bf16x8*)(Kt + (32 + r32) * KROW + (16 * ks + 8 * h) * 2);
        s0 = __builtin_amdgcn_mfma_f32_32x32x16_bf16(k0, qf[ks], s0, 0, 0, 0);
        s1 = __builtin_amdgcn_mfma_f32_32x32x16_bf16(k1, qf[ks], s1, 0, 0, 0);
    }
    float mx = NEG_INF;
    asm volatile("" ::: "memory");
#pragma unroll
    for (int kb = 0; kb < 2; ++kb) {
#pragma unroll
        for (int r = 0; r < 16; ++r) {
            const int key = key0 + 32 * kb + (r & 3) + 8 * (r >> 2) + 4 * h;
            const int dist = (MODE == 2) ? (tq - 16 * key - 31) : (tq - key);
            const int idx = dist < 0 ? 0 : (dist > 113 ? 113 : dist);
            bool valid;
            if (MODE == 0) valid = (unsigned)dist < (unsigned)W;
            else if (MODE == 1) valid = lanesel && dist >= 0;
            else valid = dist >= 0 && key < 255;
            float v = (kb ? s1[r] : s0[r]) + lut[idx];
            v = valid ? v : NEG_INF;
            if (kb) s1[r] = v; else s0[r] = v;
            mx = fmaxf(mx, v);
        }
        asm volatile("" ::: "memory");
    }
    mx = swap_max(mx);
    const float mnew = fmaxf(m, mx), alpha = __builtin_amdgcn_exp2f(m - mnew);
    float rs = 0.f;
#pragma unroll
    for (int r = 0; r < 16; ++r) { s0[r] = __builtin_amdgcn_exp2f(s0[r] - mnew); s1[r] = __builtin_amdgcn_exp2f(s1[r] - mnew); rs += s0[r] + s1[r]; }
    rs = swap_sum(rs);
    l = l * alpha + rs; m = mnew;
#pragma unroll
    for (int db = 0; db < NDB; ++db)
#pragma unroll
        for (int r = 0; r < 16; ++r) o[db][r] *= alpha;
    const int q4 = (lane & 15) >> 2, p4 = lane & 3, g2 = (lane >> 4) & 1;
#pragma unroll
    for (int kb = 0; kb < 2; ++kb)
#pragma unroll
        for (int s = 0; s < 2; ++s) {
            u32x4 pw;
            if (kb == 0) { pw.x = cvt_pk_bf16(s0[8 * s + 0], s0[8 * s + 1]); pw.y = cvt_pk_bf16(s0[8 * s + 2], s0[8 * s + 3]); pw.z = cvt_pk_bf16(s0[8 * s + 4], s0[8 * s + 5]); pw.w = cvt_pk_bf16(s0[8 * s + 6], s0[8 * s + 7]); }
            else { pw.x = cvt_pk_bf16(s1[8 * s + 0], s1[8 * s + 1]); pw.y = cvt_pk_bf16(s1[8 * s + 2], s1[8 * s + 3]); pw.z = cvt_pk_bf16(s1[8 * s + 4], s1[8 * s + 5]); pw.w = cvt_pk_bf16(s1[8 * s + 6], s1[8 * s + 7]); }
            const bf16x8 pb = __builtin_bit_cast(bf16x8, pw);
            const int rowoff = (32 * kb + 16 * s + 4 * h + q4) * KROW;
#pragma unroll
            for (int db = 0; db < NDB; ++db) {
                const LAS char* base = (db < 2 ? Vt : OVt) + rowoff + (32 * (db & 1) + 16 * g2 + 4 * p4) * 2;
                const s16x4 lo = vtr(base), hi = vtr(base + 8 * KROW);
                const bf16x8 vf = {lo[0], lo[1], lo[2], lo[3], hi[0], hi[1], hi[2], hi[3]};
                o[db] = __builtin_amdgcn_mfma_f32_32x32x16_bf16(vf, pb, o[db], 0, 0, 0);
            }
            asm volatile("" ::: "memory");
        }
}


template <int MODE>
__device__ __forceinline__ void attn_tile_fast(const LAS char* Kt, const LAS char* Vt, const bf16x8 (&qf)[4], f32x16 (&o)[2], float& m, float& l,
                                               bool lanesel, bool use_lut, const LAS float* lutp, float cfar, int lane) {
    const int r32 = lane & 31, h = lane >> 5;
    float ci = use_lut ? -m : (cfar - m);
    if (MODE == 1) ci = lanesel ? ci : NEG_INF;
    f32x16 s0, s1;
#pragma unroll
    for (int r = 0; r < 16; ++r) { s0[r] = ci; s1[r] = ci; }
#pragma unroll
    for (int ks = 0; ks < 4; ++ks) {
        const bf16x8 k0 = *(const LAS bf16x8*)(Kt + r32 * KROW + (16 * ks + 8 * h) * 2);
        const bf16x8 k1 = *(const LAS bf16x8*)(Kt + (32 + r32) * KROW + (16 * ks + 8 * h) * 2);
        s0 = __builtin_amdgcn_mfma_f32_32x32x16_bf16(k0, qf[ks], s0, 0, 0, 0);
        s1 = __builtin_amdgcn_mfma_f32_32x32x16_bf16(k1, qf[ks], s1, 0, 0, 0);
    }
    if (use_lut) {
#pragma unroll
        for (int r = 0; r < 16; ++r) { s0[r] += lutp[(r & 3) + 8 * (r >> 2)]; s1[r] += lutp[32 + (r & 3) + 8 * (r >> 2)]; }
    }
    float mx = fmaxf(s0[0], s1[0]);
#pragma unroll
    for (int r = 1; r < 16; ++r) mx = fmaxf(fmaxf(mx, s0[r]), s1[r]);
    mx = swap_max(mx);
    if (__any(mx > RESC_THR)) {
        const float dl = fmaxf(mx, 0.f), f = __builtin_amdgcn_exp2f(-dl);
        m += dl; l *= f;
#pragma unroll
        for (int r = 0; r < 16; ++r) { s0[r] -= dl; s1[r] -= dl; o[0][r] *= f; o[1][r] *= f; }
    }
    const int q4 = (lane & 15) >> 2, p4 = lane & 3, g2 = (lane >> 4) & 1;
    float rs = 0.f;
#pragma unroll
    for (int kb = 0; kb < 2; ++kb)
#pragma unroll
        for (int s = 0; s < 2; ++s) {
            float e[8];
#pragma unroll
            for (int i = 0; i < 8; ++i) { e[i] = __builtin_amdgcn_exp2f(kb ? s1[8 * s + i] : s0[8 * s + i]); rs += e[i]; }
            u32x4 pw; pw.x = cvt_pk_bf16(e[0], e[1]); pw.y = cvt_pk_bf16(e[2], e[3]); pw.z = cvt_pk_bf16(e[4], e[5]); pw.w = cvt_pk_bf16(e[6], e[7]);
            const bf16x8 pb = __builtin_bit_cast(bf16x8, pw);
            const int rowoff = (32 * kb + 16 * s + 4 * h + q4) * KROW;
#pragma unroll
            for (int db = 0; db < 2; ++db) {
                const LAS char* base = Vt + rowoff + (32 * db + 16 * g2 + 4 * p4) * 2;
                const s16x4 lo = vtr(base), hi = vtr(base + 8 * KROW);
                const bf16x8 vf = {lo[0], lo[1], lo[2], lo[3], hi[0], hi[1], hi[2], hi[3]};
                o[db] = __builtin_amdgcn_mfma_f32_32x32x16_bf16(vf, pb, o[db], 0, 0, 0);
            }
            __builtin_amdgcn_sched_barrier(0);
        }
    l += swap_sum(rs);
}

template <int MODE, int NDB>
__device__ __forceinline__ void run_branch(LAS unsigned char* lds, const bf16_t* Kg, const bf16_t* Vg, int pitch, unsigned long long tiles, const bf16x8 (&qf)[4], f32x16 (&o)[NDB], float& m, float& l,
                                           int tq, int W, unsigned long long selm, const LAS float* lut, int tid, int lane, unsigned char* wsp = nullptr) {
    const int lrow = tid >> 3, lch = tid & 7;
    if (tiles == 0ull) return;
    int j = __builtin_ctzll(tiles); tiles &= tiles - 1ull;
    auto gen_ov = [&](int tile, int b) {
        const int n = 64 * tile + lrow; unsigned short e[8];
#pragma unroll
        for (int i = 0; i < 8; ++i) { const int d = n - 4 * (8 * lch + i); e[i] = (n < 255 && d >= -1 && d <= 3) ? ((d == -1 || d == 3) ? (unsigned short)0x3f00 : (unsigned short)0x3f80) : (unsigned short)0; }
        u32x4 w; w.x = e[0] | ((unsigned)e[1] << 16); w.y = e[2] | ((unsigned)e[3] << 16); w.z = e[4] | ((unsigned)e[5] << 16); w.w = e[6] | ((unsigned)e[7] << 16);
        *(LAS u32x4*)(lds + L_OV + b * TILE_B + lrow * KROW + lch * 16) = w;
    };
#define ATT_LD(K_, V_, t_) do { K_ = *(const u32x4*)(Kg + (size_t)((t_) * 64 + lrow) * pitch + lch * 8); V_ = *(const u32x4*)(Vg + (size_t)((t_) * 64 + lrow) * pitch + lch * 8); } while (0)
#define ATT_ST(K_, V_, b_) do { *(LAS u32x4*)(lds + L_K + (b_) * TILE_B + lrow * KROW + lch * 16) = K_; *(LAS u32x4*)(lds + L_V + (b_) * TILE_B + lrow * KROW + lch * 16) = V_; } while (0)
    u32x4 kra, vra, krb, vrb;
    ATT_LD(kra, vra, j);
    int jn = -1;
    if (tiles != 0ull) { jn = __builtin_ctzll(tiles); tiles &= tiles - 1ull; }
    ATT_LD(krb, vrb, (jn < 0 ? j : jn));
    ATT_ST(kra, vra, 0);
    if (MODE == 2) gen_ov(j, 0);
    __syncthreads();
    for (;;) {
        int jnn = -1;
        if (tiles != 0ull) { jnn = __builtin_ctzll(tiles); tiles &= tiles - 1ull; }
        ATT_LD(kra, vra, (jnn < 0 ? j : jnn));
        {
        const bool lanesel = (MODE == 1) ? ((selm >> j) & 1ull) != 0ull : true;
        if constexpr (MODE == 2) {
            attn_tile<MODE, NDB>((const LAS char*)(lds + L_K + 0 * TILE_B), (const LAS char*)(lds + L_V + 0 * TILE_B), (const LAS char*)(lds + L_OV + 0 * TILE_B), qf, o, m, l, tq, 64 * j, W, lanesel, lut, lane);
        } else if (MODE != 1 || __ballot(lanesel) != 0ull) {
            const int tq0w = tq - (lane & 31);
            const int dmin = tq0w - 64 * j - 63, dmax = tq0w + 31 - 64 * j;
            const bool use_lut = (MODE == 0) ? !(dmin >= 113 && dmax < W) : !(dmin >= 113);
            const int r_ = (tid >> 6) & 3;
            const LAS float* lutp = (MODE == 0) ? (const LAS float*)(lds + L_LUT2) + r_ * LUT2_N + (64 * j + 4 * (lane >> 5) - tq + LUT2_K)
                                               : (const LAS float*)(lds + L_LUT3) + r_ * LUT3_N + (64 * j + 4 * (lane >> 5) - tq + LUT3_K);
            attn_tile_fast<MODE>((const LAS char*)(lds + L_K + 0 * TILE_B), (const LAS char*)(lds + L_V + 0 * TILE_B), qf, o, m, l, lanesel, use_lut, lutp, lut[113], lane);
        }
        }
        if (jn < 0) break;
        ATT_ST(krb, vrb, 1);
        if (MODE == 2) gen_ov(jn, 1);
        if (MODE == 1) T0W(6, wsp);
        __syncthreads();
        if (MODE == 1) T1(6, wsp);
        int jn3 = -1;
        if (tiles != 0ull) { jn3 = __builtin_ctzll(tiles); tiles &= tiles - 1ull; }
        ATT_LD(krb, vrb, (jn3 < 0 ? jn : jn3));
        {
        const bool lanesel = (MODE == 1) ? ((selm >> jn) & 1ull) != 0ull : true;
        if constexpr (MODE == 2) {
            attn_tile<MODE, NDB>((const LAS char*)(lds + L_K + 1 * TILE_B), (const LAS char*)(lds + L_V + 1 * TILE_B), (const LAS char*)(lds + L_OV + 1 * TILE_B), qf, o, m, l, tq, 64 * jn, W, lanesel, lut, lane);
        } else if (MODE != 1 || __ballot(lanesel) != 0ull) {
            const int tq0w = tq - (lane & 31);
            const int dmin = tq0w - 64 * jn - 63, dmax = tq0w + 31 - 64 * jn;
            const bool use_lut = (MODE == 0) ? !(dmin >= 113 && dmax < W) : !(dmin >= 113);
            const int r_ = (tid >> 6) & 3;
            const LAS float* lutp = (MODE == 0) ? (const LAS float*)(lds + L_LUT2) + r_ * LUT2_N + (64 * jn + 4 * (lane >> 5) - tq + LUT2_K)
                                               : (const LAS float*)(lds + L_LUT3) + r_ * LUT3_N + (64 * jn + 4 * (lane >> 5) - tq + LUT3_K);
            attn_tile_fast<MODE>((const LAS char*)(lds + L_K + 1 * TILE_B), (const LAS char*)(lds + L_V + 1 * TILE_B), qf, o, m, l, lanesel, use_lut, lutp, lut[113], lane);
        }
        }
        if (jnn < 0) break;
        ATT_ST(kra, vra, 0);
        if (MODE == 2) gen_ov(jnn, 0);
        if (MODE == 1) T0W(6, wsp);
        __syncthreads();
        if (MODE == 1) T1(6, wsp);
        j = jnn; jn = jn3;
    }
#undef ATT_LD
#undef ATT_ST
    __syncthreads();
}

__device__ __forceinline__ unsigned long long tile_range(int lo, int hi) {
    const unsigned long long a = (hi >= 63) ? ~0ull : ((1ull << (hi + 1)) - 1ull);
    return a & ~((1ull << lo) - 1ull);
}

__device__ __forceinline__ void build_lut(LAS unsigned char* lds, const float* relb, int head0, int tid) {
    LAS float* lut = (LAS float*)(lds + L_LUT);
    const int r = tid >> 7, d = tid & 127;
    lut[r * 128 + d] = relb[t5_bucket(d) * 16 + head0 + r] * LOG2E;
}

__device__ __forceinline__ void build_lut23(LAS unsigned char* lds, int W, bool want3, int tid) {
    const LAS float* lut = (const LAS float*)(lds + L_LUT);
    LAS float* l2 = (LAS float*)(lds + L_LUT2); LAS float* l3 = (LAS float*)(lds + L_LUT3);
    for (int i = tid; i < 4 * LUT2_N; i += 512) { const int r = i / LUT2_N, jj = i - r * LUT2_N, d = LUT2_K - jj; l2[i] = (d < 0 || d >= W) ? NEG_INF : lut[r * 128 + (d > 113 ? 113 : d)]; }
    if (want3) for (int i = tid; i < 4 * LUT3_N; i += 512) { const int r = i / LUT3_N, jj = i - r * LUT3_N, d = LUT3_K - jj; l3[i] = (d < 0) ? NEG_INF : lut[r * 128 + (d > 113 ? 113 : d)]; }
}

__device__ __forceinline__ void unit_swa(Frame& F, const Args& A, int b, int g, int qt) {
    LAS unsigned char* lds = F.lds;
    const int lane = F.lane, wave = F.wave, r = wave & 3, th = wave >> 2, r32 = lane & 31, h = lane >> 5;
    const int head = g * 4 + r, tq = qt * 64 + 32 * th + r32;
    build_lut(lds, INP(I_RELB), g * 4, F.tid);
    const bf16_t* qrow = WSP(bf16_t, WS_QA) + ((size_t)(b * SEQ + tq)) * 512 + head * 64;
    bf16x8 qf[4];
#pragma unroll
    for (int ks = 0; ks < 4; ++ks) qf[ks] = *(const bf16x8*)(qrow + 16 * ks + 8 * h);
    f32x16 o[2];
#pragma unroll
    for (int db = 0; db < 2; ++db)
#pragma unroll
        for (int i = 0; i < 16; ++i) o[db][i] = 0.f;
    float m = INP(I_L0_SINKS)[head] * LOG2E, l = 1.f;
    __syncthreads();
    build_lut23(lds, 128, false, F.tid);
    __syncthreads();
    const LAS float* lut = (const LAS float*)(lds + L_LUT) + r * 128;
    const bf16_t* Kg = WSP(bf16_t, WS_KA) + (size_t)b * SEQ * 128 + g * 64; const bf16_t* Vg = WSP(bf16_t, WS_VA) + (size_t)b * SEQ * 128 + g * 64;
    run_branch<0, 2>(lds, Kg, Vg, 128, tile_range(qt - 2 < 0 ? 0 : qt - 2, qt), qf, o, m, l, tq, 128, 0ull, lut, F.tid, lane);
    const float inv = FP8_SMIX0 / l;
    unsigned char* orow = F.ws + WS_MIX0 + ((size_t)(b * SEQ + tq)) * DM + head * 64;
#pragma unroll
    for (int db = 0; db < 2; ++db)
#pragma unroll
        for (int rg = 0; rg < 4; ++rg) *(unsigned*)(orow + 32 * db + 8 * rg + 4 * h) = cvt4_fp8(o[db][4 * rg] * inv, o[db][4 * rg + 1] * inv, o[db][4 * rg + 2] * inv, o[db][4 * rg + 3] * inv);
}

__device__ __forceinline__ void unit_nsa(Frame& F, const Args& A, int b, int g, int qt) {
    LAS unsigned char* lds = F.lds;
    const int lane = F.lane, wave = F.wave, r = wave & 3, th = wave >> 2, r32 = lane & 31, h = lane >> 5;
    const int hb = g * 4 + r, tq = qt * 64 + 32 * th + r32, tok = 32 * th + r32, bg = b * 2 + g;
    build_lut(lds, INP(I_RELB), 8 + g * 4, F.tid);
    const bf16_t* qrow = WSP(bf16_t, WS_QB) + ((size_t)(b * SEQ + tq)) * 512 + hb * 64;
    bf16x8 qf[4];
#pragma unroll
    for (int ks = 0; ks < 4; ++ks) qf[ks] = *(const bf16x8*)(qrow + 16 * ks + 8 * h);
    const float* gp = WSP(float, WS_GATES) + ((size_t)(b * SEQ + tq)) * 24 + hb;
    const float g_cmp = gp[0], g_slc = gp[8], g_win = gp[16];
    f32x16 acc[2];
    __syncthreads();
    build_lut23(lds, 512, true, F.tid);
    __syncthreads();
    const LAS float* lut = (const LAS float*)(lds + L_LUT) + r * 128;
    LAS float* imp = (LAS float*)(lds + L_IMP);
    LAS unsigned long long* selm = (LAS unsigned long long*)(lds + L_SELM);
    T0W(2, F.ws);
    {
        f32x16 o[4];
#pragma unroll
        for (int db = 0; db < 4; ++db)
#pragma unroll
            for (int i = 0; i < 16; ++i) o[db][i] = 0.f;
        float m = -1e30f, l = 0.f;
        const int tmax = qt * 64 + 63;
        unsigned long long tiles = 0ull;
        if (tmax >= 31) { const int nmax = (tmax - 31) >> 4; tiles = tile_range(0, (nmax > 254 ? 254 : nmax) >> 6); }
        const bf16_t* Kc = WSP(bf16_t, WS_KC) + (size_t)bg * 256 * 64; const bf16_t* Vc = WSP(bf16_t, WS_KC) + (size_t)(16 + bg) * 256 * 64;
        run_branch<2, 4>(lds, Kc, Vc, 64, tiles, qf, o, m, l, tq, 0, 0ull, lut, F.tid, lane);
        const float inv = l > 0.f ? 1.f / l : 0.f;
#pragma unroll
        for (int db = 0; db < 2; ++db)
#pragma unroll
            for (int i = 0; i < 16; ++i) acc[db][i] = o[db][i] * (inv * g_cmp);
        if (qt >= 16) {
#pragma unroll
            for (int db = 0; db < 2; ++db)
#pragma unroll
                for (int i = 0; i < 16; ++i) { const int jj = 32 * db + (i & 3) + 8 * (i >> 2) + 4 * h; imp[(r * 64 + jj) * 65 + tok] = o[2 + db][i] * inv; }
        }
    }
    __syncthreads();
    T1(2, F.ws);
    T0W(3, F.ws);
    {
        const unsigned long long adm = tile_range(0, qt);
        if (qt < 16) { if (lane < 8) selm[wave * 8 + lane] = adm; }
        else {
            int jl = lane; asm volatile("" : "+v"(jl));
            const unsigned long long ltm = (1ull << jl) - 1ull;
            const bool forced = (jl == 0) || (jl == qt) || (jl == qt - 1);
            unsigned u[8], sv[8];
#pragma unroll
            for (int i = 0; i < 8; ++i) {
                const int tk = wave * 8 + i;
                const float iv = ((imp[(0 * 64 + jl) * 65 + tk] + imp[(1 * 64 + jl) * 65 + tk]) + imp[(2 * 64 + jl) * 65 + tk]) + imp[(3 * 64 + jl) * 65 + tk];
                const float sc = forced ? 1e30f : (jl <= qt ? iv : -1e30f);
                const unsigned bits = __float_as_uint(sc); u[i] = bits ^ ((bits >> 31) ? 0xffffffffu : 0x80000000u); sv[i] = u[i];
            }
#pragma unroll
            for (int k = 2; k <= 64; k <<= 1)
#pragma unroll
                for (int d = k >> 1; d > 0; d >>= 1) {
                    const bool takemin = (((jl & d) == 0) == ((jl & k) == 0));
#pragma unroll
                    for (int i = 0; i < 8; ++i) { const unsigned pv = (unsigned)__shfl_xor((int)sv[i], d); const unsigned mn = sv[i] < pv ? sv[i] : pv, mxv = sv[i] < pv ? pv : sv[i]; sv[i] = takemin ? mn : mxv; }
                }
#pragma unroll
            for (int i = 0; i < 8; ++i) {
                const unsigned tau = (unsigned)__builtin_amdgcn_readlane((int)sv[i], 48);
                const unsigned long long mgt = __ballot(u[i] > tau), meq = __ballot(u[i] == tau);
                const int need = 16 - __popcll(mgt);
                const bool sel = (u[i] > tau) || ((u[i] == tau) && __popcll(meq & ltm) < need);
                const unsigned long long mk = __ballot(sel) & adm;
                if (jl == 0) selm[wave * 8 + i] = mk;
            }
        }
    }
    __syncthreads();
    T1(3, F.ws);
    const unsigned long long myselm = selm[tok];
    unsigned long long uni = selm[lane];
#pragma unroll
    for (int o_ = 1; o_ < 64; o_ <<= 1) { const unsigned lo = __shfl_xor((unsigned)uni, o_), hi = __shfl_xor((unsigned)(uni >> 32), o_); uni |= ((unsigned long long)hi << 32) | lo; }
    uni = ((unsigned long long)(unsigned)__builtin_amdgcn_readfirstlane((unsigned)(uni >> 32)) << 32) | (unsigned)__builtin_amdgcn_readfirstlane((unsigned)uni);
    T0W(4, F.ws);
    {
        f32x16 o[2];
#pragma unroll
        for (int db = 0; db < 2; ++db)
#pragma unroll
            for (int i = 0; i < 16; ++i) o[db][i] = 0.f;
        float m = 0.f, l = 0.f;
        const bf16_t* Kg = WSP(bf16_t, WS_KSLC) + (size_t)b * SEQ * 128 + g * 64; const bf16_t* Vg = WSP(bf16_t, WS_VSLC) + (size_t)b * SEQ * 128 + g * 64;
        run_branch<1, 2>(lds, Kg, Vg, 128, uni, qf, o, m, l, tq, 0, myselm, lut, F.tid, lane, F.ws);
        const float inv = g_slc / l;
#pragma unroll
        for (int db = 0; db < 2; ++db)
#pragma unroll
            for (int i = 0; i < 16; ++i) acc[db][i] += o[db][i] * inv;
    }
    T1(4, F.ws);
    T0W(5, F.ws);
    {
        f32x16 o[2];
#pragma unroll
        for (int db = 0; db < 2; ++db)
#pragma unroll
            for (int i = 0; i < 16; ++i) o[db][i] = 0.f;
        float m = 0.f, l = 0.f;
        const bf16_t* Kg = WSP(bf16_t, WS_KWIN) + (size_t)b * SEQ * 128 + g * 64; const bf16_t* Vg = WSP(bf16_t, WS_VWIN) + (size_t)b * SEQ * 128 + g * 64;
        run_branch<0, 2>(lds, Kg, Vg, 128, tile_range(qt - 8 < 0 ? 0 : qt - 8, qt), qf, o, m, l, tq, 512, 0ull, lut, F.tid, lane);
        const float inv = g_win / l;
#pragma unroll
        for (int db = 0; db < 2; ++db)
#pragma unroll
            for (int i = 0; i < 16; ++i) acc[db][i] += o[db][i] * inv;
    }
    T1(5, F.ws);
    unsigned char* orow = F.ws + WS_MIX0 + ((size_t)(b * SEQ + tq)) * DM + 512 + hb * 64;
#pragma unroll
    for (int db = 0; db < 2; ++db)
#pragma unroll
        for (int rg = 0; rg < 4; ++rg) *(unsigned*)(orow + 32 * db + 8 * rg + 4 * h) = cvt4_fp8(acc[db][4 * rg] * FP8_SMIX0, acc[db][4 * rg + 1] * FP8_SMIX0, acc[db][4 * rg + 2] * FP8_SMIX0, acc[db][4 * rg + 3] * FP8_SMIX0);
}

#ifndef PROBE_NSA_REP
#define PROBE_NSA_REP 1
#endif
#ifndef PROBE_SWA_REP
#define PROBE_SWA_REP 1
#endif
__device__ __forceinline__ void attn0_phase(Frame& F, const Args& A) {
    const int vcu = (F.G % 8 == 0) ? (F.bid % 8) * (F.G / 8) + F.bid / 8 : F.bid;
    for (int rep = 0; rep < PROBE_NSA_REP; ++rep)
    for (int U = vcu; U < 1024; U += F.G) {
        const int c = U & 255, i = U >> 8, bg = c >> 4, s = c & 15;
        const int qt = (i == 0) ? 63 - s : (i == 1) ? 32 + s : (i == 2) ? 31 - s : s;
        unit_nsa(F, A, bg >> 1, bg & 1, qt);
        __syncthreads();
    }
    for (int rep = 0; rep < PROBE_SWA_REP; ++rep)
    for (int U = vcu; U < 1024; U += F.G) {
        const int c = U & 255, i = U >> 8, bg = c >> 4, s = c & 15;
        unit_swa(F, A, bg >> 1, bg & 1, 16 * i + s);
        __syncthreads();
    }
}
}
namespace dsa {
constexpr int L_SC = 0;
constexpr int L_LIST = LDS_EXTRA_OFF;
constexpr int L_LUTD = L_LIST + 4096;
constexpr int L_WT = L_LUTD + 114 * 16 * 4;
static_assert(L_WT + 256 <= LDS_MISC_OFF, "dsa LDS map");
constexpr int VROW = 160;
constexpr float NEG_INF = -__builtin_huge_valf();
typedef float f32x4_t __attribute__((ext_vector_type(4)));


__device__ __forceinline__ int count_ge8(unsigned a0, unsigned a1, unsigned a2, unsigned a3, unsigned a4, unsigned a5, unsigned a6, unsigned a7, unsigned cand) {
    int c, t; unsigned long long m0, m1, m2, m3, m4, m5, m6, m7;
    asm volatile(
        "v_cmp_ge_u32_e64 %[m0], %[a0], %[cd]\n\tv_cmp_ge_u32_e64 %[m1], %[a1], %[cd]\n\tv_cmp_ge_u32_e64 %[m2], %[a2], %[cd]\n\tv_cmp_ge_u32_e64 %[m3], %[a3], %[cd]\n\t"
        "v_cmp_ge_u32_e64 %[m4], %[a4], %[cd]\n\tv_cmp_ge_u32_e64 %[m5], %[a5], %[cd]\n\tv_cmp_ge_u32_e64 %[m6], %[a6], %[cd]\n\tv_cmp_ge_u32_e64 %[m7], %[a7], %[cd]\n\t"
        "s_bcnt1_i32_b64 %[c], %[m0]\n\ts_bcnt1_i32_b64 %[t], %[m1]\n\ts_add_i32 %[c], %[c], %[t]\n\ts_bcnt1_i32_b64 %[t], %[m2]\n\ts_add_i32 %[c], %[c], %[t]\n\t"
        "s_bcnt1_i32_b64 %[t], %[m3]\n\ts_add_i32 %[c], %[c], %[t]\n\ts_bcnt1_i32_b64 %[t], %[m4]\n\ts_add_i32 %[c], %[c], %[t]\n\ts_bcnt1_i32_b64 %[t], %[m5]\n\ts_add_i32 %[c], %[c], %[t]\n\t"
        "s_bcnt1_i32_b64 %[t], %[m6]\n\ts_add_i32 %[c], %[c], %[t]\n\ts_bcnt1_i32_b64 %[t], %[m7]\n\ts_add_i32 %[c], %[c], %[t]"
        : [c] "=&s"(c), [t] "=&s"(t), [m0] "=&s"(m0), [m1] "=&s"(m1), [m2] "=&s"(m2), [m3] "=&s"(m3), [m4] "=&s"(m4), [m5] "=&s"(m5), [m6] "=&s"(m6), [m7] "=&s"(m7)
        : [a0] "v"(a0), [a1] "v"(a1), [a2] "v"(a2), [a3] "v"(a3), [a4] "v"(a4), [a5] "v"(a5), [a6] "v"(a6), [a7] "v"(a7), [cd] "s"(cand)
        : "scc");
    return c;
}

__device__ __forceinline__ void unit_dsa(Frame& F, const Args& A, int b, int t0) {
    LAS unsigned char* lds = F.lds;
    int lane_ = F.lane; asm volatile("" : "+v"(lane_));
    const int tid = F.tid, lane = lane_, wave = F.wave, r32 = lane & 31, h = lane >> 5;
    const size_t tb = (size_t)b * SEQ;
    LAS float* sc = (LAS float*)(lds + L_SC);
    LAS unsigned short* list = (LAS unsigned short*)(lds + L_LIST) + wave * 256;
    const LAS float* lutd = (const LAS float*)(lds + L_LUTD);
    LAS float* wt = (LAS float*)(lds + L_WT);
    if (tid < 64) wt[tid] = WSP(float, WS_WI)[(tb + t0) * 8 + tid];
    __syncthreads();
#ifndef PROBE_DSA_A
#define PROBE_DSA_A 1
#endif
#ifndef PROBE_DSA_B
#define PROBE_DSA_B 1
#endif
#ifndef PROBE_DSA_C
#define PROBE_DSA_C 1
#endif
    T0W(11, F.ws);
    for (int repa = 0; repa < PROBE_DSA_A; ++repa)
    if (t0 + 8 > 256) {
        const int nkb = ((t0 + 8 + 63) >> 6) << 1;
        const int hh_r = (r32 >> 2) & 1, reg_r = (r32 & 3) | ((r32 >> 3) << 2), qi4 = 2 * hh_r + (reg_r >> 3), hd = reg_r & 7;
        bf16x8 qaf[2][2]; float wv[2][16];
#pragma unroll
        for (int rb = 0; rb < 2; ++rb) {
            const bf16_t* qp = WSP(bf16_t, WS_QI) + (tb + t0 + 4 * rb + qi4) * 256 + hd * 32 + 8 * h;
            qaf[rb][0] = *(const bf16x8*)qp; qaf[rb][1] = *(const bf16x8*)(qp + 16);
#pragma unroll
            for (int rg = 0; rg < 16; ++rg) wv[rb][rg] = wt[(4 * rb + 2 * h + (rg >> 3)) * 8 + (rg & 7)];
        }
        int kb = wave;
        bf16x8 bk0 = {0, 0, 0, 0, 0, 0, 0, 0}, bk1 = {0, 0, 0, 0, 0, 0, 0, 0};
        if (kb < nkb) { const bf16_t* kp = WSP(bf16_t, WS_KI) + (tb + 32 * kb + r32) * 32 + 8 * h; bk0 = *(const bf16x8*)kp; bk1 = *(const bf16x8*)(kp + 16); }
        while (kb < nkb) {
            const int kn = kb + 8; bf16x8 nb0 = bk0, nb1 = bk1;
            if (kn < nkb) { const bf16_t* kp = WSP(bf16_t, WS_KI) + (tb + 32 * kn + r32) * 32 + 8 * h; nb0 = *(const bf16x8*)kp; nb1 = *(const bf16x8*)(kp + 16); }
            const int key = 32 * kb + r32;
#pragma unroll
            for (int rb = 0; rb < 2; ++rb) {
                f32x16 c;
#pragma unroll
                for (int i = 0; i < 16; ++i) c[i] = 0.f;
                c = __builtin_amdgcn_mfma_f32_32x32x16_bf16(qaf[rb][0], bk0, c, 0, 0, 0);
                c = __builtin_amdgcn_mfma_f32_32x32x16_bf16(qaf[rb][1], bk1, c, 0, 0, 0);
                float sA = 0.f, sB = 0.f;
#pragma unroll
                for (int i = 0; i < 8; ++i) { sA += wv[rb][i] * fmaxf(c[i], 0.f); sB += wv[rb][8 + i] * fmaxf(c[8 + i], 0.f); }
                const int qA = 4 * rb + 2 * h;
                sc[qA * 4096 + key] = (key <= t0 + qA) ? sA : NEG_INF;
                sc[(qA + 1) * 4096 + key] = (key <= t0 + qA + 1) ? sB : NEG_INF;
            }
            bk0 = nb0; bk1 = nb1; kb = kn;
        }
    }
    __syncthreads();
    T1(11, F.ws);
    T0W(12, F.ws);
    const int t = t0 + wave, n = t + 1;
    int cnt;
    for (int repb = 0; repb < PROBE_DSA_B; ++repb)
    if (n <= 256) {
#pragma unroll
        for (int i = 0; i < 4; ++i) { const int k = lane + 64 * i; list[k] = (unsigned short)(k < n ? k : 0); }
        cnt = n;
    } else {
        const int nreg = (n + 63) >> 6, ngrp = (nreg + 7) >> 3;
        LAS float* my = sc + wave * 4096;
        float f[64];
#pragma unroll
        for (int g8 = 0; g8 < 8; ++g8) {
#pragma unroll
            for (int k = 0; k < 8; ++k) f[g8 * 8 + k] = NEG_INF;
            if (g8 < ngrp) {
#pragma unroll
                for (int k = 0; k < 8; ++k) if (g8 * 8 + k < nreg) f[g8 * 8 + k] = my[64 * (g8 * 8 + k) + lane];
            }
        }
        float ta = NEG_INF, tb_ = NEG_INF, tc = NEG_INF, td = NEG_INF;
#pragma unroll
        for (int g8 = 0; g8 < 8; ++g8) if (g8 < ngrp) {
#pragma unroll
            for (int k = 0; k < 8; ++k) { const float x = f[g8 * 8 + k]; td = __builtin_amdgcn_fmed3f(tc, td, x); tc = __builtin_amdgcn_fmed3f(tb_, tc, x); tb_ = __builtin_amdgcn_fmed3f(ta, tb_, x); ta = fmaxf(ta, x); }
        }
        float L = td;
#pragma unroll
        for (int o_ = 1; o_ < 64; o_ <<= 1) L = fminf(L, __shfl_xor(L, o_));
        LAS unsigned* cval = (LAS unsigned*)my; LAS unsigned short* ckey = (LAS unsigned short*)(my + 1024);
        const unsigned long long ltmask = (1ull << lane) - 1ull;
        int ns = 0;
#pragma unroll
        for (int g8 = 0; g8 < 8; ++g8) if (g8 < ngrp) {
#pragma unroll
            for (int k = 0; k < 8; ++k) { const int i = g8 * 8 + k; const bool keep = f[i] >= L; const unsigned long long mk = __ballot(keep); const int pos = ns + __popcll(mk & ltmask);
                if (keep && pos < 1024) { const unsigned bits = __float_as_uint(f[i]); cval[pos] = bits ^ ((bits >> 31) ? 0xffffffffu : 0x80000000u); ckey[pos] = (unsigned short)(64 * i + lane); }
                ns += __popcll(mk); }
        }
        if (ns <= 1024) {
            unsigned w[16];
#pragma unroll
            for (int j = 0; j < 16; ++j) w[j] = (64 * j + lane < ns) ? cval[64 * j + lane] : 0u;
            const bool two = ns > 512;
            float Mx = ta;
#pragma unroll
            for (int o_ = 1; o_ < 64; o_ <<= 1) Mx = fmaxf(Mx, __shfl_xor(Mx, o_));
            const unsigned Lb = __float_as_uint(L), Mb = __float_as_uint(Mx);
            const unsigned Lk = __builtin_amdgcn_readfirstlane(Lb ^ ((Lb >> 31) ? 0xffffffffu : 0x80000000u)), Mk = __builtin_amdgcn_readfirstlane(Mb ^ ((Mb >> 31) ? 0xffffffffu : 0x80000000u));
            const int hb = (Lk == Mk) ? -1 : 31 - __builtin_clz(Lk ^ Mk);
            unsigned tau = (hb >= 31) ? 0u : (hb < 0 ? Mk : (Mk & ~((2u << hb) - 1u)));
            for (int bit = hb; bit >= 0; --bit) {
                const unsigned cand = tau | (1u << bit);
                int c = count_ge8(w[0], w[1], w[2], w[3], w[4], w[5], w[6], w[7], cand);
                if (two) c += count_ge8(w[8], w[9], w[10], w[11], w[12], w[13], w[14], w[15], cand);
                if (c >= 256) { tau = cand; if (c == 256) break; }
            }
            int cgt = count_ge8(w[0], w[1], w[2], w[3], w[4], w[5], w[6], w[7], tau + 1u);
            if (two) cgt += count_ge8(w[8], w[9], w[10], w[11], w[12], w[13], w[14], w[15], tau + 1u);
            const int need = 256 - cgt; int base = 0, eqseen = 0;
#pragma unroll
            for (int j = 0; j < 16; ++j) if (64 * j < ns) {
                const bool gt = w[j] > tau, eq = w[j] == tau;
                const unsigned long long meq = __ballot(eq);
                const bool sel = gt || (eq && (eqseen + __popcll(meq & ltmask)) < need);
                const unsigned long long msel = __ballot(sel);
                if (sel) list[base + __popcll(msel & ltmask)] = ckey[64 * j + lane];
                base += __popcll(msel); eqseen += __popcll(meq);
            }
        } else {
#pragma unroll
            for (int i = 0; i < 64; ++i) { const unsigned bits = __float_as_uint(f[i]); f[i] = __uint_as_float((i < nreg) ? (bits ^ ((bits >> 31) ? 0xffffffffu : 0x80000000u)) : 0u); }
#define u_(i) __float_as_uint(f[i])
            unsigned tau = 0u;
            for (int bit = 31; bit >= 0; --bit) {
                const unsigned cand = tau | (1u << bit); int c = 0;
#pragma unroll
                for (int g8 = 0; g8 < 8; ++g8) if (g8 < ngrp)
                    c += count_ge8(u_(g8 * 8 + 0), u_(g8 * 8 + 1), u_(g8 * 8 + 2), u_(g8 * 8 + 3), u_(g8 * 8 + 4), u_(g8 * 8 + 5), u_(g8 * 8 + 6), u_(g8 * 8 + 7), cand);
                if (c >= 256) { tau = cand; if (c == 256) break; }
            }
            int cgt = 0;
#pragma unroll
            for (int g8 = 0; g8 < 8; ++g8) if (g8 < ngrp)
                cgt += count_ge8(u_(g8 * 8 + 0), u_(g8 * 8 + 1), u_(g8 * 8 + 2), u_(g8 * 8 + 3), u_(g8 * 8 + 4), u_(g8 * 8 + 5), u_(g8 * 8 + 6), u_(g8 * 8 + 7), tau + 1u);
            const int need = 256 - cgt; int base = 0, eqseen = 0;
#pragma unroll
            for (int g8 = 0; g8 < 8; ++g8) if (g8 < ngrp) {
#pragma unroll
                for (int k = 0; k < 8; ++k) { const int i = g8 * 8 + k;
                    const bool gt = u_(i) > tau, eq = u_(i) == tau;
                    const unsigned long long meq = __ballot(eq);
                    const bool sel = gt || (eq && (eqseen + __popcll(meq & ltmask)) < need);
                    const unsigned long long msel = __ballot(sel);
                    if (sel) list[base + __popcll(msel & ltmask)] = (unsigned short)(64 * i + lane);
                    base += __popcll(msel); eqseen += __popcll(meq); } }
        }
#undef u_
        cnt = 256;
    }
    T1(12, F.ws);
    T0W(14, F.ws);
    asm volatile("s_waitcnt lgkmcnt(0)" ::: "memory");
    T1(14, F.ws);
    T0W(13, F.ws);
    for (int repc = 0; repc < PROBE_DSA_C; ++repc)
    {
        const int head = lane & 15, g4 = lane >> 4, q4 = (lane & 15) >> 2, p4 = lane & 3;
        const bf16_t* qp = WSP(bf16_t, WS_Q1) + (tb + t) * 1024 + head * 64 + 8 * g4;
        const bf16x8 qf0 = *(const bf16x8*)qp, qf1 = *(const bf16x8*)(qp + 32);
        const bf16_t* K1 = WSP(bf16_t, WS_K1) + tb * 64; const bf16_t* V1 = WSP(bf16_t, WS_V1) + tb * 64;
        f32x4_t sA[8], sB[8];
        float mx = NEG_INF;
        const float cfar = lutd[113 * 16 + head];
        LAS unsigned char* kst = lds + wave * 16384;
        {
            u32x4 kr[8][4];
#pragma unroll
            for (int c = 0; c < 8; ++c) {
#pragma unroll
                for (int i = 0; i < 4; ++i) { const unsigned key = list[32 * c + 8 * i + (lane >> 3)]; kr[c][i] = *(const u32x4*)((const char*)K1 + (key * 128u + (unsigned)(lane & 7) * 16u)); }
            }
#pragma unroll
            for (int c = 0; c < 8; ++c) {
#pragma unroll
                for (int i = 0; i < 4; ++i) *(LAS u32x4*)(kst + (8 * i + (lane >> 3)) * VROW + (lane & 7) * 16) = kr[c][i];
                const LAS unsigned char* ka = kst + (lane & 15) * VROW + 16 * g4;
                const bf16x8 kA0 = *(const LAS bf16x8*)ka, kA1 = *(const LAS bf16x8*)(ka + 64), kB0 = *(const LAS bf16x8*)(ka + 16 * VROW), kB1 = *(const LAS bf16x8*)(ka + 16 * VROW + 64);
                const int kmax = __builtin_amdgcn_readfirstlane((int)list[32 * c + 31]);
                if (cnt == 256 && t - kmax >= 113) {
                    f32x4_t a = {cfar, cfar, cfar, cfar}, bb = {cfar, cfar, cfar, cfar};
                    a = __builtin_amdgcn_mfma_f32_16x16x32_bf16(kA0, qf0, a, 0, 0, 0); a = __builtin_amdgcn_mfma_f32_16x16x32_bf16(kA1, qf1, a, 0, 0, 0);
                    bb = __builtin_amdgcn_mfma_f32_16x16x32_bf16(kB0, qf0, bb, 0, 0, 0); bb = __builtin_amdgcn_mfma_f32_16x16x32_bf16(kB1, qf1, bb, 0, 0, 0);
                    sA[c] = a; sB[c] = bb;
                    mx = fmaxf(mx, fmaxf(fmaxf(fmaxf(a[0], a[1]), fmaxf(a[2], a[3])), fmaxf(fmaxf(bb[0], bb[1]), fmaxf(bb[2], bb[3]))));
                } else {
                    f32x4_t a = {0.f, 0.f, 0.f, 0.f}, bb = {0.f, 0.f, 0.f, 0.f};
                    a = __builtin_amdgcn_mfma_f32_16x16x32_bf16(kA0, qf0, a, 0, 0, 0); a = __builtin_amdgcn_mfma_f32_16x16x32_bf16(kA1, qf1, a, 0, 0, 0);
                    bb = __builtin_amdgcn_mfma_f32_16x16x32_bf16(kB0, qf0, bb, 0, 0, 0); bb = __builtin_amdgcn_mfma_f32_16x16x32_bf16(kB1, qf1, bb, 0, 0, 0);
                    const u32x2 ia = *(const LAS u32x2*)(list + 32 * c + 4 * g4), ib = *(const LAS u32x2*)(list + 32 * c + 16 + 4 * g4);
#pragma unroll
                    for (int i = 0; i < 4; ++i) {
                        const int keyA = (int)(((i < 2 ? ia.x : ia.y) >> (16 * (i & 1))) & 0xffffu), keyB = (int)(((i < 2 ? ib.x : ib.y) >> (16 * (i & 1))) & 0xffffu);
                        const int dA = t - keyA, dB = t - keyB;
                        const float bA = lutd[(dA > 113 ? 113 : (dA < 0 ? 0 : dA)) * 16 + head], bB = lutd[(dB > 113 ? 113 : (dB < 0 ? 0 : dB)) * 16 + head];
                        const int slotA = 32 * c + 4 * g4 + i, slotB = slotA + 16;
                        sA[c][i] = slotA < cnt ? a[i] + bA : NEG_INF; sB[c][i] = slotB < cnt ? bb[i] + bB : NEG_INF;
                        mx = fmaxf(mx, fmaxf(sA[c][i], sB[c][i]));
                    }
                }
            }
        }
        asm volatile("" ::: "memory");
        u32x4 vr[4][4];
#pragma unroll
        for (int c = 0; c < 4; ++c) {
#pragma unroll
            for (int i = 0; i < 4; ++i) { const unsigned key = list[32 * c + 8 * i + (lane >> 3)]; vr[c][i] = *(const u32x4*)((const char*)V1 + (key * 128u + (unsigned)(lane & 7) * 16u)); }
        }
        mx = fmaxf(mx, __shfl_xor(mx, 16)); mx = fmaxf(mx, __shfl_xor(mx, 32));
        float l = 0.f;
#pragma unroll
        for (int c = 0; c < 8; ++c)
#pragma unroll
            for (int i = 0; i < 4; ++i) { sA[c][i] = __builtin_amdgcn_exp2f(sA[c][i] - mx); sB[c][i] = __builtin_amdgcn_exp2f(sB[c][i] - mx); l += sA[c][i] + sB[c][i]; }
        l += __shfl_xor(l, 16); l += __shfl_xor(l, 32);
        f32x4_t o[4];
#pragma unroll
        for (int d = 0; d < 4; ++d) o[d] = (f32x4_t){0.f, 0.f, 0.f, 0.f};
#pragma unroll
        for (int c = 0; c < 8; ++c) {
            {
                LAS unsigned char* vst = kst + (32 + 32 * (c & 1)) * VROW;
#pragma unroll
                for (int i = 0; i < 4; ++i) *(LAS u32x4*)(vst + (8 * i + (lane >> 3)) * VROW + (lane & 7) * 16) = vr[c & 3][i];
                if (c + 4 < 8) {
#pragma unroll
                    for (int i = 0; i < 4; ++i) { const unsigned key = list[32 * (c + 4) + 8 * i + (lane >> 3)]; vr[c & 3][i] = *(const u32x4*)((const char*)V1 + (key * 128u + (unsigned)(lane & 7) * 16u)); }
                }
                u32x4 pw; pw.x = cvt_pk_bf16(sA[c][0], sA[c][1]); pw.y = cvt_pk_bf16(sA[c][2], sA[c][3]); pw.z = cvt_pk_bf16(sB[c][0], sB[c][1]); pw.w = cvt_pk_bf16(sB[c][2], sB[c][3]);
                const bf16x8 pb = __builtin_bit_cast(bf16x8, pw);
#pragma unroll
                for (int d = 0; d < 4; ++d) {
                    const LAS char* base = (const LAS char*)(vst + (4 * g4 + q4) * VROW + (16 * d + 4 * p4) * 2);
                    const s16x4 lo = att::vtr(base), hi = att::vtr(base + 16 * VROW);
                    const bf16x8 vf = {lo[0], lo[1], lo[2], lo[3], hi[0], hi[1], hi[2], hi[3]};
                    o[d] = __builtin_amdgcn_mfma_f32_16x16x32_bf16(vf, pb, o[d], 0, 0, 0);
                }
            }
        }
        const float inv = FP8_SMIX / l;
        unsigned char* orow = F.ws + WS_MIX1 + (tb + t) * 1024 + head * 64 + 4 * g4;
#pragma unroll
        for (int d = 0; d < 4; ++d) *(unsigned*)(orow + 16 * d) = cvt4_fp8(o[d][0] * inv, o[d][1] * inv, o[d][2] * inv, o[d][3] * inv);
    }
    T1(13, F.ws);
    T0W(15, F.ws);
    __syncthreads();
    T1(15, F.ws);
}

__device__ __forceinline__ void dsa_phase(Frame& F, const Args& A) {
    LAS float* lutd = (LAS float*)(F.lds + L_LUTD);
    { const float* rb = INP(I_RELB); float lv[4];
#pragma unroll
      for (int k = 0; k < 4; ++k) { const int i = F.tid + 512 * k; lv[k] = (i < 114 * 16) ? rb[t5_bucket(i >> 4) * 16 + (i & 15)] : 0.f; }
#pragma unroll
      for (int k = 0; k < 4; ++k) { const int i = F.tid + 512 * k; if (i < 114 * 16) lutd[i] = lv[k] * LOG2E; } }
    __syncthreads();
#ifndef PROBE_DSA_REP
#define PROBE_DSA_REP 1
#endif
    const bool xa = (F.G == 256);
    const int nround = xa ? 16 : (4096 + F.G - 1) / F.G;
    for (int ii = 0; ii < nround * PROBE_DSA_REP; ++ii) {
        const int i = ii % nround; int b, tb; bool ok = true;
        if (xa) { const int r = F.bid >> 3; b = F.bid & 7; tb = 511 - (i * 32 + ((i & 1) ? 31 - r : r)); }
        else { const int cc = (i & 1) ? (F.G - 1 - F.bid) : F.bid; const int I = i * F.G + cc; ok = I < 4096; b = I & 7; tb = 511 - (I >> 3); }
        if (ok) unit_dsa(F, A, b, 8 * tb);
    }
}
}
constexpr int NPHASE = 19;
__global__ void __launch_bounds__(512, 2) mk_fwd(Args args) {
    extern __shared__ __attribute__((aligned(16))) unsigned char lds_raw[];
    Frame F;
    F.lds = (LAS unsigned char*)lds_raw;
    F.tid = threadIdx.x; F.lane = F.tid & 63; F.wave = __builtin_amdgcn_readfirstlane(F.tid >> 6);
    F.G = gridDim.x; F.bid = blockIdx.x; F.ws = args.ws; F.out = args.out;
    volatile LAS unsigned* MISC = (volatile LAS unsigned*)(F.lds + LDS_MISC_OFF);
    if (F.tid < 64) MISC[F.tid] = 0u;
    __syncthreads();
    if (F.tid < 28) *(LAS unsigned long long*)(F.lds + LDS_PTR_OFF + 8 * F.tid) = (unsigned long long)args.in[F.tid];
    __syncthreads();
    const int lo = args.ph_lo, hi = args.ph_hi;
    const bool use_bar = (hi - lo) > 1;
    XcdBarrier bar; bar.bar = (unsigned*)(F.ws + WS_CTL) + CW_BAR; bar.x = 0; bar.st = nullptr;
    if (use_bar) bar = xcd_barrier_post((unsigned*)(F.ws + WS_CTL) + CW_BAR, MISC);
#ifdef PH_ONLY
#define IN(k) ((k) == PH_ONLY && lo <= (k) && (k) < hi)
#else
#define IN(k) (lo <= (k) && (k) < hi)
#endif
#ifndef PROBE_PH
#define PROBE_PH -1
#endif
#define REP(k) for (int rep_ = 0; rep_ < ((k) == PROBE_PH ? 2 : 1); ++rep_)
#ifdef PSPAN_LO
#define SPAN_BEGIN(k) do { if ((k) == PSPAN_LO && blockIdx.x == 0 && threadIdx.x == 0) TPROBE_ACC(F.ws)[1] = __builtin_amdgcn_s_memrealtime(); } while (0)
#define SPAN_END(k) do { if ((k) == PSPAN_HI && blockIdx.x == 0 && threadIdx.x == 0) TPROBE_ACC(F.ws)[0] += __builtin_amdgcn_s_memrealtime() - TPROBE_ACC(F.ws)[1]; } while (0)
#else
#define SPAN_BEGIN(k) do { } while (0)
#define SPAN_END(k) do { } while (0)
#endif
#ifdef PROBE_IDLE_PH
#define SEAM(k) do { unsigned long long t0_ = 0; if ((k) == PROBE_IDLE_PH && threadIdx.x == 0) t0_ = __builtin_amdgcn_s_memrealtime(); if (IN(k) && IN((k) + 1)) xcd_barrier(bar); \
        if ((k) == PROBE_IDLE_PH && threadIdx.x == 0) atomicAdd(TPROBE_ACC(F.ws), (__builtin_amdgcn_s_memrealtime() - t0_) / (unsigned long long)gridDim.x); } while (0)
#else
#define SEAM(k) do { if (IN(k) && IN((k) + 1)) xcd_barrier(bar); SPAN_END(k); SPAN_BEGIN((k) + 1); } while (0)
#endif
    LAS unsigned char* ring = F.lds;
    const Args& A = args;

    SPAN_BEGIN(0);
    if (IN(0)) REP(0) { p0_prologue(F, A); } SEAM(0);
    if (IN(1)) REP(1) {
        pg8::Gemm g{WSP(bf16_t, WS_XB), WSP(bf16_t, WS_WIN0), DM}; pg8::Proj0OrderA S{F.G, F.bid};
        pg8::EpiProj0 E{F.ws};
        pg8::gemm_phase<pg8::EpiProj0, pg8::Proj0OrderA, true, true>(ring, g, S, E);
    } SEAM(1);
    if (IN(2)) REP(2) {
        pg8::Gemm g{WSP(bf16_t, WS_XB), WSP(bf16_t, WS_WIN0), DM}; pg8::Proj0OrderB S; S.so.init(T / 256, 7, F.G, F.bid); S.G = F.G; S.c = F.bid;
        pg8::EpiProj0 E{F.ws};
        pg8::gemm_phase<pg8::EpiProj0, pg8::Proj0OrderB, true, true>(ring, g, S, E);
    } SEAM(2);
    if (IN(3)) REP(3) { p2b_compress_tail(F, A); } SEAM(3);
    if (IN(4)) REP(4) { T0W(1, F.ws); att::attn0_phase(F, A); T1(1, F.ws); } SEAM(4);
    if (IN(5)) REP(5) {
        pg8::Gemm g{WSP(bf16_t, WS_MIX0), WSP(bf16_t, WS_WOUT0), DM / 2}; pg8::StaticOrder S; S.init(T / 256, DM / 256, F.G, F.bid);
        pg8::EpiRes E{INP(I_X), nullptr, (bf16_t*)F.out, 1.f / (FP8_SMIX0 * FP8_SWOUT)};
        pg8::gemm_phase<pg8::EpiRes, pg8::StaticOrder, true, true, false, false, true>(ring, g, S, E);
    } SEAM(5);
    if (IN(6)) REP(6) { T0W(33, F.ws); p_layernorm(F, (const bf16_t*)F.out, INP(I_L0_LN1G), INP(I_L0_LN1B), WSP(bf16_t, WS_X1B)); T1(33, F.ws); } SEAM(6);
    if (IN(7)) REP(7) {
        pg8::Gemm g{WSP(bf16_t, WS_X1B), WSP(bf16_t, WS_WGU0), DM}; pg8::StaticOrder S; S.init(T / 256, 2 * DFF / 256, F.G, F.bid);
        pg8::EpiSwiglu8 E{F.ws + WS_H0, 0, 1.f};
        T0W(50, F.ws); pg8::gemm_phase<pg8::EpiSwiglu8, pg8::StaticOrder, true, true>(ring, g, S, E); T1(50, F.ws);
    } SEAM(7);
    if (IN(8)) REP(8) {
        pg8::Gemm g{WSP(bf16_t, WS_H0), WSP(bf16_t, WS_WDN0), DFF / 2}; pg8::StaticOrder S; S.init(T / 256, DM / 256, F.G, F.bid);
        pg8::EpiRes E{nullptr, WSP(bf16_t, WS_X1B), (bf16_t*)F.out, 1.f / (FP8_SH * FP8_SWDN)};
        pg8::gemm_phase<pg8::EpiRes, pg8::StaticOrder, true, true, false, false, true>(ring, g, S, E);
    } SEAM(8);
    if (IN(9)) REP(9) { p_layernorm(F, (const bf16_t*)F.out, INP(I_L0_LN2G), INP(I_L0_LN2B), WSP(bf16_t, WS_X2B)); } SEAM(9);
    if (IN(10)) REP(10) {
        pg8::Gemm g{WSP(bf16_t, WS_X2B), WSP(bf16_t, WS_WIN1), DM}; pg8::StaticOrder S; S.init(T / 256, N_IN1P / 256, F.G, F.bid);
        pg8::EpiProj1 E{F.ws};
        pg8::gemm_phase<pg8::EpiProj1, pg8::StaticOrder, true, true>(ring, g, S, E);
    } SEAM(10);
    if (IN(11)) REP(11) { T0W(10, F.ws); dsa::dsa_phase(F, A); T1(10, F.ws); } SEAM(11);
    if (IN(12)) REP(12) {
        pg8::Gemm g{WSP(bf16_t, WS_MIX1), WSP(bf16_t, WS_WOUT1), DM / 2}; pg8::StaticOrder S; S.init(T / 256, DM / 256, F.G, F.bid);
        pg8::EpiRes E{nullptr, WSP(bf16_t, WS_X2B), WSP(bf16_t, WS_Y3), 1.f / (FP8_SMIX * FP8_SWOUT)};
        pg8::gemm_phase<pg8::EpiRes, pg8::StaticOrder, true, true, false, false, true>(ring, g, S, E);
    } SEAM(12);
    if (IN(13)) REP(13) { T0W(30, F.ws); p12_ln_router(F, A); T1(30, F.ws); } SEAM(13);
    if (IN(14)) REP(14) { T0W(31, F.ws); p13_moe_dispatch(F, A); T1(31, F.ws); } SEAM(14);
    if (IN(15)) REP(15) { LAS int* tile_e = (LAS int*)(F.lds + LDS_EXTRA_OFF); const int NT = moe_tile_table(F, tile_e);
        if (NT > 0) { pg8::Gemm g{(const bf16_t*)(F.ws + WS_X3F8), (const bf16_t*)(F.ws + WS_WGU1), DM / 2}; pg8::MoeOrder S; S.gpitch = DM / 2;
            S.so.init(NT, 2 * DFF / 256, F.G, F.bid); S.tile0 = 0; S.nN = 2 * DFF / 256; S.a_local = 0; S.tile_e = tile_e; S.rowlist = WSP(int, WS_ROWTOK);
            pg8::EpiSwiglu8 E{F.ws + WS_H1, 0, 1.f / (FP8_SX * FP8_SWGU)}; T0W(65, F.ws); pg8::gemm_phase<pg8::EpiSwiglu8, pg8::MoeOrder, true, true, true, false, true>(ring, g, S, E); T1(65, F.ws); } } SEAM(15);
    if (IN(16)) REP(16) { LAS int* tile_e = (LAS int*)(F.lds + LDS_EXTRA_OFF); const int NT = moe_tile_table(F, tile_e); const int nM_ = NT > 256 ? 256 : NT, ntail = NT - nM_;
        constexpr float SO = 1.f / (FP8_SH * FP8_SWDN);
        if (nM_ > 0) { pg8::Gemm g{(const bf16_t*)(F.ws + WS_H1), (const bf16_t*)(F.ws + WS_WDN1), DFF / 2}; pg8::MoeOrder S; S.so.init(nM_, DM / 256, F.G, F.bid); S.tile0 = 0; S.nN = DM / 256; S.a_local = 1; S.tile_e = tile_e; S.rowlist = nullptr; S.gpitch = 0;
            pg8::EpiBf16 E{WSP(bf16_t, WS_XG), SO}; T0W(66, F.ws); pg8::gemm_phase<pg8::EpiBf16, pg8::MoeOrder, true, true, false, false, true>(ring, g, S, E); T1(66, F.ws); }
        if (ntail > 0) { pg8::Gemm g{(const bf16_t*)(F.ws + WS_H1), (const bf16_t*)(F.ws + WS_WDN1), DFF / 2}; pg8::TailOrder S{F.G, F.bid, ntail, 256, 0, tile_e, nullptr, 0};
            pg8::EpiPart E{WSP(float, WS_PART), SO}; T0W(69, F.ws); pg8::gemm_phase<pg8::EpiPart, pg8::TailOrder, true, true, false, true, true>(ring, g, S, E); T1(69, F.ws); } } SEAM(16);
    if (IN(17)) REP(17) { T0W(32, F.ws); p_final(F, A); T1(32, F.ws); }
#undef IN
#undef SEAM
}

extern "C" void kernel_launch(void* const* d_in, const int* in_sizes, int n_in, void* d_out, int out_size, void* d_ws, size_t ws_size, hipStream_t stream) {
    static int grid = 0;
    if (grid == 0) {
        if (n_in != 28 || in_sizes[0] != T * DM || out_size != T * DM || ws_size < WS_END) {
            fprintf(stderr, "kernel_launch: unexpected problem (n_in %d, in0 %d, out %d, ws %zu); nothing launched\n", n_in, n_in > 0 ? in_sizes[0] : -1, out_size, ws_size); grid = -1; return; }
        int dev = 0, cus = 0, per_cu = 0;
        if (hipGetDevice(&dev) != hipSuccess || hipDeviceGetAttribute(&cus, hipDeviceAttributeMultiprocessorCount, dev) != hipSuccess) { grid = -1; return; }
        if (hipFuncSetAttribute((const void*)mk_fwd, hipFuncAttributeMaxDynamicSharedMemorySize, LDS_BYTES) != hipSuccess) { fprintf(stderr, "kernel_launch: hipFuncSetAttribute failed\n"); grid = -1; return; }
        if (hipOccupancyMaxActiveBlocksPerMultiprocessor(&per_cu, (const void*)mk_fwd, 512, LDS_BYTES) != hipSuccess || per_cu < 1) { fprintf(stderr, "kernel_launch: occupancy query says %d blocks per CU\n", per_cu); }
        (void)hipGetLastError();
        grid = cus;
    }
    if (grid < 0) return;
    (void)hipMemsetAsync((char*)d_ws + WS_CTL, 0, CTL_ZERO_BYTES, stream);
    Args a{};
    for (int i = 0; i < 28; ++i) a.in[i] = (const float*)d_in[i];
    a.out = (float*)d_out; a.ws = (unsigned char*)d_ws;
    constexpr int NPH = 18;
#if MK_N_LAUNCHES == 1
    a.ph_lo = 0; a.ph_hi = NPH;
    hipLaunchKernelGGL(mk_fwd, dim3(grid), dim3(512), LDS_BYTES, stream, a);
#else
    for (int p = 0; p < NPH; ++p) { a.ph_lo = p; a.ph_hi = p + 1; hipLaunchKernelGGL(mk_fwd, dim3(grid), dim3(512), LDS_BYTES, stream, a); }
#endif
}
```

```cpp
#include <hip/hip_runtime.h>
#include <cstdio>
#include <cstdint>

#ifndef MK_N_LAUNCHES
#define MK_N_LAUNCHES 1
#endif

#define LAS __attribute__((address_space(3)))
#define GAS __attribute__((address_space(1)))
typedef unsigned short bf16_t;
typedef short bf16x8 __attribute__((ext_vector_type(8)));
typedef short s16x4 __attribute__((ext_vector_type(4)));
typedef float f32x2 __attribute__((ext_vector_type(2)));
typedef float f32x4 __attribute__((ext_vector_type(4)));
typedef float f32x16 __attribute__((ext_vector_type(16)));
typedef unsigned u32x2 __attribute__((ext_vector_type(2)));
typedef unsigned u32x4 __attribute__((ext_vector_type(4)));

constexpr int NBATCH = 8, SEQ = 4096, T = NBATCH * SEQ, DM = 1024, DFF = 2816, NEXP = 8;
constexpr int N_IN0 = 2072, N_IN0P = 2304, N_IN1 = 1448, N_IN1P = 1536;
constexpr float ALPHA = 1.41421356237309515f;
constexpr float LN_EPS = 1e-5f;
constexpr float LOG2E = 1.4426950408889634f;
constexpr float QSCALE = 0.125f * LOG2E;

constexpr size_t MiB = 1u << 20;
constexpr size_t WS_CTL = 0, CTL_ZERO_BYTES = 1 * MiB;
constexpr size_t WS_KC = 1 * MiB;
constexpr size_t WS_POSW = 2 * MiB;
constexpr size_t WS_MOECNT = 2 * MiB + 64 * 1024;
constexpr size_t WS_MOEMETA = 2 * MiB + 128 * 1024;
constexpr size_t WS_TOKINFO = 2 * MiB + 256 * 1024;
constexpr size_t WS_WGU1 = 4 * MiB;
constexpr size_t WS_X3F8 = 48 * MiB;
constexpr size_t WS_X1F8 = 48 * MiB;
constexpr size_t WS_WDN1 = 92 * MiB;
constexpr size_t WS_WIN0 = 136 * MiB;
constexpr size_t WS_WC1 = 141 * MiB;
constexpr size_t WS_WOUT0 = 143 * MiB;
constexpr size_t WS_WGU0 = 145 * MiB;
constexpr size_t WS_WDN0 = 156 * MiB;
constexpr size_t WS_WIN1 = 162 * MiB;
constexpr size_t WS_WOUT1 = 165 * MiB;
constexpr size_t WS_XB = 168 * MiB;
constexpr size_t WS_QA = 232 * MiB;
constexpr size_t WS_QB = 264 * MiB;
constexpr size_t WS_KA = 296 * MiB;
constexpr size_t WS_VA = 304 * MiB;
constexpr size_t WS_KCMP = 312 * MiB;
constexpr size_t WS_VCMP = 320 * MiB;
constexpr size_t WS_KSLC = 328 * MiB;
constexpr size_t WS_VSLC = 336 * MiB;
constexpr size_t WS_KWIN = 344 * MiB;
constexpr size_t WS_VWIN = 352 * MiB;
constexpr size_t WS_GATES = 360 * MiB;
constexpr size_t WS_HCMP = 364 * MiB;
constexpr size_t WS_MIX0 = WS_XB;
constexpr size_t WS_X1B = 232 * MiB;
constexpr size_t WS_H0 = 296 * MiB;
constexpr size_t WS_X2B = WS_XB;
constexpr size_t WS_Q1 = 232 * MiB;
constexpr size_t WS_K1 = 296 * MiB;
constexpr size_t WS_V1 = 300 * MiB;
constexpr size_t WS_QI = 304 * MiB;
constexpr size_t WS_KI = 320 * MiB;
constexpr size_t WS_WI = 322 * MiB;
constexpr size_t WS_MIX1 = 328 * MiB;
constexpr size_t WS_Y3 = 392 * MiB;
constexpr size_t WS_X3B = 200 * MiB;
constexpr size_t WS_ROWTOK = 3 * MiB;
constexpr size_t WS_XG = 136 * MiB;
constexpr size_t WS_H1 = 268 * MiB;
constexpr size_t WS_PART = 456 * MiB;
constexpr size_t WS_END = 512 * MiB;
constexpr float FP8_SX = 8.f, FP8_SWGU = 1024.f, FP8_SH = 8.f, FP8_SWDN = 4096.f, FP8_SMIX = 32.f, FP8_SMIX0 = 16.f, FP8_SWOUT = 2048.f;
constexpr int MOE_PASS_TILES = 128;
constexpr int MOE_MAX_TILES = 264;

constexpr int CW_BAR = 4096;

constexpr int RING_BYTES = 131072;
constexpr int LDS_EXTRA_OFF = RING_BYTES;
constexpr int LDS_MISC_OFF = RING_BYTES + 16384;
constexpr int LDS_BYTES = RING_BYTES + 16384 + 512;


#ifndef PROBE_T
#define PROBE_T 0
#endif
#ifndef PROBE_TBASE
#define PROBE_TBASE 20.f
#endif
#define TPROBE_ACC(ws_) ((unsigned long long*)((ws_) + WS_CTL + 512))
#define T0W(id, ws_) do { if (PROBE_T == (id) && blockIdx.x == 0 && threadIdx.x == 0) TPROBE_ACC(ws_)[1] = __builtin_amdgcn_s_memrealtime(); } while (0)
#define T1(id, ws_) do { if (PROBE_T == (id) && blockIdx.x == 0 && threadIdx.x == 0) TPROBE_ACC(ws_)[0] += __builtin_amdgcn_s_memrealtime() - TPROBE_ACC(ws_)[1]; } while (0)

typedef __bf16 bf16x2_t __attribute__((ext_vector_type(2)));
__device__ __forceinline__ unsigned cvt_pk_bf16(float lo, float hi) { const f32x2 v = {lo, hi}; const bf16x2_t b = __builtin_convertvector(v, bf16x2_t); return __builtin_bit_cast(unsigned, b); }
__device__ __forceinline__ unsigned cvt4_fp8(float a, float b, float c, float d) {
    a = __builtin_amdgcn_fmed3f(a, 448.f, -448.f); b = __builtin_amdgcn_fmed3f(b, 448.f, -448.f); c = __builtin_amdgcn_fmed3f(c, 448.f, -448.f); d = __builtin_amdgcn_fmed3f(d, 448.f, -448.f);
    int r = __builtin_amdgcn_cvt_pk_fp8_f32(a, b, 0, false); r = __builtin_amdgcn_cvt_pk_fp8_f32(c, d, r, true); return (unsigned)r;
}
__device__ __forceinline__ float bf_lo(unsigned w) { return __uint_as_float(w << 16); }
__device__ __forceinline__ float bf_hi(unsigned w) { return __uint_as_float(w & 0xffff0000u); }
__device__ __forceinline__ float wave_sum(float v) {
#pragma unroll
    for (int o = 1; o < 64; o <<= 1) v += __shfl_xor(v, o);
    return v;
}
__device__ __forceinline__ float swap_max(float m) { auto rr = __builtin_amdgcn_permlane32_swap(__float_as_uint(m), __float_as_uint(m), false, false); return fmaxf(__uint_as_float(rr[0]), __uint_as_float(rr[1])); }
__device__ __forceinline__ float swap_sum(float m) { auto rr = __builtin_amdgcn_permlane32_swap(__float_as_uint(m), __float_as_uint(m), false, false); return __uint_as_float(rr[0]) + __uint_as_float(rr[1]); }
__device__ __forceinline__ int t5_bucket(int n) {
    if (n < 16) return n;
    int b = 16;
    b += (n >= 19); b += (n >= 21); b += (n >= 24); b += (n >= 27); b += (n >= 31); b += (n >= 35); b += (n >= 40); b += (n >= 46);
    b += (n >= 52); b += (n >= 59); b += (n >= 67); b += (n >= 77); b += (n >= 87); b += (n >= 99); b += (n >= 113);
    return b;
}
namespace pg8 {
#define PG8_LAS __attribute__((address_space(3)))
constexpr int BM = 256, BK = 64, HALF = 128, HTB = HALF * BK * 2  , STAGE_BYTES = 8 * HTB, NXCD = 8, WGM = 8;
__host__ __device__ __forceinline__ int lds_byte(int r, int c) { const int st = (r >> 4) * 2 + (c >> 5), rr = r & 15, cc = c & 31, ob = rr * 64 + cc * 2; return st * 1024 + (ob ^ (((ob >> 9) & 1) << 5)); }
__host__ __device__ __forceinline__ void stage_rc(int b, int& R, int& C) { const int st = b / 1024, sb = b % 1024, swz = sb ^ (((sb >> 9) & 1) << 5); R = (st >> 1) * 16 + swz / 64; C = (st & 1) * 32 + (swz % 64) / 2; }
__host__ __device__ __forceinline__ int perm32(int rho) { const int n = rho >> 4, i = rho & 15; return 8 * (i >> 2) + 4 * n + (i & 3); }

struct Unit { int pa, pb, pm, pn, kb, nt, aux; };
struct Gemm { const bf16_t* A; const bf16_t* Bt; int K; };

struct StaticOrder {
    int nM, nN, nwg, G, c; const int* rowlist; int gpitch;
    __host__ __device__ void init(int nM_, int nN_, int G_, int c_) { nM = nM_; nN = nN_; nwg = nM * nN; G = G_; c = c_; }
    __host__ __device__ bool next(int i, Unit& u) const {
        const long L = (long)i * G + c; if (L >= nwg) return false;
        int wgid = (int)L; { const int q = nwg / NXCD, r = nwg % NXCD, xcd = wgid % NXCD, off = wgid / NXCD; wgid = (xcd < r ? xcd * (q + 1) : r * (q + 1) + (xcd - r) * q) + off; }
        const int nig = WGM * nN, gid = wgid / nig, fm = gid * WGM, gsz = (nM - fm) < WGM ? (nM - fm) : WGM;
        u.pm = fm + ((wgid % nig) % gsz); u.pn = (wgid % nig) / gsz; u.pa = u.pm; u.pb = u.pn; return true;
    }
    __device__ __forceinline__ void a_ready(const Unit&) const {}
    __device__ __forceinline__ void done(const Unit&) const {}
};
typedef int pg8_i32x4 __attribute__((ext_vector_type(4)));
typedef int pg8_i32x8 __attribute__((ext_vector_type(8)));
template <class Epi, class Sched, bool ALIGN_EPI = false, bool SP2 = false, bool GATHER = false, bool KSPLIT = false, bool FP8 = false>
__device__ __forceinline__ void gemm_phase(PG8_LAS unsigned char* lds, const Gemm g, const Sched& S, const Epi& E) {
    const int tid = threadIdx.x, wid = __builtin_amdgcn_readfirstlane(tid >> 6), lane = tid & 63, wr = wid >> 2, wc = wid & 3, fr = lane & 15, fq = lane >> 4;
    const int K = g.K, nt = K / BK;
    unsigned voffA[2], voffB[2]; int rA[2], cA2[2];
#pragma unroll
    for (int i = 0; i < 2; ++i) { int R, C; stage_rc(tid * 16 + i * 8192, R, C); const int Rb = Epi::PERM ? ((R & ~31) + perm32(R & 31)) : R;
        voffA[i] = (unsigned)(R * K + C) * 2u; voffB[i] = (unsigned)(Rb * K + C) * 2u; rA[i] = R; cA2[i] = C; }
    unsigned vofC[2][2], vofN[2][2];
#define PG8_GOFF(dst, unit) do { if constexpr (GATHER) { _Pragma("unroll") for (int h_ = 0; h_ < 2; ++h_) _Pragma("unroll") for (int i_ = 0; i_ < 2; ++i_) \
        dst[h_][i_] = ((unsigned)S.rowlist[(unit).pm * BM + h_ * HALF + rA[i_]] * (unsigned)S.gpitch + (unsigned)cA2[i_]) * 2u; } } while (0)
    const size_t kstep = (size_t)(BK * 2);
    const size_t hstep = (size_t)HALF * K * 2;
    const size_t tstep = 2 * hstep;
    const unsigned ldsw = (unsigned)wid * 1024u;
    const int aoff = lds_byte(wr * 64 + fr, fq * 8), boff = lds_byte(wc * 32 + fr, fq * 8);
#define PG8_SA(b, h) (((b) * 2 + (h)) * HTB)
#define PG8_SB(b, h) ((4 + (b) * 2 + (h)) * HTB)
#define PG8_STAGE(bufoff, gbase, voff) do { _Pragma("unroll") for (int _i = 0; _i < 2; ++_i) \
        __builtin_amdgcn_global_load_lds((const unsigned*)((const char*)(gbase) + (voff)[_i]), (PG8_LAS unsigned*)(lds + (bufoff) + ldsw + _i * 8192), 16, 0, 0); } while (0)
#define PG8_STAGE_A(bufoff, gbase, h, VO) do { if constexpr (GATHER) PG8_STAGE(bufoff, gbase, VO[h]); else PG8_STAGE(bufoff, (gbase) + (h) * hstep, voffA); } while (0)
#define PG8_LD8(p_) __builtin_shufflevector(*(const PG8_LAS pg8_i32x4*)(p_), *(const PG8_LAS pg8_i32x4*)((p_) + 1024), 0, 1, 2, 3, 4, 5, 6, 7)
#define PG8_LDA(dst, b, h) do { if constexpr (FP8) { _Pragma("unroll") for (int m = 0; m < 4; ++m) dst##8[m] = PG8_LD8(lds + PG8_SA(b, h) + aoff + m * 2048); } else { \
        _Pragma("unroll") for (int m = 0; m < 4; ++m) _Pragma("unroll") for (int k = 0; k < 2; ++k) dst[m][k] = *(const PG8_LAS bf16x8*)(lds + PG8_SA(b, h) + aoff + m * 2048 + k * 1024); } } while (0)
#define PG8_LDB(dst, b, h) do { if constexpr (FP8) { _Pragma("unroll") for (int n = 0; n < 2; ++n) dst##8[n] = PG8_LD8(lds + PG8_SB(b, h) + boff + n * 2048); } else { \
        _Pragma("unroll") for (int n = 0; n < 2; ++n) _Pragma("unroll") for (int k = 0; k < 2; ++k) dst[n][k] = *(const PG8_LAS bf16x8*)(lds + PG8_SB(b, h) + boff + n * 2048 + k * 1024); } } while (0)
#define PG8_MMA(ai, bj, At, Bt) do { __builtin_amdgcn_s_setprio(1); if constexpr (FP8) { _Pragma("unroll") for (int m = 0; m < 4; ++m) _Pragma("unroll") for (int n = 0; n < 2; ++n) \
        asm volatile("v_mfma_f32_16x16x128_f8f6f4 %0, %1, %2, %0" : "+v"(acc[ai][bj][m][n]) : "v"(Bt##8[n]), "v"(At##8[m])); } else { \
        _Pragma("unroll") for (int m = 0; m < 4; ++m) _Pragma("unroll") for (int n = 0; n < 2; ++n) _Pragma("unroll") for (int k = 0; k < 2; ++k) \
        acc[ai][bj][m][n] = __builtin_amdgcn_mfma_f32_16x16x32_bf16(Bt[n][k], At[m][k], acc[ai][bj][m][n], 0, 0, 0); } __builtin_amdgcn_s_setprio(0); } while (0)
#define PG8_WAIT_V(n) asm volatile("s_waitcnt vmcnt(" #n ")" ::: "memory")
#define PG8_WAIT_L(n) asm volatile("s_waitcnt lgkmcnt(" #n ")" ::: "memory")
#define PG8_BAR __builtin_amdgcn_s_barrier()
#define PG8_SCHED __builtin_amdgcn_sched_barrier(0)
    Unit cur, nxt; int ui = 0;
    if (!S.next(0, cur)) return;
    f32x4 acc[2][2][4][2];
#pragma unroll
    for (int a = 0; a < 2; ++a)
#pragma unroll
        for (int b = 0; b < 2; ++b)
#pragma unroll
            for (int m = 0; m < 4; ++m)
#pragma unroll
                for (int n = 0; n < 2; ++n) acc[a][b][m][n] = (f32x4){0.f, 0.f, 0.f, 0.f};
    bf16x8 At[4][2], B0[2][2], B1[2][2]; pg8_i32x8 At8[4], B08[2], B18[2];
    const char* cA = (const char*)g.A + (size_t)cur.pa * tstep + (KSPLIT ? cur.kb : 0); const char* cB = (const char*)g.Bt + (size_t)cur.pb * tstep + (KSPLIT ? cur.kb : 0);
    S.a_ready(cur);
    PG8_GOFF(vofC, cur);
#pragma unroll
    for (int h_ = 0; h_ < 2; ++h_)
#pragma unroll
        for (int i_ = 0; i_ < 2; ++i_) { if constexpr (!GATHER) vofC[h_][i_] = 0u; vofN[h_][i_] = vofC[h_][i_]; }
    if constexpr (SP2) {
        PG8_STAGE(PG8_SB(0, 0), cB, voffB); PG8_STAGE(PG8_SB(0, 1), cB + hstep, voffB); PG8_STAGE_A(PG8_SA(0, 0), cA, 0, vofC); PG8_STAGE_A(PG8_SA(0, 1), cA, 1, vofC);
        if (wr == 1) PG8_BAR;
        PG8_WAIT_V(2); PG8_BAR;
        PG8_STAGE(PG8_SB(1, 0), cB + kstep, voffB); PG8_STAGE_A(PG8_SA(1, 0), cA + kstep, 0, vofC); PG8_STAGE(PG8_SB(1, 1), cB + hstep + kstep, voffB);
        PG8_WAIT_V(6); PG8_BAR;
    } else {
        PG8_STAGE(PG8_SB(0, 0), cB, voffB); PG8_STAGE_A(PG8_SA(0, 0), cA, 0, vofC); PG8_STAGE(PG8_SB(0, 1), cB + hstep, voffB); PG8_STAGE_A(PG8_SA(0, 1), cA, 1, vofC);
        if (wr == 1) PG8_BAR;
        PG8_WAIT_V(4); PG8_BAR;
        PG8_STAGE(PG8_SB(1, 0), cB + kstep, voffB); PG8_STAGE_A(PG8_SA(1, 0), cA + kstep, 0, vofC); PG8_STAGE(PG8_SB(1, 1), cB + hstep + kstep, voffB);
        PG8_WAIT_V(6); PG8_BAR;
    }
    for (;;) {
        const bool has_next = S.next(ui + 1, nxt);
        if constexpr (GATHER) { if (has_next) PG8_GOFF(vofN, nxt); }
        const char* nA = has_next ? (const char*)g.A + (size_t)nxt.pa * tstep + (KSPLIT ? nxt.kb : 0) : cA; const char* nB = has_next ? (const char*)g.Bt + (size_t)nxt.pb * tstep + (KSPLIT ? nxt.kb : 0) : cB;
        int ntu = KSPLIT ? cur.nt : nt; if constexpr (FP8) asm volatile("" : "+s"(ntu));
        for (int t = 0; t < ntu; t += 2) {
            const bool last = (t == ntu - 2);
            unsigned vsel[2][2];
#pragma unroll
            for (int h_ = 0; h_ < 2; ++h_)
#pragma unroll
                for (int i_ = 0; i_ < 2; ++i_) vsel[h_][i_] = last ? vofN[h_][i_] : vofC[h_][i_];
            const char* a1 = cA + (size_t)(t + 1) * kstep;
            const char* a2 = last ? nA : cA + (size_t)(t + 2) * kstep; const char* b2 = last ? nB : cB + (size_t)(t + 2) * kstep;
            const char* a3 = a2 + kstep; const char* b3 = b2 + kstep;
            if (last && has_next) S.a_ready(nxt);
            if constexpr (SP2) {
            PG8_LDB(B0, 0, 0); PG8_LDB(B1, 0, 1); PG8_SCHED; PG8_LDA(At, 0, 0); PG8_STAGE_A(PG8_SA(1, 1), a1, 1, vofC);
            PG8_WAIT_V(8); PG8_WAIT_L(0); PG8_BAR; PG8_MMA(0, 0, At, B0); PG8_MMA(0, 1, At, B1); PG8_BAR; PG8_SCHED;
            PG8_LDA(At, 0, 1); PG8_STAGE(PG8_SB(0, 0), b2, voffB); PG8_STAGE(PG8_SB(0, 1), b2 + hstep, voffB); PG8_STAGE_A(PG8_SA(0, 0), a2, 0, vsel);
            PG8_WAIT_V(8); PG8_WAIT_L(0); PG8_BAR; PG8_MMA(1, 0, At, B0); PG8_MMA(1, 1, At, B1); PG8_BAR; PG8_SCHED;
            PG8_LDB(B0, 1, 0); PG8_LDB(B1, 1, 1); PG8_SCHED; PG8_LDA(At, 1, 0); PG8_STAGE_A(PG8_SA(0, 1), a2, 1, vsel);
            PG8_WAIT_V(8); PG8_WAIT_L(0); PG8_BAR; PG8_MMA(0, 0, At, B0); PG8_MMA(0, 1, At, B1); PG8_BAR; PG8_SCHED;
            PG8_LDA(At, 1, 1); PG8_STAGE(PG8_SB(1, 0), b3, voffB); PG8_STAGE(PG8_SB(1, 1), b3 + hstep, voffB); PG8_STAGE_A(PG8_SA(1, 0), a3, 0, vsel);
            PG8_WAIT_V(8); PG8_WAIT_L(0); PG8_BAR; PG8_MMA(1, 0, At, B0); PG8_MMA(1, 1, At, B1); PG8_BAR; PG8_SCHED;
            } else {
            PG8_LDB(B0, 0, 0); PG8_SCHED; PG8_LDA(At, 0, 0); PG8_STAGE_A(PG8_SA(1, 1), a1, 1, vofC);
            PG8_WAIT_L(8); PG8_BAR; PG8_WAIT_L(0); PG8_MMA(0, 0, At, B0); PG8_BAR; PG8_SCHED;
            PG8_LDB(B1, 0, 1); PG8_STAGE(PG8_SB(0, 0), b2, voffB);
            PG8_BAR; PG8_WAIT_L(0); PG8_MMA(0, 1, At, B1); PG8_BAR;
            PG8_LDA(At, 0, 1); PG8_STAGE_A(PG8_SA(0, 0), a2, 0, vsel);
            PG8_BAR; PG8_WAIT_L(0); PG8_MMA(1, 0, At, B0); PG8_BAR; PG8_SCHED;
            PG8_STAGE(PG8_SB(0, 1), b2 + hstep, voffB);
            PG8_WAIT_V(6); PG8_BAR; PG8_MMA(1, 1, At, B1); PG8_BAR;
            PG8_LDB(B0, 1, 0); PG8_SCHED; PG8_LDA(At, 1, 0); PG8_STAGE_A(PG8_SA(0, 1), a2, 1, vsel);
            PG8_WAIT_L(8); PG8_BAR; PG8_WAIT_L(0); PG8_MMA(0, 0, At, B0); PG8_BAR; PG8_SCHED;
            PG8_LDB(B1, 1, 1); PG8_STAGE(PG8_SB(1, 0), b3, voffB);
            PG8_BAR; PG8_WAIT_L(0); PG8_MMA(0, 1, At, B1); PG8_BAR;
            PG8_LDA(At, 1, 1); PG8_STAGE_A(PG8_SA(1, 0), a3, 0, vsel);
            PG8_BAR; PG8_WAIT_L(0); PG8_MMA(1, 0, At, B0); PG8_BAR; PG8_SCHED;
            PG8_STAGE(PG8_SB(1, 1), b3 + hstep, voffB);
            PG8_WAIT_V(6); PG8_BAR; PG8_MMA(1, 1, At, B1); PG8_BAR;
            }
        }
        if constexpr (FP8) {
            asm volatile("s_nop 15\n\ts_nop 7" ::: "memory");
#define PG8_TIE8(a_, b_) asm volatile("" : "+v"(acc[a_][b_][0][0]), "+v"(acc[a_][b_][0][1]), "+v"(acc[a_][b_][1][0]), "+v"(acc[a_][b_][1][1]), "+v"(acc[a_][b_][2][0]), "+v"(acc[a_][b_][2][1]), "+v"(acc[a_][b_][3][0]), "+v"(acc[a_][b_][3][1]))
            PG8_TIE8(0, 0); PG8_TIE8(0, 1); PG8_TIE8(1, 0); PG8_TIE8(1, 1);
#undef PG8_TIE8
        }
        if constexpr (ALIGN_EPI) { if (wr == 0) PG8_BAR; }
        if constexpr (!Epi::AFTER_DRAIN) { E(acc, cur, wr, wc, fr, fq); S.done(cur); }
        if (!has_next) break;
#pragma unroll
        for (int a = 0; a < 2; ++a)
#pragma unroll
            for (int b = 0; b < 2; ++b)
#pragma unroll
                for (int m = 0; m < 4; ++m)
#pragma unroll
                    for (int n = 0; n < 2; ++n) acc[a][b][m][n] = (f32x4){0.f, 0.f, 0.f, 0.f};
        cur = nxt; cA = nA; cB = nB; ++ui;
#pragma unroll
        for (int h_ = 0; h_ < 2; ++h_)
#pragma unroll
            for (int i_ = 0; i_ < 2; ++i_) vofC[h_][i_] = vofN[h_][i_];
        if constexpr (ALIGN_EPI) { if (wr == 1) PG8_BAR; }
    }
    PG8_WAIT_V(0);
    if constexpr (!ALIGN_EPI) { if (wr == 0) PG8_BAR; }
    PG8_BAR;
    if constexpr (Epi::AFTER_DRAIN) { E.fused(acc, cur, wr, wc, fr, fq, lds, wid, lane); S.done(cur); }
#undef PG8_SA
#undef PG8_SB
#undef PG8_STAGE
#undef PG8_STAGE_A
#undef PG8_GOFF
#undef PG8_LDA
#undef PG8_LDB
#undef PG8_MMA
#undef PG8_LD8
#undef PG8_WAIT_V
#undef PG8_WAIT_L
#undef PG8_BAR
#undef PG8_SCHED
}
}
#define XB_TMO      128
#define XB_XCNT(j)  (256  + 64 * (j))
#define XB_XSUB(j)  (1280 + 64 * (j))
#define XB_XGEN(j)  (2304 + 64 * (j))
#define XB_TOP      3328
#define XB_TOPGEN   3392
#define XCD_BAR_WORDS 3456
#define XB_SPIN_CAP (1u << 18)

__device__ __forceinline__ unsigned xb_ld(unsigned* p)              { return __hip_atomic_load(p, __ATOMIC_RELAXED, __HIP_MEMORY_SCOPE_AGENT); }
__device__ __forceinline__ unsigned xb_add(unsigned* p, unsigned v) { return __hip_atomic_fetch_add(p, v, __ATOMIC_RELAXED, __HIP_MEMORY_SCOPE_AGENT); }
__device__ __forceinline__ unsigned xb_xcc_id() { return (unsigned)__builtin_amdgcn_s_getreg((3 << 11) | 20) & 0xFu; }
#define XB_SPIN(cond, bar) do { unsigned _sp = 0; while (cond) { __builtin_amdgcn_s_sleep(1); \
    if ((++_sp & 255u) == 0u) { if (xb_ld(&(bar)[XB_TMO])) break; if (_sp > XB_SPIN_CAP) { atomicAdd(&(bar)[XB_TMO], 1u); break; } } } } while (0)

struct XcdBarrier {
    unsigned* bar; unsigned x;
    volatile LAS unsigned* st;
};

__device__ __forceinline__ XcdBarrier xcd_barrier_post(unsigned* bar, volatile LAS unsigned* st) {
    XcdBarrier b; b.bar = bar; b.x = xb_xcc_id(); b.st = st;
    if (threadIdx.x == 0) (void)xb_add(&bar[XB_XCNT(b.x)], 1u);
    return b;
}
__device__ __forceinline__ void xcd_barrier_complete(unsigned* bar, unsigned x, unsigned& nloc, unsigned& nx) {
    const unsigned G = gridDim.x * gridDim.y * gridDim.z;
    unsigned sum, cnt, mine, sp = 0u;
    for (;;) {
        sum = 0u; cnt = 0u; mine = 0u;
#pragma unroll
        for (unsigned j = 0; j < 16; ++j) { const unsigned c = xb_ld(&bar[XB_XCNT(j)]); sum += c; cnt += (c > 0u) ? 1u : 0u; mine = (j == x) ? c : mine; }
        if (sum == G) break;
        __builtin_amdgcn_s_sleep(1);
        if ((++sp & 255u) == 0u) { if (xb_ld(&bar[XB_TMO])) break; if (sp > XB_SPIN_CAP) { atomicAdd(&bar[XB_TMO], 1u); break; } }
    }
    nloc = mine > 0u ? mine : 1u; nx = cnt > 0u ? cnt : 1u;
}

__device__ __forceinline__ void xcd_barrier(const XcdBarrier& b) {
    asm volatile("s_waitcnt vmcnt(0)" ::: "memory");
    __syncthreads();
    if (threadIdx.x == 0) {
        unsigned* bar = b.bar;
        __builtin_amdgcn_s_waitcnt(0);
        unsigned nloc = b.st[0], nx = b.st[1];
        if (nloc == 0u) { xcd_barrier_complete(bar, b.x, nloc, nx); b.st[0] = nloc; b.st[1] = nx; }
        const unsigned old = xb_add(&bar[XB_XSUB(b.x)], 1u);
        const unsigned gen = old / nloc;
        if (old + 1u == (gen + 1u) * nloc) {
            __builtin_amdgcn_fence(__ATOMIC_RELEASE, "agent");
            asm volatile("s_waitcnt vmcnt(0)" ::: "memory");
            const unsigned og = xb_add(&bar[XB_TOP], 1u);
            const unsigned tg = og / nx;
            if (og + 1u == (tg + 1u) * nx) xb_add(&bar[XB_TOPGEN], 1u);
            else XB_SPIN(xb_ld(&bar[XB_TOPGEN]) == tg, bar);
            __builtin_amdgcn_fence(__ATOMIC_ACQUIRE, "agent");
            xb_add(&bar[XB_XGEN(b.x)], 1u);
            asm volatile("s_waitcnt vmcnt(0)" ::: "memory");
        } else {
            XB_SPIN(xb_ld(&bar[XB_XGEN(b.x)]) == gen, bar);
            __builtin_amdgcn_fence(__ATOMIC_ACQUIRE, "agent");
            asm volatile("s_waitcnt vmcnt(0)" ::: "memory");
        }
    }
    __syncthreads();
}
struct Args {
    const float* in[28];
    float* out; unsigned char* ws;
    int ph_lo, ph_hi;
};
struct Frame {
    LAS unsigned char* lds;
    int tid, lane, wave, G, bid;
    unsigned char* ws; float* out;
};
#define WSP(type, off) ((type*)(F.ws + (off)))
constexpr int LDS_PTR_OFF = LDS_MISC_OFF + 16;
__device__ __forceinline__ const float* in_ptr(LAS unsigned char* lds, int k) {
    const unsigned long long v = *(volatile LAS unsigned long long*)(lds + LDS_PTR_OFF + 8 * k);
    const unsigned lo = __builtin_amdgcn_readfirstlane((unsigned)v), hi = __builtin_amdgcn_readfirstlane((unsigned)(v >> 32));
    return (const float*)(((unsigned long long)hi << 32) | lo);
}
#define INP(k) in_ptr(F.lds, (k))

namespace pg8 {
struct EpiProj0 {
    static constexpr bool PERM = true, AFTER_DRAIN = false;
    unsigned char* ws;
    __device__ __forceinline__ void operator()(const f32x4 (&acc)[2][2][4][2], const Unit& u, int wr, int wc, int fr, int fq) const {
        const int row0 = u.pm * BM + wr * 64 + fr, cl = wc * 32 + 8 * fq;
        if (u.pn >= 16) {
            float* H = (float*)(ws + WS_HCMP);
#pragma unroll
            for (int ai = 0; ai < 2; ++ai)
#pragma unroll
                for (int m = 0; m < 4; ++m) { float* rp = H + (size_t)(row0 + ai * HALF + m * 16) * 512 + (u.pn - 16) * BM + cl;
#pragma unroll
                    for (int bj = 0; bj < 2; ++bj) { *(f32x4*)(rp + bj * HALF) = acc[ai][bj][m][0]; *(f32x4*)(rp + bj * HALF + 4) = acc[ai][bj][m][1]; } }
            return;
        }
#pragma unroll
        for (int bj = 0; bj < 2; ++bj) {
            const int hb = 2 * u.pn + bj;
            bf16_t* dst = nullptr; int pitch = 128, cb = cl, mode = 0; float sc = 1.f;
            if (hb < 4) { dst = (bf16_t*)(ws + WS_QA); pitch = 512; cb = hb * 128 + cl; sc = QSCALE; }
            else if (hb == 4) dst = (bf16_t*)(ws + WS_KA);
            else if (hb == 5) dst = (bf16_t*)(ws + WS_VA);
            else if (hb < 10) { dst = (bf16_t*)(ws + WS_QB); pitch = 512; cb = (hb - 6) * 128 + cl; sc = QSCALE; }
            else if (hb == 10) { dst = (bf16_t*)(ws + WS_KCMP); mode = 1; }
            else if (hb == 11) { dst = (bf16_t*)(ws + WS_VCMP); mode = 1; }
            else if (hb == 12) dst = (bf16_t*)(ws + WS_KSLC);
            else if (hb == 13) dst = (bf16_t*)(ws + WS_VSLC);
            else if (hb == 14) dst = (bf16_t*)(ws + WS_KWIN);
            else if (hb == 15) dst = (bf16_t*)(ws + WS_VWIN);
            else if (hb == 16) mode = (cl < 24) ? 2 : 3;
            else mode = 3;
            if (mode == 3) continue;
#pragma unroll
            for (int ai = 0; ai < 2; ++ai)
#pragma unroll
                for (int m = 0; m < 4; ++m) {
                    const int row = row0 + ai * HALF + m * 16;
                    const f32x4 v0 = acc[ai][bj][m][0], v1 = acc[ai][bj][m][1];
                    if (mode == 2) {
                        float* gp = (float*)(ws + WS_GATES) + (size_t)row * 24 + cl;
                        f32x4 a, b;
#pragma unroll
                        for (int i = 0; i < 4; ++i) { a[i] = 1.f / (1.f + __expf(-v0[i])); b[i] = 1.f / (1.f + __expf(-v1[i])); }
                        *(f32x4*)gp = a; *(f32x4*)(gp + 4) = b;
                    } else {
                        u32x4 w; w.x = cvt_pk_bf16(v0[0] * sc, v0[1] * sc); w.y = cvt_pk_bf16(v0[2] * sc, v0[3] * sc); w.z = cvt_pk_bf16(v1[0] * sc, v1[1] * sc); w.w = cvt_pk_bf16(v1[2] * sc, v1[3] * sc);
                        size_t off;
                        if (mode == 1) { const int b = row >> 12, t = row & 4095, g = cb >> 6, d = cb & 63; off = ((size_t)((b * 2 + g) * 4096 + t)) * 64 + d; }
                        else off = (size_t)row * pitch + cb;
                        *(u32x4*)(dst + off) = w;
                    }
                }
        }
    }
};
struct EpiProj1 {
    static constexpr bool PERM = true, AFTER_DRAIN = false;
    unsigned char* ws;
    __device__ __forceinline__ void operator()(const f32x4 (&acc)[2][2][4][2], const Unit& u, int wr, int wc, int fr, int fq) const {
        const int row0 = u.pm * BM + wr * 64 + fr, cl = wc * 32 + 8 * fq;
#pragma unroll
        for (int bj = 0; bj < 2; ++bj) {
            const int hb = 2 * u.pn + bj;
            bf16_t* dst = nullptr; int pitch = 1024, cb = cl, mode = 0; float sc = 1.f;
            if (hb < 8) { dst = (bf16_t*)(ws + WS_Q1); cb = hb * 128 + cl; sc = QSCALE; }
            else if (hb == 8) { if (cl < 64) { dst = (bf16_t*)(ws + WS_K1); pitch = 64; } else { dst = (bf16_t*)(ws + WS_V1); pitch = 64; cb = cl - 64; } }
            else if (hb < 11) { dst = (bf16_t*)(ws + WS_QI); pitch = 256; cb = (hb - 9) * 128 + cl; }
            else if (hb == 11) { if (cl < 32) { dst = (bf16_t*)(ws + WS_KI); pitch = 32; } else if (cl < 40) mode = 2; else mode = 3; }
            else mode = 3;
            if (mode == 3) continue;
#pragma unroll
            for (int ai = 0; ai < 2; ++ai)
#pragma unroll
                for (int m = 0; m < 4; ++m) {
                    const int row = row0 + ai * HALF + m * 16;
                    const f32x4 v0 = acc[ai][bj][m][0], v1 = acc[ai][bj][m][1];
                    if (mode == 2) { float* gp = (float*)(ws + WS_WI) + (size_t)row * 8; *(f32x4*)gp = v0; *(f32x4*)(gp + 4) = v1; }
                    else { u32x4 w; w.x = cvt_pk_bf16(v0[0] * sc, v0[1] * sc); w.y = cvt_pk_bf16(v0[2] * sc, v0[3] * sc); w.z = cvt_pk_bf16(v1[0] * sc, v1[1] * sc); w.w = cvt_pk_bf16(v1[2] * sc, v1[3] * sc);
                        *(u32x4*)(dst + (size_t)row * pitch + cb) = w; }
                }
        }
    }
};
struct EpiF32 {
    static constexpr bool PERM = false, AFTER_DRAIN = false;
    float* out; int ldc;
    __device__ __forceinline__ void operator()(const f32x4 (&acc)[2][2][4][2], const Unit& u, int wr, int wc, int fr, int fq) const {
#pragma unroll
        for (int ai = 0; ai < 2; ++ai)
#pragma unroll
            for (int m = 0; m < 4; ++m) { float* rp = out + (size_t)(u.pm * BM + ai * HALF + wr * 64 + m * 16 + fr) * ldc + u.pn * BM + wc * 32 + 4 * fq;
#pragma unroll
                for (int bj = 0; bj < 2; ++bj)
#pragma unroll
                    for (int n = 0; n < 2; ++n) *(f32x4*)(rp + bj * HALF + n * 16) = acc[ai][bj][m][n]; }
    }
};
struct EpiRes {
    static constexpr bool PERM = true, AFTER_DRAIN = false;
    const float* resf; const bf16_t* resb; bf16_t* out; float sc;
    __device__ __forceinline__ void operator()(const f32x4 (&acc)[2][2][4][2], const Unit& u, int wr, int wc, int fr, int fq) const {
#pragma unroll
        for (int ai = 0; ai < 2; ++ai)
#pragma unroll
            for (int m = 0; m < 4; ++m) { const size_t ro = (size_t)(u.pm * BM + ai * HALF + wr * 64 + m * 16 + fr) * DM + u.pn * BM + wc * 32 + 8 * fq;
#pragma unroll
                for (int bj = 0; bj < 2; ++bj) { const size_t o = ro + bj * HALF; f32x4 r0, r1;
                    if (resf) { r0 = *(const f32x4*)(resf + o); r1 = *(const f32x4*)(resf + o + 4); }
                    else { const u32x4 w = *(const u32x4*)(resb + o); r0 = (f32x4){bf_lo(w.x), bf_hi(w.x), bf_lo(w.y), bf_hi(w.y)}; r1 = (f32x4){bf_lo(w.z), bf_hi(w.z), bf_lo(w.w), bf_hi(w.w)}; }
                    const f32x4 v0 = r0 * ALPHA + acc[ai][bj][m][0] * sc, v1 = r1 * ALPHA + acc[ai][bj][m][1] * sc;
                    u32x4 q; q.x = cvt_pk_bf16(v0[0], v0[1]); q.y = cvt_pk_bf16(v0[2], v0[3]); q.z = cvt_pk_bf16(v1[0], v1[1]); q.w = cvt_pk_bf16(v1[2], v1[3]);
                    *(u32x4*)(out + o) = q; } }
    }
};
struct EpiSwiglu {
    static constexpr bool PERM = true, AFTER_DRAIN = false;
    bf16_t* H; int row_tile0;
    __device__ __forceinline__ void operator()(const f32x4 (&acc)[2][2][4][2], const Unit& u, int wr, int wc, int fr, int fq) const {
        const int row0 = (u.pm - row_tile0) * BM + wr * 64 + fr, col = u.pn * HALF + wc * 32 + 8 * fq;
#pragma unroll
        for (int ai = 0; ai < 2; ++ai)
#pragma unroll
            for (int m = 0; m < 4; ++m) {
                float h[8];
#pragma unroll
                for (int n = 0; n < 2; ++n)
#pragma unroll
                    for (int i = 0; i < 4; ++i) { const float g = acc[ai][0][m][n][i], up = acc[ai][1][m][n][i];
                        h[n * 4 + i] = g * __builtin_amdgcn_rcpf(1.f + __builtin_amdgcn_exp2f(-g * LOG2E)) * up; }
                u32x4 w; w.x = cvt_pk_bf16(h[0], h[1]); w.y = cvt_pk_bf16(h[2], h[3]); w.z = cvt_pk_bf16(h[4], h[5]); w.w = cvt_pk_bf16(h[6], h[7]);
                *(u32x4*)(H + (size_t)(row0 + ai * HALF + m * 16) * DFF + col) = w;
            }
    }
};
struct EpiSwiglu8 {
    static constexpr bool PERM = true, AFTER_DRAIN = false;
    unsigned char* H; int row_tile0; float SI;
    __device__ __forceinline__ void operator()(const f32x4 (&acc)[2][2][4][2], const Unit& u, int wr, int wc, int fr, int fq) const {
        const int row0 = (u.pm - row_tile0) * BM + wr * 64 + fr, col = u.pn * HALF + wc * 32 + 8 * fq;
        const float c1 = -SI * LOG2E, ic2 = 1.f / (SI * SI * FP8_SH);
#pragma unroll
        for (int ai = 0; ai < 2; ++ai)
#pragma unroll
            for (int m = 0; m < 4; ++m) {
                float h[8];
#pragma unroll
                for (int n = 0; n < 2; ++n)
#pragma unroll
                    for (int i = 0; i < 4; ++i) { const float a = acc[ai][0][m][n][i], b = acc[ai][1][m][n][i];
                        h[n * 4 + i] = (a * b) * __builtin_amdgcn_rcpf(__builtin_fmaf(__builtin_amdgcn_exp2f(a * c1), ic2, ic2)); }
                u32x2 w; w.x = cvt4_fp8(h[0], h[1], h[2], h[3]); w.y = cvt4_fp8(h[4], h[5], h[6], h[7]);
                *(u32x2*)(H + (size_t)(row0 + ai * HALF + m * 16) * DFF + col) = w;
            }
    }
};
struct EpiBf16 {
    static constexpr bool PERM = true, AFTER_DRAIN = false;
    bf16_t* O; float sc;
    __device__ __forceinline__ void operator()(const f32x4 (&acc)[2][2][4][2], const Unit& u, int wr, int wc, int fr, int fq) const {
        const int row0 = u.pm * BM + wr * 64 + fr, col0 = u.pn * BM + wc * 32 + 8 * fq;
#pragma unroll
        for (int ai = 0; ai < 2; ++ai)
#pragma unroll
            for (int m = 0; m < 4; ++m) { bf16_t* rowp = O + (size_t)(row0 + ai * HALF + m * 16) * DM + col0;
#pragma unroll
                for (int bj = 0; bj < 2; ++bj) { const f32x4 v0 = acc[ai][bj][m][0] * sc, v1 = acc[ai][bj][m][1] * sc;
                    u32x4 w; w.x = cvt_pk_bf16(v0[0], v0[1]); w.y = cvt_pk_bf16(v0[2], v0[3]); w.z = cvt_pk_bf16(v1[0], v1[1]); w.w = cvt_pk_bf16(v1[2], v1[3]);
                    *(u32x4*)(rowp + bj * HALF) = w; } }
    }
};
struct Proj0OrderA {
    int G, c; const int* rowlist; int gpitch;
    __device__ bool next(int i, Unit& u) const { const int L = i * G + c; if (L >= 256) return false; u.pm = L >> 1; u.pa = u.pm; u.pn = (L & 1) ? 8 : 5; u.pb = u.pn; return true; }
    __device__ __forceinline__ void a_ready(const Unit&) const {}
    __device__ __forceinline__ void done(const Unit&) const {}
};
struct Proj0OrderB {
    StaticOrder so; int G, c; const int* rowlist; int gpitch;
    __device__ bool next(int i, Unit& u) const {
        if (so.next(i, u)) { u.pn = u.pn < 5 ? u.pn : u.pn + 1; u.pb = u.pn; return true; }
        const int L = i * G + c - 896; if (L < 0 || L >= 64) return false;
        const int ct = L >> 1; u.pm = ct; u.pa = (int)((WS_KCMP - WS_XB) / (512 * 1024)) + ct; u.pn = 16 + (L & 1); u.pb = (int)((WS_WC1 - WS_WIN0) / (512 * 1024)) + (ct >> 4) * 2 + (L & 1); return true;
    }
    __device__ __forceinline__ void a_ready(const Unit&) const {}
    __device__ __forceinline__ void done(const Unit&) const {}
};
struct MoeOrder {
    StaticOrder so; int tile0, nN, a_local, gpitch; const LAS int* tile_e; const int* rowlist;
    __device__ bool next(int i, Unit& u) const {
        if (!so.next(i, u)) return false;
        const int tile = tile0 + u.pm; u.pa = a_local ? u.pm : 0; u.pb = tile_e[tile] * nN + u.pn; u.pm = tile; return true;
    }
    __device__ __forceinline__ void a_ready(const Unit&) const {}
    __device__ __forceinline__ void done(const Unit&) const {}
};
struct EpiPart {
    static constexpr bool PERM = false, AFTER_DRAIN = false;
    float* part; float sc;
    __device__ __forceinline__ void operator()(const f32x4 (&acc)[2][2][4][2], const Unit& u, int wr, int wc, int fr, int fq) const {
        float* base = part + (size_t)u.aux * (8 * 256 * DM);
#pragma unroll
        for (int ai = 0; ai < 2; ++ai)
#pragma unroll
            for (int m = 0; m < 4; ++m) { float* rp = base + (size_t)(u.pm * BM + ai * HALF + wr * 64 + m * 16 + fr) * DM + u.pn * BM + wc * 32 + 4 * fq;
#pragma unroll
                for (int bj = 0; bj < 2; ++bj)
#pragma unroll
                    for (int n = 0; n < 2; ++n) *(f32x4*)(rp + bj * HALF + n * 16) = acc[ai][bj][m][n] * sc; }
    }
};
struct TailOrder {
    int G, c, ntail, tile_first, tile0; const LAS int* tile_e; const int* rowlist; int gpitch;
    __device__ bool next(int i, Unit& u) const {
        const int L = i * G + c; if (L >= ntail * 16) return false;
        const int sl = L & 3, pn = (L >> 2) & 3, tl = L >> 4, tile = tile_first + tl;
        u.pa = tile - tile0; u.pb = tile_e[tile] * 4 + pn; u.pm = tl; u.pn = pn; u.aux = sl;
        u.kb = sl * 768; u.nt = sl < 3 ? 6 : 4; return true;
    }
    __device__ __forceinline__ void a_ready(const Unit&) const {}
    __device__ __forceinline__ void done(const Unit&) const {}
};
}
enum { I_X = 0, I_RELB, I_L0_WIN, I_L0_SINKS, I_CK_POS, I_CK_W1, I_CK_W2, I_CV_POS, I_CV_W1, I_CV_W2, I_L0_WOUT, I_L0_LN1G, I_L0_LN1B, I_L0_GATE, I_L0_UP, I_L0_DOWN, I_L0_LN2G, I_L0_LN2B,
       I_L1_WIN, I_L1_WOUT, I_L1_LN1G, I_L1_LN1B, I_L1_ROUTER, I_L1_EGATE, I_L1_EUP, I_L1_EDOWN, I_L1_LN2G, I_L1_LN2B };

__device__ __forceinline__ void p0_transpose_item(const float* W, int ldw, int ncols, bf16_t* WT, int dk, int k0, int n0, int drow0, LAS float* scr, int lane, float f8scale) {
    const int cn = n0 + (lane & 31); const bool okc = cn < ncols;
    float tv[32];
#pragma unroll
    for (int i = 0; i < 32; ++i) { const int kk = 2 * i + (lane >> 5); tv[i] = okc ? W[(size_t)(k0 + kk) * ldw + cn] : 0.f; }
#pragma unroll
    for (int i = 0; i < 32; ++i) { const int kk = 2 * i + (lane >> 5); scr[kk * 33 + (lane & 31)] = tv[i]; }
    asm volatile("s_waitcnt lgkmcnt(0)" ::: "memory");
    const int c = lane & 7;
    if (f8scale > 0.f) {
#pragma unroll
        for (int j = 0; j < 4; ++j) { const int n = (lane >> 3) + 8 * j; const LAS float* s = scr + (8 * c) * 33 + n;
            u32x2 o; o.x = cvt4_fp8(s[0 * 33] * f8scale, s[1 * 33] * f8scale, s[2 * 33] * f8scale, s[3 * 33] * f8scale); o.y = cvt4_fp8(s[4 * 33] * f8scale, s[5 * 33] * f8scale, s[6 * 33] * f8scale, s[7 * 33] * f8scale);
            *(u32x2*)((unsigned char*)WT + (size_t)(drow0 + n) * dk + k0 + 8 * c) = o; }
    } else {
#pragma unroll
    for (int j = 0; j < 4; ++j) { const int n = (lane >> 3) + 8 * j; const LAS float* s = scr + (8 * c) * 33 + n;
        u32x4 o; o.x = cvt_pk_bf16(s[0 * 33], s[1 * 33]); o.y = cvt_pk_bf16(s[2 * 33], s[3 * 33]); o.z = cvt_pk_bf16(s[4 * 33], s[5 * 33]); o.w = cvt_pk_bf16(s[6 * 33], s[7 * 33]);
        *(u32x4*)(WT + (size_t)(drow0 + n) * dk + k0 + 8 * c) = o; }
    }
    asm volatile("s_waitcnt lgkmcnt(0)" ::: "memory");
}
struct TJob { const float* W; bf16_t* WT; int ldw, ncols, npad, ksrc, dk, map; float f8scale; };
__device__ __forceinline__ int tjob_items(const TJob& j) { return (j.ksrc / 64) * (j.npad / 32); }
__device__ __forceinline__ void tjob_run(const TJob& j, int item, LAS float* scr, int lane) {
    const int nblk = j.npad / 32, kb = item / nblk, nb = item % nblk, n0 = nb * 32;
    int drow0 = n0; if (j.map) drow0 = 256 * (n0 >> 7) + (n0 & 127) + (j.map == 2 ? 128 : 0);
    p0_transpose_item(j.W, j.ldw, j.ncols, j.WT, j.dk, kb * 64, n0, drow0, scr, lane, j.f8scale);
}
__device__ __forceinline__ void p0_prologue(Frame& F, const Args& A) {
    LAS float* scr = (LAS float*)(F.lds + F.wave * 16384);
    const int gw = F.bid * 8 + F.wave, NGW = F.G * 8;
    T0W(20, F.ws);
    int base = 0;
#define RUN_JOB(jb) do { const TJob j_ = (jb); const int n_ = tjob_items(j_); \
        int it_ = gw - (base % NGW); if (it_ < 0) it_ += NGW; for (; it_ < n_; it_ += NGW) tjob_run(j_, it_, scr, F.lane); base += n_; } while (0)
    RUN_JOB((TJob{INP(I_L0_WIN), WSP(bf16_t, WS_WIN0), N_IN0, N_IN0, N_IN0P, DM, DM, 0, 0.f}));
    RUN_JOB((TJob{INP(I_CK_W1), WSP(bf16_t, WS_WC1), 256, 256, 256, 1024, 1024, 0, 0.f}));
    RUN_JOB((TJob{INP(I_CK_W1) + 1024 * 256, WSP(bf16_t, WS_WC1) + 256 * 1024, 256, 256, 256, 1024, 1024, 0, 0.f}));
    RUN_JOB((TJob{INP(I_CV_W1), WSP(bf16_t, WS_WC1) + 512 * 1024, 256, 256, 256, 1024, 1024, 0, 0.f}));
    RUN_JOB((TJob{INP(I_CV_W1) + 1024 * 256, WSP(bf16_t, WS_WC1) + 768 * 1024, 256, 256, 256, 1024, 1024, 0, 0.f}));
    RUN_JOB((TJob{INP(I_L0_WOUT), WSP(bf16_t, WS_WOUT0), DM, DM, DM, DM, DM, 0, FP8_SWOUT}));
    RUN_JOB((TJob{INP(I_L0_GATE), WSP(bf16_t, WS_WGU0), DFF, DFF, DFF, DM, DM, 1, FP8_SWGU}));
    RUN_JOB((TJob{INP(I_L0_UP), WSP(bf16_t, WS_WGU0), DFF, DFF, DFF, DM, DM, 2, FP8_SWGU}));
    RUN_JOB((TJob{INP(I_L0_DOWN), WSP(bf16_t, WS_WDN0), DM, DM, DM, DFF, DFF, 0, FP8_SWDN}));
    RUN_JOB((TJob{INP(I_L1_WIN), WSP(bf16_t, WS_WIN1), N_IN1, N_IN1, N_IN1P, DM, DM, 0, 0.f}));
    RUN_JOB((TJob{INP(I_L1_WOUT), WSP(bf16_t, WS_WOUT1), DM, DM, DM, DM, DM, 0, FP8_SWOUT}));
    for (int e = 0; e < NEXP; ++e) {
        RUN_JOB((TJob{INP(I_L1_EGATE) + (size_t)e * DM * DFF, (bf16_t*)(F.ws + WS_WGU1 + (size_t)e * 2 * DFF * DM), DFF, DFF, DFF, DM, DM, 1, FP8_SWGU}));
        RUN_JOB((TJob{INP(I_L1_EUP) + (size_t)e * DM * DFF, (bf16_t*)(F.ws + WS_WGU1 + (size_t)e * 2 * DFF * DM), DFF, DFF, DFF, DM, DM, 2, FP8_SWGU}));
        RUN_JOB((TJob{INP(I_L1_EDOWN) + (size_t)e * DFF * DM, (bf16_t*)(F.ws + WS_WDN1 + (size_t)e * DM * DFF), DM, DM, DM, DFF, DFF, 0, FP8_SWDN}));
    }
#undef RUN_JOB
    T1(20, F.ws);
    T0W(21, F.ws);
    {   const float* xin = INP(I_X);
        for (int m = 4 * gw; m < T; m += 4 * NGW) {
            f32x4 v[4][4];
#pragma unroll
            for (int r = 0; r < 4; ++r)
#pragma unroll
                for (int j = 0; j < 4; ++j) v[r][j] = *((const f32x4*)(xin + (size_t)(m + r) * DM) + F.lane + 64 * j);
#pragma unroll
            for (int r = 0; r < 4; ++r)
#pragma unroll
                for (int j = 0; j < 4; ++j) { u32x2 w; w.x = cvt_pk_bf16(v[r][j][0], v[r][j][1]); w.y = cvt_pk_bf16(v[r][j][2], v[r][j][3]); *((u32x2*)(WSP(bf16_t, WS_XB) + (size_t)(m + r) * DM) + F.lane + 64 * j) = w; }
        }
    }
    T1(21, F.ws);
    T0W(22, F.ws);
    for (int it = F.bid; it < 64; it += F.G) {
        const int which = it >> 5, sl = it & 31, hcol = F.tid & 255, part = F.tid >> 8;
        const float* pos = INP(which ? I_CV_POS : I_CK_POS) + sl * 64 + part * 32; const float* w1 = INP(which ? I_CV_W1 : I_CK_W1) + (size_t)(sl * 64 + part * 32) * 256 + hcol;
        float s = 0.f;
#pragma unroll 8
        for (int r = 0; r < 32; ++r) s += pos[r] * w1[(size_t)r * 256];
        LAS float* red = (LAS float*)F.lds;
        __syncthreads();
        if (part) red[hcol] = s;
        __syncthreads();
        if (!part) WSP(float, WS_POSW)[(which * 32 + sl) * 256 + hcol] = s + red[hcol];
    }
    T1(22, F.ws);
}

__device__ __forceinline__ void p2b_compress_tail(Frame& F, const Args& A) {
    LAS float* hid = (LAS float*)(F.lds + F.wave * 1024);
    const int gw = F.bid * 8 + F.wave, NGW = F.G * 8;
    const float* H = WSP(float, WS_HCMP); const float* PW = WSP(float, WS_POSW);
    for (int it = gw; it < 2 * 16 * 256; it += NGW) {
        const int which = it >> 12, bg = (it >> 8) & 15, n = it & 255;
        bf16_t* dst = WSP(bf16_t, WS_KC) + ((size_t)(which * 16 + bg) * 256 + n) * 64;
        if (n == 255) { dst[F.lane] = 0; continue; }
        const size_t r0 = (size_t)(which * 4096 + bg * 256 + n) * 512;
        const f32x4 a = *(const f32x4*)(H + r0 + 4 * F.lane), b = *(const f32x4*)(H + r0 + 512 + 256 + 4 * F.lane);
        f32x4 pw = {0.f, 0.f, 0.f, 0.f};
#pragma unroll
        for (int s = 0; s < 32; ++s) pw += *(const f32x4*)(PW + (which * 32 + s) * 256 + 4 * F.lane);
        const f32x4 v = a + b + pw; f32x4 g;
#pragma unroll
        for (int i = 0; i < 4; ++i) { const float x = v[i], u = 0.7978845608028654f * (x + 0.044715f * x * x * x); const float th = 1.f - 2.f / (1.f + __expf(2.f * u)); g[i] = 0.5f * x * (1.f + th); }
        *(LAS f32x4*)(hid + 4 * F.lane) = g;
        asm volatile("s_waitcnt lgkmcnt(0)" ::: "memory");
        const float* w2 = INP(which ? I_CV_W2 : I_CK_W2) + F.lane; float acc = 0.f;
#pragma unroll 8
        for (int j = 0; j < 256; ++j) acc += hid[j] * w2[(size_t)j * 64];
        dst[F.lane] = (bf16_t)(cvt_pk_bf16(acc, 0.f) & 0xffffu);
        asm volatile("s_waitcnt lgkmcnt(0)" ::: "memory");
    }
}

__device__ __forceinline__ f32x4 ld_bf4(const bf16_t* p) { const u32x2 w = *(const u32x2*)p; return (f32x4){bf_lo(w.x), bf_hi(w.x), bf_lo(w.y), bf_hi(w.y)}; }
__device__ __forceinline__ void ln_row(const bf16_t* y, const float* g, const float* b, int lane, f32x4 (&v)[4]) {
    float s = 0.f;
#pragma unroll
    for (int j = 0; j < 4; ++j) { v[j] = ld_bf4(y + 4 * (lane + 64 * j)); s += (v[j][0] + v[j][1]) + (v[j][2] + v[j][3]); }
    const float mean = wave_sum(s) * (1.f / DM); float s2 = 0.f;
#pragma unroll
    for (int j = 0; j < 4; ++j) { v[j] = v[j] - mean; s2 += (v[j][0] * v[j][0] + v[j][1] * v[j][1]) + (v[j][2] * v[j][2] + v[j][3] * v[j][3]); }
    const float rstd = 1.f / sqrtf(wave_sum(s2) * (1.f / DM) + LN_EPS);
#pragma unroll
    for (int j = 0; j < 4; ++j) { const f32x4 gg = *((const f32x4*)g + lane + 64 * j), bb = *((const f32x4*)b + lane + 64 * j); v[j] = v[j] * rstd * gg + bb; }
}
__device__ __forceinline__ void ln_row2(const bf16_t* y0, const bf16_t* y1, const float* g, const float* b, int lane, f32x4 (&v)[4], f32x4 (&w)[4]) {
    float s = 0.f, t = 0.f;
#pragma unroll
    for (int j = 0; j < 4; ++j) { v[j] = ld_bf4(y0 + 4 * (lane + 64 * j)); w[j] = ld_bf4(y1 + 4 * (lane + 64 * j)); }
#pragma unroll
    for (int j = 0; j < 4; ++j) { s += (v[j][0] + v[j][1]) + (v[j][2] + v[j][3]); t += (w[j][0] + w[j][1]) + (w[j][2] + w[j][3]); }
#pragma unroll
    for (int o = 1; o < 64; o <<= 1) { s += __shfl_xor(s, o); t += __shfl_xor(t, o); }
    const float m0 = s * (1.f / DM), m1 = t * (1.f / DM); float s2 = 0.f, t2 = 0.f;
#pragma unroll
    for (int j = 0; j < 4; ++j) { v[j] = v[j] - m0; w[j] = w[j] - m1; s2 += (v[j][0] * v[j][0] + v[j][1] * v[j][1]) + (v[j][2] * v[j][2] + v[j][3] * v[j][3]); t2 += (w[j][0] * w[j][0] + w[j][1] * w[j][1]) + (w[j][2] * w[j][2] + w[j][3] * w[j][3]); }
#pragma unroll
    for (int o = 1; o < 64; o <<= 1) { s2 += __shfl_xor(s2, o); t2 += __shfl_xor(t2, o); }
    const float r0 = 1.f / sqrtf(s2 * (1.f / DM) + LN_EPS), r1 = 1.f / sqrtf(t2 * (1.f / DM) + LN_EPS);
#pragma unroll
    for (int j = 0; j < 4; ++j) { const f32x4 gg = *((const f32x4*)g + lane + 64 * j), bb = *((const f32x4*)b + lane + 64 * j); v[j] = v[j] * r0 * gg + bb; w[j] = w[j] * r1 * gg + bb; }
}
template <int N>
__device__ __forceinline__ void ln_rowsN(const bf16_t* y, const float* g, const float* b, int lane, f32x4 (&v)[N][4]) {
    float s[N], s2[N];
#pragma unroll
    for (int r = 0; r < N; ++r)
#pragma unroll
        for (int j = 0; j < 4; ++j) v[r][j] = ld_bf4(y + (size_t)r * DM + 4 * (lane + 64 * j));
#pragma unroll
    for (int r = 0; r < N; ++r) { s[r] = 0.f;
#pragma unroll
        for (int j = 0; j < 4; ++j) s[r] += (v[r][j][0] + v[r][j][1]) + (v[r][j][2] + v[r][j][3]); }
#pragma unroll
    for (int o = 1; o < 64; o <<= 1)
#pragma unroll
        for (int r = 0; r < N; ++r) s[r] += __shfl_xor(s[r], o);
#pragma unroll
    for (int r = 0; r < N; ++r) { const float m0 = s[r] * (1.f / DM); s2[r] = 0.f;
#pragma unroll
        for (int j = 0; j < 4; ++j) { v[r][j] = v[r][j] - m0; s2[r] += (v[r][j][0] * v[r][j][0] + v[r][j][1] * v[r][j][1]) + (v[r][j][2] * v[r][j][2] + v[r][j][3] * v[r][j][3]); } }
#pragma unroll
    for (int o = 1; o < 64; o <<= 1)
#pragma unroll
        for (int r = 0; r < N; ++r) s2[r] += __shfl_xor(s2[r], o);
#pragma unroll
    for (int j = 0; j < 4; ++j) { const f32x4 gg = *((const f32x4*)g + lane + 64 * j), bb = *((const f32x4*)b + lane + 64 * j);
#pragma unroll
        for (int r = 0; r < N; ++r) { const float rs = 1.f / sqrtf(s2[r] * (1.f / DM) + LN_EPS); v[r][j] = v[r][j] * rs * gg + bb; } }
}
__device__ __forceinline__ void p_layernorm(Frame& F, const bf16_t* y, const float* g, const float* b, bf16_t* ob, unsigned char* o8) {
    const int gw = F.bid * 8 + F.wave, NGW = F.G * 8;
    for (int m = 4 * gw; m < T; m += 4 * NGW) {
        f32x4 v[4][4]; ln_rowsN<4>(y + (size_t)m * DM, g, b, F.lane, v);
#pragma unroll
        for (int r = 0; r < 4; ++r) { u32x2* o = (u32x2*)(ob + (size_t)(m + r) * DM) + F.lane;
#pragma unroll
            for (int j = 0; j < 4; ++j) { u32x2 q; q.x = cvt_pk_bf16(v[r][j][0], v[r][j][1]); q.y = cvt_pk_bf16(v[r][j][2], v[r][j][3]); o[64 * j] = q; } }
        if (o8) {
#pragma unroll
            for (int r = 0; r < 4; ++r) { unsigned* o = (unsigned*)(o8 + (size_t)(m + r) * DM) + F.lane;
#pragma unroll
                for (int j = 0; j < 4; ++j) o[64 * j] = cvt4_fp8(v[r][j][0] * FP8_SX, v[r][j][1] * FP8_SX, v[r][j][2] * FP8_SX, v[r][j][3] * FP8_SX); }
        }
    }
}
struct TokInfo { int p0, p1; float g0, g1; };
__device__ __forceinline__ void p12_ln_router(Frame& F, const Args& A) {
    LAS float* rt = (LAS float*)F.lds;
    LAS int* cnt = (LAS int*)(F.lds + 32768);
    {
        const f32x4* rg = (const f32x4*)INP(I_L1_ROUTER); f32x4 rv[4];
#pragma unroll
        for (int k = 0; k < 4; ++k) rv[k] = rg[F.tid + 512 * k];
#pragma unroll
        for (int k = 0; k < 4; ++k)
#pragma unroll
            for (int c = 0; c < 4; ++c) { const int i = 4 * (F.tid + 512 * k) + c; rt[(i & 7) * DM + (i >> 3)] = rv[k][c]; }
    }
    if (F.tid < 8) cnt[F.tid] = 0;
    for (int i = F.bid * 512 + F.tid; i < 264 * 256; i += F.G * 512) WSP(int, WS_ROWTOK)[i] = 0;
    __syncthreads();
    const bf16_t* y = WSP(bf16_t, WS_Y3); bf16_t* xb = (bf16_t*)F.out + 1024; TokInfo* ti = WSP(TokInfo, WS_TOKINFO);
    for (int blk = F.bid; blk < T / 128; blk += F.G) {
        for (int i = 0; i < 16; i += 2) {
            const int m = blk * 128 + F.wave * 16 + i;
            f32x4 v[2][4]; ln_row2(y + (size_t)m * DM, y + (size_t)(m + 1) * DM, INP(I_L1_LN1G), INP(I_L1_LN1B), F.lane, v[0], v[1]);
            float lg[2][8];
#pragma unroll
            for (int q = 0; q < 2; ++q) {
                u32x2* o = (u32x2*)(xb + (size_t)(m + q) * 2048) + F.lane;
#pragma unroll
                for (int j = 0; j < 4; ++j) { u32x2 w; w.x = cvt_pk_bf16(v[q][j][0], v[q][j][1]); w.y = cvt_pk_bf16(v[q][j][2], v[q][j][3]); o[64 * j] = w; }
                unsigned* o8 = (unsigned*)(F.ws + WS_X3F8 + (size_t)(m + q) * DM) + F.lane;
#pragma unroll
                for (int j = 0; j < 4; ++j) o8[64 * j] = cvt4_fp8(v[q][j][0] * FP8_SX, v[q][j][1] * FP8_SX, v[q][j][2] * FP8_SX, v[q][j][3] * FP8_SX);
            }
#pragma unroll
            for (int e = 0; e < 8; ++e) { float s0 = 0.f, s1 = 0.f;
#pragma unroll
                for (int j = 0; j < 4; ++j) { const f32x4 r = *(const LAS f32x4*)(rt + e * DM + 4 * (F.lane + 64 * j));
                    s0 += (v[0][j][0] * r[0] + v[0][j][1] * r[1]) + (v[0][j][2] * r[2] + v[0][j][3] * r[3]); s1 += (v[1][j][0] * r[0] + v[1][j][1] * r[1]) + (v[1][j][2] * r[2] + v[1][j][3] * r[3]); }
                lg[0][e] = s0; lg[1][e] = s1; }
            {
                const bool b0 = F.lane & 1, b1 = F.lane & 2, b2 = F.lane & 4;
                float r4[2][4], r2[2][2], r1[2];
#pragma unroll
                for (int q = 0; q < 2; ++q)
#pragma unroll
                    for (int k = 0; k < 4; ++k) { const float send = b0 ? lg[q][k] : lg[q][k + 4], keep = b0 ? lg[q][k + 4] : lg[q][k]; r4[q][k] = keep + __shfl_xor(send, 1); }
#pragma unroll
                for (int q = 0; q < 2; ++q)
#pragma unroll
                    for (int k = 0; k < 2; ++k) { const float send = b1 ? r4[q][k] : r4[q][k + 2], keep = b1 ? r4[q][k + 2] : r4[q][k]; r2[q][k] = keep + __shfl_xor(send, 2); }
#pragma unroll
                for (int q = 0; q < 2; ++q) { const float send = b2 ? r2[q][0] : r2[q][1], keep = b2 ? r2[q][1] : r2[q][0]; r1[q] = keep + __shfl_xor(send, 4); }
#pragma unroll
                for (int o_ = 8; o_ < 64; o_ <<= 1) { r1[0] += __shfl_xor(r1[0], o_); r1[1] += __shfl_xor(r1[1], o_); }
#pragma unroll
                for (int q = 0; q < 2; ++q) { const int ri = __float_as_int(r1[q]);
                    lg[q][0] = __int_as_float(__builtin_amdgcn_readlane(ri, 0)); lg[q][1] = __int_as_float(__builtin_amdgcn_readlane(ri, 4)); lg[q][2] = __int_as_float(__builtin_amdgcn_readlane(ri, 2)); lg[q][3] = __int_as_float(__builtin_amdgcn_readlane(ri, 6));
                    lg[q][4] = __int_as_float(__builtin_amdgcn_readlane(ri, 1)); lg[q][5] = __int_as_float(__builtin_amdgcn_readlane(ri, 5)); lg[q][6] = __int_as_float(__builtin_amdgcn_readlane(ri, 3)); lg[q][7] = __int_as_float(__builtin_amdgcn_readlane(ri, 7)); }
            }
#pragma unroll
            for (int q = 0; q < 2; ++q) {
                int e0 = 0; float v0 = lg[q][0];
#pragma unroll
                for (int e = 1; e < 8; ++e) if (lg[q][e] > v0) { v0 = lg[q][e]; e0 = e; }
                int e1 = -1; float v1 = -3.0e38f;
#pragma unroll
                for (int e = 0; e < 8; ++e) if (e != e0 && lg[q][e] > v1) { v1 = lg[q][e]; e1 = e; }
                const float g1 = 1.f / (1.f + __expf(v0 - v1)), g0 = 1.f - g1;
                if (F.lane == 0) { ti[m + q] = TokInfo{e0, e1, g0, g1}; atomicAdd((int*)&cnt[e0], 1); atomicAdd((int*)&cnt[e1], 1); }
            }
        }
        __syncthreads();
        if (F.tid < 8) { WSP(int, WS_MOECNT)[blk * 8 + F.tid] = cnt[F.tid]; cnt[F.tid] = 0; }
        __syncthreads();
    }
}
__device__ __forceinline__ void p13_moe_dispatch(Frame& F, const Args& A) {
    LAS int* call = (LAS int*)F.lds;
    LAS int* base = (LAS int*)(F.lds + 8192);
    LAS int* segs = (LAS int*)(F.lds + 8192 + 64);
    LAS int* pos = (LAS int*)(F.lds + 8192 + 128);
    { int cv[4];
#pragma unroll
      for (int k = 0; k < 4; ++k) cv[k] = WSP(int, WS_MOECNT)[F.tid + 512 * k];
#pragma unroll
      for (int k = 0; k < 4; ++k) call[F.tid + 512 * k] = cv[k]; }
    __syncthreads();
    TokInfo* ti = WSP(TokInfo, WS_TOKINFO);
    for (int blk = F.bid; blk < T / 128; blk += F.G) {
        if (F.tid < 8) { int tot = 0, pre = 0; for (int w = 0; w < 256; ++w) { const int c = call[w * 8 + F.tid]; if (w < blk) pre += c; tot += c; } base[F.tid] = pre; segs[F.tid] = (tot + 255) & ~255; }
        __syncthreads();
        if (F.tid == 0) { int s = 0; for (int e = 0; e < 8; ++e) { const int p = segs[e]; segs[e] = s; base[e] += s; s += p; } segs[8] = s;
            if (blk == 0) { int* meta = WSP(int, WS_MOEMETA); meta[0] = s / 256; for (int e = 0; e <= 8; ++e) meta[1 + e] = segs[e] / 256; } }
        __syncthreads();
        if (F.wave == 0) {
            int run[8];
#pragma unroll
            for (int e = 0; e < 8; ++e) run[e] = base[e];
            for (int st = 0; st < 4; ++st) {
                const int tk = (st >> 1) * 64 + F.lane, slot = st & 1; const TokInfo t = ti[blk * 128 + tk]; const int me = slot ? t.p1 : t.p0; int p = 0;
#pragma unroll
                for (int e = 0; e < 8; ++e) { const unsigned long long mk = __ballot(me == e); if (me == e) p = run[e] + __popcll(mk & ((1ull << F.lane) - 1ull)); run[e] += __popcll(mk); }
                pos[tk * 2 + slot] = p;
            }
        }
        __syncthreads();
        if (F.tid < 128) { TokInfo t = ti[blk * 128 + F.tid]; t.p0 = pos[F.tid * 2]; t.p1 = pos[F.tid * 2 + 1]; ti[blk * 128 + F.tid] = t; }
        if (F.tid < 256) WSP(int, WS_ROWTOK)[pos[F.tid]] = blk * 128 + (F.tid >> 1);
        __syncthreads();
    }
}
__device__ __forceinline__ int moe_tile_table(Frame& F, LAS int* tile_e) {
    const int* meta = WSP(int, WS_MOEMETA); const int NT = meta[0];
    for (int t = F.tid; t < MOE_MAX_TILES; t += 512) { int e = 0;
#pragma unroll
        for (int k = 1; k < 8; ++k) e += (t >= meta[1 + k]) ? 1 : 0;
        tile_e[t] = e; }
    __syncthreads();
    return NT;
}
__device__ __forceinline__ void p_final(Frame& F, const Args& A) {
    int tid_ = threadIdx.x; asm volatile("" : "+v"(tid_)); const int lane = tid_ & 63;
    const int gw = F.bid * 8 + F.wave, NGW = F.G * 8; const TokInfo* ti = WSP(TokInfo, WS_TOKINFO); const bf16_t* O = WSP(bf16_t, WS_XG);
    const float* lg = INP(I_L1_LN2G); const float* lb = INP(I_L1_LN2B);
    float tscale = 1.f;
    if (PROBE_T) { const float us = (float)(*TPROBE_ACC(F.ws)) * 0.01f; float thr = PROBE_TBASE; int k = 0;
#pragma unroll
        for (int i = 0; i < 12; ++i) { k += (us > thr) ? 1 : 0;
#ifdef PROBE_TSTEP
            thr += PROBE_TSTEP;
#else
            thr *= 1.25f;
#endif
        }
        tscale = 1.f + 0.02f * (float)k; }
    for (int m = 4 * gw; m < T; m += 4 * NGW) {
        f32x4 v[4][4]; float s[4], s2[4];
#pragma unroll
        for (int q = 0; q < 4; ++q) {
            const TokInfo t = ti[m + q]; const bf16_t* xs = (const bf16_t*)F.out + (size_t)(m + q) * 2048 + 1024;
            const u32x2* o0 = (const u32x2*)(O + (size_t)t.p0 * DM) + lane; const u32x2* o1 = (const u32x2*)(O + (size_t)t.p1 * DM) + lane;
            s[q] = 0.f;
#pragma unroll
            for (int j = 0; j < 4; ++j) { const f32x4 x = ld_bf4(xs + 4 * (lane + 64 * j)); const u32x2 a = o0[64 * j], b = o1[64 * j];
                const f32x4 fa = {bf_lo(a.x), bf_hi(a.x), bf_lo(a.y), bf_hi(a.y)}, fb = {bf_lo(b.x), bf_hi(b.x), bf_lo(b.y), bf_hi(b.y)};
                v[q][j] = x * ALPHA + (fa * t.g0 + fb * t.g1); s[q] += (v[q][j][0] + v[q][j][1]) + (v[q][j][2] + v[q][j][3]); }
        }
#pragma unroll
        for (int o = 1; o < 64; o <<= 1) { s[0] += __shfl_xor(s[0], o); s[1] += __shfl_xor(s[1], o); s[2] += __shfl_xor(s[2], o); s[3] += __shfl_xor(s[3], o); }
#pragma unroll
        for (int q = 0; q < 4; ++q) { const float mean = s[q] * (1.f / DM); s2[q] = 0.f;
#pragma unroll
            for (int j = 0; j < 4; ++j) { v[q][j] = v[q][j] - mean; s2[q] += (v[q][j][0] * v[q][j][0] + v[q][j][1] * v[q][j][1]) + (v[q][j][2] * v[q][j][2] + v[q][j][3] * v[q][j][3]); } }
#pragma unroll
        for (int o = 1; o < 64; o <<= 1) { s2[0] += __shfl_xor(s2[0], o); s2[1] += __shfl_xor(s2[1], o); s2[2] += __shfl_xor(s2[2], o); s2[3] += __shfl_xor(s2[3], o); }
#pragma unroll
        for (int q = 0; q < 4; ++q) { const float rstd = 1.f / sqrtf(s2[q] * (1.f / DM) + LN_EPS); f32x4* yr = (f32x4*)(F.out + (size_t)(m + q) * DM) + lane;
            if (ti[m + q].p0 >= 256 * 256 || ti[m + q].p1 >= 256 * 256) continue;
#pragma unroll
            for (int j = 0; j < 4; ++j) { const f32x4 gg = *((const f32x4*)lg + lane + 64 * j), bb = *((const f32x4*)lb + lane + 64 * j); yr[64 * j] = (v[q][j] * rstd * gg + bb) * tscale; } }
    }
    const int mi = gw + lane * NGW; bool rare = false;
    if (mi < T) { const u32x2 pp01 = *(const u32x2*)&ti[mi]; rare = (int)pp01.x >= 256 * 256 || (int)pp01.y >= 256 * 256; }
    for (unsigned long long rm = __ballot(rare); rm; rm &= rm - 1) {
        const int m = gw + __builtin_ctzll(rm) * NGW;
        const TokInfo t = ti[m];
        const bf16_t* xs = (const bf16_t*)F.out + (size_t)m * 2048 + 1024; f32x4 v[4]; float s = 0.f;
#pragma unroll
        for (int j = 0; j < 4; ++j) { const f32x4 x = ld_bf4(xs + 4 * (lane + 64 * j)); f32x4 fa, fb;
            if (t.p0 >= 256 * 256) { const float* pp = WSP(float, WS_PART) + (size_t)(t.p0 - 256 * 256) * DM + 4 * (lane + 64 * j); fa = ((*(const f32x4*)pp + *(const f32x4*)(pp + 8 * 256 * DM)) + *(const f32x4*)(pp + 2 * 8 * 256 * DM)) + *(const f32x4*)(pp + 3 * 8 * 256 * DM); }
            else { const u32x2 a = *((const u32x2*)(O + (size_t)t.p0 * DM) + lane + 64 * j); fa = (f32x4){bf_lo(a.x), bf_hi(a.x), bf_lo(a.y), bf_hi(a.y)}; }
            if (t.p1 >= 256 * 256) { const float* pp = WSP(float, WS_PART) + (size_t)(t.p1 - 256 * 256) * DM + 4 * (lane + 64 * j); fb = ((*(const f32x4*)pp + *(const f32x4*)(pp + 8 * 256 * DM)) + *(const f32x4*)(pp + 2 * 8 * 256 * DM)) + *(const f32x4*)(pp + 3 * 8 * 256 * DM); }
            else { const u32x2 b = *((const u32x2*)(O + (size_t)t.p1 * DM) + lane + 64 * j); fb = (f32x4){bf_lo(b.x), bf_hi(b.x), bf_lo(b.y), bf_hi(b.y)}; }
            v[j] = x * ALPHA + (fa * t.g0 + fb * t.g1); s += (v[j][0] + v[j][1]) + (v[j][2] + v[j][3]); }
        const float mean = wave_sum(s) * (1.f / DM); float s2 = 0.f;
#pragma unroll
        for (int j = 0; j < 4; ++j) { v[j] = v[j] - mean; s2 += (v[j][0] * v[j][0] + v[j][1] * v[j][1]) + (v[j][2] * v[j][2] + v[j][3] * v[j][3]); }
        const float rstd = 1.f / sqrtf(wave_sum(s2) * (1.f / DM) + LN_EPS); f32x4* yr = (f32x4*)(F.out + (size_t)m * DM) + lane;
#pragma unroll
        for (int j = 0; j < 4; ++j) { const f32x4 gg = *((const f32x4*)lg + lane + 64 * j), bb = *((const f32x4*)lb + lane + 64 * j); yr[64 * j] = (v[j] * rstd * gg + bb) * tscale; }
    }
}
namespace att {
constexpr int KROW = 144;
constexpr int TILE_B = 64 * KROW;
constexpr int L_K = 0, L_V = 2 * TILE_B, L_OV = 4 * TILE_B;
constexpr int L_LUT = 6 * TILE_B;
constexpr int L_IMP = L_LUT + 2048;
constexpr int L_SELM = L_IMP + 4 * 64 * 65 * 4;
constexpr int L_END = L_SELM + 512;
static_assert(L_END <= RING_BYTES, "attention LDS map");
constexpr float NEG_INF = -__builtin_huge_valf();
constexpr int L_LUT2 = LDS_EXTRA_OFF, LUT2_N = 704, LUT2_K = 639;
constexpr int L_LUT3 = LDS_EXTRA_OFF + 4 * LUT2_N * 4, LUT3_N = 320, LUT3_K = 255;
static_assert(L_LUT3 + 4 * LUT3_N * 4 <= LDS_MISC_OFF, "attention LUT map");
constexpr float RESC_THR = 8.f;

__device__ __forceinline__ s16x4 vtr(const LAS char* p) { return __builtin_bit_cast(s16x4, __builtin_amdgcn_ds_read_tr16_b64_v4i16((LAS s16x4*)p)); }

template <int MODE, int NDB>
__device__ __forceinline__ void attn_tile(const LAS char* Kt, const LAS char* Vt, const LAS char* OVt, const bf16x8 (&qf)[4], f32x16 (&o)[NDB], float& m, float& l,
                                          int tq, int key0, int W, bool lanesel, const LAS float* lut, int lane) {
    const int r32 = lane & 31, h = lane >> 5;
    f32x16 s0, s1;
#pragma unroll
    for (int r = 0; r < 16; ++r) { s0[r] = 0.f; s1[r] = 0.f; }
#pragma unroll
    for (int ks = 0; ks < 4; ++ks) {
        const bf16x8 k0 = *(const LAS bf16x8*)(Kt + r32 * KROW + (16 * ks + 8 * h) * 2);
        const bf16x8 k1 = *(const LAS bf16x8*)(Kt + (32 + r32) * KROW + (16 * ks + 8 * h) * 2);
        s0 = __builtin_amdgcn_mfma_f32_32x32x16_bf16(k0, qf[ks], s0, 0, 0, 0);
        s1 = __builtin_amdgcn_mfma_f32_32x32x16_bf16(k1, qf[ks], s1, 0, 0, 0);
    }
    float mx = NEG_INF;
    asm volatile("" ::: "memory");
#pragma unroll
    for (int kb = 0; kb < 2; ++kb) {
#pragma unroll
        for (int r = 0; r < 16; ++r) {
            const int key = key0 + 32 * kb + (r & 3) + 8 * (r >> 2) + 4 * h;
            const int dist = (MODE == 2) ? (tq - 16 * key - 31) : (tq - key);
            const int idx = dist < 0 ? 0 : (dist > 113 ? 113 : dist);
            bool valid;
            if (MODE == 0) valid = (unsigned)dist < (unsigned)W;
            else if (MODE == 1) valid = lanesel && dist >= 0;
            else valid = dist >= 0 && key < 255;
            float v = (kb ? s1[r] : s0[r]) + lut[idx];
            v = valid ? v : NEG_INF;
            if (kb) s1[r] = v; else s0[r] = v;
            mx = fmaxf(mx, v);
        }
        asm volatile("" ::: "memory");
    }
    mx = swap_max(mx);
    const float mnew = fmaxf(m, mx), alpha = __builtin_amdgcn_exp2f(m - mnew);
    float rs = 0.f;
#pragma unroll
    for (int r = 0; r < 16; ++r) { s0[r] = __builtin_amdgcn_exp2f(s0[r] - mnew); s1[r] = __builtin_amdgcn_exp2f(s1[r] - mnew); rs += s0[r] + s1[r]; }
    rs = swap_sum(rs);
    l = l * alpha + rs; m = mnew;
#pragma unroll
    for (int db = 0; db < NDB; ++db)
#pragma unroll
        for (int r = 0; r < 16; ++r) o[db][r] *= alpha;
    const int q4 = (lane & 15) >> 2, p4 = lane & 3, g2 = (lane >> 4) & 1;
#pragma unroll
    for (int kb = 0; kb < 2; ++kb)
#pragma unroll
        for (int s = 0; s < 2; ++s) {
            u32x4 pw;
            if (kb == 0) { pw.x = cvt_pk_bf16(s0[8 * s + 0], s0[8 * s + 1]); pw.y = cvt_pk_bf16(s0[8 * s + 2], s0[8 * s + 3]); pw.z = cvt_pk_bf16(s0[8 * s + 4], s0[8 * s + 5]); pw.w = cvt_pk_bf16(s0[8 * s + 6], s0[8 * s + 7]); }
            else { pw.x = cvt_pk_bf16(s1[8 * s + 0], s1[8 * s + 1]); pw.y = cvt_pk_bf16(s1[8 * s + 2], s1[8 * s + 3]); pw.z = cvt_pk_bf16(s1[8 * s + 4], s1[8 * s + 5]); pw.w = cvt_pk_bf16(s1[8 * s + 6], s1[8 * s + 7]); }
            const bf16x8 pb = __builtin_bit_cast(bf16x8, pw);
            const int rowoff = (32 * kb + 16 * s + 4 * h + q4) * KROW;
#pragma unroll
            for (int db = 0; db < NDB; ++db) {
                const LAS char* base = (db < 2 ? Vt : OVt) + rowoff + (32 * (db & 1) + 16 * g2 + 4 * p4) * 2;
                const s16x4 lo = vtr(base), hi = vtr(base + 8 * KROW);
                const bf16x8 vf = {lo[0], lo[1], lo[2], lo[3], hi[0], hi[1], hi[2], hi[3]};
                o[db] = __builtin_amdgcn_mfma_f32_32x32x16_bf16(vf, pb, o[db], 0, 0, 0);
            }
            asm volatile("" ::: "memory");
        }
}


template <int MODE>
__device__ __forceinline__ void attn_tile_fast(const LAS char* Kt, const LAS char* Vt, const bf16x8 (&qf)[4], f32x16 (&o)[2], float& m, float& l,
                                               bool lanesel, bool use_lut, const LAS float* lutp, float cfar, int lane) {
    const int r32 = lane & 31, h = lane >> 5;
    float ci = use_lut ? -m : (cfar - m);
    if (MODE == 1) ci = lanesel ? ci : NEG_INF;
    f32x16 s0, s1;
#pragma unroll
    for (int r = 0; r < 16; ++r) { s0[r] = ci; s1[r] = ci; }
#pragma unroll
    for (int ks = 0; ks < 4; ++ks) {
        const bf16x8 k0 = *(const LAS bf16x8*)(Kt + r32 * KROW + (16 * ks + 8 * h) * 2);
        const bf16x8 k1 = *(const LAS bf16x8*)(Kt + (32 + r32) * KROW + (16 * ks + 8 * h) * 2);
        s0 = __builtin_amdgcn_mfma_f32_32x32x16_bf16(k0, qf[ks], s0, 0, 0, 0);
        s1 = __builtin_amdgcn_mfma_f32_32x32x16_bf16(k1, qf[ks], s1, 0, 0, 0);
    }
    if (use_lut) {
#pragma unroll
        for (int r = 0; r < 16; ++r) { s0[r] += lutp[(r & 3) + 8 * (r >> 2)]; s1[r] += lutp[32 + (r & 3) + 8 * (r >> 2)]; }
    }
    float mx = fmaxf(s0[0], s1[0]);
#pragma unroll
    for (int r = 1; r < 16; ++r) mx = fmaxf(fmaxf(mx, s0[r]), s1[r]);
    mx = swap_max(mx);
    if (__any(mx > RESC_THR)) {
        const float dl = fmaxf(mx, 0.f), f = __builtin_amdgcn_exp2f(-dl);
        m += dl; l *= f;
#pragma unroll
        for (int r = 0; r < 16; ++r) { s0[r] -= dl; s1[r] -= dl; o[0][r] *= f; o[1][r] *= f; }
    }
    const int q4 = (lane & 15) >> 2, p4 = lane & 3, g2 = (lane >> 4) & 1;
    float rs = 0.f;
#pragma unroll
    for (int kb = 0; kb < 2; ++kb)
#pragma unroll
        for (int s = 0; s < 2; ++s) {
            float e[8];
#pragma unroll
            for (int i = 0; i < 8; ++i) { e[i] = __builtin_amdgcn_exp2f(kb ? s1[8 * s + i] : s0[8 * s + i]); rs += e[i]; }
            u32x4 pw; pw.x = cvt_pk_bf16(e[0], e[1]); pw.y = cvt_pk_bf16(e[2], e[3]); pw.z = cvt_pk_bf16(e[4], e[5]); pw.w = cvt_pk_bf16(e[6], e[7]);
            const bf16x8 pb = __builtin_bit_cast(bf16x8, pw);
            const int rowoff = (32 * kb + 16 * s + 4 * h + q4) * KROW;
#pragma unroll
            for (int db = 0; db < 2; ++db) {
                const LAS char* base = Vt + rowoff + (32 * db + 16 * g2 + 4 * p4) * 2;
                const s16x4 lo = vtr(base), hi = vtr(base + 8 * KROW);
                const bf16x8 vf = {lo[0], lo[1], lo[2], lo[3], hi[0], hi[1], hi[2], hi[3]};
                o[db] = __builtin_amdgcn_mfma_f32_32x32x16_bf16(vf, pb, o[db], 0, 0, 0);
            }
            __builtin_amdgcn_sched_barrier(0);
        }
    l += swap_sum(rs);
}

template <int MODE, int NDB>
__device__ __forceinline__ void run_branch(LAS unsigned char* lds, const bf16_t* Kg, const bf16_t* Vg, int pitch, unsigned long long tiles, const bf16x8 (&qf)[4], f32x16 (&o)[NDB], float& m, float& l,
                                           int tq, int W, unsigned long long selm, const LAS float* lut, int tid, int lane, unsigned char* wsp = nullptr) {
    const int lrow = tid >> 3, lch = tid & 7;
    if (tiles == 0ull) return;
    int j = __builtin_ctzll(tiles); tiles &= tiles - 1ull;
    auto gen_ov = [&](int tile, int b) {
        const int n = 64 * tile + lrow; unsigned short e[8];
#pragma unroll
        for (int i = 0; i < 8; ++i) { const int d = n - 4 * (8 * lch + i); e[i] = (n < 255 && d >= -1 && d <= 3) ? ((d == -1 || d == 3) ? (unsigned short)0x3f00 : (unsigned short)0x3f80) : (unsigned short)0; }
        u32x4 w; w.x = e[0] | ((unsigned)e[1] << 16); w.y = e[2] | ((unsigned)e[3] << 16); w.z = e[4] | ((unsigned)e[5] << 16); w.w = e[6] | ((unsigned)e[7] << 16);
        *(LAS u32x4*)(lds + L_OV + b * TILE_B + lrow * KROW + lch * 16) = w;
    };
#define ATT_LD(K_, V_, t_) do { K_ = *(const u32x4*)(Kg + (size_t)((t_) * 64 + lrow) * pitch + lch * 8); V_ = *(const u32x4*)(Vg + (size_t)((t_) * 64 + lrow) * pitch + lch * 8); } while (0)
#define ATT_ST(K_, V_, b_) do { *(LAS u32x4*)(lds + L_K + (b_) * TILE_B + lrow * KROW + lch * 16) = K_; *(LAS u32x4*)(lds + L_V + (b_) * TILE_B + lrow * KROW + lch * 16) = V_; } while (0)
    u32x4 kra, vra, krb, vrb;
    ATT_LD(kra, vra, j);
    int jn = -1;
    if (tiles != 0ull) { jn = __builtin_ctzll(tiles); tiles &= tiles - 1ull; }
    ATT_LD(krb, vrb, (jn < 0 ? j : jn));
    ATT_ST(kra, vra, 0);
    if (MODE == 2) gen_ov(j, 0);
    __syncthreads();
    for (;;) {
        int jnn = -1;
        if (tiles != 0ull) { jnn = __builtin_ctzll(tiles); tiles &= tiles - 1ull; }
        ATT_LD(kra, vra, (jnn < 0 ? j : jnn));
        {
        const bool lanesel = (MODE == 1) ? ((selm >> j) & 1ull) != 0ull : true;
        if constexpr (MODE == 2) {
            attn_tile<MODE, NDB>((const LAS char*)(lds + L_K + 0 * TILE_B), (const LAS char*)(lds + L_V + 0 * TILE_B), (const LAS char*)(lds + L_OV + 0 * TILE_B), qf, o, m, l, tq, 64 * j, W, lanesel, lut, lane);
        } else if (MODE != 1 || __ballot(lanesel) != 0ull) {
            const int tq0w = tq - (lane & 31);
            const int dmin = tq0w - 64 * j - 63, dmax = tq0w + 31 - 64 * j;
            const bool use_lut = (MODE == 0) ? !(dmin >= 113 && dmax < W) : !(dmin >= 113);
            const int r_ = (tid >> 6) & 3;
            const LAS float* lutp = (MODE == 0) ? (const LAS float*)(lds + L_LUT2) + r_ * LUT2_N + (64 * j + 4 * (lane >> 5) - tq + LUT2_K)
                                               : (const LAS float*)(lds + L_LUT3) + r_ * LUT3_N + (64 * j + 4 * (lane >> 5) - tq + LUT3_K);
            attn_tile_fast<MODE>((const LAS char*)(lds + L_K + 0 * TILE_B), (const LAS char*)(lds + L_V + 0 * TILE_B), qf, o, m, l, lanesel, use_lut, lutp, lut[113], lane);
        }
        }
        if (jn < 0) break;
        ATT_ST(krb, vrb, 1);
        if (MODE == 2) gen_ov(jn, 1);
        if (MODE == 1) T0W(6, wsp);
        __syncthreads();
        if (MODE == 1) T1(6, wsp);
        int jn3 = -1;
        if (tiles != 0ull) { jn3 = __builtin_ctzll(tiles); tiles &= tiles - 1ull; }
        ATT_LD(krb, vrb, (jn3 < 0 ? jn : jn3));
        {
        const bool lanesel = (MODE == 1) ? ((selm >> jn) & 1ull) != 0ull : true;
        if constexpr (MODE == 2) {
            attn_tile<MODE, NDB>((const LAS char*)(lds + L_K + 1 * TILE_B), (const LAS char*)(lds + L_V + 1 * TILE_B), (const LAS char*)(lds + L_OV + 1 * TILE_B), qf, o, m, l, tq, 64 * jn, W, lanesel, lut, lane);
        } else if (MODE != 1 || __ballot(lanesel) != 0ull) {
            const int tq0w = tq - (lane & 31);
            const int dmin = tq0w - 64 * jn - 63, dmax = tq0w + 31 - 64 * jn;
            const bool use_lut = (MODE == 0) ? !(dmin >= 113 && dmax < W) : !(dmin >= 113);
            const int r_ = (tid >> 6) & 3;
            const LAS float* lutp = (MODE == 0) ? (const LAS float*)(lds + L_LUT2) + r_ * LUT2_N + (64 * jn + 4 * (lane >> 5) - tq + LUT2_K)
                                               : (const LAS float*)(lds + L_LUT3) + r_ * LUT3_N + (64 * jn + 4 * (lane >> 5) - tq + LUT3_K);
            attn_tile_fast<MODE>((const LAS char*)(lds + L_K + 1 * TILE_B), (const LAS char*)(lds + L_V + 1 * TILE_B), qf, o, m, l, lanesel, use_lut, lutp, lut[113], lane);
        }
        }
        if (jnn < 0) break;
        ATT_ST(kra, vra, 0);
        if (MODE == 2) gen_ov(jnn, 0);
        if (MODE == 1) T0W(6, wsp);
        __syncthreads();
        if (MODE == 1) T1(6, wsp);
        j = jnn; jn = jn3;
    }
#undef ATT_LD
#undef ATT_ST
    __syncthreads();
}

__device__ __forceinline__ unsigned long long tile_range(int lo, int hi) {
    const unsigned long long a = (hi >= 63) ? ~0ull : ((1ull << (hi + 1)) - 1ull);
    return a & ~((1ull << lo) - 1ull);
}

__device__ __forceinline__ void build_lut(LAS unsigned char* lds, const float* relb, int head0, int tid) {
    LAS float* lut = (LAS float*)(lds + L_LUT);
    const int r = tid >> 7, d = tid & 127;
    lut[r * 128 + d] = relb[t5_bucket(d) * 16 + head0 + r] * LOG2E;
}

__device__ __forceinline__ void build_lut23(LAS unsigned char* lds, int W, bool want3, int tid) {
    const LAS float* lut = (const LAS float*)(lds + L_LUT);
    LAS float* l2 = (LAS float*)(lds + L_LUT2); LAS float* l3 = (LAS float*)(lds + L_LUT3);
    for (int i = tid; i < 4 * LUT2_N; i += 512) { const int r = i / LUT2_N, jj = i - r * LUT2_N, d = LUT2_K - jj; l2[i] = (d < 0 || d >= W) ? NEG_INF : lut[r * 128 + (d > 113 ? 113 : d)]; }
    if (want3) for (int i = tid; i < 4 * LUT3_N; i += 512) { const int r = i / LUT3_N, jj = i - r * LUT3_N, d = LUT3_K - jj; l3[i] = (d < 0) ? NEG_INF : lut[r * 128 + (d > 113 ? 113 : d)]; }
}

__device__ __forceinline__ void unit_swa(Frame& F, const Args& A, int b, int g, int qt) {
    LAS unsigned char* lds = F.lds;
    const int lane = F.lane, wave = F.wave, r = wave & 3, th = wave >> 2, r32 = lane & 31, h = lane >> 5;
    const int head = g * 4 + r, tq = qt * 64 + 32 * th + r32;
    build_lut(lds, INP(I_RELB), g * 4, F.tid);
    const bf16_t* qrow = WSP(bf16_t, WS_QA) + ((size_t)(b * SEQ + tq)) * 512 + head * 64;
    bf16x8 qf[4];
#pragma unroll
    for (int ks = 0; ks < 4; ++ks) qf[ks] = *(const bf16x8*)(qrow + 16 * ks + 8 * h);
    f32x16 o[2];
#pragma unroll
    for (int db = 0; db < 2; ++db)
#pragma unroll
        for (int i = 0; i < 16; ++i) o[db][i] = 0.f;
    float m = INP(I_L0_SINKS)[head] * LOG2E, l = 1.f;
    __syncthreads();
    build_lut23(lds, 128, false, F.tid);
    __syncthreads();
    const LAS float* lut = (const LAS float*)(lds + L_LUT) + r * 128;
    const bf16_t* Kg = WSP(bf16_t, WS_KA) + (size_t)b * SEQ * 128 + g * 64; const bf16_t* Vg = WSP(bf16_t, WS_VA) + (size_t)b * SEQ * 128 + g * 64;
    run_branch<0, 2>(lds, Kg, Vg, 128, tile_range(qt - 2 < 0 ? 0 : qt - 2, qt), qf, o, m, l, tq, 128, 0ull, lut, F.tid, lane);
    const float inv = FP8_SMIX0 / l;
    unsigned char* orow = F.ws + WS_MIX0 + ((size_t)(b * SEQ + tq)) * DM + head * 64;
#pragma unroll
    for (int db = 0; db < 2; ++db)
#pragma unroll
        for (int rg = 0; rg < 4; ++rg) *(unsigned*)(orow + 32 * db + 8 * rg + 4 * h) = cvt4_fp8(o[db][4 * rg] * inv, o[db][4 * rg + 1] * inv, o[db][4 * rg + 2] * inv, o[db][4 * rg + 3] * inv);
}

__device__ __forceinline__ void unit_nsa(Frame& F, const Args& A, int b, int g, int qt) {
    LAS unsigned char* lds = F.lds;
    const int lane = F.lane, wave = F.wave, r = wave & 3, th = wave >> 2, r32 = lane & 31, h = lane >> 5;
    const int hb = g * 4 + r, tq = qt * 64 + 32 * th + r32, tok = 32 * th + r32, bg = b * 2 + g;
    build_lut(lds, INP(I_RELB), 8 + g * 4, F.tid);
    const bf16_t* qrow = WSP(bf16_t, WS_QB) + ((size_t)(b * SEQ + tq)) * 512 + hb * 64;
    bf16x8 qf[4];
#pragma unroll
    for (int ks = 0; ks < 4; ++ks) qf[ks] = *(const bf16x8*)(qrow + 16 * ks + 8 * h);
    const float* gp = WSP(float, WS_GATES) + ((size_t)(b * SEQ + tq)) * 24 + hb;
    const float g_cmp = gp[0], g_slc = gp[8], g_win = gp[16];
    f32x16 acc[2];
    __syncthreads();
    build_lut23(lds, 512, true, F.tid);
    __syncthreads();
    const LAS float* lut = (const LAS float*)(lds + L_LUT) + r * 128;
    LAS float* imp = (LAS float*)(lds + L_IMP);
    LAS unsigned long long* selm = (LAS unsigned long long*)(lds + L_SELM);
    T0W(2, F.ws);
    {
        f32x16 o[4];
#pragma unroll
        for (int db = 0; db < 4; ++db)
#pragma unroll
            for (int i = 0; i < 16; ++i) o[db][i] = 0.f;
        float m = -1e30f, l = 0.f;
        const int tmax = qt * 64 + 63;
        unsigned long long tiles = 0ull;
        if (tmax >= 31) { const int nmax = (tmax - 31) >> 4; tiles = tile_range(0, (nmax > 254 ? 254 : nmax) >> 6); }
        const bf16_t* Kc = WSP(bf16_t, WS_KC) + (size_t)bg * 256 * 64; const bf16_t* Vc = WSP(bf16_t, WS_KC) + (size_t)(16 + bg) * 256 * 64;
        run_branch<2, 4>(lds, Kc, Vc, 64, tiles, qf, o, m, l, tq, 0, 0ull, lut, F.tid, lane);
        const float inv = l > 0.f ? 1.f / l : 0.f;
#pragma unroll
        for (int db = 0; db < 2; ++db)
#pragma unroll
            for (int i = 0; i < 16; ++i) acc[db][i] = o[db][i] * (inv * g_cmp);
        if (qt >= 16) {
#pragma unroll
            for (int db = 0; db < 2; ++db)
#pragma unroll
                for (int i = 0; i < 16; ++i) { const int jj = 32 * db + (i & 3) + 8 * (i >> 2) + 4 * h; imp[(r * 64 + jj) * 65 + tok] = o[2 + db][i] * inv; }
        }
    }
    __syncthreads();
    T1(2, F.ws);
    T0W(3, F.ws);
    {
        const unsigned long long adm = tile_range(0, qt);
        if (qt < 16) { if (lane < 8) selm[wave * 8 + lane] = adm; }
        else {
            int jl = lane; asm volatile("" : "+v"(jl));
            const unsigned long long ltm = (1ull << jl) - 1ull;
            const bool forced = (jl == 0) || (jl == qt) || (jl == qt - 1);
            unsigned u[8], sv[8];
#pragma unroll
            for (int i = 0; i < 8; ++i) {
                const int tk = wave * 8 + i;
                const float iv = ((imp[(0 * 64 + jl) * 65 + tk] + imp[(1 * 64 + jl) * 65 + tk]) + imp[(2 * 64 + jl) * 65 + tk]) + imp[(3 * 64 + jl) * 65 + tk];
                const float sc = forced ? 1e30f : (jl <= qt ? iv : -1e30f);
                const unsigned bits = __float_as_uint(sc); u[i] = bits ^ ((bits >> 31) ? 0xffffffffu : 0x80000000u); sv[i] = u[i];
            }
#pragma unroll
            for (int k = 2; k <= 64; k <<= 1)
#pragma unroll
                for (int d = k >> 1; d > 0; d >>= 1) {
                    const bool takemin = (((jl & d) == 0) == ((jl & k) == 0));
#pragma unroll
                    for (int i = 0; i < 8; ++i) { const unsigned pv = (unsigned)__shfl_xor((int)sv[i], d); const unsigned mn = sv[i] < pv ? sv[i] : pv, mxv = sv[i] < pv ? pv : sv[i]; sv[i] = takemin ? mn : mxv; }
                }
#pragma unroll
            for (int i = 0; i < 8; ++i) {
                const unsigned tau = (unsigned)__builtin_amdgcn_readlane((int)sv[i], 48);
                const unsigned long long mgt = __ballot(u[i] > tau), meq = __ballot(u[i] == tau);
                const int need = 16 - __popcll(mgt);
                const bool sel = (u[i] > tau) || ((u[i] == tau) && __popcll(meq & ltm) < need);
                const unsigned long long mk = __ballot(sel) & adm;
                if (jl == 0) selm[wave * 8 + i] = mk;
            }
        }
    }
    __syncthreads();
    T1(3, F.ws);
    const unsigned long long myselm = selm[tok];
    unsigned long long uni = selm[lane];
#pragma unroll
    for (int o_ = 1; o_ < 64; o_ <<= 1) { const unsigned lo = __shfl_xor((unsigned)uni, o_), hi = __shfl_xor((unsigned)(uni >> 32), o_); uni |= ((unsigned long long)hi << 32) | lo; }
    uni = ((unsigned long long)(unsigned)__builtin_amdgcn_readfirstlane((unsigned)(uni >> 32)) << 32) | (unsigned)__builtin_amdgcn_readfirstlane((unsigned)uni);
    T0W(4, F.ws);
    {
        f32x16 o[2];
#pragma unroll
        for (int db = 0; db < 2; ++db)
#pragma unroll
            for (int i = 0; i < 16; ++i) o[db][i] = 0.f;
        float m = 0.f, l = 0.f;
        const bf16_t* Kg = WSP(bf16_t, WS_KSLC) + (size_t)b * SEQ * 128 + g * 64; const bf16_t* Vg = WSP(bf16_t, WS_VSLC) + (size_t)b * SEQ * 128 + g * 64;
        run_branch<1, 2>(lds, Kg, Vg, 128, uni, qf, o, m, l, tq, 0, myselm, lut, F.tid, lane, F.ws);
        const float inv = g_slc / l;
#pragma unroll
        for (int db = 0; db < 2; ++db)
#pragma unroll
            for (int i = 0; i < 16; ++i) acc[db][i] += o[db][i] * inv;
    }
    T1(4, F.ws);
    T0W(5, F.ws);
    {
        f32x16 o[2];
#pragma unroll
        for (int db = 0; db < 2; ++db)
#pragma unroll
            for (int i = 0; i < 16; ++i) o[db][i] = 0.f;
        float m = 0.f, l = 0.f;
        const bf16_t* Kg = WSP(bf16_t, WS_KWIN) + (size_t)b * SEQ * 128 + g * 64; const bf16_t* Vg = WSP(bf16_t, WS_VWIN) + (size_t)b * SEQ * 128 + g * 64;
        run_branch<0, 2>(lds, Kg, Vg, 128, tile_range(qt - 8 < 0 ? 0 : qt - 8, qt), qf, o, m, l, tq, 512, 0ull, lut, F.tid, lane);
        const float inv = g_win / l;
#pragma unroll
        for (int db = 0; db < 2; ++db)
#pragma unroll
            for (int i = 0; i < 16; ++i) acc[db][i] += o[db][i] * inv;
    }
    T1(5, F.ws);
    unsigned char* orow = F.ws + WS_MIX0 + ((size_t)(b * SEQ + tq)) * DM + 512 + hb * 64;
#pragma unroll
    for (int db = 0; db < 2; ++db)
#pragma unroll
        for (int rg = 0; rg < 4; ++rg) *(unsigned*)(orow + 32 * db + 8 * rg + 4 * h) = cvt4_fp8(acc[db][4 * rg] * FP8_SMIX0, acc[db][4 * rg + 1] * FP8_SMIX0, acc[db][4 * rg + 2] * FP8_SMIX0, acc[db][4 * rg + 3] * FP8_SMIX0);
}

#ifndef PROBE_NSA_REP
#define PROBE_NSA_REP 1
#endif
#ifndef PROBE_SWA_REP
#define PROBE_SWA_REP 1
#endif
__device__ __forceinline__ void attn0_phase(Frame& F, const Args& A) {
    const int vcu = (F.G % 8 == 0) ? (F.bid % 8) * (F.G / 8) + F.bid / 8 : F.bid;
    for (int rep = 0; rep < PROBE_NSA_REP; ++rep)
    for (int U = vcu; U < 1024; U += F.G) {
        const int c = U & 255, i = U >> 8, bg = c >> 4, s = c & 15;
        const int qt = (i == 0) ? 63 - s : (i == 1) ? 32 + s : (i == 2) ? 31 - s : s;
        unit_nsa(F, A, bg >> 1, bg & 1, qt);
        __syncthreads();
    }
    for (int rep = 0; rep < PROBE_SWA_REP; ++rep)
    for (int U = vcu; U < 1024; U += F.G) {
        const int c = U & 255, i = U >> 8, bg = c >> 4, s = c & 15;
        unit_swa(F, A, bg >> 1, bg & 1, 16 * i + s);
        __syncthreads();
    }
}
}
namespace dsa {
constexpr int L_SC = 0;
constexpr int L_LIST = LDS_EXTRA_OFF;
constexpr int L_LUTD = L_LIST + 4096;
constexpr int L_WT = L_LUTD + 114 * 16 * 4;
static_assert(L_WT + 256 <= LDS_MISC_OFF, "dsa LDS map");
constexpr int VROW = 160;
constexpr float NEG_INF = -__builtin_huge_valf();
typedef float f32x4_t __attribute__((ext_vector_type(4)));


__device__ __forceinline__ int count_ge8(unsigned a0, unsigned a1, unsigned a2, unsigned a3, unsigned a4, unsigned a5, unsigned a6, unsigned a7, unsigned cand) {
    int c, t; unsigned long long m0, m1, m2, m3, m4, m5, m6, m7;
    asm volatile(
        "v_cmp_ge_u32_e64 %[m0], %[a0], %[cd]\n\tv_cmp_ge_u32_e64 %[m1], %[a1], %[cd]\n\tv_cmp_ge_u32_e64 %[m2], %[a2], %[cd]\n\tv_cmp_ge_u32_e64 %[m3], %[a3], %[cd]\n\t"
        "v_cmp_ge_u32_e64 %[m4], %[a4], %[cd]\n\tv_cmp_ge_u32_e64 %[m5], %[a5], %[cd]\n\tv_cmp_ge_u32_e64 %[m6], %[a6], %[cd]\n\tv_cmp_ge_u32_e64 %[m7], %[a7], %[cd]\n\t"
        "s_bcnt1_i32_b64 %[c], %[m0]\n\ts_bcnt1_i32_b64 %[t], %[m1]\n\ts_add_i32 %[c], %[c], %[t]\n\ts_bcnt1_i32_b64 %[t], %[m2]\n\ts_add_i32 %[c], %[c], %[t]\n\t"
        "s_bcnt1_i32_b64 %[t], %[m3]\n\ts_add_i32 %[c], %[c], %[t]\n\ts_bcnt1_i32_b64 %[t], %[m4]\n\ts_add_i32 %[c], %[c], %[t]\n\ts_bcnt1_i32_b64 %[t], %[m5]\n\ts_add_i32 %[c], %[c], %[t]\n\t"
        "s_bcnt1_i32_b64 %[t], %[m6]\n\ts_add_i32 %[c], %[c], %[t]\n\ts_bcnt1_i32_b64 %[t], %[m7]\n\ts_add_i32 %[c], %[c], %[t]"
        : [c] "=&s"(c), [t] "=&s"(t), [m0] "=&s"(m0), [m1] "=&s"(m1), [m2] "=&s"(m2), [m3] "=&s"(m3), [m4] "=&s"(m4), [m5] "=&s"(m5), [m6] "=&s"(m6), [m7] "=&s"(m7)
        : [a0] "v"(a0), [a1] "v"(a1), [a2] "v"(a2), [a3] "v"(a3), [a4] "v"(a4), [a5] "v"(a5), [a6] "v"(a6), [a7] "v"(a7), [cd] "s"(cand)
        : "scc");
    return c;
}

__device__ __forceinline__ void unit_dsa(Frame& F, const Args& A, int b, int t0) {
    LAS unsigned char* lds = F.lds;
    int lane_ = F.lane; asm volatile("" : "+v"(lane_));
    const int tid = F.tid, lane = lane_, wave = F.wave, r32 = lane & 31, h = lane >> 5;
    const size_t tb = (size_t)b * SEQ;
    LAS float* sc = (LAS float*)(lds + L_SC);
    LAS unsigned short* list = (LAS unsigned short*)(lds + L_LIST) + wave * 256;
    const LAS float* lutd = (const LAS float*)(lds + L_LUTD);
    LAS float* wt = (LAS float*)(lds + L_WT);
    if (tid < 64) wt[tid] = WSP(float, WS_WI)[(tb + t0) * 8 + tid];
    __syncthreads();
#ifndef PROBE_DSA_A
#define PROBE_DSA_A 1
#endif
#ifndef PROBE_DSA_B
#define PROBE_DSA_B 1
#endif
#ifndef PROBE_DSA_C
#define PROBE_DSA_C 1
#endif
    T0W(11, F.ws);
    for (int repa = 0; repa < PROBE_DSA_A; ++repa)
    if (t0 + 8 > 256) {
        const int nkb = ((t0 + 8 + 63) >> 6) << 1;
        const int hh_r = (r32 >> 2) & 1, reg_r = (r32 & 3) | ((r32 >> 3) << 2), qi4 = 2 * hh_r + (reg_r >> 3), hd = reg_r & 7;
        bf16x8 qaf[2][2]; float wv[2][16];
#pragma unroll
        for (int rb = 0; rb < 2; ++rb) {
            const bf16_t* qp = WSP(bf16_t, WS_QI) + (tb + t0 + 4 * rb + qi4) * 256 + hd * 32 + 8 * h;
            qaf[rb][0] = *(const bf16x8*)qp; qaf[rb][1] = *(const bf16x8*)(qp + 16);
#pragma unroll
            for (int rg = 0; rg < 16; ++rg) wv[rb][rg] = wt[(4 * rb + 2 * h + (rg >> 3)) * 8 + (rg & 7)];
        }
        int kb = wave;
        bf16x8 bk0 = {0, 0, 0, 0, 0, 0, 0, 0}, bk1 = {0, 0, 0, 0, 0, 0, 0, 0};
        if (kb < nkb) { const bf16_t* kp = WSP(bf16_t, WS_KI) + (tb + 32 * kb + r32) * 32 + 8 * h; bk0 = *(const bf16x8*)kp; bk1 = *(const bf16x8*)(kp + 16); }
        while (kb < nkb) {
            const int kn = kb + 8; bf16x8 nb0 = bk0, nb1 = bk1;
            if (kn < nkb) { const bf16_t* kp = WSP(bf16_t, WS_KI) + (tb + 32 * kn + r32) * 32 + 8 * h; nb0 = *(const bf16x8*)kp; nb1 = *(const bf16x8*)(kp + 16); }
            const int key = 32 * kb + r32;
#pragma unroll
            for (int rb = 0; rb < 2; ++rb) {
                f32x16 c;
#pragma unroll
                for (int i = 0; i < 16; ++i) c[i] = 0.f;
                c = __builtin_amdgcn_mfma_f32_32x32x16_bf16(qaf[rb][0], bk0, c, 0, 0, 0);
                c = __builtin_amdgcn_mfma_f32_32x32x16_bf16(qaf[rb][1], bk1, c, 0, 0, 0);
                float sA = 0.f, sB = 0.f;
#pragma unroll
                for (int i = 0; i < 8; ++i) { sA += wv[rb][i] * fmaxf(c[i], 0.f); sB += wv[rb][8 + i] * fmaxf(c[8 + i], 0.f); }
                const int qA = 4 * rb + 2 * h;
                sc[qA * 4096 + key] = (key <= t0 + qA) ? sA : NEG_INF;
                sc[(qA + 1) * 4096 + key] = (key <= t0 + qA + 1) ? sB : NEG_INF;
            }
            bk0 = nb0; bk1 = nb1; kb = kn;
        }
    }
    __syncthreads();
    T1(11, F.ws);
    T0W(12, F.ws);
    const int t = t0 + wave, n = t + 1;
    int cnt;
    for (int repb = 0; repb < PROBE_DSA_B; ++repb)
    if (n <= 256) {
#pragma unroll
        for (int i = 0; i < 4; ++i) { const int k = lane + 64 * i; list[k] = (unsigned short)(k < n ? k : 0); }
        cnt = n;
    } else {
        const int nreg = (n + 63) >> 6, ngrp = (nreg + 7) >> 3;
        LAS float* my = sc + wave * 4096;
        float f[64];
#pragma unroll
        for (int g8 = 0; g8 < 8; ++g8) {
#pragma unroll
            for (int k = 0; k < 8; ++k) f[g8 * 8 + k] = NEG_INF;
            if (g8 < ngrp) {
#pragma unroll
                for (int k = 0; k < 8; ++k) if (g8 * 8 + k < nreg) f[g8 * 8 + k] = my[64 * (g8 * 8 + k) + lane];
            }
        }
        float ta = NEG_INF, tb_ = NEG_INF, tc = NEG_INF, td = NEG_INF;
#pragma unroll
        for (int g8 = 0; g8 < 8; ++g8) if (g8 < ngrp) {
#pragma unroll
            for (int k = 0; k < 8; ++k) { const float x = f[g8 * 8 + k]; td = __builtin_amdgcn_fmed3f(tc, td, x); tc = __builtin_amdgcn_fmed3f(tb_, tc, x); tb_ = __builtin_amdgcn_fmed3f(ta, tb_, x); ta = fmaxf(ta, x); }
        }
        float L = td;
#pragma unroll
        for (int o_ = 1; o_ < 64; o_ <<= 1) L = fminf(L, __shfl_xor(L, o_));
        LAS unsigned* cval = (LAS unsigned*)my; LAS unsigned short* ckey = (LAS unsigned short*)(my + 1024);
        const unsigned long long ltmask = (1ull << lane) - 1ull;
        int ns = 0;
#pragma unroll
        for (int g8 = 0; g8 < 8; ++g8) if (g8 < ngrp) {
#pragma unroll
            for (int k = 0; k < 8; ++k) { const int i = g8 * 8 + k; const bool keep = f[i] >= L; const unsigned long long mk = __ballot(keep); const int pos = ns + __popcll(mk & ltmask);
                if (keep && pos < 1024) { const unsigned bits = __float_as_uint(f[i]); cval[pos] = bits ^ ((bits >> 31) ? 0xffffffffu : 0x80000000u); ckey[pos] = (unsigned short)(64 * i + lane); }
                ns += __popcll(mk); }
        }
        if (ns <= 1024) {
            unsigned w[16];
#pragma unroll
            for (int j = 0; j < 16; ++j) w[j] = (64 * j + lane < ns) ? cval[64 * j + lane] : 0u;
            const bool two = ns > 512;
            float Mx = ta;
#pragma unroll
            for (int o_ = 1; o_ < 64; o_ <<= 1) Mx = fmaxf(Mx, __shfl_xor(Mx, o_));
            const unsigned Lb = __float_as_uint(L), Mb = __float_as_uint(Mx);
            const unsigned Lk = __builtin_amdgcn_readfirstlane(Lb ^ ((Lb >> 31) ? 0xffffffffu : 0x80000000u)), Mk = __builtin_amdgcn_readfirstlane(Mb ^ ((Mb >> 31) ? 0xffffffffu : 0x80000000u));
            const int hb = (Lk == Mk) ? -1 : 31 - __builtin_clz(Lk ^ Mk);
            unsigned tau = (hb >= 31) ? 0u : (hb < 0 ? Mk : (Mk & ~((2u << hb) - 1u)));
            for (int bit = hb; bit >= 0; --bit) {
                const unsigned cand = tau | (1u << bit);
                int c = count_ge8(w[0], w[1], w[2], w[3], w[4], w[5], w[6], w[7], cand);
                if (two) c += count_ge8(w[8], w[9], w[10], w[11], w[12], w[13], w[14], w[15], cand);
                if (c >= 256) { tau = cand; if (c == 256) break; }
            }
            int cgt = count_ge8(w[0], w[1], w[2], w[3], w[4], w[5], w[6], w[7], tau + 1u);
            if (two) cgt += count_ge8(w[8], w[9], w[10], w[11], w[12], w[13], w[14], w[15], tau + 1u);
            const int need = 256 - cgt; int base = 0, eqseen = 0;
#pragma unroll
            for (int j = 0; j < 16; ++j) if (64 * j < ns) {
                const bool gt = w[j] > tau, eq = w[j] == tau;
                const unsigned long long meq = __ballot(eq);
                const bool sel = gt || (eq && (eqseen + __popcll(meq & ltmask)) < need);
                const unsigned long long msel = __ballot(sel);
                if (sel) list[base + __popcll(msel & ltmask)] = ckey[64 * j + lane];
                base += __popcll(msel); eqseen += __popcll(meq);
            }
        } else {
#pragma unroll
            for (int i = 0; i < 64; ++i) { const unsigned bits = __float_as_uint(f[i]); f[i] = __uint_as_float((i < nreg) ? (bits ^ ((bits >> 31) ? 0xffffffffu : 0x80000000u)) : 0u); }
#define u_(i) __float_as_uint(f[i])
            unsigned tau = 0u;
            for (int bit = 31; bit >= 0; --bit) {
                const unsigned cand = tau | (1u << bit); int c = 0;
#pragma unroll
                for (int g8 = 0; g8 < 8; ++g8) if (g8 < ngrp)
                    c += count_ge8(u_(g8 * 8 + 0), u_(g8 * 8 + 1), u_(g8 * 8 + 2), u_(g8 * 8 + 3), u_(g8 * 8 + 4), u_(g8 * 8 + 5), u_(g8 * 8 + 6), u_(g8 * 8 + 7), cand);
                if (c >= 256) { tau = cand; if (c == 256) break; }
            }
            int cgt = 0;
#pragma unroll
            for (int g8 = 0; g8 < 8; ++g8) if (g8 < ngrp)
                cgt += count_ge8(u_(g8 * 8 + 0), u_(g8 * 8 + 1), u_(g8 * 8 + 2), u_(g8 * 8 + 3), u_(g8 * 8 + 4), u_(g8 * 8 + 5), u_(g8 * 8 + 6), u_(g8 * 8 + 7), tau + 1u);
            const int need = 256 - cgt; int base = 0, eqseen = 0;
#pragma unroll
            for (int g8 = 0; g8 < 8; ++g8) if (g8 < ngrp) {
#pragma unroll
                for (int k = 0; k < 8; ++k) { const int i = g8 * 8 + k;
                    const bool gt = u_(i) > tau, eq = u_(i) == tau;
                    const unsigned long long meq = __ballot(eq);
                    const bool sel = gt || (eq && (eqseen + __popcll(meq & ltmask)) < need);
                    const unsigned long long msel = __ballot(sel);
                    if (sel) list[base + __popcll(msel & ltmask)] = (unsigned short)(64 * i + lane);
                    base += __popcll(msel); eqseen += __popcll(meq); } }
        }
#undef u_
        cnt = 256;
    }
    T1(12, F.ws);
    T0W(14, F.ws);
    asm volatile("s_waitcnt lgkmcnt(0)" ::: "memory");
    T1(14, F.ws);
    T0W(13, F.ws);
    for (int repc = 0; repc < PROBE_DSA_C; ++repc)
    {
        const int head = lane & 15, g4 = lane >> 4, q4 = (lane & 15) >> 2, p4 = lane & 3;
        const bf16_t* qp = WSP(bf16_t, WS_Q1) + (tb + t) * 1024 + head * 64 + 8 * g4;
        const bf16x8 qf0 = *(const bf16x8*)qp, qf1 = *(const bf16x8*)(qp + 32);
        const bf16_t* K1 = WSP(bf16_t, WS_K1) + tb * 64; const bf16_t* V1 = WSP(bf16_t, WS_V1) + tb * 64;
        f32x4_t sA[8], sB[8];
        float mx = NEG_INF;
        const float cfar = lutd[113 * 16 + head];
        LAS unsigned char* kst = lds + wave * 16384;
        {
            u32x4 kr[8][4];
#pragma unroll
            for (int c = 0; c < 8; ++c) {
#pragma unroll
                for (int i = 0; i < 4; ++i) { const unsigned key = list[32 * c + 8 * i + (lane >> 3)]; kr[c][i] = *(const u32x4*)((const char*)K1 + (key * 128u + (unsigned)(lane & 7) * 16u)); }
            }
#pragma unroll
            for (int c = 0; c < 8; ++c) {
#pragma unroll
                for (int i = 0; i < 4; ++i) *(LAS u32x4*)(kst + (8 * i + (lane >> 3)) * VROW + (lane & 7) * 16) = kr[c][i];
                const LAS unsigned char* ka = kst + (lane & 15) * VROW + 16 * g4;
                const bf16x8 kA0 = *(const LAS bf16x8*)ka, kA1 = *(const LAS bf16x8*)(ka + 64), kB0 = *(const LAS bf16x8*)(ka + 16 * VROW), kB1 = *(const LAS bf16x8*)(ka + 16 * VROW + 64);
                const int kmax = __builtin_amdgcn_readfirstlane((int)list[32 * c + 31]);
                if (cnt == 256 && t - kmax >= 113) {
                    f32x4_t a = {cfar, cfar, cfar, cfar}, bb = {cfar, cfar, cfar, cfar};
                    a = __builtin_amdgcn_mfma_f32_16x16x32_bf16(kA0, qf0, a, 0, 0, 0); a = __builtin_amdgcn_mfma_f32_16x16x32_bf16(kA1, qf1, a, 0, 0, 0);
                    bb = __builtin_amdgcn_mfma_f32_16x16x32_bf16(kB0, qf0, bb, 0, 0, 0); bb = __builtin_amdgcn_mfma_f32_16x16x32_bf16(kB1, qf1, bb, 0, 0, 0);
                    sA[c] = a; sB[c] = bb;
                    mx = fmaxf(mx, fmaxf(fmaxf(fmaxf(a[0], a[1]), fmaxf(a[2], a[3])), fmaxf(fmaxf(bb[0], bb[1]), fmaxf(bb[2], bb[3]))));
                } else {
                    f32x4_t a = {0.f, 0.f, 0.f, 0.f}, bb = {0.f, 0.f, 0.f, 0.f};
                    a = __builtin_amdgcn_mfma_f32_16x16x32_bf16(kA0, qf0, a, 0, 0, 0); a = __builtin_amdgcn_mfma_f32_16x16x32_bf16(kA1, qf1, a, 0, 0, 0);
                    bb = __builtin_amdgcn_mfma_f32_16x16x32_bf16(kB0, qf0, bb, 0, 0, 0); bb = __builtin_amdgcn_mfma_f32_16x16x32_bf16(kB1, qf1, bb, 0, 0, 0);
                    const u32x2 ia = *(const LAS u32x2*)(list + 32 * c + 4 * g4), ib = *(const LAS u32x2*)(list + 32 * c + 16 + 4 * g4);
#pragma unroll
                    for (int i = 0; i < 4; ++i) {
                        const int keyA = (int)(((i < 2 ? ia.x : ia.y) >> (16 * (i & 1))) & 0xffffu), keyB = (int)(((i < 2 ? ib.x : ib.y) >> (16 * (i & 1))) & 0xffffu);
                        const int dA = t - keyA, dB = t - keyB;
                        const float bA = lutd[(dA > 113 ? 113 : (dA < 0 ? 0 : dA)) * 16 + head], bB = lutd[(dB > 113 ? 113 : (dB < 0 ? 0 : dB)) * 16 + head];
                        const int slotA = 32 * c + 4 * g4 + i, slotB = slotA + 16;
                        sA[c][i] = slotA < cnt ? a[i] + bA : NEG_INF; sB[c][i] = slotB < cnt ? bb[i] + bB : NEG_INF;
                        mx = fmaxf(mx, fmaxf(sA[c][i], sB[c][i]));
                    }
                }
            }
        }
        asm volatile("" ::: "memory");
        u32x4 vr[4][4];
#pragma unroll
        for (int c = 0; c < 4; ++c) {
#pragma unroll
            for (int i = 0; i < 4; ++i) { const unsigned key = list[32 * c + 8 * i + (lane >> 3)]; vr[c][i] = *(const u32x4*)((const char*)V1 + (key * 128u + (unsigned)(lane & 7) * 16u)); }
        }
        mx = fmaxf(mx, __shfl_xor(mx, 16)); mx = fmaxf(mx, __shfl_xor(mx, 32));
        float l = 0.f;
#pragma unroll
        for (int c = 0; c < 8; ++c)
#pragma unroll
            for (int i = 0; i < 4; ++i) { sA[c][i] = __builtin_amdgcn_exp2f(sA[c][i] - mx); sB[c][i] = __builtin_amdgcn_exp2f(sB[c][i] - mx); l += sA[c][i] + sB[c][i]; }
        l += __shfl_xor(l, 16); l += __shfl_xor(l, 32);
        f32x4_t o[4];
#pragma unroll
        for (int d = 0; d < 4; ++d) o[d] = (f32x4_t){0.f, 0.f, 0.f, 0.f};
#pragma unroll
        for (int c = 0; c < 8; ++c) {
            {
                LAS unsigned char* vst = kst + (32 + 32 * (c & 1)) * VROW;
#pragma unroll
                for (int i = 0; i < 4; ++i) *(LAS u32x4*)(vst + (8 * i + (lane >> 3)) * VROW + (lane & 7) * 16) = vr[c & 3][i];
                if (c + 4 < 8) {
#pragma unroll
                    for (int i = 0; i < 4; ++i) { const unsigned key = list[32 * (c + 4) + 8 * i + (lane >> 3)]; vr[c & 3][i] = *(const u32x4*)((const char*)V1 + (key * 128u + (unsigned)(lane & 7) * 16u)); }
                }
                u32x4 pw; pw.x = cvt_pk_bf16(sA[c][0], sA[c][1]); pw.y = cvt_pk_bf16(sA[c][2], sA[c][3]); pw.z = cvt_pk_bf16(sB[c][0], sB[c][1]); pw.w = cvt_pk_bf16(sB[c][2], sB[c][3]);
                const bf16x8 pb = __builtin_bit_cast(bf16x8, pw);
#pragma unroll
                for (int d = 0; d < 4; ++d) {
                    const LAS char* base = (const LAS char*)(vst + (4 * g4 + q4) * VROW + (16 * d + 4 * p4) * 2);
                    const s16x4 lo = att::vtr(base), hi = att::vtr(base + 16 * VROW);
                    const bf16x8 vf = {lo[0], lo[1], lo[2], lo[3], hi[0], hi[1], hi[2], hi[3]};
                    o[d] = __builtin_amdgcn_mfma_f32_16x16x32_bf16(vf, pb, o[d], 0, 0, 0);
                }
            }
        }
        const float inv = FP8_SMIX / l;
        unsigned char* orow = F.ws + WS_MIX1 + (tb + t) * 1024 + head * 64 + 4 * g4;
#pragma unroll
        for (int d = 0; d < 4; ++d) *(unsigned*)(orow + 16 * d) = cvt4_fp8(o[d][0] * inv, o[d][1] * inv, o[d][2] * inv, o[d][3] * inv);
    }
    T1(13, F.ws);
    T0W(15, F.ws);
    __syncthreads();
    T1(15, F.ws);
}

__device__ __forceinline__ void dsa_phase(Frame& F, const Args& A) {
    LAS float* lutd = (LAS float*)(F.lds + L_LUTD);
    { const float* rb = INP(I_RELB); float lv[4];
#pragma unroll
      for (int k = 0; k < 4; ++k) { const int i = F.tid + 512 * k; lv[k] = (i < 114 * 16) ? rb[t5_bucket(i >> 4) * 16 + (i & 15)] : 0.f; }
#pragma unroll
      for (int k = 0; k < 4; ++k) { const int i = F.tid + 512 * k; if (i < 114 * 16) lutd[i] = lv[k] * LOG2E; } }
    __syncthreads();
#ifndef PROBE_DSA_REP
#define PROBE_DSA_REP 1
#endif
    const bool xa = (F.G == 256);
    const int nround = xa ? 16 : (4096 + F.G - 1) / F.G;
    for (int ii = 0; ii < nround * PROBE_DSA_REP; ++ii) {
        const int i = ii % nround; int b, tb; bool ok = true;
        if (xa) { const int r = F.bid >> 3; b = F.bid & 7; tb = 511 - (i * 32 + ((i & 1) ? 31 - r : r)); }
        else { const int cc = (i & 1) ? (F.G - 1 - F.bid) : F.bid; const int I = i * F.G + cc; ok = I < 4096; b = I & 7; tb = 511 - (I >> 3); }
        if (ok) unit_dsa(F, A, b, 8 * tb);
    }
}
}
constexpr int NPHASE = 19;
__global__ void __launch_bounds__(512, 2) mk_fwd(Args args) {
    extern __shared__ __attribute__((aligned(16))) unsigned char lds_raw[];
    Frame F;
    F.lds = (LAS unsigned char*)lds_raw;
    F.tid = threadIdx.x; F.lane = F.tid & 63; F.wave = __builtin_amdgcn_readfirstlane(F.tid >> 6);
    F.G = gridDim.x; F.bid = blockIdx.x; F.ws = args.ws; F.out = args.out;
    volatile LAS unsigned* MISC = (volatile LAS unsigned*)(F.lds + LDS_MISC_OFF);
    if (F.tid < 64) MISC[F.tid] = 0u;
    __syncthreads();
    if (F.tid < 28) *(LAS unsigned long long*)(F.lds + LDS_PTR_OFF + 8 * F.tid) = (unsigned long long)args.in[F.tid];
    __syncthreads();
    const int lo = args.ph_lo, hi = args.ph_hi;
    const bool use_bar = (hi - lo) > 1;
    XcdBarrier bar; bar.bar = (unsigned*)(F.ws + WS_CTL) + CW_BAR; bar.x = 0; bar.st = nullptr;
    if (use_bar) bar = xcd_barrier_post((unsigned*)(F.ws + WS_CTL) + CW_BAR, MISC);
#ifdef PH_ONLY
#define IN(k) ((k) == PH_ONLY && lo <= (k) && (k) < hi)
#else
#define IN(k) (lo <= (k) && (k) < hi)
#endif
#ifndef PROBE_PH
#define PROBE_PH -1
#endif
#define REP(k) for (int rep_ = 0; rep_ < ((k) == PROBE_PH ? 2 : 1); ++rep_)
#ifdef PSPAN_LO
#define SPAN_BEGIN(k) do { if ((k) == PSPAN_LO && blockIdx.x == 0 && threadIdx.x == 0) TPROBE_ACC(F.ws)[1] = __builtin_amdgcn_s_memrealtime(); } while (0)
#define SPAN_END(k) do { if ((k) == PSPAN_HI && blockIdx.x == 0 && threadIdx.x == 0) TPROBE_ACC(F.ws)[0] += __builtin_amdgcn_s_memrealtime() - TPROBE_ACC(F.ws)[1]; } while (0)
#else
#define SPAN_BEGIN(k) do { } while (0)
#define SPAN_END(k) do { } while (0)
#endif
#ifdef PROBE_IDLE_PH
#define SEAM(k) do { unsigned long long t0_ = 0; if ((k) == PROBE_IDLE_PH && threadIdx.x == 0) t0_ = __builtin_amdgcn_s_memrealtime(); if (IN(k) && IN((k) + 1)) xcd_barrier(bar); \
        if ((k) == PROBE_IDLE_PH && threadIdx.x == 0) atomicAdd(TPROBE_ACC(F.ws), (__builtin_amdgcn_s_memrealtime() - t0_) / (unsigned long long)gridDim.x); } while (0)
#else
#define SEAM(k) do { if (IN(k) && IN((k) + 1)) xcd_barrier(bar); SPAN_END(k); SPAN_BEGIN((k) + 1); } while (0)
#endif
    LAS unsigned char* ring = F.lds;
    const Args& A = args;

    SPAN_BEGIN(0);
    if (IN(0)) REP(0) { p0_prologue(F, A); } SEAM(0);
    if (IN(1)) REP(1) {
        pg8::Gemm g{WSP(bf16_t, WS_XB), WSP(bf16_t, WS_WIN0), DM}; pg8::Proj0OrderA S{F.G, F.bid};
        pg8::EpiProj0 E{F.ws};
        pg8::gemm_phase<pg8::EpiProj0, pg8::Proj0OrderA, true, true>(ring, g, S, E);
    } SEAM(1);
    if (IN(2)) REP(2) {
        pg8::Gemm g{WSP(bf16_t, WS_XB), WSP(bf16_t, WS_WIN0), DM}; pg8::Proj0OrderB S; S.so.init(T / 256, 7, F.G, F.bid); S.G = F.G; S.c = F.bid;
        pg8::EpiProj0 E{F.ws};
        pg8::gemm_phase<pg8::EpiProj0, pg8::Proj0OrderB, true, true>(ring, g, S, E);
    } SEAM(2);
    if (IN(3)) REP(3) { p2b_compress_tail(F, A); } SEAM(3);
    if (IN(4)) REP(4) { T0W(1, F.ws); att::attn0_phase(F, A); T1(1, F.ws); } SEAM(4);
    if (IN(5)) REP(5) {
        pg8::Gemm g{WSP(bf16_t, WS_MIX0), WSP(bf16_t, WS_WOUT0), DM / 2}; pg8::StaticOrder S; S.init(T / 256, DM / 256, F.G, F.bid);
        pg8::EpiRes E{INP(I_X), nullptr, (bf16_t*)F.out, 1.f / (FP8_SMIX0 * FP8_SWOUT)};
        pg8::gemm_phase<pg8::EpiRes, pg8::StaticOrder, true, true, false, false, true>(ring, g, S, E);
    } SEAM(5);
    if (IN(6)) REP(6) { T0W(33, F.ws); p_layernorm(F, (const bf16_t*)F.out, INP(I_L0_LN1G), INP(I_L0_LN1B), WSP(bf16_t, WS_X1B), F.ws + WS_X1F8); T1(33, F.ws); } SEAM(6);
    if (IN(7)) REP(7) {
        pg8::Gemm g{(const bf16_t*)(F.ws + WS_X1F8), WSP(bf16_t, WS_WGU0), DM / 2}; pg8::StaticOrder S; S.init(T / 256, 2 * DFF / 256, F.G, F.bid);
        pg8::EpiSwiglu8 E{F.ws + WS_H0, 0, 1.f / (FP8_SX * FP8_SWGU)};
        T0W(50, F.ws); pg8::gemm_phase<pg8::EpiSwiglu8, pg8::StaticOrder, true, true, false, false, true>(ring, g, S, E); T1(50, F.ws);
    } SEAM(7);
    if (IN(8)) REP(8) {
        pg8::Gemm g{WSP(bf16_t, WS_H0), WSP(bf16_t, WS_WDN0), DFF / 2}; pg8::StaticOrder S; S.init(T / 256, DM / 256, F.G, F.bid);
        pg8::EpiRes E{nullptr, WSP(bf16_t, WS_X1B), (bf16_t*)F.out, 1.f / (FP8_SH * FP8_SWDN)};
        pg8::gemm_phase<pg8::EpiRes, pg8::StaticOrder, true, true, false, false, true>(ring, g, S, E);
    } SEAM(8);
    if (IN(9)) REP(9) { p_layernorm(F, (const bf16_t*)F.out, INP(I_L0_LN2G), INP(I_L0_LN2B), WSP(bf16_t, WS_X2B), nullptr); } SEAM(9);
    if (IN(10)) REP(10) {
        pg8::Gemm g{WSP(bf16_t, WS_X2B), WSP(bf16_t, WS_WIN1), DM}; pg8::StaticOrder S; S.init(T / 256, N_IN1P / 256, F.G, F.bid);
        pg8::EpiProj1 E{F.ws};
        pg8::gemm_phase<pg8::EpiProj1, pg8::StaticOrder, true, true>(ring, g, S, E);
    } SEAM(10);
    if (IN(11)) REP(11) { T0W(10, F.ws); dsa::dsa_phase(F, A); T1(10, F.ws); } SEAM(11);
    if (IN(12)) REP(12) {
        pg8::Gemm g{WSP(bf16_t, WS_MIX1), WSP(bf16_t, WS_WOUT1), DM / 2}; pg8::StaticOrder S; S.init(T / 256, DM / 256, F.G, F.bid);
        pg8::EpiRes E{nullptr, WSP(bf16_t, WS_X2B), WSP(bf16_t, WS_Y3), 1.f / (FP8_SMIX * FP8_SWOUT)};
        pg8::gemm_phase<pg8::EpiRes, pg8::StaticOrder, true, true, false, false, true>(ring, g, S, E);
    } SEAM(12);
    if (IN(13)) REP(13) { T0W(30, F.ws); p12_ln_router(F, A); T1(30, F.ws); } SEAM(13);
    if (IN(14)) REP(14) { T0W(31, F.ws); p13_moe_dispatch(F, A); T1(31, F.ws); } SEAM(14);
    if (IN(15)) REP(15) { LAS int* tile_e = (LAS int*)(F.lds + LDS_EXTRA_OFF); const int NT = moe_tile_table(F, tile_e);
        if (NT > 0) { pg8::Gemm g{(const bf16_t*)(F.ws + WS_X3F8), (const bf16_t*)(F.ws + WS_WGU1), DM / 2}; pg8::MoeOrder S; S.gpitch = DM / 2;
            S.so.init(NT, 2 * DFF / 256, F.G, F.bid); S.tile0 = 0; S.nN = 2 * DFF / 256; S.a_local = 0; S.tile_e = tile_e; S.rowlist = WSP(int, WS_ROWTOK);
            pg8::EpiSwiglu8 E{F.ws + WS_H1, 0, 1.f / (FP8_SX * FP8_SWGU)}; T0W(65, F.ws); pg8::gemm_phase<pg8::EpiSwiglu8, pg8::MoeOrder, true, true, true, false, true>(ring, g, S, E); T1(65, F.ws); } } SEAM(15);
    if (IN(16)) REP(16) { LAS int* tile_e = (LAS int*)(F.lds + LDS_EXTRA_OFF); const int NT = moe_tile_table(F, tile_e); const int nM_ = NT > 256 ? 256 : NT, ntail = NT - nM_;
        constexpr float SO = 1.f / (FP8_SH * FP8_SWDN);
        if (nM_ > 0) { pg8::Gemm g{(const bf16_t*)(F.ws + WS_H1), (const bf16_t*)(F.ws + WS_WDN1), DFF / 2}; pg8::MoeOrder S; S.so.init(nM_, DM / 256, F.G, F.bid); S.tile0 = 0; S.nN = DM / 256; S.a_local = 1; S.tile_e = tile_e; S.rowlist = nullptr; S.gpitch = 0;
            pg8::EpiBf16 E{WSP(bf16_t, WS_XG), SO}; T0W(66, F.ws); pg8::gemm_phase<pg8::EpiBf16, pg8::MoeOrder, true, true, false, false, true>(ring, g, S, E); T1(66, F.ws); }
        if (ntail > 0) { pg8::Gemm g{(const bf16_t*)(F.ws + WS_H1), (const bf16_t*)(F.ws + WS_WDN1), DFF / 2}; pg8::TailOrder S{F.G, F.bid, ntail, 256, 0, tile_e, nullptr, 0};
            pg8::EpiPart E{WSP(float, WS_PART), SO}; T0W(69, F.ws); pg8::gemm_phase<pg8::EpiPart, pg8::TailOrder, true, true, false, true, true>(ring, g, S, E); T1(69, F.ws); } } SEAM(16);
    if (IN(17)) REP(17) { T0W(32, F.ws); p_final(F, A); T1(32, F.ws); }
#undef IN
#undef SEAM
}

extern "C" void kernel_launch(void* const* d_in, const int* in_sizes, int n_in, void* d_out, int out_size, void* d_ws, size_t ws_size, hipStream_t stream) {
    static int grid = 0;
    if (grid == 0) {
        if (n_in != 28 || in_sizes[0] != T * DM || out_size != T * DM || ws_size < WS_END) {
            fprintf(stderr, "kernel_launch: unexpected problem (n_in %d, in0 %d, out %d, ws %zu); nothing launched\n", n_in, n_in > 0 ? in_sizes[0] : -1, out_size, ws_size); grid = -1; return; }
        int dev = 0, cus = 0, per_cu = 0;
        if (hipGetDevice(&dev) != hipSuccess || hipDeviceGetAttribute(&cus, hipDeviceAttributeMultiprocessorCount, dev) != hipSuccess) { grid = -1; return; }
        if (hipFuncSetAttribute((const void*)mk_fwd, hipFuncAttributeMaxDynamicSharedMemorySize, LDS_BYTES) != hipSuccess) { fprintf(stderr, "kernel_launch: hipFuncSetAttribute failed\n"); grid = -1; return; }
        if (hipOccupancyMaxActiveBlocksPerMultiprocessor(&per_cu, (const void*)mk_fwd, 512, LDS_BYTES) != hipSuccess || per_cu < 1) { fprintf(stderr, "kernel_launch: occupancy query says %d blocks per CU\n", per_cu); }
        (void)hipGetLastError();
        grid = cus;
    }
    if (grid < 0) return;
    (void)hipMemsetAsync((char*)d_ws + WS_CTL, 0, CTL_ZERO_BYTES, stream);
    Args a{};
    for (int i = 0; i < 28; ++i) a.in[i] = (const float*)d_in[i];
    a.out = (float*)d_out; a.ws = (unsigned char*)d_ws;
    constexpr int NPH = 18;
#if MK_N_LAUNCHES == 1
    a.ph_lo = 0; a.ph_hi = NPH;
    hipLaunchKernelGGL(mk_fwd, dim3(grid), dim3(512), LDS_BYTES, stream, a);
#else
    for (int p = 0; p < NPH; ++p) { a.ph_lo = p; a.ph_hi = p + 1; hipLaunchKernelGGL(mk_fwd, dim3(grid), dim3(512), LDS_BYTES, stream, a); }
#endif
}
```
